# Optimizing an MI355X kernel written in HIP

```python
import math
import jax, jax.numpy as jnp
from jax import lax
import numpy as np

D_MODEL = 4096
BATCH = 2
SEQ = 8192
DEPTH = 2

N_MIXERS = 2
NORM_EPS = 1e-6
MLA_HEADS = 32
Q_LORA = 1024
KV_LORA = 512
NOPE_DIM = 128
ROPE_DIM = 64
V_DIM = 128
QK_DIM = NOPE_DIM + ROPE_DIM
ROPE_THETA = 10000.0
Q_BLOCK = 128
MLA_WIDTH = MLA_HEADS * V_DIM
MLA_IN = Q_LORA + KV_LORA + ROPE_DIM + MLA_WIDTH
HG_EXPAND = 128
HG_HEADS = D_MODEL // HG_EXPAND
HG_K = HG_EXPAND
HG_V = HG_EXPAND
HG_WIDTH = HG_HEADS * HG_V
HG_IN = 2 * HG_HEADS * HG_K + 2 * HG_WIDTH
CHUNK = 64

kernel_name = "mla_hgrn2_interleaved_gated_trunk"


def rmsnorm(x, w):
    xf = x.astype(jnp.float32)
    y = xf * lax.rsqrt(jnp.mean(xf * xf, axis=-1, keepdims=True) + NORM_EPS)
    return (y * w.astype(jnp.float32)).astype(x.dtype)


def rope(t, positions):
    d = t.shape[-1]
    inv_freq = 1.0 / (ROPE_THETA ** (jnp.arange(0, d, 2, dtype=jnp.float32) / d))
    ang = positions.astype(jnp.float32)[..., None] * inv_freq
    cos = jnp.cos(ang)[:, :, None, :]
    sin = jnp.sin(ang)[:, :, None, :]
    tf = t.astype(jnp.float32)
    t1, t2 = tf[..., : d // 2], tf[..., d // 2:]
    out = jnp.concatenate([t1 * cos - t2 * sin, t2 * cos + t1 * sin], axis=-1)
    return out.astype(t.dtype)


def causal_block_attention(q, k, v, scale):
    B, S, H, D = q.shape
    nb = S // Q_BLOCK
    qb = q.reshape(B, nb, Q_BLOCK, H, D).transpose(1, 0, 2, 3, 4)
    kpos = jnp.arange(S)
    neg = jnp.finfo(jnp.float32).min

    def one_block(args):
        qi, blk = args
        s = jnp.einsum('bqhd,bkhd->bhqk', qi, k).astype(jnp.float32) * scale
        qpos = blk * Q_BLOCK + jnp.arange(Q_BLOCK)
        mask = kpos[None, :] <= qpos[:, None]
        s = jnp.where(mask[None, None], s, neg)
        p = jax.nn.softmax(s, axis=-1).astype(v.dtype)
        return jnp.einsum('bhqk,bkhd->bqhd', p, v)

    out = lax.map(one_block, (qb, jnp.arange(nb)))
    return out.transpose(1, 0, 2, 3, 4).reshape(B, S, H, v.shape[-1])


def mla_mixer(h, positions, w_in, q_norm, w_uq, kv_norm, w_ukv, w_o):
    B, S, _ = h.shape
    proj = h @ w_in
    c_q, c_kv, k_rot, z = jnp.split(
        proj, [Q_LORA, Q_LORA + KV_LORA, Q_LORA + KV_LORA + ROPE_DIM], axis=-1)
    q = (rmsnorm(c_q, q_norm) @ w_uq).reshape(B, S, MLA_HEADS, QK_DIM)
    q_nope, q_rot = q[..., :NOPE_DIM], rope(q[..., NOPE_DIM:], positions)
    k_rot = rope(k_rot[:, :, None, :], positions)
    kv = (rmsnorm(c_kv, kv_norm) @ w_ukv).reshape(B, S, MLA_HEADS, NOPE_DIM + V_DIM)
    k_nope, v = kv[..., :NOPE_DIM], kv[..., NOPE_DIM:]
    q_full = jnp.concatenate([q_nope, q_rot], axis=-1)
    k_full = jnp.concatenate(
        [k_nope, jnp.broadcast_to(k_rot, (B, S, MLA_HEADS, ROPE_DIM))], axis=-1)
    o = causal_block_attention(q_full, k_full, v, 1.0 / math.sqrt(QK_DIM))
    o = o.reshape(B, S, MLA_WIDTH) * jax.nn.silu(z)
    return o @ w_o


def hgrn2_chunk_recurrence(q, k, v, log_f):
    B, S, H, K = q.shape
    V = v.shape[-1]
    nc = S // CHUNK

    def to_chunks(t):
        return t.astype(jnp.float32).reshape(B, nc, CHUNK, H, t.shape[-1]).transpose(1, 0, 3, 2, 4)

    qc, kc, vc, gc = to_chunks(q), to_chunks(k), to_chunks(v), to_chunks(log_f)
    causal = jnp.tril(jnp.ones((CHUNK, CHUNK), dtype=bool))

    def step(state, xs):
        qi, ki, vi, gi = xs
        b = jnp.cumsum(gi, axis=-2)
        b_ref = b[..., CHUNK // 2:CHUNK // 2 + 1, :]
        b_end = b[..., -1:, :]
        att = jnp.einsum('bhck,bhsk->bhcs', qi * jnp.exp(b - b_ref), ki * jnp.exp(b_ref - b))
        att = jnp.where(causal, att, 0.0)
        o = (jnp.einsum('bhcs,bhsv->bhcv', att, vi)
             + jnp.einsum('bhck,bhkv->bhcv', qi * jnp.exp(b), state))
        new_state = (state * jnp.exp(b_end)[..., 0, :, None]
                     + jnp.einsum('bhsk,bhsv->bhkv', ki * jnp.exp(b_end - b), vi))
        return new_state, o

    init = jnp.zeros((B, H, K, V), dtype=jnp.float32)
    _, o = lax.scan(step, init, (qc, kc, vc, gc))
    return o.transpose(1, 0, 3, 2, 4).reshape(B, S, H, V).astype(v.dtype)


def hgrn2_mixer(h, lower_bound, w_in, g_norm, w_o):
    B, S, _ = h.shape
    fd = HG_HEADS * HG_K
    proj = h @ w_in
    q, f, i, z = jnp.split(proj, [fd, 2 * fd, 2 * fd + HG_WIDTH], axis=-1)
    q = jax.nn.silu(q)
    lb = lower_bound.astype(jnp.float32)
    forget = lb + (1.0 - lb) * jax.nn.sigmoid(f.astype(jnp.float32))
    k = (1.0 - forget).astype(h.dtype)
    log_f = jnp.log(forget)
    rs = lambda t: t.reshape(B, S, HG_HEADS, t.shape[-1] // HG_HEADS)
    o = hgrn2_chunk_recurrence(rs(q), rs(k), rs(i), rs(log_f))
    o = rmsnorm(o, g_norm).reshape(B, S, HG_WIDTH) * jax.nn.silu(z)
    return o @ w_o


def setup_inputs(seed: int = 0) -> dict:
    key = jax.random.key(seed)
    ks = jax.random.split(key, 20)
    nrm = lambda k, shape, fan_in: jax.random.normal(k, shape, jnp.float32) * (fan_in ** -0.5)
    gain = lambda k, n: 1.0 + 0.02 * jax.random.normal(k, (n,), jnp.float32)
    x = jax.random.normal(ks[0], (BATCH, SEQ, D_MODEL), jnp.float32)
    offsets = jax.random.randint(ks[1], (BATCH, 1), 0, 1024, dtype=jnp.int32)
    positions = (offsets + jnp.arange(SEQ, dtype=jnp.int32)[None, :]).astype(jnp.int32)
    return {
        "x": x,
        "positions": positions,
        "l0_norm": gain(ks[2], D_MODEL),
        "l0_w_in": nrm(ks[3], (D_MODEL, MLA_IN), D_MODEL),
        "l0_q_norm": gain(ks[4], Q_LORA),
        "l0_w_uq": nrm(ks[5], (Q_LORA, MLA_HEADS * QK_DIM), Q_LORA),
        "l0_kv_norm": gain(ks[6], KV_LORA),
        "l0_w_ukv": nrm(ks[7], (KV_LORA, MLA_HEADS * (NOPE_DIM + V_DIM)), KV_LORA),
        "l0_w_o": nrm(ks[8], (MLA_WIDTH, D_MODEL), MLA_WIDTH),
        "l1_norm": gain(ks[9], D_MODEL),
        "l1_w_in": nrm(ks[10], (D_MODEL, HG_IN), D_MODEL),
        "l1_g_norm": gain(ks[11], HG_V),
        "l1_w_o": nrm(ks[12], (HG_WIDTH, D_MODEL), HG_WIDTH),
        "lower_bounds": 0.1 * jax.random.normal(ks[13], (DEPTH, HG_HEADS * HG_K), jnp.float32),
        "final_norm": gain(ks[14], D_MODEL),
    }


def reference(x, positions, l0_norm, l0_w_in, l0_q_norm, l0_w_uq, l0_kv_norm, l0_w_ukv, l0_w_o,
              l1_norm, l1_w_in, l1_g_norm, l1_w_o, lower_bounds, final_norm):
    lb_soft = jax.nn.softmax(lower_bounds.astype(jnp.float32), axis=0)
    lb_all = jnp.cumsum(lb_soft, axis=0) - lb_soft[0]
    layers = [
        (l0_norm, (l0_w_in, l0_q_norm, l0_w_uq, l0_kv_norm, l0_w_ukv, l0_w_o)),
        (l1_norm, (l1_w_in, l1_g_norm, l1_w_o)),
    ]
    for i in range(DEPTH):
        norm_w, params = layers[i]
        h = rmsnorm(x, norm_w)
        if i % N_MIXERS == 0:
            delta = mla_mixer(h, positions, *params)
        else:
            delta = hgrn2_mixer(h, lb_all[i], *params)
        x = x + delta.astype(x.dtype)
    return rmsnorm(x, final_norm)
```

```cpp
#include <hip/hip_runtime.h>
#include <hip/hip_cooperative_groups.h>
#include <cstdio>
#include <cstdint>
#include <cmath>
namespace cg = cooperative_groups;

typedef unsigned short bf16_t;
typedef short bf16x8 __attribute__((ext_vector_type(8)));
typedef short s16x4 __attribute__((ext_vector_type(4)));
typedef float f32x4 __attribute__((ext_vector_type(4)));
typedef float f32x16 __attribute__((ext_vector_type(16)));
typedef unsigned u32x4 __attribute__((ext_vector_type(4)));
typedef unsigned u32x2 __attribute__((ext_vector_type(2)));
#define LAS __attribute__((address_space(3)))

constexpr int T_TOK = 16384, SEQ = 8192, DM = 4096;
constexpr int N0 = 5696, N0P = 5888;
constexpr int NQ = 6144, NKV = 8192, N1 = 16384;
constexpr float EPS = 1e-6f;

constexpr size_t WS_W0IN = 0;
constexpr size_t WS_WUQ  = WS_W0IN + (size_t)N0P * 4096 * 2;
constexpr size_t WS_WUKV = WS_WUQ + (size_t)NQ * 1024 * 2;
constexpr size_t WS_W0O  = WS_WUKV + (size_t)NKV * 512 * 2;
constexpr size_t WS_W1IN = WS_W0O + (size_t)4096 * 4096 * 2;
constexpr size_t WS_W1O  = WS_W1IN + (size_t)N1 * 4096 * 2;
constexpr size_t WS_RSTD0 = WS_W1O + (size_t)4096 * 4096 * 2;
constexpr size_t WS_RSTDQ = WS_RSTD0 + 65536;
constexpr size_t WS_RSTDKV = WS_RSTDQ + 65536;
constexpr size_t WS_RSTD1 = WS_RSTDKV + 65536;
constexpr size_t WS_LB = WS_RSTD1 + 65536;
constexpr size_t WS_COS = WS_LB + 16384;
constexpr size_t WS_SIN = WS_COS + (size_t)T_TOK * 32 * 4;
constexpr size_t WS_KROT = WS_SIN + (size_t)T_TOK * 32 * 4;
constexpr size_t WS_ACTA = WS_KROT + (size_t)T_TOK * 64 * 2;
constexpr size_t WS_R = WS_ACTA + (size_t)T_TOK * 4096 * 2;
constexpr size_t WS_PROJ0 = WS_R;
constexpr size_t WS_Q = WS_PROJ0 + (size_t)T_TOK * N0P * 2;
constexpr size_t WS_PROJ1 = WS_R;
constexpr size_t WS_END = WS_R + (size_t)T_TOK * N1 * 2;

struct Params {
    const float* x; const int* pos; const float* l0_norm; const float* l0_w_in; const float* l0_q_norm; const float* l0_w_uq;
    const float* l0_kv_norm; const float* l0_w_ukv; const float* l0_w_o; const float* l1_norm; const float* l1_w_in;
    const float* l1_g_norm; const float* l1_w_o; const float* lower_bounds; const float* final_norm;
    float* out; unsigned char* ws;
    float inv_freq[32];
};

__device__ __forceinline__ unsigned cvtpk(float lo, float hi) { unsigned r; asm volatile("v_cvt_pk_bf16_f32 %0, %1, %2" : "=v"(r) : "v"(lo), "v"(hi)); return r; }
typedef float f32x2 __attribute__((ext_vector_type(2)));
typedef __bf16 bf16x2_t __attribute__((ext_vector_type(2)));
__device__ __forceinline__ unsigned cvtpk_n(float lo, float hi) { f32x2 v = {lo, hi}; bf16x2_t h = __builtin_convertvector(v, bf16x2_t); return __builtin_bit_cast(unsigned, h); }
__device__ __forceinline__ bf16_t f2bf_n(float f) { return (bf16_t)(cvtpk_n(f, 0.f) & 0xffffu); }
__device__ __forceinline__ bf16_t f2bf(float f) { return (bf16_t)(cvtpk(f, 0.f) & 0xffffu); }
__device__ __forceinline__ float bf2f(unsigned short h) { return __uint_as_float((unsigned)h << 16); }
__device__ __forceinline__ float bflo(unsigned w) { return __uint_as_float(w << 16); }
__device__ __forceinline__ float bfhi(unsigned w) { return __uint_as_float(w & 0xffff0000u); }
__device__ __forceinline__ bf16x8 pack8(f32x4 a, f32x4 b) {
    u32x4 w = {cvtpk(a[0], a[1]), cvtpk(a[2], a[3]), cvtpk(b[0], b[1]), cvtpk(b[2], b[3])};
    return *reinterpret_cast<bf16x8*>(&w);
}
__device__ __forceinline__ float fast_exp(float x) { return __builtin_amdgcn_exp2f(x * 1.4426950408889634f); }
__device__ __forceinline__ float silu_f(float v) { return v * __builtin_amdgcn_rcpf(1.0f + fast_exp(-v)); }
__device__ __forceinline__ float wave_sum(float v) {
#pragma unroll
    for (int o = 32; o > 0; o >>= 1) v += __shfl_xor(v, o);
    return v;
}

namespace pg8 {
constexpr int BM = 256, BK = 64, HALF = 128, HTB = HALF * BK * 2, STAGE_BYTES = 8 * HTB, NXCD = 8, WGM = 8;
__host__ __device__ __forceinline__ int lds_byte(int r, int c) { const int st = (r >> 4) * 2 + (c >> 5), rr = r & 15, cc = c & 31, ob = rr * 64 + cc * 2; return st * 1024 + (ob ^ (((ob >> 9) & 1) << 5)); }
__host__ __device__ __forceinline__ void stage_rc(int b, int& R, int& C) { const int st = b / 1024, sb = b % 1024, swz = sb ^ (((sb >> 9) & 1) << 5); R = (st >> 1) * 16 + swz / 64; C = (st & 1) * 32 + (swz % 64) / 2; }
__host__ __device__ __forceinline__ int perm32(int rho) { const int n = rho >> 4, i = rho & 15; return 8 * (i >> 2) + 4 * n + (i & 3); }
struct Unit { int pm, pn; };
struct Gemm { const bf16_t* A; const bf16_t* Bt; int M, N, K, lda; };
struct StaticOrder {
    int nM, nN, nwg, G, c;
    __device__ void init(int M, int N, int G_, int c_) { nM = M / BM; nN = N / BM; nwg = nM * nN; G = G_; c = c_; }
    __device__ bool next(int i, Unit& u) const {
        const long L = (long)i * G + c; if (L >= nwg) return false;
        int wgid = (int)L; { const int q = nwg / NXCD, r = nwg % NXCD, xcd = wgid % NXCD, off = wgid / NXCD; wgid = (xcd < r ? xcd * (q + 1) : r * (q + 1) + (xcd - r) * q) + off; }
        const int nig = WGM * nN, gid = wgid / nig, fm = gid * WGM, gsz = (nM - fm) < WGM ? (nM - fm) : WGM;
        u.pm = fm + ((wgid % nig) % gsz); u.pn = (wgid % nig) / gsz; return true;
    }
};

template <int MODE> struct EpiBf16 {
    static constexpr bool PERM = true;
    bf16_t* O; int ldc; const float* rs; int thr; const float* lb;
    __device__ __forceinline__ void operator()(const f32x4 (&acc)[2][2][4][2], const Unit& u, int wr, int wc, int fr, int fq) const {
        const int row0 = u.pm * BM + wr * 64 + fr, col0 = u.pn * BM + wc * 32 + 8 * fq;
        const int sec = (u.pn * BM) >> 12;
#pragma unroll
        for (int ai = 0; ai < 2; ++ai)
#pragma unroll
            for (int m = 0; m < 4; ++m) {
                const int row = row0 + ai * HALF + m * 16; const float s = rs[row];
                bf16_t* rowp = O + (size_t)row * ldc + col0;
#pragma unroll
                for (int bj = 0; bj < 2; ++bj) {
                    f32x4 v0 = acc[ai][bj][m][0] * s, v1 = acc[ai][bj][m][1] * s;
                    const int col = col0 + bj * HALF;
                    if (MODE == 1) { if (col >= thr) {
#pragma unroll
                        for (int j = 0; j < 4; ++j) { v0[j] = silu_f(v0[j]); v1[j] = silu_f(v1[j]); } } }
                    if (MODE == 2) {
                        if (sec == 0 || sec == 3) {
#pragma unroll
                            for (int j = 0; j < 4; ++j) { v0[j] = silu_f(v0[j]); v1[j] = silu_f(v1[j]); } }
                        else if (sec == 1) {
                            const f32x4 l0 = *(const f32x4*)(lb + col - 4096), l1 = *(const f32x4*)(lb + col - 4096 + 4);
#pragma unroll
                            for (int j = 0; j < 4; ++j) {
                                float sg = __builtin_amdgcn_rcpf(1.0f + fast_exp(-v0[j])); float fg = l0[j] + (1.0f - l0[j]) * sg; v0[j] = __logf(fg);
                                sg = __builtin_amdgcn_rcpf(1.0f + fast_exp(-v1[j])); fg = l1[j] + (1.0f - l1[j]) * sg; v1[j] = __logf(fg); }
                        }
                    }
                    u32x4 w; w.x = cvtpk(v0[0], v0[1]); w.y = cvtpk(v0[2], v0[3]); w.z = cvtpk(v1[0], v1[1]); w.w = cvtpk(v1[2], v1[3]);
                    *(u32x4*)(rowp + bj * HALF) = w;
                }
            }
    }
};
struct EpiResF32 {
    static constexpr bool PERM = false;
    const float* base; float* out; int ldc;
    __device__ __forceinline__ void operator()(const f32x4 (&acc)[2][2][4][2], const Unit& u, int wr, int wc, int fr, int fq) const {
        const int row0 = u.pm * BM + wr * 64 + fr, col0 = u.pn * BM + wc * 32 + 4 * fq;
#pragma unroll
        for (int ai = 0; ai < 2; ++ai)
#pragma unroll
            for (int m = 0; m < 4; ++m) { const size_t off = (size_t)(row0 + ai * HALF + m * 16) * ldc + col0;
#pragma unroll
                for (int bj = 0; bj < 2; ++bj)
#pragma unroll
                    for (int n = 0; n < 2; ++n) { const f32x4 bs = *(const f32x4*)(base + off + bj * HALF + n * 16); *(f32x4*)(out + off + bj * HALF + n * 16) = bs + acc[ai][bj][m][n]; }
                asm volatile("" ::: "memory"); }
    }
};

template <class Epi, class Sched>
__device__ __forceinline__ void gemm_phase(LAS unsigned char* lds, const Gemm g, const Sched& S, const Epi& E) {
    const int tid = threadIdx.x, wid = __builtin_amdgcn_readfirstlane(tid >> 6), lane = tid & 63, wr = wid >> 2, wc = wid & 3, fr = lane & 15, fq = lane >> 4;
    const int K = g.K, nt = K / BK, lda = g.lda;
    unsigned voffA[2], voffB[2];
#pragma unroll
    for (int i = 0; i < 2; ++i) { int R, C; stage_rc(tid * 16 + i * 8192, R, C); const int Rb = Epi::PERM ? ((R & ~31) + perm32(R & 31)) : R;
        voffA[i] = (unsigned)(R * lda + C) * 2u; voffB[i] = (unsigned)(Rb * K + C) * 2u; }
    const size_t kstep = (size_t)(BK * 2);
    const size_t hstepA = (size_t)HALF * lda * 2, hstepB = (size_t)HALF * K * 2;
    const size_t tstepA = 2 * hstepA, tstepB = 2 * hstepB;
    const unsigned ldsw = (unsigned)wid * 1024u;
    const int aoff = lds_byte(wr * 64 + fr, fq * 8), boff = lds_byte(wc * 32 + fr, fq * 8);
#define PG8_SA(b, h) (((b) * 2 + (h)) * HTB)
#define PG8_SB(b, h) ((4 + (b) * 2 + (h)) * HTB)
#define PG8_STAGE(bufoff, gbase, voff) do { _Pragma("unroll") for (int _i = 0; _i < 2; ++_i) \
        __builtin_amdgcn_global_load_lds((const unsigned*)((const char*)(gbase) + (voff)[_i]), (LAS unsigned*)(lds + (bufoff) + ldsw + _i * 8192), 16, 0, 0); } while (0)
#define PG8_LDA(dst, b, h) do { _Pragma("unroll") for (int m = 0; m < 4; ++m) _Pragma("unroll") for (int k = 0; k < 2; ++k) dst[m][k] = *(const LAS bf16x8*)(lds + PG8_SA(b, h) + aoff + m * 2048 + k * 1024); } while (0)
#define PG8_LDB(dst, b, h) do { _Pragma("unroll") for (int n = 0; n < 2; ++n) _Pragma("unroll") for (int k = 0; k < 2; ++k) dst[n][k] = *(const LAS bf16x8*)(lds + PG8_SB(b, h) + boff + n * 2048 + k * 1024); } while (0)
#define PG8_MMA(ai, bj, At, Bt) do { __builtin_amdgcn_s_setprio(1); _Pragma("unroll") for (int m = 0; m < 4; ++m) _Pragma("unroll") for (int n = 0; n < 2; ++n) _Pragma("unroll") for (int k = 0; k < 2; ++k) \
        acc[ai][bj][m][n] = __builtin_amdgcn_mfma_f32_16x16x32_bf16(Bt[n][k], At[m][k], acc[ai][bj][m][n], 0, 0, 0); __builtin_amdgcn_s_setprio(0); } while (0)
#define PG8_WAIT_V(n) asm volatile("s_waitcnt vmcnt(" #n ")" ::: "memory")
#define PG8_WAIT_L(n) asm volatile("s_waitcnt lgkmcnt(" #n ")" ::: "memory")
#define PG8_BAR __builtin_amdgcn_s_barrier()
#define PG8_SCHED __builtin_amdgcn_sched_barrier(0)
    Unit cur, nxt; int ui = 0;
    if (!S.next(0, cur)) return;
    f32x4 acc[2][2][4][2];
#pragma unroll
    for (int a = 0; a < 2; ++a)
#pragma unroll
        for (int b = 0; b < 2; ++b)
#pragma unroll
            for (int m = 0; m < 4; ++m)
#pragma unroll
                for (int n = 0; n < 2; ++n) acc[a][b][m][n] = (f32x4){0.f, 0.f, 0.f, 0.f};
    bf16x8 At[4][2], B0[2][2], B1[2][2];
    const char* cA = (const char*)g.A + (size_t)cur.pm * tstepA; const char* cB = (const char*)g.Bt + (size_t)cur.pn * tstepB;
    PG8_STAGE(PG8_SB(0, 0), cB, voffB); PG8_STAGE(PG8_SA(0, 0), cA, voffA); PG8_STAGE(PG8_SB(0, 1), cB + hstepB, voffB); PG8_STAGE(PG8_SA(0, 1), cA + hstepA, voffA);
    if (wr == 1) PG8_BAR;
    PG8_WAIT_V(4); PG8_BAR;
    PG8_STAGE(PG8_SB(1, 0), cB + kstep, voffB); PG8_STAGE(PG8_SA(1, 0), cA + kstep, voffA); PG8_STAGE(PG8_SB(1, 1), cB + hstepB + kstep, voffB);
    PG8_WAIT_V(6); PG8_BAR;
    for (;;) {
        const bool has_next = S.next(ui + 1, nxt);
        const char* nA = has_next ? (const char*)g.A + (size_t)nxt.pm * tstepA : cA; const char* nB = has_next ? (const char*)g.Bt + (size_t)nxt.pn * tstepB : cB;
        for (int t = 0; t < nt; t += 2) {
            const bool last = (t == nt - 2);
            const char* a1 = cA + (size_t)(t + 1) * kstep;
            const char* a2 = last ? nA : cA + (size_t)(t + 2) * kstep; const char* b2 = last ? nB : cB + (size_t)(t + 2) * kstep;
            const char* a3 = a2 + kstep; const char* b3 = b2 + kstep;
            PG8_LDB(B0, 0, 0); PG8_SCHED; PG8_LDA(At, 0, 0); PG8_STAGE(PG8_SA(1, 1), a1 + hstepA, voffA);
            PG8_WAIT_L(8); PG8_BAR; PG8_WAIT_L(0); PG8_MMA(0, 0, At, B0); PG8_BAR; PG8_SCHED;
            PG8_LDB(B1, 0, 1); PG8_STAGE(PG8_SB(0, 0), b2, voffB);
            PG8_BAR; PG8_WAIT_L(0); PG8_MMA(0, 1, At, B1); PG8_BAR;
            PG8_LDA(At, 0, 1); PG8_STAGE(PG8_SA(0, 0), a2, voffA);
            PG8_BAR; PG8_WAIT_L(0); PG8_MMA(1, 0, At, B0); PG8_BAR; PG8_SCHED;
            PG8_STAGE(PG8_SB(0, 1), b2 + hstepB, voffB);
            PG8_WAIT_V(6); PG8_BAR; PG8_MMA(1, 1, At, B1); PG8_BAR;
            PG8_LDB(B0, 1, 0); PG8_SCHED; PG8_LDA(At, 1, 0); PG8_STAGE(PG8_SA(0, 1), a2 + hstepA, voffA);
            PG8_WAIT_L(8); PG8_BAR; PG8_WAIT_L(0); PG8_MMA(0, 0, At, B0); PG8_BAR; PG8_SCHED;
            PG8_LDB(B1, 1, 1); PG8_STAGE(PG8_SB(1, 0), b3, voffB);
            PG8_BAR; PG8_WAIT_L(0); PG8_MMA(0, 1, At, B1); PG8_BAR;
            PG8_LDA(At, 1, 1); PG8_STAGE(PG8_SA(1, 0), a3, voffA);
            PG8_BAR; PG8_WAIT_L(0); PG8_MMA(1, 0, At, B0); PG8_BAR; PG8_SCHED;
            PG8_STAGE(PG8_SB(1, 1), b3 + hstepB, voffB);
            PG8_WAIT_V(6); PG8_BAR; PG8_MMA(1, 1, At, B1); PG8_BAR;
        }
        E(acc, cur, wr, wc, fr, fq);
        if (!has_next) break;
#pragma unroll
        for (int a = 0; a < 2; ++a)
#pragma unroll
            for (int b = 0; b < 2; ++b)
#pragma unroll
                for (int m = 0; m < 4; ++m)
#pragma unroll
                    for (int n = 0; n < 2; ++n) acc[a][b][m][n] = (f32x4){0.f, 0.f, 0.f, 0.f};
        cur = nxt; cA = nA; cB = nB; ++ui;
    }
    PG8_WAIT_V(0);
    if (wr == 0) PG8_BAR;
    PG8_BAR;
#undef PG8_SA
#undef PG8_SB
#undef PG8_STAGE
#undef PG8_LDA
#undef PG8_LDB
#undef PG8_MMA
#undef PG8_WAIT_V
#undef PG8_WAIT_L
#undef PG8_BAR
#undef PG8_SCHED
}
}
namespace att {
constexpr int NW = 8, QBLK = 32, KVBLK = 64, QB = NW * QBLK;
constexpr int DQ = 192, DV = 128;
constexpr int QS = NQ, KVS = NKV, KRS = 64, OS = 4096, ZS = N0P;
constexpr int SHM_V = KVBLK * DV * 2, SHM_K = KVBLK * DQ * 2;
constexpr int QR_OFF = 2 * SHM_V + 2 * SHM_K + NW * 64 * 4;
constexpr int LDS_BYTES = QR_OFF + NW * 4096;
constexpr float SCALE = 0.07216878364870322f;
constexpr float THR = 8.f;
constexpr unsigned WBIG = 0x40000000u;

#define KSWZ(row, colB) ((row) * 384 + ((colB) ^ (((row) & 7) << 4)))
#define SBAR() __builtin_amdgcn_sched_barrier(0)
__device__ __forceinline__ int v_st(int k, int c) { const int kk = (k & ~0xC) | ((k & 4) << 1) | ((k & 8) >> 1); return ((kk >> 3) * 4 + (c >> 5)) * 512 + ((kk & 7) * 32 + (c & 31)) * 2; }
__device__ __forceinline__ int v_rd_base(int lane) { return ((lane & 3) << 3) | (((lane >> 2) & 3) << 6) | (((lane >> 4) & 1) << 5) | (((lane >> 5) & 1) << 8); }
constexpr int v_rd_off(int d0, int ks, int half) { return d0 * 512 + ks * 4096 + half * 2048; }
__device__ __forceinline__ int crow(int r, int hi) { return (r & 3) + 8 * (r >> 2) + 4 * hi; }
__device__ __forceinline__ bf16x8 load8(const bf16_t* p) { return *reinterpret_cast<const bf16x8*>(p); }

__device__ __forceinline__ void mask_tile(f32x16& p0, f32x16& p1, int dq) {
    const float NEG = -__builtin_inff();
#pragma unroll
    for (int r = 0; r < 16; ++r) {
        const int c = (r & 3) + 8 * (r >> 2);
        if ((unsigned)(dq - c) >= WBIG) p0[r] = NEG;
        if ((unsigned)(dq - c - 32) >= WBIG) p1[r] = NEG;
    }
}
__device__ __forceinline__ void partialSM(f32x16& p0, f32x16& p1, float& m_reg, float& mn, float& alpha) {
    float pmax = p0[0];
#pragma unroll
    for (int r = 1; r < 16; ++r) pmax = fmaxf(pmax, p0[r]);
#pragma unroll
    for (int r = 0; r < 16; ++r) pmax = fmaxf(pmax, p1[r]);
    { auto rr = __builtin_amdgcn_permlane32_swap(__float_as_uint(pmax), __float_as_uint(pmax), false, false);
      pmax = fmaxf(__uint_as_float(rr[0]), __uint_as_float(rr[1])); }
    constexpr float C2 = 1.4426950408889634f * SCALE;
    if (__builtin_expect(__all((pmax - m_reg) * SCALE <= THR), 1)) { mn = m_reg; alpha = 1.f; }
    else { mn = fmaxf(m_reg, pmax); alpha = __builtin_amdgcn_exp2f((m_reg - mn) * C2); m_reg = mn; }
    const float mnL = -mn * C2;
#pragma unroll
    for (int r = 0; r < 16; ++r) p0[r] = fmaf(p0[r], C2, mnL);
#pragma unroll
    for (int r = 0; r < 16; ++r) p1[r] = fmaf(p1[r], C2, mnL);
#pragma unroll
    for (int r = 0; r < 16; ++r) p0[r] = __builtin_amdgcn_exp2f(p0[r]);
}
__device__ __forceinline__ void finishSM(f32x16& p0, f32x16& p1, float alpha, float& l_reg, bf16x8& pa0, bf16x8& pa1, bf16x8& pa2, bf16x8& pa3) {
#pragma unroll
    for (int r = 0; r < 16; ++r) p1[r] = __builtin_amdgcn_exp2f(p1[r]);
    float ps = 0;
#pragma unroll
    for (int r = 0; r < 16; ++r) ps += p0[r];
#pragma unroll
    for (int r = 0; r < 16; ++r) ps += p1[r];
    { auto rr = __builtin_amdgcn_permlane32_swap(__float_as_uint(ps), __float_as_uint(ps), false, false);
      ps = __uint_as_float(rr[0]) + __uint_as_float(rr[1]); }
    l_reg = l_reg * alpha + ps;
#define PK4(P, B_, OUT) do { unsigned a0 = cvtpk(P[B_+0], P[B_+1]), a1 = cvtpk(P[B_+2], P[B_+3]);                          \
        unsigned b0 = cvtpk(P[B_+4], P[B_+5]), b1 = cvtpk(P[B_+6], P[B_+7]);                                             \
        auto r0 = __builtin_amdgcn_permlane32_swap(a0, b0, false, false); auto r1 = __builtin_amdgcn_permlane32_swap(a1, b1, false, false); \
        u32x4 w = {r0[0], r1[0], r0[1], r1[1]}; OUT = *reinterpret_cast<bf16x8*>(&w); } while (0)
    PK4(p0, 0, pa0); PK4(p0, 8, pa1); PK4(p1, 0, pa2); PK4(p1, 8, pa3);
#undef PK4
}
template <int KB>
__device__ __forceinline__ void qkt(f32x16& p0, f32x16& p1, const char* K_lds, int r32, int hi, const bf16x8* qr, const char* qrl) {
    p0 = f32x16{}; p1 = f32x16{};
    const char* kb[4];
#pragma unroll
    for (int dd = 0; dd < 4; ++dd) kb[dd] = K_lds + KB * SHM_K + KSWZ(r32, (dd * 16 + hi * 8) * 2);
#pragma unroll
    for (int d0 = 0; d0 < 12; ++d0) { const char* a = kb[d0 & 3] + (d0 >> 2) * 128;
        bf16x8 b0 = *reinterpret_cast<const bf16x8*>(a);
        bf16x8 b1 = *reinterpret_cast<const bf16x8*>(a + 32 * 384);
        bf16x8 qf; if (d0 < 8) qf = qr[d0]; else qf = *reinterpret_cast<const bf16x8*>(qrl + (d0 - 8) * 1024);
        p0 = __builtin_amdgcn_mfma_f32_32x32x16_bf16(b0, qf, p0, 0, 0, 0);
        p1 = __builtin_amdgcn_mfma_f32_32x32x16_bf16(b1, qf, p1, 0, 0, 0);
    }
}
template <int VB>
__device__ __forceinline__ void pv_tile(f32x16* o, int vb0, bf16x8 pa0, bf16x8 pa1, bf16x8 pa2, bf16x8 pa3) {
#define TRRD(dst, off) asm volatile("ds_read_b64_tr_b16 %0, %1 offset:%2" : "=&v"(dst) : "v"(vb0), "i"(off) : "memory")
#define PV_D0(d0) do { s16x4 l0, l1, l2, l3, h0, h1, h2, h3; constexpr int b_ = VB * SHM_V + v_rd_off(d0, 0, 0); \
        TRRD(l0, b_); TRRD(h0, b_ + 2048); TRRD(l1, b_ + 4096); TRRD(h1, b_ + 6144); TRRD(l2, b_ + 8192); TRRD(h2, b_ + 10240); TRRD(l3, b_ + 12288); TRRD(h3, b_ + 14336); \
        asm volatile("s_waitcnt lgkmcnt(0)" ::: "memory"); SBAR();   \
        o[d0] = __builtin_amdgcn_mfma_f32_32x32x16_bf16(pa0, (bf16x8){l0[0], l0[1], l0[2], l0[3], h0[0], h0[1], h0[2], h0[3]}, o[d0], 0, 0, 0);   \
        o[d0] = __builtin_amdgcn_mfma_f32_32x32x16_bf16(pa1, (bf16x8){l1[0], l1[1], l1[2], l1[3], h1[0], h1[1], h1[2], h1[3]}, o[d0], 0, 0, 0);   \
        o[d0] = __builtin_amdgcn_mfma_f32_32x32x16_bf16(pa2, (bf16x8){l2[0], l2[1], l2[2], l2[3], h2[0], h2[1], h2[2], h2[3]}, o[d0], 0, 0, 0);   \
        o[d0] = __builtin_amdgcn_mfma_f32_32x32x16_bf16(pa3, (bf16x8){l3[0], l3[1], l3[2], l3[3], h3[0], h3[1], h3[2], h3[3]}, o[d0], 0, 0, 0); } while (0)
    PV_D0(0); PV_D0(1); PV_D0(2); PV_D0(3);
#undef PV_D0
#undef TRRD
}

struct BlockRef { const bf16_t* Q; const bf16_t* K; const bf16_t* KR; const bf16_t* V; bf16_t* O; const bf16_t* Z; const float* CS; const float* SN; int P0; };
struct Stage { bf16x8 st_v0, st_v1, st_k0, st_k1, st_kr; };
#define VMW() asm volatile("s_waitcnt vmcnt(0)" ::: "memory")
#define SLOAD_H(R, k0) do { const char* kt_ = (const char*)(R).K + (size_t)(k0) * (KVS * 2); const char* kt2_ = kt_ + 32 * KVS * 2; const char* krt_ = (const char*)(R).KR + (size_t)(k0) * (KRS * 2); \
                            S.st_v0 = *(const bf16x8*)(kt_ + koff + 256); S.st_v1 = *(const bf16x8*)(kt2_ + koff + 256);  \
                            S.st_k0 = *(const bf16x8*)(kt_ + koff); S.st_k1 = *(const bf16x8*)(kt2_ + koff);  \
                            S.st_kr = *(const bf16x8*)(krt_ + kroff); } while (0)
#define SWRITE_HK(bf) do { *(bf16x8*)(K_lds + (bf) * SHM_K + kws) = S.st_k0; *(bf16x8*)(K_lds + (bf) * SHM_K + kws + 32 * 384) = S.st_k1; \
                           *(bf16x8*)(K_lds + (bf) * SHM_K + kwr) = S.st_kr; } while (0)
#define SWRITE_HV(bf) do { *(bf16x8*)(V_lds + (bf) * SHM_V + vst0) = S.st_v0; *(bf16x8*)(V_lds + (bf) * SHM_V + vst1) = S.st_v1; } while (0)
#define SWRITE_H(bf) do { SWRITE_HV(bf); SWRITE_HK(bf); } while (0)

__device__ __forceinline__ void rope_q(const BlockRef& cur, const bf16x8* qrp, char* qrl, int wid, int r32, int hi) {
    const int row = wid * QBLK + r32;
    const unsigned toff = (unsigned)((row * 32 + hi * 8) * 4);
    const float* cp = (const float*)((const char*)cur.CS + toff); const float* sp = (const float*)((const char*)cur.SN + toff);
#pragma unroll
    for (int pr = 0; pr < 2; ++pr) {
        const f32x4 c0 = *(const f32x4*)(cp + pr * 16), c1 = *(const f32x4*)(cp + pr * 16 + 4), s0 = *(const f32x4*)(sp + pr * 16), s1 = *(const f32x4*)(sp + pr * 16 + 4);
        const bf16x8 a = qrp[pr], b = qrp[2 + pr];
        f32x4 o1l, o1h, o2l, o2h;
#pragma unroll
        for (int j = 0; j < 4; ++j) {
            float t1 = bf2f((unsigned short)a[j]), t2 = bf2f((unsigned short)b[j]);
            o1l[j] = t1 * c0[j] - t2 * s0[j]; o2l[j] = t2 * c0[j] + t1 * s0[j];
            t1 = bf2f((unsigned short)a[4 + j]); t2 = bf2f((unsigned short)b[4 + j]);
            o1h[j] = t1 * c1[j] - t2 * s1[j]; o2h[j] = t2 * c1[j] + t1 * s1[j];
        }
        *(bf16x8*)(qrl + pr * 1024) = pack8(o1l, o1h); *(bf16x8*)(qrl + (2 + pr) * 1024) = pack8(o2l, o2h);
    }
}
__device__ __forceinline__ void causal_block(const BlockRef& cur, char* lds) {
    const int tid = threadIdx.x, wid = __builtin_amdgcn_readfirstlane(tid >> 6), lane = tid & 63, r32 = lane & 31, hi = lane >> 5;
    const int NT = (cur.P0 + QB - 1) / KVBLK + 1;
    const int qlo = cur.P0 + wid * QBLK, qm = qlo + r32 - 4 * hi;
    char* V_lds = lds; char* K_lds = lds + 2 * SHM_V;
    float* ws = (float*)(lds + 2 * SHM_V + 2 * SHM_K) + wid * 64; float* li_l = ws, * al_l = ws + 32;
    float m_reg = -1e30f, l_reg = 0; f32x16 o[4] = {};
    const int sr = tid >> 4, sc = (tid & 15) * 8, vst0 = v_st(sr, sc), vst1 = v_st(32 + sr, sc), kws = KSWZ(sr, sc * 2);
    const int krr = tid >> 3, krc = (tid & 7) * 8, kwr = KSWZ(krr, (128 + krc) * 2);
    const int vb0 = (int)(uintptr_t)V_lds + v_rd_base(lane);
    unsigned koff = (unsigned)((sr * KVS + sc) * 2), kroff = (unsigned)((krr * KRS + krc) * 2);
    unsigned qoff = (unsigned)(((wid * QBLK + r32) * QS + hi * 8) * 2);
    asm volatile("" : "+v"(koff), "+v"(kroff), "+v"(qoff));
    Stage S; bf16x8 qr[8]; char* qrl = lds + QR_OFF + wid * 4096 + lane * 16;
    { bf16x8 qrp[4];
#pragma unroll
      for (int d0 = 0; d0 < 8; ++d0) qr[d0] = *(const bf16x8*)((const char*)cur.Q + qoff + d0 * 32);
#pragma unroll
      for (int d0 = 0; d0 < 4; ++d0) qrp[d0] = *(const bf16x8*)((const char*)cur.Q + qoff + (8 + d0) * 32);
      SLOAD_H(cur, 0);
      rope_q(cur, qrp, qrl, wid, r32, hi); }
    VMW(); SWRITE_H(0); SBAR();
    SLOAD_H(cur, KVBLK); SBAR();
    __syncthreads();
#define RESC(a) do { if (__any((a) < 1.f)) { if (hi == 0) al_l[r32] = (a); asm volatile("s_waitcnt lgkmcnt(0)" ::: "memory");              \
                     for (int d_ = 0; d_ < 4; ++d_) for (int r = 0; r < 16; ++r) o[d_][r] *= al_l[crow(r, hi)]; } } while (0)
#define KBASE(t) ((t) * KVBLK)
#define MASKT(P0_, P1_, t) do { const int kb_ = KBASE(t); if (kb_ + KVBLK - 1 > qlo) mask_tile(P0_, P1_, qm - kb_); } while (0)
    f32x16 pA0, pA1, pB0, pB1; float mnA, mnB, alA, alB; bf16x8 pa0, pa1, pa2, pa3;
    qkt<0>(pA0, pA1, K_lds, r32, hi, qr, qrl);
    MASKT(pA0, pA1, 0); partialSM(pA0, pA1, m_reg, mnA, alA);
    VMW(); SWRITE_H(1);
    __syncthreads();
#define HALF_STEP(PX0, PX1, mnX, alX, PY0, PY1, alY, t, KB, VB, SB) do {                                                      \
        SBAR(); qkt<KB>(PX0, PX1, K_lds, r32, hi, qr, qrl);                                                                        \
        finishSM(PY0, PY1, alY, l_reg, pa0, pa1, pa2, pa3); SBAR();                                                           \
        if ((t) + 1 < NT) { SLOAD_H(cur, KBASE((t) + 1)); SBAR(); }                                                           \
        pv_tile<VB>(o, vb0, pa0, pa1, pa2, pa3); MASKT(PX0, PX1, (t)); partialSM(PX0, PX1, m_reg, mnX, alX);                  \
        __syncthreads();                                                                                                      \
        if ((t) + 1 < NT) { VMW(); SWRITE_H(SB); }                                                                            \
        RESC(alX); __syncthreads(); } while (0)
    for (int t = 1; t + 1 < NT; t += 2) {
        HALF_STEP(pB0, pB1, mnB, alB, pA0, pA1, alA, t, 1, 0, 0);
        HALF_STEP(pA0, pA1, mnA, alA, pB0, pB1, alB, t + 1, 0, 1, 1);
    }
    SBAR(); qkt<1>(pB0, pB1, K_lds, r32, hi, qr, qrl); SBAR();
    finishSM(pA0, pA1, alA, l_reg, pa0, pa1, pa2, pa3); SBAR();
    pv_tile<0>(o, vb0, pa0, pa1, pa2, pa3);
    MASKT(pB0, pB1, NT - 1); partialSM(pB0, pB1, m_reg, mnB, alB); __syncthreads(); RESC(alB);
    finishSM(pB0, pB1, alB, l_reg, pa0, pa1, pa2, pa3); SBAR(); pv_tile<1>(o, vb0, pa0, pa1, pa2, pa3);
    SBAR();
    if (hi == 0) li_l[r32] = l_reg;
    __syncthreads();
    {
        char* ot = lds + wid * (32 * 272);
        const int wb = 4 * hi * 272 + r32 * 2;
#pragma unroll
        for (int rg = 0; rg < 4; ++rg) {
            const f32x4 lv = *(const f32x4*)(li_l + 8 * rg + 4 * hi);
#pragma unroll
            for (int j = 0; j < 4; ++j) { const int r = rg * 4 + j; const float rl = __builtin_amdgcn_rcpf(lv[j]);
#pragma unroll
                for (int d0 = 0; d0 < 4; ++d0) *(bf16_t*)(ot + wb + (j + 8 * rg) * 272 + d0 * 64) = f2bf(o[d0][r] * rl); }
        }
        asm volatile("s_waitcnt lgkmcnt(0)" ::: "memory");
        const int rr = lane >> 4, c8 = (lane & 15) * 8;
        const unsigned zoff = (unsigned)(((wid * QBLK + rr) * ZS + c8) * 2), ooff = (unsigned)(((wid * QBLK + rr) * OS + c8) * 2);
#pragma unroll
        for (int i = 0; i < 8; ++i) {
            const bf16x8 ov = *(const bf16x8*)(ot + (i * 4 + rr) * 272 + c8 * 2);
            const bf16x8 zv = *(const bf16x8*)((const char*)cur.Z + (size_t)(i * 4 * ZS * 2) + zoff);
            f32x4 a, b;
#pragma unroll
            for (int j = 0; j < 4; ++j) { a[j] = bf2f((unsigned short)ov[j]) * bf2f((unsigned short)zv[j]); b[j] = bf2f((unsigned short)ov[4 + j]) * bf2f((unsigned short)zv[4 + j]); }
            *(bf16x8*)((char*)cur.O + (size_t)(i * 4 * OS * 2) + ooff) = pack8(a, b);
        }
    }
    __syncthreads();
#undef RESC
#undef KBASE
#undef MASKT
#undef HALF_STEP
}
#undef VMW
#undef SLOAD_H
#undef SWRITE_HK
#undef SWRITE_HV
#undef SWRITE_H

struct Item { int bh, qb0, qb1; };
constexpr int NQB = SEQ / QB, NX = NQB / 2, NBH = 64, TOTAL = NX * NBH;
__device__ __forceinline__ Item decode(int L) {
    Item it; const int xcd = L & 7, k = L >> 3, gi = k / NX, r = k - gi * NX;
    it.bh = gi * 8 + xcd; it.qb0 = r; it.qb1 = NQB - 1 - r; return it;
}
struct Tensors { const bf16_t* q; const bf16_t* kv; const bf16_t* krot; bf16_t* og; const bf16_t* proj0; const float* cs; const float* sn; };
__device__ __forceinline__ BlockRef mkref(const Item& it, int pass, const Tensors& T) {
    const int qb = pass ? it.qb1 : it.qb0, b = it.bh >> 5, h = it.bh & 31;
    const size_t tok0 = (size_t)b * SEQ, row0 = tok0 + (size_t)qb * QB;
    BlockRef r;
    r.Q = T.q + row0 * QS + h * DQ; r.K = T.kv + tok0 * KVS + h * 256; r.V = r.K + 128; r.KR = T.krot + tok0 * KRS;
    r.O = T.og + row0 * OS + h * DV; r.Z = T.proj0 + row0 * ZS + 1600 + h * DV; r.CS = T.cs + row0 * 32; r.SN = T.sn + row0 * 32; r.P0 = qb * QB;
    return r;
}
__device__ __forceinline__ void attn_phase(char* lds, const Tensors& T) {
    for (int L = blockIdx.x; L < TOTAL; L += gridDim.x) {
        const Item it = decode(L);
#pragma unroll 1
        for (int pass = 0; pass < 2; ++pass) { const BlockRef cur = mkref(it, pass, T); causal_block(cur, lds); }
    }
}
}
__device__ __forceinline__ void wt_phase(const float* __restrict__ W, int K, int N, const float* __restrict__ scale, bf16_t* __restrict__ out, float* tile  ) {
    const int tid = threadIdx.x, ntn = N / 64, ntk = K / 64, ntiles = ntn * ntk;
    for (int t = blockIdx.x; t < ntiles; t += gridDim.x) {
        const int kb = (t / ntn) * 64, nb = (t % ntn) * 64;
        { const int n = tid & 63, k0 = tid >> 6;
#pragma unroll
          for (int i = 0; i < 8; ++i) { const int k = k0 + i * 8; float v = W[(size_t)(kb + k) * N + nb + n]; if (scale) v *= scale[kb + k]; tile[k * 65 + n] = v; } }
        __syncthreads();
        { const int n = tid >> 3, kc = (tid & 7) * 8; f32x4 a, b;
#pragma unroll
          for (int j = 0; j < 4; ++j) { a[j] = tile[(kc + j) * 65 + n]; b[j] = tile[(kc + 4 + j) * 65 + n]; }
          *(bf16x8*)(out + (size_t)(nb + n) * K + kb + kc) = pack8(a, b); }
        __syncthreads();
    }
}
__device__ __forceinline__ void cast_rstd_phase(const float* __restrict__ src, bf16_t* __restrict__ dst, float* __restrict__ rstd) {
    const int lane = threadIdx.x & 63, gw = blockIdx.x * 8 + (threadIdx.x >> 6), nw = gridDim.x * 8;
    for (int row = gw; row < T_TOK; row += nw) {
        const float* s = src + (size_t)row * DM; bf16_t* d = dst + (size_t)row * DM; float ss = 0.f;
#pragma unroll
        for (int i = 0; i < 8; ++i) { const int c = (i * 64 + lane) * 8; const f32x4 a = *(const f32x4*)(s + c), b = *(const f32x4*)(s + c + 4);
            ss += a[0] * a[0] + a[1] * a[1] + a[2] * a[2] + a[3] * a[3] + b[0] * b[0] + b[1] * b[1] + b[2] * b[2] + b[3] * b[3];
            *(bf16x8*)(d + c) = pack8(a, b); }
        ss = wave_sum(ss);
        if (lane == 0) rstd[row] = 1.0f / sqrtf(ss * (1.0f / DM) + EPS);
    }
}
__device__ __forceinline__ void final_norm_phase(float* __restrict__ io, const float* __restrict__ w) {
    const int lane = threadIdx.x & 63, gw = blockIdx.x * 8 + (threadIdx.x >> 6), nw = gridDim.x * 8;
    for (int row = gw; row < T_TOK; row += nw) {
        float* s = io + (size_t)row * DM; f32x4 v[16]; float ss = 0.f;
#pragma unroll
        for (int i = 0; i < 16; ++i) { v[i] = *(const f32x4*)(s + (i * 64 + lane) * 4); ss += v[i][0] * v[i][0] + v[i][1] * v[i][1] + v[i][2] * v[i][2] + v[i][3] * v[i][3]; }
        ss = wave_sum(ss);
        const float r = 1.0f / sqrtf(ss * (1.0f / DM) + EPS);
#pragma unroll
        for (int i = 0; i < 16; ++i) { const f32x4 g = *(const f32x4*)(w + (i * 64 + lane) * 4); *(f32x4*)(s + (i * 64 + lane) * 4) = v[i] * r * g; }
    }
}
__device__ __forceinline__ void tables_phase(const Params& p, float* cs, float* sn, float* lb) {
    const int gt = blockIdx.x * blockDim.x + threadIdx.x, nt = gridDim.x * blockDim.x;
    for (int i = gt; i < T_TOK * 32; i += nt) {
        const int tok = i >> 5, j = i & 31;
        const float ang = (float)p.pos[tok] * p.inv_freq[j];
        const double rev = (double)ang * 0.15915494309189535; const float fr = (float)(rev - rint(rev));
        cs[i] = __builtin_amdgcn_cosf(fr); sn[i] = __builtin_amdgcn_sinf(fr);
    }
    for (int i = gt; i < 4096; i += nt) { const float l0 = p.lower_bounds[i], l1 = p.lower_bounds[4096 + i]; lb[i] = 1.0f / (1.0f + expf(l0 - l1)); }
}
__device__ __forceinline__ void stats_krot_phase(const bf16_t* __restrict__ proj0, float* __restrict__ rq, float* __restrict__ rkv, const float* __restrict__ cs, const float* __restrict__ sn, bf16_t* __restrict__ krot) {
    const int lane = threadIdx.x & 63, gw = blockIdx.x * 8 + (threadIdx.x >> 6), nw = gridDim.x * 8;
    for (int row = gw; row < T_TOK; row += nw) {
        const bf16_t* s = proj0 + (size_t)row * N0P;
        const bf16x8 a = *(const bf16x8*)(s + lane * 8), b = *(const bf16x8*)(s + 512 + lane * 8), c = *(const bf16x8*)(s + 1024 + lane * 8);
        float sq = 0.f, sk = 0.f;
#pragma unroll
        for (int j = 0; j < 8; ++j) { const float x = bf2f((unsigned short)a[j]), y = bf2f((unsigned short)b[j]), z = bf2f((unsigned short)c[j]); sq += x * x + y * y; sk += z * z; }
        sq = wave_sum(sq); sk = wave_sum(sk);
        if (lane == 0) { rq[row] = 1.0f / sqrtf(sq * (1.0f / 1024.0f) + EPS); rkv[row] = 1.0f / sqrtf(sk * (1.0f / 512.0f) + EPS); }
        if (lane < 32) { const float t1 = bf2f(s[1536 + lane]), t2 = bf2f(s[1568 + lane]); const float cc = cs[(size_t)row * 32 + lane], sv = sn[(size_t)row * 32 + lane];
            krot[(size_t)row * 64 + lane] = f2bf(t1 * cc - t2 * sv); krot[(size_t)row * 64 + 32 + lane] = f2bf(t2 * cc + t1 * sv); }
    }
}
__device__ __forceinline__ void headnorm_phase(bf16_t* __restrict__ proj1, const bf16_t* __restrict__ oraw, const float* __restrict__ gn) {
    const int tid = threadIdx.x, per = T_TOK / gridDim.x;
    const int h = tid >> 4, vs = (tid & 15) >> 2, c8 = (tid & 3) * 8;
    for (int tok = blockIdx.x * per; tok < (blockIdx.x + 1) * per; ++tok) {
        const int b = tok >> 13, sq = tok & (SEQ - 1);
        bf16_t* s = proj1 + (size_t)tok * N1;
        const bf16x8 o = *(const bf16x8*)(oraw + ((size_t)((b * 32 + h) * 4 + vs) * SEQ + sq) * 32 + c8), z = *(const bf16x8*)(s + 12288 + tid * 8);
        float f[8], ss = 0.f;
#pragma unroll
        for (int j = 0; j < 8; ++j) { f[j] = bf2f((unsigned short)o[j]); ss += f[j] * f[j]; }
        ss += __shfl_xor(ss, 1); ss += __shfl_xor(ss, 2); ss += __shfl_xor(ss, 4); ss += __shfl_xor(ss, 8);
        const float r = 1.0f / sqrtf(ss * (1.0f / 128.0f) + EPS);
        const int v0 = (tid & 15) * 8; const f32x4 g0 = *(const f32x4*)(gn + v0), g1 = *(const f32x4*)(gn + v0 + 4);
        f32x4 a, bb;
#pragma unroll
        for (int j = 0; j < 4; ++j) { a[j] = f[j] * r * g0[j] * bf2f((unsigned short)z[j]); bb[j] = f[4 + j] * r * g1[j] * bf2f((unsigned short)z[4 + j]); }
        *(bf16x8*)(s + 8192 + tid * 8) = pack8(a, bb);
    }
}

namespace hg {
constexpr int QT_S = 272, KD_S = 144;
constexpr int OFF_QT = 0, OFF_KT = OFF_QT + 64 * QT_S, OFF_QB = OFF_KT + 64 * QT_S, OFF_KD = OFF_QB + 64 * QT_S;
constexpr int OFF_VT = OFF_KD + 128 * KD_S, OFF_ST = OFF_VT + 32 * KD_S, OFF_ATT = OFF_ST + 32 * QT_S;
constexpr int OFF_SEG = OFF_ATT + 64 * KD_S, OFF_G32 = OFF_SEG + 2048, OFF_DEC = OFF_G32 + 512, LDS_BYTES = OFF_DEC + 512;
__device__ __forceinline__ int crow(int r, int hi) { return (r & 3) + 8 * (r >> 2) + 4 * hi; }

__device__ __forceinline__ void hgrn2_phase(char* lds, const bf16_t* __restrict__ proj1, bf16_t* __restrict__ oraw) {
    const int tid = threadIdx.x, wid = __builtin_amdgcn_readfirstlane(tid >> 6), lane = tid & 63, r32 = lane & 31, hi = lane >> 5;
    const int kch = tid & 127, seg = tid >> 7;
    float* segtot = (float*)(lds + OFF_SEG); float* g32s = (float*)(lds + OFF_G32); float* decay = (float*)(lds + OFF_DEC);
    for (int item = blockIdx.x; item < 256; item += gridDim.x) {
        const int vs = item & 3, bh = item >> 2, b = bh >> 5, h = bh & 31;
        const bf16_t* base = proj1 + (size_t)b * SEQ * N1; bf16_t* ob = oraw + (size_t)item * SEQ * 32;
        const int qcol = h * 128 + kch, gcol = 4096 + h * 128 + kch, vcol = 8192 + h * 128 + vs * 32;
        f32x16 sacc = {};
        for (int i = tid; i < 32 * QT_S / 4; i += 512) ((unsigned*)(lds + OFF_ST))[i] = 0u;
        unsigned short graw[16], qraw[16]; u32x2 vraw;
        { const bf16_t* rp = base + (size_t)(seg * 16) * N1;
#pragma unroll
          for (int i = 0; i < 16; ++i) { graw[i] = rp[(size_t)i * N1 + gcol]; qraw[i] = rp[(size_t)i * N1 + qcol]; }
          vraw = *(const u32x2*)(base + (size_t)(tid >> 3) * N1 + vcol + (tid & 7) * 4); }
        for (int ch = 0; ch < 128; ++ch) {
            const int tok0 = ch * 64;
            float gl[16]; float cum = 0.f;
#pragma unroll
            for (int i = 0; i < 16; ++i) { cum += bf2f(graw[i]); gl[i] = cum; }
            segtot[seg * 128 + kch] = cum; if (seg == 2) g32s[kch] = bf2f(graw[0]);
            __syncthreads();
            { const float s0 = segtot[kch], s1 = segtot[128 + kch], s2 = segtot[256 + kch], s3 = segtot[384 + kch];
              const float off = (seg > 0 ? s0 : 0.f) + (seg > 1 ? s1 : 0.f) + (seg > 2 ? s2 : 0.f);
              const float tot = (s0 + s1) + (s2 + s3), bref = s0 + s1 + g32s[kch];
              if (seg == 0) decay[kch] = fast_exp(tot);
              float kd[16];
#pragma unroll
              for (int i = 0; i < 16; ++i) { const int t = seg * 16 + i; const float bb = off + gl[i], gv = bf2f(graw[i]), qv = bf2f(qraw[i]); const float kk = 1.0f - fast_exp(gv);
                  *(bf16_t*)(lds + OFF_QT + t * QT_S + kch * 2) = f2bf_n(qv * fast_exp(bb - bref));
                  *(bf16_t*)(lds + OFF_KT + t * QT_S + kch * 2) = f2bf_n(kk * fast_exp(bref - bb));
                  *(bf16_t*)(lds + OFF_QB + t * QT_S + kch * 2) = f2bf_n(qv * fast_exp(bb));
                  kd[i] = kk * fast_exp(tot - bb); }
              *(bf16x8*)(lds + OFF_KD + kch * KD_S + seg * 32) = pack8((f32x4){kd[0], kd[1], kd[2], kd[3]}, (f32x4){kd[4], kd[5], kd[6], kd[7]});
              *(bf16x8*)(lds + OFF_KD + kch * KD_S + seg * 32 + 16) = pack8((f32x4){kd[8], kd[9], kd[10], kd[11]}, (f32x4){kd[12], kd[13], kd[14], kd[15]});
              { const int t = tid >> 3, v4 = (tid & 7) * 4;
                *(bf16_t*)(lds + OFF_VT + (v4 + 0) * KD_S + t * 2) = (bf16_t)(vraw.x & 0xffffu); *(bf16_t*)(lds + OFF_VT + (v4 + 1) * KD_S + t * 2) = (bf16_t)(vraw.x >> 16);
                *(bf16_t*)(lds + OFF_VT + (v4 + 2) * KD_S + t * 2) = (bf16_t)(vraw.y & 0xffffu); *(bf16_t*)(lds + OFF_VT + (v4 + 3) * KD_S + t * 2) = (bf16_t)(vraw.y >> 16); }
            }
            if (ch + 1 < 128) { const bf16_t* rp = base + (size_t)(tok0 + 64 + seg * 16) * N1;
#pragma unroll
                for (int i = 0; i < 16; ++i) { graw[i] = rp[(size_t)i * N1 + gcol]; qraw[i] = rp[(size_t)i * N1 + qcol]; }
                vraw = *(const u32x2*)(base + (size_t)(tok0 + 64 + (tid >> 3)) * N1 + vcol + (tid & 7) * 4); }
            __syncthreads();
            f32x16 oacc = {};
            if (wid < 4) {
                const int ci = wid >> 1, si = wid & 1;
                if (!(ci == 0 && si == 1)) {
                    f32x16 aacc = {};
#pragma unroll
                    for (int kk = 0; kk < 8; ++kk) {
                        const bf16x8 af = *(const bf16x8*)(lds + OFF_QT + (32 * ci + r32) * QT_S + kk * 32 + hi * 16);
                        const bf16x8 bfr = *(const bf16x8*)(lds + OFF_KT + (32 * si + r32) * QT_S + kk * 32 + hi * 16);
                        aacc = __builtin_amdgcn_mfma_f32_32x32x16_bf16(af, bfr, aacc, 0, 0, 0); }
#pragma unroll
                    for (int i = 0; i < 16; ++i) { const int c = 32 * ci + crow(i, hi), s = 32 * si + r32; const float v = (c >= s) ? aacc[i] : 0.f;
                        *(bf16_t*)(lds + OFF_ATT + c * KD_S + s * 2) = f2bf_n(v); }
                } else {
#pragma unroll
                    for (int i = 0; i < 16; ++i) { const int c = crow(i, hi), s = 32 + r32; *(bf16_t*)(lds + OFF_ATT + c * KD_S + s * 2) = (bf16_t)0; }
                }
#pragma unroll
                for (int g4 = 0; g4 < 4; ++g4) { const f32x4 d = *(const f32x4*)(decay + 32 * wid + 8 * g4 + 4 * hi);
#pragma unroll
                    for (int j = 0; j < 4; ++j) sacc[g4 * 4 + j] *= d[j]; }
#pragma unroll
                for (int kk = 0; kk < 4; ++kk) {
                    const bf16x8 af = *(const bf16x8*)(lds + OFF_KD + (32 * wid + r32) * KD_S + kk * 32 + hi * 16);
                    const bf16x8 bfr = *(const bf16x8*)(lds + OFF_VT + r32 * KD_S + kk * 32 + hi * 16);
                    sacc = __builtin_amdgcn_mfma_f32_32x32x16_bf16(af, bfr, sacc, 0, 0, 0); }
            } else if (wid < 6) {
                const int ci = wid - 4;
#pragma unroll
                for (int kk = 0; kk < 8; ++kk) {
                    const bf16x8 af = *(const bf16x8*)(lds + OFF_QB + (32 * ci + r32) * QT_S + kk * 32 + hi * 16);
                    const bf16x8 bfr = *(const bf16x8*)(lds + OFF_ST + r32 * QT_S + kk * 32 + hi * 16);
                    oacc = __builtin_amdgcn_mfma_f32_32x32x16_bf16(af, bfr, oacc, 0, 0, 0); }
            }
            __syncthreads();
            if (wid < 4) {
#pragma unroll
                for (int g4 = 0; g4 < 4; ++g4) { u32x2 w; w.x = cvtpk_n(sacc[g4 * 4 + 0], sacc[g4 * 4 + 1]); w.y = cvtpk_n(sacc[g4 * 4 + 2], sacc[g4 * 4 + 3]);
                    *(u32x2*)(lds + OFF_ST + r32 * QT_S + (32 * wid + 8 * g4 + 4 * hi) * 2) = w; }
            } else if (wid < 6) {
                const int ci = wid - 4;
#pragma unroll
                for (int kk = 0; kk < 4; ++kk) {
                    const bf16x8 af = *(const bf16x8*)(lds + OFF_ATT + (32 * ci + r32) * KD_S + kk * 32 + hi * 16);
                    const bf16x8 bfr = *(const bf16x8*)(lds + OFF_VT + r32 * KD_S + kk * 32 + hi * 16);
                    oacc = __builtin_amdgcn_mfma_f32_32x32x16_bf16(af, bfr, oacc, 0, 0, 0); }
#pragma unroll
                for (int i = 0; i < 16; ++i) { const int c = 32 * ci + crow(i, hi); ob[(size_t)(tok0 + c) * 32 + r32] = f2bf_n(oacc[i]); }
            }
        }
        __syncthreads();
    }
}
}
constexpr int LDS_TOTAL = pg8::STAGE_BYTES;
static_assert(att::LDS_BYTES <= LDS_TOTAL && hg::LDS_BYTES <= LDS_TOTAL, "lds");

#ifndef PHMASK
#define PHMASK 0xFFFF
#endif
#define EN(n) (((PHMASK) >> (n)) & 1)

__global__ void __launch_bounds__(512) mla_hgrn2_fwd(Params p) {
    extern __shared__ __attribute__((aligned(16))) unsigned char lds[];
    cg::grid_group grid = cg::this_grid();
    unsigned char* ws = p.ws;
    bf16_t* W0IN = (bf16_t*)(ws + WS_W0IN); bf16_t* WUQ = (bf16_t*)(ws + WS_WUQ); bf16_t* WUKV = (bf16_t*)(ws + WS_WUKV);
    bf16_t* W0O = (bf16_t*)(ws + WS_W0O); bf16_t* W1IN = (bf16_t*)(ws + WS_W1IN); bf16_t* W1O = (bf16_t*)(ws + WS_W1O);
    float* RSTD0 = (float*)(ws + WS_RSTD0); float* RSTDQ = (float*)(ws + WS_RSTDQ); float* RSTDKV = (float*)(ws + WS_RSTDKV); float* RSTD1 = (float*)(ws + WS_RSTD1);
    float* LB = (float*)(ws + WS_LB); float* COS = (float*)(ws + WS_COS); float* SIN = (float*)(ws + WS_SIN);
    bf16_t* KROT = (bf16_t*)(ws + WS_KROT); bf16_t* ACTA = (bf16_t*)(ws + WS_ACTA);
    bf16_t* PROJ0 = (bf16_t*)(ws + WS_PROJ0); bf16_t* QBUF = (bf16_t*)(ws + WS_Q); bf16_t* PROJ1 = (bf16_t*)(ws + WS_PROJ1);
    bf16_t* KVBUF = (bf16_t*)p.out;
    LAS unsigned char* ldsl = (LAS unsigned char*)lds;
    const int G = gridDim.x, c = blockIdx.x;

    if (EN(0))
    {
        float* tile = (float*)lds;
        wt_phase(p.l0_w_in, 4096, N0, p.l0_norm, W0IN, tile);
        wt_phase(p.l0_w_uq, 1024, NQ, p.l0_q_norm, WUQ, tile);
        wt_phase(p.l0_w_ukv, 512, NKV, p.l0_kv_norm, WUKV, tile);
        wt_phase(p.l0_w_o, 4096, 4096, nullptr, W0O, tile);
        wt_phase(p.l1_w_in, 4096, N1, p.l1_norm, W1IN, tile);
        wt_phase(p.l1_w_o, 4096, 4096, nullptr, W1O, tile);
        { u32x4 z = {0u, 0u, 0u, 0u}; u32x4* pad = (u32x4*)(W0IN + (size_t)N0 * 4096); const int n16 = (N0P - N0) * 4096 * 2 / 16;
          for (int i = c * 512 + threadIdx.x; i < n16; i += G * 512) pad[i] = z; }
        cast_rstd_phase(p.x, ACTA, RSTD0);
        tables_phase(p, COS, SIN, LB);
    }
    grid.sync();
    if (EN(1)) {
        pg8::Gemm g{ACTA, W0IN, T_TOK, N0P, 4096, 4096}; pg8::StaticOrder S; S.init(T_TOK, N0P, G, c);
        pg8::EpiBf16<1> E{PROJ0, N0P, RSTD0, 1600, nullptr};
        pg8::gemm_phase(ldsl, g, S, E);
    }
    grid.sync();
    if (EN(2)) stats_krot_phase(PROJ0, RSTDQ, RSTDKV, COS, SIN, KROT);
    grid.sync();
    if (EN(3)) {
        pg8::Gemm g{PROJ0, WUQ, T_TOK, NQ, 1024, N0P}; pg8::StaticOrder S; S.init(T_TOK, NQ, G, c);
        pg8::EpiBf16<0> E{QBUF, NQ, RSTDQ, 0, nullptr};
        pg8::gemm_phase(ldsl, g, S, E);
    }
    if (EN(3)) {
        pg8::Gemm g{PROJ0 + 1024, WUKV, T_TOK, NKV, 512, N0P}; pg8::StaticOrder S; S.init(T_TOK, NKV, G, c);
        pg8::EpiBf16<0> E{KVBUF, NKV, RSTDKV, 0, nullptr};
        pg8::gemm_phase(ldsl, g, S, E);
    }
    grid.sync();
    if (EN(4)) {
        att::Tensors T{QBUF, KVBUF, KROT, ACTA, PROJ0, COS, SIN};
        att::attn_phase((char*)lds, T);
    }
    grid.sync();
    if (EN(5)) {
        pg8::Gemm g{ACTA, W0O, T_TOK, 4096, 4096, 4096}; pg8::StaticOrder S; S.init(T_TOK, 4096, G, c);
        pg8::EpiResF32 E{p.x, p.out, 4096};
        pg8::gemm_phase(ldsl, g, S, E);
    }
    grid.sync();
    if (EN(6)) cast_rstd_phase(p.out, ACTA, RSTD1);
    grid.sync();
    if (EN(7)) {
        pg8::Gemm g{ACTA, W1IN, T_TOK, N1, 4096, 4096}; pg8::StaticOrder S; S.init(T_TOK, N1, G, c);
        pg8::EpiBf16<2> E{PROJ1, N1, RSTD1, 0, LB};
        pg8::gemm_phase(ldsl, g, S, E);
    }
    grid.sync();
    if (EN(8)) hg::hgrn2_phase((char*)lds, PROJ1, ACTA);
    grid.sync();
    if (EN(9)) headnorm_phase(PROJ1, ACTA, p.l1_g_norm);
    grid.sync();
    if (EN(10)) {
        pg8::Gemm g{PROJ1 + 8192, W1O, T_TOK, 4096, 4096, N1}; pg8::StaticOrder S; S.init(T_TOK, 4096, G, c);
        pg8::EpiResF32 E{p.out, p.out, 4096};
        pg8::gemm_phase(ldsl, g, S, E);
    }
    grid.sync();
    if (EN(11)) final_norm_phase(p.out, p.final_norm);
}

extern "C" void kernel_launch(void* const* d_in, const int* in_sizes, int n_in, void* d_out, int out_size, void* d_ws, size_t ws_size, hipStream_t stream) {
    static int grid = 0;
    if (grid == 0) {
        if (n_in != 15 || ws_size < WS_END) { fprintf(stderr, "kernel_launch: unexpected inputs (n_in %d, ws %zu, need %zu)\n", n_in, ws_size, (size_t)WS_END); grid = -1; return; }
        int dev = 0, cus = 0, per_cu = 0;
        (void)hipGetDevice(&dev); (void)hipDeviceGetAttribute(&cus, hipDeviceAttributeMultiprocessorCount, dev);
        if (hipFuncSetAttribute((const void*)mla_hgrn2_fwd, hipFuncAttributeMaxDynamicSharedMemorySize, LDS_TOTAL) != hipSuccess) { fprintf(stderr, "kernel_launch: hipFuncSetAttribute failed\n"); grid = -1; return; }
        if (hipOccupancyMaxActiveBlocksPerMultiprocessor(&per_cu, (const void*)mla_hgrn2_fwd, 512, LDS_TOTAL) != hipSuccess || per_cu < 1) { fprintf(stderr, "kernel_launch: occupancy query gave %d\n", per_cu); per_cu = 1; }
        (void)hipGetLastError();
        if (cus <= 0) cus = 256;
        grid = cus * per_cu;
        fprintf(stderr, "kernel_launch: grid %d (cus %d x %d)\n", grid, cus, per_cu);
    }
    if (grid < 0) return;
    Params p{};
    p.x = (const float*)d_in[0]; p.pos = (const int*)d_in[1]; p.l0_norm = (const float*)d_in[2]; p.l0_w_in = (const float*)d_in[3]; p.l0_q_norm = (const float*)d_in[4];
    p.l0_w_uq = (const float*)d_in[5]; p.l0_kv_norm = (const float*)d_in[6]; p.l0_w_ukv = (const float*)d_in[7]; p.l0_w_o = (const float*)d_in[8]; p.l1_norm = (const float*)d_in[9];
    p.l1_w_in = (const float*)d_in[10]; p.l1_g_norm = (const float*)d_in[11]; p.l1_w_o = (const float*)d_in[12]; p.lower_bounds = (const float*)d_in[13]; p.final_norm = (const float*)d_in[14];
    p.out = (float*)d_out; p.ws = (unsigned char*)d_ws;
    for (int j = 0; j < 32; ++j) p.inv_freq[j] = (float)(1.0 / pow(10000.0, (double)(2 * j) / 64.0));
    void* args[] = {&p};
    hipError_t e = hipLaunchCooperativeKernel((const void*)mla_hgrn2_fwd, dim3(grid), dim3(512), args, LDS_TOTAL, stream);
    if (e != hipSuccess) fprintf(stderr, "kernel_launch: cooperative launch failed: %s (grid %d)\n", hipGetErrorString(e), grid);
}
```

```cpp
#include <hip/hip_runtime.h>
#include <hip/hip_cooperative_groups.h>
#include <cstdio>
#include <cstdint>
#include <cmath>
namespace cg = cooperative_groups;

typedef unsigned short bf16_t;
typedef short bf16x8 __attribute__((ext_vector_type(8)));
typedef short s16x4 __attribute__((ext_vector_type(4)));
typedef float f32x4 __attribute__((ext_vector_type(4)));
typedef float f32x16 __attribute__((ext_vector_type(16)));
typedef unsigned u32x4 __attribute__((ext_vector_type(4)));
typedef unsigned u32x2 __attribute__((ext_vector_type(2)));
#define LAS __attribute__((address_space(3)))

constexpr int T_TOK = 16384, SEQ = 8192, DM = 4096;
constexpr int N0 = 5696, N0P = 5888;
constexpr int NQ = 6144, NKV = 8192, N1 = 16384;
constexpr float EPS = 1e-6f;

constexpr size_t WS_W0IN = 0;
constexpr size_t WS_WUQ  = WS_W0IN + (size_t)N0P * 4096 * 2;
constexpr size_t WS_WUKV = WS_WUQ + (size_t)NQ * 1024 * 2;
constexpr size_t WS_W0O  = WS_WUKV + (size_t)NKV * 512 * 2;
constexpr size_t WS_W1IN = WS_W0O + (size_t)4096 * 4096 * 2;
constexpr size_t WS_W1O  = WS_W1IN + (size_t)N1 * 4096 * 2;
constexpr size_t WS_RSTD0 = WS_W1O + (size_t)4096 * 4096 * 2;
constexpr size_t WS_RSTDQ = WS_RSTD0 + 65536;
constexpr size_t WS_RSTDKV = WS_RSTDQ + 65536;
constexpr size_t WS_RSTD1 = WS_RSTDKV + 65536;
constexpr size_t WS_LB = WS_RSTD1 + 65536;
constexpr size_t WS_COS = WS_LB + 16384;
constexpr size_t WS_SIN = WS_COS + (size_t)T_TOK * 32 * 4;
constexpr size_t WS_KROT = WS_SIN + (size_t)T_TOK * 32 * 4;
constexpr size_t WS_ACTA = WS_KROT + (size_t)T_TOK * 64 * 2;
constexpr size_t WS_R = WS_ACTA + (size_t)T_TOK * 4096 * 2;
constexpr size_t WS_PROJ0 = WS_R;
constexpr size_t WS_Q = WS_PROJ0 + (size_t)T_TOK * N0P * 2;
constexpr size_t WS_PROJ1 = WS_R;
constexpr size_t WS_END = WS_R + (size_t)T_TOK * N1 * 2;

struct Params {
    const float* x; const int* pos; const float* l0_norm; const float* l0_w_in; const float* l0_q_norm; const float* l0_w_uq;
    const float* l0_kv_norm; const float* l0_w_ukv; const float* l0_w_o; const float* l1_norm; const float* l1_w_in;
    const float* l1_g_norm; const float* l1_w_o; const float* lower_bounds; const float* final_norm;
    float* out; unsigned char* ws;
    float inv_freq[32];
};

__device__ __forceinline__ unsigned cvtpk(float lo, float hi) { unsigned r; asm volatile("v_cvt_pk_bf16_f32 %0, %1, %2" : "=v"(r) : "v"(lo), "v"(hi)); return r; }
typedef float f32x2 __attribute__((ext_vector_type(2)));
typedef __bf16 bf16x2_t __attribute__((ext_vector_type(2)));
__device__ __forceinline__ unsigned cvtpk_n(float lo, float hi) { f32x2 v = {lo, hi}; bf16x2_t h = __builtin_convertvector(v, bf16x2_t); return __builtin_bit_cast(unsigned, h); }
__device__ __forceinline__ bf16_t f2bf_n(float f) { return (bf16_t)(cvtpk_n(f, 0.f) & 0xffffu); }
__device__ __forceinline__ bf16_t f2bf(float f) { return (bf16_t)(cvtpk(f, 0.f) & 0xffffu); }
__device__ __forceinline__ float bf2f(unsigned short h) { return __uint_as_float((unsigned)h << 16); }
__device__ __forceinline__ float bflo(unsigned w) { return __uint_as_float(w << 16); }
__device__ __forceinline__ float bfhi(unsigned w) { return __uint_as_float(w & 0xffff0000u); }
__device__ __forceinline__ bf16x8 pack8(f32x4 a, f32x4 b) {
    u32x4 w = {cvtpk(a[0], a[1]), cvtpk(a[2], a[3]), cvtpk(b[0], b[1]), cvtpk(b[2], b[3])};
    return *reinterpret_cast<bf16x8*>(&w);
}
__device__ __forceinline__ float fast_exp(float x) { return __builtin_amdgcn_exp2f(x * 1.4426950408889634f); }
__device__ __forceinline__ float silu_f(float v) { return v * __builtin_amdgcn_rcpf(1.0f + fast_exp(-v)); }
__device__ __forceinline__ float wave_sum(float v) {
#pragma unroll
    for (int o = 32; o > 0; o >>= 1) v += __shfl_xor(v, o);
    return v;
}

namespace pg8 {
constexpr int BM = 256, BK = 64, HALF = 128, HTB = HALF * BK * 2, STAGE_BYTES = 8 * HTB, NXCD = 8, WGM = 8;
__host__ __device__ __forceinline__ int lds_byte(int r, int c) { const int st = (r >> 4) * 2 + (c >> 5), rr = r & 15, cc = c & 31, ob = rr * 64 + cc * 2; return st * 1024 + (ob ^ (((ob >> 9) & 1) << 5)); }
__host__ __device__ __forceinline__ void stage_rc(int b, int& R, int& C) { const int st = b / 1024, sb = b % 1024, swz = sb ^ (((sb >> 9) & 1) << 5); R = (st >> 1) * 16 + swz / 64; C = (st & 1) * 32 + (swz % 64) / 2; }
__host__ __device__ __forceinline__ int perm32(int rho) { const int n = rho >> 4, i = rho & 15; return 8 * (i >> 2) + 4 * n + (i & 3); }
struct Unit { int pm, pn; };
struct Gemm { const bf16_t* A; const bf16_t* Bt; int M, N, K, lda; };
struct StaticOrder {
    int nM, nN, nwg, G, c, dup;
    __device__ void init(int M, int N, int G_, int c_, int dup_ = 0) { nM = M / BM; nN = N / BM; nwg = nM * nN; G = G_; c = c_; dup = dup_; }
    __device__ bool next(int i, Unit& u) const {
        const long L = (long)(i >> dup) * G + c; if (L >= nwg) return false;
        int wgid = (int)L; { const int q = nwg / NXCD, r = nwg % NXCD, xcd = wgid % NXCD, off = wgid / NXCD; wgid = (xcd < r ? xcd * (q + 1) : r * (q + 1) + (xcd - r) * q) + off; }
        const int nig = WGM * nN, gid = wgid / nig, fm = gid * WGM, gsz = (nM - fm) < WGM ? (nM - fm) : WGM;
        u.pm = fm + ((wgid % nig) % gsz); u.pn = (wgid % nig) / gsz; return true;
    }
};

template <int MODE> struct EpiBf16 {
    static constexpr bool PERM = true;
    bf16_t* O; int ldc; const float* rs; int thr; const float* lb;
    __device__ __forceinline__ void operator()(const f32x4 (&acc)[2][2][4][2], const Unit& u, int wr, int wc, int fr, int fq) const {
        const int row0 = u.pm * BM + wr * 64 + fr, col0 = u.pn * BM + wc * 32 + 8 * fq;
        const int sec = (u.pn * BM) >> 12;
        f32x4 lbv[2][2] = {};
        if (MODE == 2) { if (sec == 1) {
#pragma unroll
            for (int bj = 0; bj < 2; ++bj) { lbv[bj][0] = *(const f32x4*)(lb + col0 + bj * HALF - 4096); lbv[bj][1] = *(const f32x4*)(lb + col0 + bj * HALF - 4096 + 4); } } }
        float rsv[2][4];
#pragma unroll
        for (int ai = 0; ai < 2; ++ai)
#pragma unroll
            for (int m = 0; m < 4; ++m) rsv[ai][m] = rs[row0 + ai * HALF + m * 16];
#pragma unroll
        for (int ai = 0; ai < 2; ++ai)
#pragma unroll
            for (int m = 0; m < 4; ++m) {
                const int row = row0 + ai * HALF + m * 16; const float s = rsv[ai][m];
                bf16_t* rowp = O + (size_t)row * ldc + col0;
#pragma unroll
                for (int bj = 0; bj < 2; ++bj) {
                    f32x4 v0 = acc[ai][bj][m][0] * s, v1 = acc[ai][bj][m][1] * s;
                    const int col = col0 + bj * HALF;
                    if (MODE == 1) { if (col >= thr) {
#pragma unroll
                        for (int j = 0; j < 4; ++j) { v0[j] = silu_f(v0[j]); v1[j] = silu_f(v1[j]); } } }
                    if (MODE == 2) {
                        if (sec == 0 || sec == 3) {
#pragma unroll
                            for (int j = 0; j < 4; ++j) { v0[j] = silu_f(v0[j]); v1[j] = silu_f(v1[j]); } }
                        else if (sec == 1) {
                            const f32x4 l0 = lbv[bj][0], l1 = lbv[bj][1];
#pragma unroll
                            for (int j = 0; j < 4; ++j) {
                                float sg = __builtin_amdgcn_rcpf(1.0f + fast_exp(-v0[j])); float fg = l0[j] + (1.0f - l0[j]) * sg; v0[j] = __logf(fg);
                                sg = __builtin_amdgcn_rcpf(1.0f + fast_exp(-v1[j])); fg = l1[j] + (1.0f - l1[j]) * sg; v1[j] = __logf(fg); }
                        }
                    }
                    u32x4 w; w.x = cvtpk(v0[0], v0[1]); w.y = cvtpk(v0[2], v0[3]); w.z = cvtpk(v1[0], v1[1]); w.w = cvtpk(v1[2], v1[3]);
                    *(u32x4*)(rowp + bj * HALF) = w;
                }
            }
    }
};
struct EpiResF32 {
    static constexpr bool PERM = false;
    const float* base; float* out; int ldc;
    __device__ __forceinline__ void operator()(const f32x4 (&acc)[2][2][4][2], const Unit& u, int wr, int wc, int fr, int fq) const {
        const int row0 = u.pm * BM + wr * 64 + fr, col0 = u.pn * BM + wc * 32 + 4 * fq;
        f32x4 bs[2][4];
#define RES_LOAD(g, slot) do { const size_t off_ = (size_t)(row0 + ((g) >> 2) * HALF + ((g) & 3) * 16) * ldc + col0; \
        _Pragma("unroll") for (int bj = 0; bj < 2; ++bj) _Pragma("unroll") for (int n = 0; n < 2; ++n) bs[slot][bj * 2 + n] = *(const f32x4*)(base + off_ + bj * HALF + n * 16); } while (0)
        RES_LOAD(0, 0);
#pragma unroll
        for (int g = 0; g < 8; ++g) {
            if (g + 1 < 8) RES_LOAD(g + 1, (g + 1) & 1);
            const int ai = g >> 2, m = g & 3; const size_t off = (size_t)(row0 + ai * HALF + m * 16) * ldc + col0;
#pragma unroll
            for (int bj = 0; bj < 2; ++bj)
#pragma unroll
                for (int n = 0; n < 2; ++n) *(f32x4*)(out + off + bj * HALF + n * 16) = bs[g & 1][bj * 2 + n] + acc[ai][bj][m][n];
        }
#undef RES_LOAD
    }
};

template <class Epi, class Sched>
__device__ __forceinline__ void gemm_phase(LAS unsigned char* lds, const Gemm g, const Sched& S, const Epi& E) {
    int tid = threadIdx.x; asm volatile("" : "+v"(tid));
    const int wid = __builtin_amdgcn_readfirstlane(tid >> 6), lane = tid & 63, wr = wid >> 2, wc = wid & 3, fr = lane & 15, fq = lane >> 4;
    const int K = g.K, nt = K / BK, lda = g.lda;
    unsigned voffA[2], voffB[2];
#pragma unroll
    for (int i = 0; i < 2; ++i) { int R, C; stage_rc(tid * 16 + i * 8192, R, C); const int Rb = Epi::PERM ? ((R & ~31) + perm32(R & 31)) : R;
        voffA[i] = (unsigned)(R * lda + C) * 2u; voffB[i] = (unsigned)(Rb * K + C) * 2u; }
    const size_t kstep = (size_t)(BK * 2);
    const size_t hstepA = (size_t)HALF * lda * 2, hstepB = (size_t)HALF * K * 2;
    const size_t tstepA = 2 * hstepA, tstepB = 2 * hstepB;
    const unsigned ldsw = (unsigned)wid * 1024u;
    const int aoff = lds_byte(wr * 64 + fr, fq * 8), boff = lds_byte(wc * 32 + fr, fq * 8);
#define PG8_SA(b, h) (((b) * 2 + (h)) * HTB)
#define PG8_SB(b, h) ((4 + (b) * 2 + (h)) * HTB)
#define PG8_STAGE(bufoff, gbase, voff) do { _Pragma("unroll") for (int _i = 0; _i < 2; ++_i) \
        __builtin_amdgcn_global_load_lds((const unsigned*)((const char*)(gbase) + (voff)[_i]), (LAS unsigned*)(lds + (bufoff) + ldsw + _i * 8192), 16, 0, 0); } while (0)
#define PG8_LDA(dst, b, h) do { _Pragma("unroll") for (int m = 0; m < 4; ++m) _Pragma("unroll") for (int k = 0; k < 2; ++k) dst[m][k] = *(const LAS bf16x8*)(lds + PG8_SA(b, h) + aoff + m * 2048 + k * 1024); } while (0)
#define PG8_LDB(dst, b, h) do { _Pragma("unroll") for (int n = 0; n < 2; ++n) _Pragma("unroll") for (int k = 0; k < 2; ++k) dst[n][k] = *(const LAS bf16x8*)(lds + PG8_SB(b, h) + boff + n * 2048 + k * 1024); } while (0)
#define PG8_MMA(ai, bj, At, Bt) do { __builtin_amdgcn_s_setprio(1); _Pragma("unroll") for (int m = 0; m < 4; ++m) _Pragma("unroll") for (int n = 0; n < 2; ++n) _Pragma("unroll") for (int k = 0; k < 2; ++k) \
        acc[ai][bj][m][n] = __builtin_amdgcn_mfma_f32_16x16x32_bf16(Bt[n][k], At[m][k], acc[ai][bj][m][n], 0, 0, 0); __builtin_amdgcn_s_setprio(0); } while (0)
#define PG8_WAIT_V(n) asm volatile("s_waitcnt vmcnt(" #n ")" ::: "memory")
#define PG8_WAIT_L(n) asm volatile("s_waitcnt lgkmcnt(" #n ")" ::: "memory")
#define PG8_BAR __builtin_amdgcn_s_barrier()
#define PG8_SCHED __builtin_amdgcn_sched_barrier(0)
    Unit cur, nxt; int ui = 0;
    if (!S.next(0, cur)) return;
    f32x4 acc[2][2][4][2];
#pragma unroll
    for (int a = 0; a < 2; ++a)
#pragma unroll
        for (int b = 0; b < 2; ++b)
#pragma unroll
            for (int m = 0; m < 4; ++m)
#pragma unroll
                for (int n = 0; n < 2; ++n) acc[a][b][m][n] = (f32x4){0.f, 0.f, 0.f, 0.f};
    bf16x8 At[4][2], B0[2][2], B1[2][2];
    const char* cA = (const char*)g.A + (size_t)cur.pm * tstepA; const char* cB = (const char*)g.Bt + (size_t)cur.pn * tstepB;
    PG8_STAGE(PG8_SB(0, 0), cB, voffB); PG8_STAGE(PG8_SA(0, 0), cA, voffA); PG8_STAGE(PG8_SB(0, 1), cB + hstepB, voffB); PG8_STAGE(PG8_SA(0, 1), cA + hstepA, voffA);
    if (wr == 1) PG8_BAR;
    PG8_WAIT_V(4); PG8_BAR;
    PG8_STAGE(PG8_SB(1, 0), cB + kstep, voffB); PG8_STAGE(PG8_SA(1, 0), cA + kstep, voffA); PG8_STAGE(PG8_SB(1, 1), cB + hstepB + kstep, voffB);
    PG8_WAIT_V(6); PG8_BAR;
    for (;;) {
        const bool has_next = S.next(ui + 1, nxt);
        const char* nA = has_next ? (const char*)g.A + (size_t)nxt.pm * tstepA : cA; const char* nB = has_next ? (const char*)g.Bt + (size_t)nxt.pn * tstepB : cB;
        for (int t = 0; t < nt; t += 2) {
            const bool last = (t == nt - 2);
            const char* a1 = cA + (size_t)(t + 1) * kstep;
            const char* a2 = last ? nA : cA + (size_t)(t + 2) * kstep; const char* b2 = last ? nB : cB + (size_t)(t + 2) * kstep;
            const char* a3 = a2 + kstep; const char* b3 = b2 + kstep;
            PG8_LDB(B0, 0, 0); PG8_SCHED; PG8_LDA(At, 0, 0); PG8_STAGE(PG8_SA(1, 1), a1 + hstepA, voffA);
            PG8_WAIT_L(8); PG8_BAR; PG8_WAIT_L(0); PG8_MMA(0, 0, At, B0); PG8_BAR; PG8_SCHED;
            PG8_LDB(B1, 0, 1); PG8_STAGE(PG8_SB(0, 0), b2, voffB);
            PG8_BAR; PG8_WAIT_L(0); PG8_MMA(0, 1, At, B1); PG8_BAR;
            PG8_LDA(At, 0, 1); PG8_STAGE(PG8_SA(0, 0), a2, voffA);
            PG8_BAR; PG8_WAIT_L(0); PG8_MMA(1, 0, At, B0); PG8_BAR; PG8_SCHED;
            PG8_STAGE(PG8_SB(0, 1), b2 + hstepB, voffB);
            PG8_WAIT_V(6); PG8_BAR; PG8_MMA(1, 1, At, B1); PG8_BAR;
            PG8_LDB(B0, 1, 0); PG8_SCHED; PG8_LDA(At, 1, 0); PG8_STAGE(PG8_SA(0, 1), a2 + hstepA, voffA);
            PG8_WAIT_L(8); PG8_BAR; PG8_WAIT_L(0); PG8_MMA(0, 0, At, B0); PG8_BAR; PG8_SCHED;
            PG8_LDB(B1, 1, 1); PG8_STAGE(PG8_SB(1, 0), b3, voffB);
            PG8_BAR; PG8_WAIT_L(0); PG8_MMA(0, 1, At, B1); PG8_BAR;
            PG8_LDA(At, 1, 1); PG8_STAGE(PG8_SA(1, 0), a3, voffA);
            PG8_BAR; PG8_WAIT_L(0); PG8_MMA(1, 0, At, B0); PG8_BAR; PG8_SCHED;
            PG8_STAGE(PG8_SB(1, 1), b3 + hstepB, voffB);
            PG8_WAIT_V(6); PG8_BAR; PG8_MMA(1, 1, At, B1); PG8_BAR;
        }
        E(acc, cur, wr, wc, fr, fq);
        if (!has_next) break;
#pragma unroll
        for (int a = 0; a < 2; ++a)
#pragma unroll
            for (int b = 0; b < 2; ++b)
#pragma unroll
                for (int m = 0; m < 4; ++m)
#pragma unroll
                    for (int n = 0; n < 2; ++n) acc[a][b][m][n] = (f32x4){0.f, 0.f, 0.f, 0.f};
        cur = nxt; cA = nA; cB = nB; ++ui;
    }
    PG8_WAIT_V(0);
    if (wr == 0) PG8_BAR;
    PG8_BAR;
#undef PG8_SA
#undef PG8_SB
#undef PG8_STAGE
#undef PG8_LDA
#undef PG8_LDB
#undef PG8_MMA
#undef PG8_WAIT_V
#undef PG8_WAIT_L
#undef PG8_BAR
#undef PG8_SCHED
}
}
namespace att {
constexpr int NW = 8, QBLK = 32, KVBLK = 64, QB = NW * QBLK;
constexpr int DQ = 192, DV = 128;
constexpr int QS = NQ, KVS = NKV, KRS = 64, OS = 4096, ZS = N0P;
constexpr int SHM_V = KVBLK * DV * 2, SHM_K = KVBLK * DQ * 2;
constexpr int QR_OFF = 2 * SHM_V + 2 * SHM_K + NW * 64 * 4;
constexpr int LDS_BYTES = QR_OFF + NW * 4096;
constexpr float SCALE = 0.07216878364870322f;
constexpr float THR = 8.f;
constexpr unsigned WBIG = 0x40000000u;

#define KSWZ(row, colB) ((row) * 384 + ((colB) ^ (((row) & 7) << 4)))
#define SBAR() __builtin_amdgcn_sched_barrier(0)
__device__ __forceinline__ int v_st(int k, int c) { const int kk = (k & ~0xC) | ((k & 4) << 1) | ((k & 8) >> 1); return ((kk >> 3) * 4 + (c >> 5)) * 512 + ((kk & 7) * 32 + (c & 31)) * 2; }
__device__ __forceinline__ int v_rd_base(int lane) { return ((lane & 3) << 3) | (((lane >> 2) & 3) << 6) | (((lane >> 4) & 1) << 5) | (((lane >> 5) & 1) << 8); }
constexpr int v_rd_off(int d0, int ks, int half) { return d0 * 512 + ks * 4096 + half * 2048; }
__device__ __forceinline__ int crow(int r, int hi) { return (r & 3) + 8 * (r >> 2) + 4 * hi; }
__device__ __forceinline__ bf16x8 load8(const bf16_t* p) { return *reinterpret_cast<const bf16x8*>(p); }

__device__ __forceinline__ void mask_tile(f32x16& p0, f32x16& p1, int dq) {
    const float NEG = -__builtin_inff();
#pragma unroll
    for (int r = 0; r < 16; ++r) {
        const int c = (r & 3) + 8 * (r >> 2);
        if ((unsigned)(dq - c) >= WBIG) p0[r] = NEG;
        if ((unsigned)(dq - c - 32) >= WBIG) p1[r] = NEG;
    }
}
__device__ __forceinline__ void partialSM(f32x16& p0, f32x16& p1, float& m_reg, float& mn, float& alpha) {
    float pmax = p0[0];
#pragma unroll
    for (int r = 1; r < 16; ++r) pmax = fmaxf(pmax, p0[r]);
#pragma unroll
    for (int r = 0; r < 16; ++r) pmax = fmaxf(pmax, p1[r]);
    { auto rr = __builtin_amdgcn_permlane32_swap(__float_as_uint(pmax), __float_as_uint(pmax), false, false);
      pmax = fmaxf(__uint_as_float(rr[0]), __uint_as_float(rr[1])); }
    constexpr float C2 = 1.4426950408889634f * SCALE;
    if (__builtin_expect(__all((pmax - m_reg) * SCALE <= THR), 1)) { mn = m_reg; alpha = 1.f; }
    else { mn = fmaxf(m_reg, pmax); alpha = __builtin_amdgcn_exp2f((m_reg - mn) * C2); m_reg = mn; }
    const float mnL = -mn * C2;
#pragma unroll
    for (int r = 0; r < 16; ++r) p0[r] = fmaf(p0[r], C2, mnL);
#pragma unroll
    for (int r = 0; r < 16; ++r) p1[r] = fmaf(p1[r], C2, mnL);
#pragma unroll
    for (int r = 0; r < 16; ++r) p0[r] = __builtin_amdgcn_exp2f(p0[r]);
}
__device__ __forceinline__ void finishSM(f32x16& p0, f32x16& p1, float alpha, float& l_reg, bf16x8& pa0, bf16x8& pa1, bf16x8& pa2, bf16x8& pa3) {
#pragma unroll
    for (int r = 0; r < 16; ++r) p1[r] = __builtin_amdgcn_exp2f(p1[r]);
    float ps = 0;
#pragma unroll
    for (int r = 0; r < 16; ++r) ps += p0[r];
#pragma unroll
    for (int r = 0; r < 16; ++r) ps += p1[r];
    { auto rr = __builtin_amdgcn_permlane32_swap(__float_as_uint(ps), __float_as_uint(ps), false, false);
      ps = __uint_as_float(rr[0]) + __uint_as_float(rr[1]); }
    l_reg = l_reg * alpha + ps;
#define PK4(P, B_, OUT) do { unsigned a0 = cvtpk(P[B_+0], P[B_+1]), a1 = cvtpk(P[B_+2], P[B_+3]);                          \
        unsigned b0 = cvtpk(P[B_+4], P[B_+5]), b1 = cvtpk(P[B_+6], P[B_+7]);                                             \
        auto r0 = __builtin_amdgcn_permlane32_swap(a0, b0, false, false); auto r1 = __builtin_amdgcn_permlane32_swap(a1, b1, false, false); \
        u32x4 w = {r0[0], r1[0], r0[1], r1[1]}; OUT = *reinterpret_cast<bf16x8*>(&w); } while (0)
    PK4(p0, 0, pa0); PK4(p0, 8, pa1); PK4(p1, 0, pa2); PK4(p1, 8, pa3);
#undef PK4
}
template <int KB>
__device__ __forceinline__ void qkt(f32x16& p0, f32x16& p1, const char* K_lds, int r32, int hi, const bf16x8* qr, const char* qrl) {
    p0 = f32x16{}; p1 = f32x16{};
    const char* kb[4];
#pragma unroll
    for (int dd = 0; dd < 4; ++dd) kb[dd] = K_lds + KB * SHM_K + KSWZ(r32, (dd * 16 + hi * 8) * 2);
#pragma unroll
    for (int d0 = 0; d0 < 12; ++d0) { const char* a = kb[d0 & 3] + (d0 >> 2) * 128;
        bf16x8 b0 = *reinterpret_cast<const bf16x8*>(a);
        bf16x8 b1 = *reinterpret_cast<const bf16x8*>(a + 32 * 384);
        bf16x8 qf; if (d0 < 8) qf = qr[d0]; else qf = *reinterpret_cast<const bf16x8*>(qrl + (d0 - 8) * 1024);
        p0 = __builtin_amdgcn_mfma_f32_32x32x16_bf16(b0, qf, p0, 0, 0, 0);
        p1 = __builtin_amdgcn_mfma_f32_32x32x16_bf16(b1, qf, p1, 0, 0, 0);
    }
}
template <int VB>
__device__ __forceinline__ void pv_tile(f32x16* o, int vb0, bf16x8 pa0, bf16x8 pa1, bf16x8 pa2, bf16x8 pa3) {
#define TRRD(dst, off) asm volatile("ds_read_b64_tr_b16 %0, %1 offset:%2" : "=&v"(dst) : "v"(vb0), "i"(off) : "memory")
#define PV_D0(d0) do { s16x4 l0, l1, l2, l3, h0, h1, h2, h3; constexpr int b_ = VB * SHM_V + v_rd_off(d0, 0, 0); \
        TRRD(l0, b_); TRRD(h0, b_ + 2048); TRRD(l1, b_ + 4096); TRRD(h1, b_ + 6144); TRRD(l2, b_ + 8192); TRRD(h2, b_ + 10240); TRRD(l3, b_ + 12288); TRRD(h3, b_ + 14336); \
        asm volatile("s_waitcnt lgkmcnt(0)" ::: "memory"); SBAR();   \
        o[d0] = __builtin_amdgcn_mfma_f32_32x32x16_bf16(pa0, (bf16x8){l0[0], l0[1], l0[2], l0[3], h0[0], h0[1], h0[2], h0[3]}, o[d0], 0, 0, 0);   \
        o[d0] = __builtin_amdgcn_mfma_f32_32x32x16_bf16(pa1, (bf16x8){l1[0], l1[1], l1[2], l1[3], h1[0], h1[1], h1[2], h1[3]}, o[d0], 0, 0, 0);   \
        o[d0] = __builtin_amdgcn_mfma_f32_32x32x16_bf16(pa2, (bf16x8){l2[0], l2[1], l2[2], l2[3], h2[0], h2[1], h2[2], h2[3]}, o[d0], 0, 0, 0);   \
        o[d0] = __builtin_amdgcn_mfma_f32_32x32x16_bf16(pa3, (bf16x8){l3[0], l3[1], l3[2], l3[3], h3[0], h3[1], h3[2], h3[3]}, o[d0], 0, 0, 0); } while (0)
    PV_D0(0); PV_D0(1); PV_D0(2); PV_D0(3);
#undef PV_D0
#undef TRRD
}

struct BlockRef { const bf16_t* Q; const bf16_t* K; const bf16_t* KR; const bf16_t* V; bf16_t* O; const bf16_t* Z; const float* CS; const float* SN; int P0; };
struct Stage { bf16x8 st_v0, st_v1, st_k0, st_k1, st_kr; };
#define VMW() asm volatile("s_waitcnt vmcnt(0)" ::: "memory")
#define SLOAD_H(R, k0) do { const char* kt_ = (const char*)(R).K + (size_t)(k0) * (KVS * 2); const char* kt2_ = kt_ + 32 * KVS * 2; const char* krt_ = (const char*)(R).KR + (size_t)(k0) * (KRS * 2); \
                            S.st_v0 = *(const bf16x8*)(kt_ + koff + 256); S.st_v1 = *(const bf16x8*)(kt2_ + koff + 256);  \
                            S.st_k0 = *(const bf16x8*)(kt_ + koff); S.st_k1 = *(const bf16x8*)(kt2_ + koff);  \
                            S.st_kr = *(const bf16x8*)(krt_ + kroff); } while (0)
#define SWRITE_HK(bf) do { *(bf16x8*)(K_lds + (bf) * SHM_K + kws) = S.st_k0; *(bf16x8*)(K_lds + (bf) * SHM_K + kws + 32 * 384) = S.st_k1; \
                           *(bf16x8*)(K_lds + (bf) * SHM_K + kwr) = S.st_kr; } while (0)
#define SWRITE_HV(bf) do { *(bf16x8*)(V_lds + (bf) * SHM_V + vst0) = S.st_v0; *(bf16x8*)(V_lds + (bf) * SHM_V + vst1) = S.st_v1; } while (0)
#define SWRITE_H(bf) do { SWRITE_HV(bf); SWRITE_HK(bf); } while (0)

__device__ __forceinline__ void rope_q(const BlockRef& cur, const bf16x8* qrp, char* qrl, int wid, int r32, int hi) {
    const int row = wid * QBLK + r32;
    const unsigned toff = (unsigned)((row * 32 + hi * 8) * 4);
    const float* cp = (const float*)((const char*)cur.CS + toff); const float* sp = (const float*)((const char*)cur.SN + toff);
#pragma unroll
    for (int pr = 0; pr < 2; ++pr) {
        const f32x4 c0 = *(const f32x4*)(cp + pr * 16), c1 = *(const f32x4*)(cp + pr * 16 + 4), s0 = *(const f32x4*)(sp + pr * 16), s1 = *(const f32x4*)(sp + pr * 16 + 4);
        const bf16x8 a = qrp[pr], b = qrp[2 + pr];
        f32x4 o1l, o1h, o2l, o2h;
#pragma unroll
        for (int j = 0; j < 4; ++j) {
            float t1 = bf2f((unsigned short)a[j]), t2 = bf2f((unsigned short)b[j]);
            o1l[j] = t1 * c0[j] - t2 * s0[j]; o2l[j] = t2 * c0[j] + t1 * s0[j];
            t1 = bf2f((unsigned short)a[4 + j]); t2 = bf2f((unsigned short)b[4 + j]);
            o1h[j] = t1 * c1[j] - t2 * s1[j]; o2h[j] = t2 * c1[j] + t1 * s1[j];
        }
        *(bf16x8*)(qrl + pr * 1024) = pack8(o1l, o1h); *(bf16x8*)(qrl + (2 + pr) * 1024) = pack8(o2l, o2h);
    }
}
__device__ __forceinline__ void causal_block(const BlockRef& cur, char* lds) {
    int tid = threadIdx.x; asm volatile("" : "+v"(tid));
    const int wid = __builtin_amdgcn_readfirstlane(tid >> 6), lane = tid & 63, r32 = lane & 31, hi = lane >> 5;
    const int NT = (cur.P0 + QB - 1) / KVBLK + 1;
    const int qlo = cur.P0 + wid * QBLK, qm = qlo + r32 - 4 * hi;
    char* V_lds = lds; char* K_lds = lds + 2 * SHM_V;
    float* ws = (float*)(lds + 2 * SHM_V + 2 * SHM_K) + wid * 64; float* li_l = ws, * al_l = ws + 32;
    float m_reg = -1e30f, l_reg = 0; f32x16 o[4] = {};
    const int sr = tid >> 4, sc = (tid & 15) * 8, vst0 = v_st(sr, sc), vst1 = v_st(32 + sr, sc), kws = KSWZ(sr, sc * 2);
    const int krr = tid >> 3, krc = (tid & 7) * 8, kwr = KSWZ(krr, (128 + krc) * 2);
    const int vb0 = (int)(uintptr_t)V_lds + v_rd_base(lane);
    unsigned koff = (unsigned)((sr * KVS + sc) * 2), kroff = (unsigned)((krr * KRS + krc) * 2);
    unsigned qoff = (unsigned)(((wid * QBLK + r32) * QS + hi * 8) * 2);
    asm volatile("" : "+v"(koff), "+v"(kroff), "+v"(qoff));
    Stage S; bf16x8 qr[8]; char* qrl = lds + QR_OFF + wid * 4096 + lane * 16;
    { bf16x8 qrp[4];
#pragma unroll
      for (int d0 = 0; d0 < 8; ++d0) qr[d0] = *(const bf16x8*)((const char*)cur.Q + qoff + d0 * 32);
#pragma unroll
      for (int d0 = 0; d0 < 4; ++d0) qrp[d0] = *(const bf16x8*)((const char*)cur.Q + qoff + (8 + d0) * 32);
      SLOAD_H(cur, 0);
      rope_q(cur, qrp, qrl, wid, r32, hi); }
    VMW(); SWRITE_H(0); SBAR();
    SLOAD_H(cur, KVBLK); SBAR();
    __syncthreads();
#define RESC(a) do { if (__any((a) < 1.f)) { if (hi == 0) al_l[r32] = (a); asm volatile("s_waitcnt lgkmcnt(0)" ::: "memory");              \
                     for (int d_ = 0; d_ < 4; ++d_) for (int r = 0; r < 16; ++r) o[d_][r] *= al_l[crow(r, hi)]; } } while (0)
#define KBASE(t) ((t) * KVBLK)
#define MASKT(P0_, P1_, t) do { const int kb_ = KBASE(t); if (kb_ + KVBLK - 1 > qlo) mask_tile(P0_, P1_, qm - kb_); } while (0)
    f32x16 pA0, pA1, pB0, pB1; float mnA, mnB, alA, alB; bf16x8 pa0, pa1, pa2, pa3;
    qkt<0>(pA0, pA1, K_lds, r32, hi, qr, qrl);
    MASKT(pA0, pA1, 0); partialSM(pA0, pA1, m_reg, mnA, alA);
    VMW(); SWRITE_H(1);
    __syncthreads();
#define HALF_STEP(PX0, PX1, mnX, alX, PY0, PY1, alY, t, KB, VB, SB) do {                                                      \
        SBAR(); qkt<KB>(PX0, PX1, K_lds, r32, hi, qr, qrl);                                                                        \
        finishSM(PY0, PY1, alY, l_reg, pa0, pa1, pa2, pa3); SBAR();                                                           \
        if ((t) + 1 < NT) { SLOAD_H(cur, KBASE((t) + 1)); SBAR(); }                                                           \
        pv_tile<VB>(o, vb0, pa0, pa1, pa2, pa3); MASKT(PX0, PX1, (t)); partialSM(PX0, PX1, m_reg, mnX, alX);                  \
        __syncthreads();                                                                                                      \
        if ((t) + 1 < NT) { VMW(); SWRITE_H(SB); }                                                                            \
        RESC(alX); __syncthreads(); } while (0)
    for (int t = 1; t + 1 < NT; t += 2) {
        HALF_STEP(pB0, pB1, mnB, alB, pA0, pA1, alA, t, 1, 0, 0);
        HALF_STEP(pA0, pA1, mnA, alA, pB0, pB1, alB, t + 1, 0, 1, 1);
    }
    SBAR(); qkt<1>(pB0, pB1, K_lds, r32, hi, qr, qrl); SBAR();
    finishSM(pA0, pA1, alA, l_reg, pa0, pa1, pa2, pa3); SBAR();
    pv_tile<0>(o, vb0, pa0, pa1, pa2, pa3);
    MASKT(pB0, pB1, NT - 1); partialSM(pB0, pB1, m_reg, mnB, alB); __syncthreads(); RESC(alB);
    finishSM(pB0, pB1, alB, l_reg, pa0, pa1, pa2, pa3); SBAR(); pv_tile<1>(o, vb0, pa0, pa1, pa2, pa3);
    SBAR();
    if (hi == 0) li_l[r32] = l_reg;
    __syncthreads();
    {
        char* ot = lds + wid * (32 * 272);
        const int wb = 4 * hi * 272 + r32 * 2;
#pragma unroll
        for (int rg = 0; rg < 4; ++rg) {
            const f32x4 lv = *(const f32x4*)(li_l + 8 * rg + 4 * hi);
#pragma unroll
            for (int j = 0; j < 4; ++j) { const int r = rg * 4 + j; const float rl = __builtin_amdgcn_rcpf(lv[j]);
#pragma unroll
                for (int d0 = 0; d0 < 4; ++d0) *(bf16_t*)(ot + wb + (j + 8 * rg) * 272 + d0 * 64) = f2bf(o[d0][r] * rl); }
        }
        asm volatile("s_waitcnt lgkmcnt(0)" ::: "memory");
        const int rr = lane >> 4, c8 = (lane & 15) * 8;
        const unsigned zoff = (unsigned)(((wid * QBLK + rr) * ZS + c8) * 2), ooff = (unsigned)(((wid * QBLK + rr) * OS + c8) * 2);
#pragma unroll
        for (int i = 0; i < 8; ++i) {
            const bf16x8 ov = *(const bf16x8*)(ot + (i * 4 + rr) * 272 + c8 * 2);
            const bf16x8 zv = *(const bf16x8*)((const char*)cur.Z + (size_t)(i * 4 * ZS * 2) + zoff);
            f32x4 a, b;
#pragma unroll
            for (int j = 0; j < 4; ++j) { a[j] = bf2f((unsigned short)ov[j]) * bf2f((unsigned short)zv[j]); b[j] = bf2f((unsigned short)ov[4 + j]) * bf2f((unsigned short)zv[4 + j]); }
            *(bf16x8*)((char*)cur.O + (size_t)(i * 4 * OS * 2) + ooff) = pack8(a, b);
        }
    }
    __syncthreads();
#undef RESC
#undef KBASE
#undef MASKT
#undef HALF_STEP
}
#undef VMW
#undef SLOAD_H
#undef SWRITE_HK
#undef SWRITE_HV
#undef SWRITE_H

struct Item { int bh, qb0, qb1; };
constexpr int NQB = SEQ / QB, NX = NQB / 2, NBH = 64, TOTAL = NX * NBH;
__device__ __forceinline__ Item decode(int L) {
    Item it; const int xcd = L & 7, k = L >> 3, gi = k / NX, r = k - gi * NX;
    it.bh = gi * 8 + xcd; it.qb0 = r; it.qb1 = NQB - 1 - r; return it;
}
struct Tensors { const bf16_t* q; const bf16_t* kv; const bf16_t* krot; bf16_t* og; const bf16_t* proj0; const float* cs; const float* sn; };
__device__ __forceinline__ BlockRef mkref(const Item& it, int pass, const Tensors& T) {
    const int qb = pass ? it.qb1 : it.qb0, b = it.bh >> 5, h = it.bh & 31;
    const size_t tok0 = (size_t)b * SEQ, row0 = tok0 + (size_t)qb * QB;
    BlockRef r;
    r.Q = T.q + row0 * QS + h * DQ; r.K = T.kv + tok0 * KVS + h * 256; r.V = r.K + 128; r.KR = T.krot + tok0 * KRS;
    r.O = T.og + row0 * OS + h * DV; r.Z = T.proj0 + row0 * ZS + 1600 + h * DV; r.CS = T.cs + row0 * 32; r.SN = T.sn + row0 * 32; r.P0 = qb * QB;
    return r;
}
__device__ __forceinline__ void attn_phase(char* lds, const Tensors& T) {
#ifndef PROBE_ATTDUP
#define PROBE_ATTDUP 0
#endif
    for (int i = 0; ; ++i) {
        const int L = blockIdx.x + (i >> PROBE_ATTDUP) * gridDim.x; if (L >= TOTAL) break;
        const Item it = decode(L);
#pragma unroll 1
        for (int pass = 0; pass < 2; ++pass) { const BlockRef cur = mkref(it, pass, T); causal_block(cur, lds); }
    }
}
}
__device__ __forceinline__ void wt_phase(const float* __restrict__ W, int K, int N, const float* __restrict__ scale, bf16_t* __restrict__ out, float* tile  ) {
    const int tid = threadIdx.x, ntn = N / 64, ntk = K / 64, ntiles = ntn * ntk;
    for (int t = blockIdx.x; t < ntiles; t += gridDim.x) {
        const int kb = (t / ntn) * 64, nb = (t % ntn) * 64;
        { const int n = tid & 63, k0 = tid >> 6;
#pragma unroll
          for (int i = 0; i < 8; ++i) { const int k = k0 + i * 8; float v = W[(size_t)(kb + k) * N + nb + n]; if (scale) v *= scale[kb + k]; tile[k * 65 + n] = v; } }
        __syncthreads();
        { const int n = tid >> 3, kc = (tid & 7) * 8; f32x4 a, b;
#pragma unroll
          for (int j = 0; j < 4; ++j) { a[j] = tile[(kc + j) * 65 + n]; b[j] = tile[(kc + 4 + j) * 65 + n]; }
          *(bf16x8*)(out + (size_t)(nb + n) * K + kb + kc) = pack8(a, b); }
        __syncthreads();
    }
}
__device__ __forceinline__ void cast_rstd_phase(const float* __restrict__ src, bf16_t* __restrict__ dst, float* __restrict__ rstd) {
    const int lane = threadIdx.x & 63, gw = blockIdx.x * 8 + (threadIdx.x >> 6), nw = gridDim.x * 8;
    for (int row = gw; row < T_TOK; row += nw) {
        const float* s = src + (size_t)row * DM; bf16_t* d = dst + (size_t)row * DM; float ss = 0.f;
#pragma unroll
        for (int i = 0; i < 8; ++i) { const int c = (i * 64 + lane) * 8; const f32x4 a = *(const f32x4*)(s + c), b = *(const f32x4*)(s + c + 4);
            ss += a[0] * a[0] + a[1] * a[1] + a[2] * a[2] + a[3] * a[3] + b[0] * b[0] + b[1] * b[1] + b[2] * b[2] + b[3] * b[3];
            *(bf16x8*)(d + c) = pack8(a, b); }
        ss = wave_sum(ss);
        if (lane == 0) rstd[row] = 1.0f / sqrtf(ss * (1.0f / DM) + EPS);
    }
}
__device__ __forceinline__ void final_norm_phase(float* __restrict__ io, const float* __restrict__ w) {
    const int lane = threadIdx.x & 63, gw = blockIdx.x * 8 + (threadIdx.x >> 6), nw = gridDim.x * 8;
    for (int row = gw; row < T_TOK; row += nw) {
        float* s = io + (size_t)row * DM; f32x4 v[16]; float ss = 0.f;
#pragma unroll
        for (int i = 0; i < 16; ++i) { v[i] = *(const f32x4*)(s + (i * 64 + lane) * 4); ss += v[i][0] * v[i][0] + v[i][1] * v[i][1] + v[i][2] * v[i][2] + v[i][3] * v[i][3]; }
        ss = wave_sum(ss);
        const float r = 1.0f / sqrtf(ss * (1.0f / DM) + EPS);
#pragma unroll
        for (int i = 0; i < 16; ++i) { const f32x4 g = *(const f32x4*)(w + (i * 64 + lane) * 4); *(f32x4*)(s + (i * 64 + lane) * 4) = v[i] * r * g; }
    }
}
__device__ __forceinline__ void tables_phase(const Params& p, float* cs, float* sn, float* lb) {
    const int gt = blockIdx.x * blockDim.x + threadIdx.x, nt = gridDim.x * blockDim.x;
    for (int i = gt; i < T_TOK * 32; i += nt) {
        const int tok = i >> 5, j = i & 31;
        const float ang = (float)p.pos[tok] * p.inv_freq[j];
        const double rev = (double)ang * 0.15915494309189535; const float fr = (float)(rev - rint(rev));
        cs[i] = __builtin_amdgcn_cosf(fr); sn[i] = __builtin_amdgcn_sinf(fr);
    }
    for (int i = gt; i < 4096; i += nt) { const float l0 = p.lower_bounds[i], l1 = p.lower_bounds[4096 + i]; lb[i] = 1.0f / (1.0f + expf(l0 - l1)); }
}
__device__ __forceinline__ void stats_krot_phase(const bf16_t* __restrict__ proj0, float* __restrict__ rq, float* __restrict__ rkv, const float* __restrict__ cs, const float* __restrict__ sn, bf16_t* __restrict__ krot) {
    const int lane = threadIdx.x & 63, gw = blockIdx.x * 8 + (threadIdx.x >> 6), nw = gridDim.x * 8;
    for (int row = gw; row < T_TOK; row += nw) {
        const bf16_t* s = proj0 + (size_t)row * N0P;
        const bf16x8 a = *(const bf16x8*)(s + lane * 8), b = *(const bf16x8*)(s + 512 + lane * 8), c = *(const bf16x8*)(s + 1024 + lane * 8);
        float sq = 0.f, sk = 0.f;
#pragma unroll
        for (int j = 0; j < 8; ++j) { const float x = bf2f((unsigned short)a[j]), y = bf2f((unsigned short)b[j]), z = bf2f((unsigned short)c[j]); sq += x * x + y * y; sk += z * z; }
        sq = wave_sum(sq); sk = wave_sum(sk);
        if (lane == 0) { rq[row] = 1.0f / sqrtf(sq * (1.0f / 1024.0f) + EPS); rkv[row] = 1.0f / sqrtf(sk * (1.0f / 512.0f) + EPS); }
        if (lane < 32) { const float t1 = bf2f(s[1536 + lane]), t2 = bf2f(s[1568 + lane]); const float cc = cs[(size_t)row * 32 + lane], sv = sn[(size_t)row * 32 + lane];
            krot[(size_t)row * 64 + lane] = f2bf(t1 * cc - t2 * sv); krot[(size_t)row * 64 + 32 + lane] = f2bf(t2 * cc + t1 * sv); }
    }
}
__device__ __forceinline__ void headnorm_phase(bf16_t* __restrict__ proj1, const bf16_t* __restrict__ oraw, const float* __restrict__ gn) {
    const int tid = threadIdx.x, per = T_TOK / gridDim.x;
    const int h = tid >> 4, vs = (tid & 15) >> 2, c8 = (tid & 3) * 8;
    for (int tok = blockIdx.x * per; tok < (blockIdx.x + 1) * per; ++tok) {
        const int b = tok >> 13, sq = tok & (SEQ - 1);
        bf16_t* s = proj1 + (size_t)tok * N1;
        const bf16x8 o = *(const bf16x8*)(oraw + ((size_t)((b * 32 + h) * 4 + vs) * SEQ + sq) * 32 + c8), z = *(const bf16x8*)(s + 12288 + tid * 8);
        float f[8], ss = 0.f;
#pragma unroll
        for (int j = 0; j < 8; ++j) { f[j] = bf2f((unsigned short)o[j]); ss += f[j] * f[j]; }
        ss += __shfl_xor(ss, 1); ss += __shfl_xor(ss, 2); ss += __shfl_xor(ss, 4); ss += __shfl_xor(ss, 8);
        const float r = 1.0f / sqrtf(ss * (1.0f / 128.0f) + EPS);
        const int v0 = (tid & 15) * 8; const f32x4 g0 = *(const f32x4*)(gn + v0), g1 = *(const f32x4*)(gn + v0 + 4);
        f32x4 a, bb;
#pragma unroll
        for (int j = 0; j < 4; ++j) { a[j] = f[j] * r * g0[j] * bf2f((unsigned short)z[j]); bb[j] = f[4 + j] * r * g1[j] * bf2f((unsigned short)z[4 + j]); }
        *(bf16x8*)(s + 8192 + tid * 8) = pack8(a, bb);
    }
}

namespace hg {
constexpr int QT_S = 272, KD_S = 144;
constexpr int OFF_QT = 0, OFF_KT = OFF_QT + 64 * QT_S, OFF_QB = OFF_KT + 64 * QT_S, OFF_KD = OFF_QB + 64 * QT_S;
constexpr int OFF_VT = OFF_KD + 128 * KD_S, OFF_ST = OFF_VT + 32 * KD_S, OFF_ATT = OFF_ST + 32 * QT_S;
constexpr int OFF_SEG = OFF_ATT + 64 * KD_S, OFF_G32 = OFF_SEG + 2048, OFF_DEC = OFF_G32 + 512, LDS_BYTES = OFF_DEC + 512;
__device__ __forceinline__ int crow(int r, int hi) { return (r & 3) + 8 * (r >> 2) + 4 * hi; }

__device__ __forceinline__ void hgrn2_phase(char* lds, const bf16_t* __restrict__ proj1, bf16_t* __restrict__ oraw) {
    int tid = threadIdx.x; asm volatile("" : "+v"(tid));
    const int wid = __builtin_amdgcn_readfirstlane(tid >> 6), lane = tid & 63, r32 = lane & 31, hi = lane >> 5;
    const int kch = tid & 127, seg = tid >> 7;
    float* segtot = (float*)(lds + OFF_SEG); float* g32s = (float*)(lds + OFF_G32); float* decay = (float*)(lds + OFF_DEC);
    for (int item = blockIdx.x; item < 256; item += gridDim.x) {
        const int vs = item & 3, bh = item >> 2, b = bh >> 5, h = bh & 31;
        const bf16_t* base = proj1 + (size_t)b * SEQ * N1; bf16_t* ob = oraw + (size_t)item * SEQ * 32;
        const int qcol = h * 128 + kch, gcol = 4096 + h * 128 + kch, vcol = 8192 + h * 128 + vs * 32;
        f32x16 sacc = {};
        for (int i = tid; i < 32 * QT_S / 4; i += 512) ((unsigned*)(lds + OFF_ST))[i] = 0u;
        unsigned short graw[16], qraw[16]; u32x2 vraw;
        { const bf16_t* rp = base + (size_t)(seg * 16) * N1;
#pragma unroll
          for (int i = 0; i < 16; ++i) { graw[i] = rp[(size_t)i * N1 + gcol]; qraw[i] = rp[(size_t)i * N1 + qcol]; }
          vraw = *(const u32x2*)(base + (size_t)(tid >> 3) * N1 + vcol + (tid & 7) * 4); }
        for (int ch = 0; ch < 128; ++ch) {
            const int tok0 = ch * 64;
            float gl[16]; float cum = 0.f;
#pragma unroll
            for (int i = 0; i < 16; ++i) { cum += bf2f(graw[i]); gl[i] = cum; }
            segtot[seg * 128 + kch] = cum; if (seg == 2) g32s[kch] = bf2f(graw[0]);
            __syncthreads();
            { const float s0 = segtot[kch], s1 = segtot[128 + kch], s2 = segtot[256 + kch], s3 = segtot[384 + kch];
              const float off = (seg > 0 ? s0 : 0.f) + (seg > 1 ? s1 : 0.f) + (seg > 2 ? s2 : 0.f);
              const float tot = (s0 + s1) + (s2 + s3), bref = s0 + s1 + g32s[kch];
              if (seg == 0) decay[kch] = fast_exp(tot);
              float kd[16];
#pragma unroll
              for (int i = 0; i < 16; ++i) { const int t = seg * 16 + i; const float bb = off + gl[i], gv = bf2f(graw[i]), qv = bf2f(qraw[i]); const float kk = 1.0f - fast_exp(gv);
                  *(bf16_t*)(lds + OFF_QT + t * QT_S + kch * 2) = f2bf_n(qv * fast_exp(bb - bref));
                  *(bf16_t*)(lds + OFF_KT + t * QT_S + kch * 2) = f2bf_n(kk * fast_exp(bref - bb));
                  *(bf16_t*)(lds + OFF_QB + t * QT_S + kch * 2) = f2bf_n(qv * fast_exp(bb));
                  kd[i] = kk * fast_exp(tot - bb); }
              *(bf16x8*)(lds + OFF_KD + kch * KD_S + seg * 32) = pack8((f32x4){kd[0], kd[1], kd[2], kd[3]}, (f32x4){kd[4], kd[5], kd[6], kd[7]});
              *(bf16x8*)(lds + OFF_KD + kch * KD_S + seg * 32 + 16) = pack8((f32x4){kd[8], kd[9], kd[10], kd[11]}, (f32x4){kd[12], kd[13], kd[14], kd[15]});
              { const int t = tid >> 3, v4 = (tid & 7) * 4;
                *(bf16_t*)(lds + OFF_VT + (v4 + 0) * KD_S + t * 2) = (bf16_t)(vraw.x & 0xffffu); *(bf16_t*)(lds + OFF_VT + (v4 + 1) * KD_S + t * 2) = (bf16_t)(vraw.x >> 16);
                *(bf16_t*)(lds + OFF_VT + (v4 + 2) * KD_S + t * 2) = (bf16_t)(vraw.y & 0xffffu); *(bf16_t*)(lds + OFF_VT + (v4 + 3) * KD_S + t * 2) = (bf16_t)(vraw.y >> 16); }
            }
            if (ch + 1 < 128) { const bf16_t* rp = base + (size_t)(tok0 + 64 + seg * 16) * N1;
#pragma unroll
                for (int i = 0; i < 16; ++i) { graw[i] = rp[(size_t)i * N1 + gcol]; qraw[i] = rp[(size_t)i * N1 + qcol]; }
                vraw = *(const u32x2*)(base + (size_t)(tok0 + 64 + (tid >> 3)) * N1 + vcol + (tid & 7) * 4); }
            __syncthreads();
            f32x16 oacc = {};
            if (wid < 4) {
                const int ci = wid >> 1, si = wid & 1;
                if (!(ci == 0 && si == 1)) {
                    f32x16 aacc = {};
#pragma unroll
                    for (int kk = 0; kk < 8; ++kk) {
                        const bf16x8 af = *(const bf16x8*)(lds + OFF_QT + (32 * ci + r32) * QT_S + kk * 32 + hi * 16);
                        const bf16x8 bfr = *(const bf16x8*)(lds + OFF_KT + (32 * si + r32) * QT_S + kk * 32 + hi * 16);
                        aacc = __builtin_amdgcn_mfma_f32_32x32x16_bf16(af, bfr, aacc, 0, 0, 0); }
#pragma unroll
                    for (int i = 0; i < 16; ++i) { const int c = 32 * ci + crow(i, hi), s = 32 * si + r32; const float v = (c >= s) ? aacc[i] : 0.f;
                        *(bf16_t*)(lds + OFF_ATT + c * KD_S + s * 2) = f2bf_n(v); }
                } else {
#pragma unroll
                    for (int i = 0; i < 16; ++i) { const int c = crow(i, hi), s = 32 + r32; *(bf16_t*)(lds + OFF_ATT + c * KD_S + s * 2) = (bf16_t)0; }
                }
#pragma unroll
                for (int g4 = 0; g4 < 4; ++g4) { const f32x4 d = *(const f32x4*)(decay + 32 * wid + 8 * g4 + 4 * hi);
#pragma unroll
                    for (int j = 0; j < 4; ++j) sacc[g4 * 4 + j] *= d[j]; }
#pragma unroll
                for (int kk = 0; kk < 4; ++kk) {
                    const bf16x8 af = *(const bf16x8*)(lds + OFF_KD + (32 * wid + r32) * KD_S + kk * 32 + hi * 16);
                    const bf16x8 bfr = *(const bf16x8*)(lds + OFF_VT + r32 * KD_S + kk * 32 + hi * 16);
                    sacc = __builtin_amdgcn_mfma_f32_32x32x16_bf16(af, bfr, sacc, 0, 0, 0); }
            } else if (wid < 6) {
                const int ci = wid - 4;
#pragma unroll
                for (int kk = 0; kk < 8; ++kk) {
                    const bf16x8 af = *(const bf16x8*)(lds + OFF_QB + (32 * ci + r32) * QT_S + kk * 32 + hi * 16);
                    const bf16x8 bfr = *(const bf16x8*)(lds + OFF_ST + r32 * QT_S + kk * 32 + hi * 16);
                    oacc = __builtin_amdgcn_mfma_f32_32x32x16_bf16(af, bfr, oacc, 0, 0, 0); }
            }
            __syncthreads();
            if (wid < 4) {
#pragma unroll
                for (int g4 = 0; g4 < 4; ++g4) { u32x2 w; w.x = cvtpk_n(sacc[g4 * 4 + 0], sacc[g4 * 4 + 1]); w.y = cvtpk_n(sacc[g4 * 4 + 2], sacc[g4 * 4 + 3]);
                    *(u32x2*)(lds + OFF_ST + r32 * QT_S + (32 * wid + 8 * g4 + 4 * hi) * 2) = w; }
            } else if (wid < 6) {
                const int ci = wid - 4;
#pragma unroll
                for (int kk = 0; kk < 4; ++kk) {
                    const bf16x8 af = *(const bf16x8*)(lds + OFF_ATT + (32 * ci + r32) * KD_S + kk * 32 + hi * 16);
                    const bf16x8 bfr = *(const bf16x8*)(lds + OFF_VT + r32 * KD_S + kk * 32 + hi * 16);
                    oacc = __builtin_amdgcn_mfma_f32_32x32x16_bf16(af, bfr, oacc, 0, 0, 0); }
#pragma unroll
                for (int i = 0; i < 16; ++i) { const int c = 32 * ci + crow(i, hi); ob[(size_t)(tok0 + c) * 32 + r32] = f2bf_n(oacc[i]); }
            }
        }
        __syncthreads();
    }
}
}
constexpr int LDS_TOTAL = pg8::STAGE_BYTES;
static_assert(att::LDS_BYTES <= LDS_TOTAL && hg::LDS_BYTES <= LDS_TOTAL, "lds");

#ifndef PHMASK
#define PHMASK 0xFFFF
#endif
#define EN(n) (((PHMASK) >> (n)) & 1)
#ifndef PROBE_DUP7
#define PROBE_DUP7 0
#endif

__global__ void __launch_bounds__(512) mla_hgrn2_fwd(Params p) {
    extern __shared__ __attribute__((aligned(16))) unsigned char lds[];
    cg::grid_group grid = cg::this_grid();
    unsigned char* ws = p.ws;
    bf16_t* W0IN = (bf16_t*)(ws + WS_W0IN); bf16_t* WUQ = (bf16_t*)(ws + WS_WUQ); bf16_t* WUKV = (bf16_t*)(ws + WS_WUKV);
    bf16_t* W0O = (bf16_t*)(ws + WS_W0O); bf16_t* W1IN = (bf16_t*)(ws + WS_W1IN); bf16_t* W1O = (bf16_t*)(ws + WS_W1O);
    float* RSTD0 = (float*)(ws + WS_RSTD0); float* RSTDQ = (float*)(ws + WS_RSTDQ); float* RSTDKV = (float*)(ws + WS_RSTDKV); float* RSTD1 = (float*)(ws + WS_RSTD1);
    float* LB = (float*)(ws + WS_LB); float* COS = (float*)(ws + WS_COS); float* SIN = (float*)(ws + WS_SIN);
    bf16_t* KROT = (bf16_t*)(ws + WS_KROT); bf16_t* ACTA = (bf16_t*)(ws + WS_ACTA);
    bf16_t* PROJ0 = (bf16_t*)(ws + WS_PROJ0); bf16_t* QBUF = (bf16_t*)(ws + WS_Q); bf16_t* PROJ1 = (bf16_t*)(ws + WS_PROJ1);
    bf16_t* KVBUF = (bf16_t*)p.out;
    LAS unsigned char* ldsl = (LAS unsigned char*)lds;
    const int G = gridDim.x, c = blockIdx.x;

    if (EN(0))
    {
        float* tile = (float*)lds;
        wt_phase(p.l0_w_in, 4096, N0, p.l0_norm, W0IN, tile);
        wt_phase(p.l0_w_uq, 1024, NQ, p.l0_q_norm, WUQ, tile);
        wt_phase(p.l0_w_ukv, 512, NKV, p.l0_kv_norm, WUKV, tile);
        wt_phase(p.l0_w_o, 4096, 4096, nullptr, W0O, tile);
        wt_phase(p.l1_w_in, 4096, N1, p.l1_norm, W1IN, tile);
        wt_phase(p.l1_w_o, 4096, 4096, nullptr, W1O, tile);
        { u32x4 z = {0u, 0u, 0u, 0u}; u32x4* pad = (u32x4*)(W0IN + (size_t)N0 * 4096); const int n16 = (N0P - N0) * 4096 * 2 / 16;
          for (int i = c * 512 + threadIdx.x; i < n16; i += G * 512) pad[i] = z; }
        cast_rstd_phase(p.x, ACTA, RSTD0);
        tables_phase(p, COS, SIN, LB);
    }
#ifdef PROBE_P02
    {
        float* tile = (float*)lds;
        wt_phase(p.l0_w_in, 4096, N0, p.l0_norm, W0IN, tile);
        wt_phase(p.l0_w_uq, 1024, NQ, p.l0_q_norm, WUQ, tile);
        wt_phase(p.l0_w_ukv, 512, NKV, p.l0_kv_norm, WUKV, tile);
        wt_phase(p.l0_w_o, 4096, 4096, nullptr, W0O, tile);
        wt_phase(p.l1_w_in, 4096, N1, p.l1_norm, W1IN, tile);
        wt_phase(p.l1_w_o, 4096, 4096, nullptr, W1O, tile);
    }
#endif
    grid.sync();
    if (EN(1)) {
        pg8::Gemm g{ACTA, W0IN, T_TOK, N0P, 4096, 4096}; pg8::StaticOrder S; S.init(T_TOK, N0P, G, c);
        pg8::EpiBf16<1> E{PROJ0, N0P, RSTD0, 1600, nullptr};
        pg8::gemm_phase(ldsl, g, S, E);
    }
    grid.sync();
    if (EN(2)) stats_krot_phase(PROJ0, RSTDQ, RSTDKV, COS, SIN, KROT);
    grid.sync();
    if (EN(3)) {
        pg8::Gemm g{PROJ0, WUQ, T_TOK, NQ, 1024, N0P}; pg8::StaticOrder S; S.init(T_TOK, NQ, G, c);
        pg8::EpiBf16<0> E{QBUF, NQ, RSTDQ, 0, nullptr};
        pg8::gemm_phase(ldsl, g, S, E);
    }
    if (EN(3)) {
        pg8::Gemm g{PROJ0 + 1024, WUKV, T_TOK, NKV, 512, N0P}; pg8::StaticOrder S; S.init(T_TOK, NKV, G, c);
        pg8::EpiBf16<0> E{KVBUF, NKV, RSTDKV, 0, nullptr};
        pg8::gemm_phase(ldsl, g, S, E);
    }
    grid.sync();
    if (EN(4)) {
        att::Tensors T{QBUF, KVBUF, KROT, ACTA, PROJ0, COS, SIN};
        att::attn_phase((char*)lds, T);
    }
    grid.sync();
    if (EN(5)) {
        pg8::Gemm g{ACTA, W0O, T_TOK, 4096, 4096, 4096}; pg8::StaticOrder S; S.init(T_TOK, 4096, G, c);
        pg8::EpiResF32 E{p.x, p.out, 4096};
        pg8::gemm_phase(ldsl, g, S, E);
    }
    grid.sync();
    if (EN(6)) cast_rstd_phase(p.out, ACTA, RSTD1);
    grid.sync();
    if (EN(7)) {
        pg8::Gemm g{ACTA, W1IN, T_TOK, N1, 4096, 4096}; pg8::StaticOrder S; S.init(T_TOK, N1, G, c, PROBE_DUP7);
        pg8::EpiBf16<2> E{PROJ1, N1, RSTD1, 0, LB};
        pg8::gemm_phase(ldsl, g, S, E);
    }
    grid.sync();
    if (EN(8)) hg::hgrn2_phase((char*)lds, PROJ1, ACTA);
#ifdef PROBE_HG2
    __syncthreads(); hg::hgrn2_phase((char*)lds, PROJ1, ACTA);
#endif
    grid.sync();
    if (EN(9)) headnorm_phase(PROJ1, ACTA, p.l1_g_norm);
    grid.sync();
    if (EN(10)) {
        pg8::Gemm g{PROJ1 + 8192, W1O, T_TOK, 4096, 4096, N1}; pg8::StaticOrder S; S.init(T_TOK, 4096, G, c);
        pg8::EpiResF32 E{p.out, p.out, 4096};
        pg8::gemm_phase(ldsl, g, S, E);
    }
    grid.sync();
    if (EN(11)) final_norm_phase(p.out, p.final_norm);
}

extern "C" void kernel_launch(void* const* d_in, const int* in_sizes, int n_in, void* d_out, int out_size, void* d_ws, size_t ws_size, hipStream_t stream) {
    static int grid = 0;
    if (grid == 0) {
        if (n_in != 15 || ws_size < WS_END) { fprintf(stderr, "kernel_launch: unexpected inputs (n_in %d, ws %zu, need %zu)\n", n_in, ws_size, (size_t)WS_END); grid = -1; return; }
        int dev = 0, cus = 0, per_cu = 0;
        (void)hipGetDevice(&dev); (void)hipDeviceGetAttribute(&cus, hipDeviceAttributeMultiprocessorCount, dev);
        if (hipFuncSetAttribute((const void*)mla_hgrn2_fwd, hipFuncAttributeMaxDynamicSharedMemorySize, LDS_TOTAL) != hipSuccess) { fprintf(stderr, "kernel_launch: hipFuncSetAttribute failed\n"); grid = -1; return; }
        if (hipOccupancyMaxActiveBlocksPerMultiprocessor(&per_cu, (const void*)mla_hgrn2_fwd, 512, LDS_TOTAL) != hipSuccess || per_cu < 1) { fprintf(stderr, "kernel_launch: occupancy query gave %d\n", per_cu); per_cu = 1; }
        (void)hipGetLastError();
        if (cus <= 0) cus = 256;
        grid = cus * per_cu;
        fprintf(stderr, "kernel_launch: grid %d (cus %d x %d)\n", grid, cus, per_cu);
    }
    if (grid < 0) return;
    Params p{};
    p.x = (const float*)d_in[0]; p.pos = (const int*)d_in[1]; p.l0_norm = (const float*)d_in[2]; p.l0_w_in = (const float*)d_in[3]; p.l0_q_norm = (const float*)d_in[4];
    p.l0_w_uq = (const float*)d_in[5]; p.l0_kv_norm = (const float*)d_in[6]; p.l0_w_ukv = (const float*)d_in[7]; p.l0_w_o = (const float*)d_in[8]; p.l1_norm = (const float*)d_in[9];
    p.l1_w_in = (const float*)d_in[10]; p.l1_g_norm = (const float*)d_in[11]; p.l1_w_o = (const float*)d_in[12]; p.lower_bounds = (const float*)d_in[13]; p.final_norm = (const float*)d_in[14];
    p.out = (float*)d_out; p.ws = (unsigned char*)d_ws;
    for (int j = 0; j < 32; ++j) p.inv_freq[j] = (float)(1.0 / pow(10000.0, (double)(2 * j) / 64.0));
    void* args[] = {&p};
    hipError_t e = hipLaunchCooperativeKernel((const void*)mla_hgrn2_fwd, dim3(grid), dim3(512), args, LDS_TOTAL, stream);
    if (e != hipSuccess) fprintf(stderr, "kernel_launch: cooperative launch failed: %s (grid %d)\n", hipGetErrorString(e), grid);
}
```

```cpp
#include <hip/hip_runtime.h>
#include <hip/hip_cooperative_groups.h>
#include <cstdio>
#include <cstdint>
#include <cmath>
namespace cg = cooperative_groups;

typedef unsigned short bf16_t;
typedef short bf16x8 __attribute__((ext_vector_type(8)));
typedef short s16x4 __attribute__((ext_vector_type(4)));
typedef float f32x4 __attribute__((ext_vector_type(4)));
typedef float f32x16 __attribute__((ext_vector_type(16)));
typedef unsigned u32x4 __attribute__((ext_vector_type(4)));
typedef unsigned u32x2 __attribute__((ext_vector_type(2)));
#define LAS __attribute__((address_space(3)))

constexpr int T_TOK = 16384, SEQ = 8192, DM = 4096;
constexpr int N0 = 5696, N0P = 5888;
constexpr int NQ = 6144, NKV = 8192, N1 = 16384;
constexpr float EPS = 1e-6f;

constexpr size_t WS_W0IN = 0;
constexpr size_t WS_WUQ  = WS_W0IN + (size_t)N0P * 4096 * 2;
constexpr size_t WS_WUKV = WS_WUQ + (size_t)NQ * 1024 * 2;
constexpr size_t WS_W0O  = WS_WUKV + (size_t)NKV * 512 * 2;
constexpr size_t WS_W1IN = WS_W0O + (size_t)4096 * 4096 * 2;
constexpr size_t WS_W1O  = WS_W1IN + (size_t)N1 * 4096 * 2;
constexpr size_t WS_RSTD0 = WS_W1O + (size_t)4096 * 4096 * 2;
constexpr size_t WS_RSTDQ = WS_RSTD0 + 65536;
constexpr size_t WS_RSTDKV = WS_RSTDQ + 65536;
constexpr size_t WS_RSTD1 = WS_RSTDKV + 65536;
constexpr size_t WS_LB = WS_RSTD1 + 65536;
constexpr size_t WS_COS = WS_LB + 16384;
constexpr size_t WS_SIN = WS_COS + (size_t)T_TOK * 32 * 4;
constexpr size_t WS_KROT = WS_SIN + (size_t)T_TOK * 32 * 4;
constexpr size_t WS_ACTA = WS_KROT + (size_t)T_TOK * 64 * 2;
constexpr size_t WS_R = WS_ACTA + (size_t)T_TOK * 4096 * 2;
constexpr size_t WS_PROJ0 = WS_R;
constexpr size_t WS_Q = WS_PROJ0 + (size_t)T_TOK * N0P * 2;
constexpr size_t WS_PROJ1 = WS_R;
constexpr size_t WS_END = WS_R + (size_t)T_TOK * N1 * 2;

struct Params {
    const float* x; const int* pos; const float* l0_norm; const float* l0_w_in; const float* l0_q_norm; const float* l0_w_uq;
    const float* l0_kv_norm; const float* l0_w_ukv; const float* l0_w_o; const float* l1_norm; const float* l1_w_in;
    const float* l1_g_norm; const float* l1_w_o; const float* lower_bounds; const float* final_norm;
    float* out; unsigned char* ws;
    float inv_freq[32];
};

__device__ __forceinline__ unsigned cvtpk(float lo, float hi) { unsigned r; asm volatile("v_cvt_pk_bf16_f32 %0, %1, %2" : "=v"(r) : "v"(lo), "v"(hi)); return r; }
typedef float f32x2 __attribute__((ext_vector_type(2)));
typedef __bf16 bf16x2_t __attribute__((ext_vector_type(2)));
__device__ __forceinline__ unsigned cvtpk_n(float lo, float hi) { f32x2 v = {lo, hi}; bf16x2_t h = __builtin_convertvector(v, bf16x2_t); return __builtin_bit_cast(unsigned, h); }
__device__ __forceinline__ bf16_t f2bf_n(float f) { return (bf16_t)(cvtpk_n(f, 0.f) & 0xffffu); }
__device__ __forceinline__ bf16_t f2bf(float f) { return (bf16_t)(cvtpk(f, 0.f) & 0xffffu); }
__device__ __forceinline__ float bf2f(unsigned short h) { return __uint_as_float((unsigned)h << 16); }
__device__ __forceinline__ float bflo(unsigned w) { return __uint_as_float(w << 16); }
__device__ __forceinline__ float bfhi(unsigned w) { return __uint_as_float(w & 0xffff0000u); }
__device__ __forceinline__ bf16x8 pack8(f32x4 a, f32x4 b) {
    u32x4 w = {cvtpk(a[0], a[1]), cvtpk(a[2], a[3]), cvtpk(b[0], b[1]), cvtpk(b[2], b[3])};
    return *reinterpret_cast<bf16x8*>(&w);
}
__device__ __forceinline__ float fast_exp(float x) { return __builtin_amdgcn_exp2f(x * 1.4426950408889634f); }
__device__ __forceinline__ float silu_f(float v) { return v * __builtin_amdgcn_rcpf(1.0f + fast_exp(-v)); }
__device__ __forceinline__ float wave_sum(float v) {
#pragma unroll
    for (int o = 32; o > 0; o >>= 1) v += __shfl_xor(v, o);
    return v;
}

namespace pg8 {
constexpr int BM = 256, BK = 64, HALF = 128, HTB = HALF * BK * 2, STAGE_BYTES = 8 * HTB, NXCD = 8, WGM = 8;
__host__ __device__ __forceinline__ int lds_byte(int r, int c) { const int st = (r >> 4) * 2 + (c >> 5), rr = r & 15, cc = c & 31, ob = rr * 64 + cc * 2; return st * 1024 + (ob ^ (((ob >> 9) & 1) << 5)); }
__host__ __device__ __forceinline__ void stage_rc(int b, int& R, int& C) { const int st = b / 1024, sb = b % 1024, swz = sb ^ (((sb >> 9) & 1) << 5); R = (st >> 1) * 16 + swz / 64; C = (st & 1) * 32 + (swz % 64) / 2; }
__host__ __device__ __forceinline__ int perm32(int rho) { const int n = rho >> 4, i = rho & 15; return 8 * (i >> 2) + 4 * n + (i & 3); }
struct Unit { int pm, pn; };
struct Gemm { const bf16_t* A; const bf16_t* Bt; int M, N, K, lda; };
struct StaticOrder {
    int nM, nN, nwg, G, c, dup;
    __device__ void init(int M, int N, int G_, int c_, int dup_ = 0) { nM = M / BM; nN = N / BM; nwg = nM * nN; G = G_; c = c_; dup = dup_; }
    __device__ bool next(int i, Unit& u) const {
        const long L = (long)(i >> dup) * G + c; if (L >= nwg) return false;
        int wgid = (int)L; { const int q = nwg / NXCD, r = nwg % NXCD, xcd = wgid % NXCD, off = wgid / NXCD; wgid = (xcd < r ? xcd * (q + 1) : r * (q + 1) + (xcd - r) * q) + off; }
        const int nig = WGM * nN, gid = wgid / nig, fm = gid * WGM, gsz = (nM - fm) < WGM ? (nM - fm) : WGM;
        u.pm = fm + ((wgid % nig) % gsz); u.pn = (wgid % nig) / gsz; return true;
    }
};

template <int MODE> struct EpiBf16 {
    static constexpr bool PERM = true;
    bf16_t* O; int ldc; const float* rs; int thr; const float* lb;
    __device__ __forceinline__ void operator()(const f32x4 (&acc)[2][2][4][2], const Unit& u, int wr, int wc, int fr, int fq) const {
        const int row0 = u.pm * BM + wr * 64 + fr, col0 = u.pn * BM + wc * 32 + 8 * fq;
        const int sec = (u.pn * BM) >> 12;
        f32x4 lbv[2][2] = {};
        if (MODE == 2) { if (sec == 1) {
#pragma unroll
            for (int bj = 0; bj < 2; ++bj) { lbv[bj][0] = *(const f32x4*)(lb + col0 + bj * HALF - 4096); lbv[bj][1] = *(const f32x4*)(lb + col0 + bj * HALF - 4096 + 4); } } }
        float rsv[2][4];
#pragma unroll
        for (int ai = 0; ai < 2; ++ai)
#pragma unroll
            for (int m = 0; m < 4; ++m) rsv[ai][m] = rs[row0 + ai * HALF + m * 16];
#pragma unroll
        for (int ai = 0; ai < 2; ++ai)
#pragma unroll
            for (int m = 0; m < 4; ++m) {
                const int row = row0 + ai * HALF + m * 16; const float s = rsv[ai][m];
                bf16_t* rowp = O + (size_t)row * ldc + col0;
#pragma unroll
                for (int bj = 0; bj < 2; ++bj) {
                    f32x4 v0 = acc[ai][bj][m][0] * s, v1 = acc[ai][bj][m][1] * s;
                    const int col = col0 + bj * HALF;
                    if (MODE == 1) { if (col >= thr) {
#pragma unroll
                        for (int j = 0; j < 4; ++j) { v0[j] = silu_f(v0[j]); v1[j] = silu_f(v1[j]); } } }
                    if (MODE == 2) {
                        if (sec == 0 || sec == 3) {
#pragma unroll
                            for (int j = 0; j < 4; ++j) { v0[j] = silu_f(v0[j]); v1[j] = silu_f(v1[j]); } }
                        else if (sec == 1) {
                            const f32x4 l0 = lbv[bj][0], l1 = lbv[bj][1];
#pragma unroll
                            for (int j = 0; j < 4; ++j) {
                                float sg = __builtin_amdgcn_rcpf(1.0f + fast_exp(-v0[j])); float fg = l0[j] + (1.0f - l0[j]) * sg; v0[j] = __logf(fg);
                                sg = __builtin_amdgcn_rcpf(1.0f + fast_exp(-v1[j])); fg = l1[j] + (1.0f - l1[j]) * sg; v1[j] = __logf(fg); }
                        }
                    }
                    u32x4 w; w.x = cvtpk(v0[0], v0[1]); w.y = cvtpk(v0[2], v0[3]); w.z = cvtpk(v1[0], v1[1]); w.w = cvtpk(v1[2], v1[3]);
                    *(u32x4*)(rowp + bj * HALF) = w;
                }
            }
    }
};
struct EpiResF32 {
    static constexpr bool PERM = false;
    const float* base; float* out; int ldc;
    __device__ __forceinline__ void operator()(const f32x4 (&acc)[2][2][4][2], const Unit& u, int wr, int wc, int fr, int fq) const {
        const int row0 = u.pm * BM + wr * 64 + fr, col0 = u.pn * BM + wc * 32 + 4 * fq;
        f32x4 bs[2][4];
#define RES_LOAD(g, slot) do { const size_t off_ = (size_t)(row0 + ((g) >> 2) * HALF + ((g) & 3) * 16) * ldc + col0; \
        _Pragma("unroll") for (int bj = 0; bj < 2; ++bj) _Pragma("unroll") for (int n = 0; n < 2; ++n) bs[slot][bj * 2 + n] = *(const f32x4*)(base + off_ + bj * HALF + n * 16); } while (0)
        RES_LOAD(0, 0);
#pragma unroll
        for (int g = 0; g < 8; ++g) {
            if (g + 1 < 8) RES_LOAD(g + 1, (g + 1) & 1);
            const int ai = g >> 2, m = g & 3; const size_t off = (size_t)(row0 + ai * HALF + m * 16) * ldc + col0;
#pragma unroll
            for (int bj = 0; bj < 2; ++bj)
#pragma unroll
                for (int n = 0; n < 2; ++n) *(f32x4*)(out + off + bj * HALF + n * 16) = bs[g & 1][bj * 2 + n] + acc[ai][bj][m][n];
        }
#undef RES_LOAD
    }
};

template <class Epi, class Sched>
__device__ __forceinline__ void gemm_phase(LAS unsigned char* lds, const Gemm g, const Sched& S, const Epi& E) {
    int tid = threadIdx.x; asm volatile("" : "+v"(tid));
    const int wid = __builtin_amdgcn_readfirstlane(tid >> 6), lane = tid & 63, wr = wid >> 2, wc = wid & 3, fr = lane & 15, fq = lane >> 4;
    const int K = g.K, nt = K / BK, lda = g.lda;
    unsigned voffA[2], voffB[2];
#pragma unroll
    for (int i = 0; i < 2; ++i) { int R, C; stage_rc(tid * 16 + i * 8192, R, C); const int Rb = Epi::PERM ? ((R & ~31) + perm32(R & 31)) : R;
        voffA[i] = (unsigned)(R * lda + C) * 2u; voffB[i] = (unsigned)(Rb * K + C) * 2u; }
    const size_t kstep = (size_t)(BK * 2);
    const size_t hstepA = (size_t)HALF * lda * 2, hstepB = (size_t)HALF * K * 2;
    const size_t tstepA = 2 * hstepA, tstepB = 2 * hstepB;
    const unsigned ldsw = (unsigned)wid * 1024u;
    const int aoff = lds_byte(wr * 64 + fr, fq * 8), boff = lds_byte(wc * 32 + fr, fq * 8);
#define PG8_SA(b, h) (((b) * 2 + (h)) * HTB)
#define PG8_SB(b, h) ((4 + (b) * 2 + (h)) * HTB)
#define PG8_STAGE(bufoff, gbase, voff) do { _Pragma("unroll") for (int _i = 0; _i < 2; ++_i) \
        __builtin_amdgcn_global_load_lds((const unsigned*)((const char*)(gbase) + (voff)[_i]), (LAS unsigned*)(lds + (bufoff) + ldsw + _i * 8192), 16, 0, 0); } while (0)
#define PG8_LDA(dst, b, h) do { _Pragma("unroll") for (int m = 0; m < 4; ++m) _Pragma("unroll") for (int k = 0; k < 2; ++k) dst[m][k] = *(const LAS bf16x8*)(lds + PG8_SA(b, h) + aoff + m * 2048 + k * 1024); } while (0)
#define PG8_LDB(dst, b, h) do { _Pragma("unroll") for (int n = 0; n < 2; ++n) _Pragma("unroll") for (int k = 0; k < 2; ++k) dst[n][k] = *(const LAS bf16x8*)(lds + PG8_SB(b, h) + boff + n * 2048 + k * 1024); } while (0)
#define PG8_MMA(ai, bj, At, Bt) do { __builtin_amdgcn_s_setprio(1); _Pragma("unroll") for (int m = 0; m < 4; ++m) _Pragma("unroll") for (int n = 0; n < 2; ++n) _Pragma("unroll") for (int k = 0; k < 2; ++k) \
        acc[ai][bj][m][n] = __builtin_amdgcn_mfma_f32_16x16x32_bf16(Bt[n][k], At[m][k], acc[ai][bj][m][n], 0, 0, 0); __builtin_amdgcn_s_setprio(0); } while (0)
#define PG8_WAIT_V(n) asm volatile("s_waitcnt vmcnt(" #n ")" ::: "memory")
#define PG8_WAIT_L(n) asm volatile("s_waitcnt lgkmcnt(" #n ")" ::: "memory")
#define PG8_BAR __builtin_amdgcn_s_barrier()
#define PG8_SCHED __builtin_amdgcn_sched_barrier(0)
    Unit cur, nxt; int ui = 0;
    if (!S.next(0, cur)) return;
    f32x4 acc[2][2][4][2];
#pragma unroll
    for (int a = 0; a < 2; ++a)
#pragma unroll
        for (int b = 0; b < 2; ++b)
#pragma unroll
            for (int m = 0; m < 4; ++m)
#pragma unroll
                for (int n = 0; n < 2; ++n) acc[a][b][m][n] = (f32x4){0.f, 0.f, 0.f, 0.f};
    bf16x8 At[4][2], B0[2][2], B1[2][2];
    const char* cA = (const char*)g.A + (size_t)cur.pm * tstepA; const char* cB = (const char*)g.Bt + (size_t)cur.pn * tstepB;
    PG8_STAGE(PG8_SB(0, 0), cB, voffB); PG8_STAGE(PG8_SA(0, 0), cA, voffA); PG8_STAGE(PG8_SB(0, 1), cB + hstepB, voffB); PG8_STAGE(PG8_SA(0, 1), cA + hstepA, voffA);
    if (wr == 1) PG8_BAR;
    PG8_WAIT_V(4); PG8_BAR;
    PG8_STAGE(PG8_SB(1, 0), cB + kstep, voffB); PG8_STAGE(PG8_SA(1, 0), cA + kstep, voffA); PG8_STAGE(PG8_SB(1, 1), cB + hstepB + kstep, voffB);
    PG8_WAIT_V(6); PG8_BAR;
    for (;;) {
        const bool has_next = S.next(ui + 1, nxt);
        const char* nA = has_next ? (const char*)g.A + (size_t)nxt.pm * tstepA : cA; const char* nB = has_next ? (const char*)g.Bt + (size_t)nxt.pn * tstepB : cB;
        for (int t = 0; t < nt; t += 2) {
            const bool last = (t == nt - 2);
            const char* a1 = cA + (size_t)(t + 1) * kstep;
            const char* a2 = last ? nA : cA + (size_t)(t + 2) * kstep; const char* b2 = last ? nB : cB + (size_t)(t + 2) * kstep;
            const char* a3 = a2 + kstep; const char* b3 = b2 + kstep;
            PG8_LDB(B0, 0, 0); PG8_SCHED; PG8_LDA(At, 0, 0); PG8_STAGE(PG8_SA(1, 1), a1 + hstepA, voffA);
            PG8_WAIT_L(8); PG8_BAR; PG8_WAIT_L(0); PG8_MMA(0, 0, At, B0); PG8_BAR; PG8_SCHED;
            PG8_LDB(B1, 0, 1); PG8_STAGE(PG8_SB(0, 0), b2, voffB);
            PG8_BAR; PG8_WAIT_L(0); PG8_MMA(0, 1, At, B1); PG8_BAR;
            PG8_LDA(At, 0, 1); PG8_STAGE(PG8_SA(0, 0), a2, voffA);
            PG8_BAR; PG8_WAIT_L(0); PG8_MMA(1, 0, At, B0); PG8_BAR; PG8_SCHED;
            PG8_STAGE(PG8_SB(0, 1), b2 + hstepB, voffB);
            PG8_WAIT_V(6); PG8_BAR; PG8_MMA(1, 1, At, B1); PG8_BAR;
            PG8_LDB(B0, 1, 0); PG8_SCHED; PG8_LDA(At, 1, 0); PG8_STAGE(PG8_SA(0, 1), a2 + hstepA, voffA);
            PG8_WAIT_L(8); PG8_BAR; PG8_WAIT_L(0); PG8_MMA(0, 0, At, B0); PG8_BAR; PG8_SCHED;
            PG8_LDB(B1, 1, 1); PG8_STAGE(PG8_SB(1, 0), b3, voffB);
            PG8_BAR; PG8_WAIT_L(0); PG8_MMA(0, 1, At, B1); PG8_BAR;
            PG8_LDA(At, 1, 1); PG8_STAGE(PG8_SA(1, 0), a3, voffA);
            PG8_BAR; PG8_WAIT_L(0); PG8_MMA(1, 0, At, B0); PG8_BAR; PG8_SCHED;
            PG8_STAGE(PG8_SB(1, 1), b3 + hstepB, voffB);
            PG8_WAIT_V(6); PG8_BAR; PG8_MMA(1, 1, At, B1); PG8_BAR;
        }
        E(acc, cur, wr, wc, fr, fq);
        if (!has_next) break;
#pragma unroll
        for (int a = 0; a < 2; ++a)
#pragma unroll
            for (int b = 0; b < 2; ++b)
#pragma unroll
                for (int m = 0; m < 4; ++m)
#pragma unroll
                    for (int n = 0; n < 2; ++n) acc[a][b][m][n] = (f32x4){0.f, 0.f, 0.f, 0.f};
        cur = nxt; cA = nA; cB = nB; ++ui;
    }
    PG8_WAIT_V(0);
    if (wr == 0) PG8_BAR;
    PG8_BAR;
#undef PG8_SA
#undef PG8_SB
#undef PG8_STAGE
#undef PG8_LDA
#undef PG8_LDB
#undef PG8_MMA
#undef PG8_WAIT_V
#undef PG8_WAIT_L
#undef PG8_BAR
#undef PG8_SCHED
}
}
namespace att {
constexpr int NW = 8, QBLK = 32, KVBLK = 64, QB = NW * QBLK;
constexpr int DQ = 192, DV = 128;
constexpr int QS = NQ, KVS = NKV, KRS = 64, OS = 4096, ZS = N0P;
constexpr int SHM_V = KVBLK * DV * 2, SHM_K = KVBLK * DQ * 2;
constexpr int QR_OFF = 2 * SHM_V + 2 * SHM_K + NW * 64 * 4;
constexpr int LDS_BYTES = QR_OFF + NW * 4096;
constexpr float SCALE = 0.07216878364870322f;
constexpr float THR = 8.f;
constexpr unsigned WBIG = 0x40000000u;

#define KSWZ(row, colB) ((row) * 384 + ((colB) ^ (((row) & 7) << 4)))
#define SBAR() __builtin_amdgcn_sched_barrier(0)
__device__ __forceinline__ int v_st(int k, int c) { const int kk = (k & ~0xC) | ((k & 4) << 1) | ((k & 8) >> 1); return ((kk >> 3) * 4 + (c >> 5)) * 512 + ((kk & 7) * 32 + (c & 31)) * 2; }
__device__ __forceinline__ int v_rd_base(int lane) { return ((lane & 3) << 3) | (((lane >> 2) & 3) << 6) | (((lane >> 4) & 1) << 5) | (((lane >> 5) & 1) << 8); }
constexpr int v_rd_off(int d0, int ks, int half) { return d0 * 512 + ks * 4096 + half * 2048; }
__device__ __forceinline__ int crow(int r, int hi) { return (r & 3) + 8 * (r >> 2) + 4 * hi; }
__device__ __forceinline__ bf16x8 load8(const bf16_t* p) { return *reinterpret_cast<const bf16x8*>(p); }

__device__ __forceinline__ void mask_tile(f32x16& p0, f32x16& p1, int dq) {
    const float NEG = -__builtin_inff();
#pragma unroll
    for (int r = 0; r < 16; ++r) {
        const int c = (r & 3) + 8 * (r >> 2);
        if ((unsigned)(dq - c) >= WBIG) p0[r] = NEG;
        if ((unsigned)(dq - c - 32) >= WBIG) p1[r] = NEG;
    }
}
__device__ __forceinline__ void partialSM(f32x16& p0, f32x16& p1, float& m_reg, float& mn, float& alpha) {
    float pmax = p0[0];
#pragma unroll
    for (int r = 1; r < 16; ++r) pmax = fmaxf(pmax, p0[r]);
#pragma unroll
    for (int r = 0; r < 16; ++r) pmax = fmaxf(pmax, p1[r]);
    { auto rr = __builtin_amdgcn_permlane32_swap(__float_as_uint(pmax), __float_as_uint(pmax), false, false);
      pmax = fmaxf(__uint_as_float(rr[0]), __uint_as_float(rr[1])); }
    constexpr float C2 = 1.4426950408889634f * SCALE;
    if (__builtin_expect(__all((pmax - m_reg) * SCALE <= THR), 1)) { mn = m_reg; alpha = 1.f; }
    else { mn = fmaxf(m_reg, pmax); alpha = __builtin_amdgcn_exp2f((m_reg - mn) * C2); m_reg = mn; }
    const float mnL = -mn * C2;
#pragma unroll
    for (int r = 0; r < 16; ++r) p0[r] = fmaf(p0[r], C2, mnL);
#pragma unroll
    for (int r = 0; r < 16; ++r) p1[r] = fmaf(p1[r], C2, mnL);
#pragma unroll
    for (int r = 0; r < 16; ++r) p0[r] = __builtin_amdgcn_exp2f(p0[r]);
}
__device__ __forceinline__ void finishSM(f32x16& p0, f32x16& p1, float alpha, float& l_reg, bf16x8& pa0, bf16x8& pa1, bf16x8& pa2, bf16x8& pa3) {
#pragma unroll
    for (int r = 0; r < 16; ++r) p1[r] = __builtin_amdgcn_exp2f(p1[r]);
    float ps = 0;
#pragma unroll
    for (int r = 0; r < 16; ++r) ps += p0[r];
#pragma unroll
    for (int r = 0; r < 16; ++r) ps += p1[r];
    { auto rr = __builtin_amdgcn_permlane32_swap(__float_as_uint(ps), __float_as_uint(ps), false, false);
      ps = __uint_as_float(rr[0]) + __uint_as_float(rr[1]); }
    l_reg = l_reg * alpha + ps;
#define PK4(P, B_, OUT) do { unsigned a0 = cvtpk(P[B_+0], P[B_+1]), a1 = cvtpk(P[B_+2], P[B_+3]);                          \
        unsigned b0 = cvtpk(P[B_+4], P[B_+5]), b1 = cvtpk(P[B_+6], P[B_+7]);                                             \
        auto r0 = __builtin_amdgcn_permlane32_swap(a0, b0, false, false); auto r1 = __builtin_amdgcn_permlane32_swap(a1, b1, false, false); \
        u32x4 w = {r0[0], r1[0], r0[1], r1[1]}; OUT = *reinterpret_cast<bf16x8*>(&w); } while (0)
    PK4(p0, 0, pa0); PK4(p0, 8, pa1); PK4(p1, 0, pa2); PK4(p1, 8, pa3);
#undef PK4
}
template <int KB>
__device__ __forceinline__ void qkt(f32x16& p0, f32x16& p1, const char* K_lds, int r32, int hi, const bf16x8* qr, const char* qrl) {
    p0 = f32x16{}; p1 = f32x16{};
    const char* kb[4];
#pragma unroll
    for (int dd = 0; dd < 4; ++dd) kb[dd] = K_lds + KB * SHM_K + KSWZ(r32, (dd * 16 + hi * 8) * 2);
#pragma unroll
    for (int d0 = 0; d0 < 12; ++d0) { const char* a = kb[d0 & 3] + (d0 >> 2) * 128;
        bf16x8 b0 = *reinterpret_cast<const bf16x8*>(a);
        bf16x8 b1 = *reinterpret_cast<const bf16x8*>(a + 32 * 384);
        bf16x8 qf; if (d0 < 8) qf = qr[d0]; else qf = *reinterpret_cast<const bf16x8*>(qrl + (d0 - 8) * 1024);
        p0 = __builtin_amdgcn_mfma_f32_32x32x16_bf16(b0, qf, p0, 0, 0, 0);
        p1 = __builtin_amdgcn_mfma_f32_32x32x16_bf16(b1, qf, p1, 0, 0, 0);
    }
}
template <int VB>
__device__ __forceinline__ void pv_tile(f32x16* o, int vb0, bf16x8 pa0, bf16x8 pa1, bf16x8 pa2, bf16x8 pa3) {
#define TRRD(dst, off) asm volatile("ds_read_b64_tr_b16 %0, %1 offset:%2" : "=&v"(dst) : "v"(vb0), "i"(off) : "memory")
#define PV_D0(d0) do { s16x4 l0, l1, l2, l3, h0, h1, h2, h3; constexpr int b_ = VB * SHM_V + v_rd_off(d0, 0, 0); \
        TRRD(l0, b_); TRRD(h0, b_ + 2048); TRRD(l1, b_ + 4096); TRRD(h1, b_ + 6144); TRRD(l2, b_ + 8192); TRRD(h2, b_ + 10240); TRRD(l3, b_ + 12288); TRRD(h3, b_ + 14336); \
        asm volatile("s_waitcnt lgkmcnt(0)" ::: "memory"); SBAR();   \
        o[d0] = __builtin_amdgcn_mfma_f32_32x32x16_bf16(pa0, (bf16x8){l0[0], l0[1], l0[2], l0[3], h0[0], h0[1], h0[2], h0[3]}, o[d0], 0, 0, 0);   \
        o[d0] = __builtin_amdgcn_mfma_f32_32x32x16_bf16(pa1, (bf16x8){l1[0], l1[1], l1[2], l1[3], h1[0], h1[1], h1[2], h1[3]}, o[d0], 0, 0, 0);   \
        o[d0] = __builtin_amdgcn_mfma_f32_32x32x16_bf16(pa2, (bf16x8){l2[0], l2[1], l2[2], l2[3], h2[0], h2[1], h2[2], h2[3]}, o[d0], 0, 0, 0);   \
        o[d0] = __builtin_amdgcn_mfma_f32_32x32x16_bf16(pa3, (bf16x8){l3[0], l3[1], l3[2], l3[3], h3[0], h3[1], h3[2], h3[3]}, o[d0], 0, 0, 0); } while (0)
    PV_D0(0); PV_D0(1); PV_D0(2); PV_D0(3);
#undef PV_D0
#undef TRRD
}

struct BlockRef { const bf16_t* Q; const bf16_t* K; const bf16_t* KR; const bf16_t* V; bf16_t* O; const bf16_t* Z; const float* CS; const float* SN; int P0; };
struct Stage { bf16x8 st_v0, st_v1, st_k0, st_k1, st_kr; };
#define VMW() asm volatile("s_waitcnt vmcnt(0)" ::: "memory")
#define SLOAD_H(R, k0) do { const char* kt_ = (const char*)(R).K + (size_t)(k0) * (KVS * 2); const char* kt2_ = kt_ + 32 * KVS * 2; const char* krt_ = (const char*)(R).KR + (size_t)(k0) * (KRS * 2); \
                            S.st_v0 = *(const bf16x8*)(kt_ + koff + 256); S.st_v1 = *(const bf16x8*)(kt2_ + koff + 256);  \
                            S.st_k0 = *(const bf16x8*)(kt_ + koff); S.st_k1 = *(const bf16x8*)(kt2_ + koff);  \
                            S.st_kr = *(const bf16x8*)(krt_ + kroff); } while (0)
#define SWRITE_HK(bf) do { *(bf16x8*)(K_lds + (bf) * SHM_K + kws) = S.st_k0; *(bf16x8*)(K_lds + (bf) * SHM_K + kws + 32 * 384) = S.st_k1; \
                           *(bf16x8*)(K_lds + (bf) * SHM_K + kwr) = S.st_kr; } while (0)
#define SWRITE_HV(bf) do { *(bf16x8*)(V_lds + (bf) * SHM_V + vst0) = S.st_v0; *(bf16x8*)(V_lds + (bf) * SHM_V + vst1) = S.st_v1; } while (0)
#define SWRITE_H(bf) do { SWRITE_HV(bf); SWRITE_HK(bf); } while (0)

__device__ __forceinline__ void rope_q(const BlockRef& cur, const bf16x8* qrp, char* qrl, int wid, int r32, int hi) {
    const int row = wid * QBLK + r32;
    const unsigned toff = (unsigned)((row * 32 + hi * 8) * 4);
    const float* cp = (const float*)((const char*)cur.CS + toff); const float* sp = (const float*)((const char*)cur.SN + toff);
#pragma unroll
    for (int pr = 0; pr < 2; ++pr) {
        const f32x4 c0 = *(const f32x4*)(cp + pr * 16), c1 = *(const f32x4*)(cp + pr * 16 + 4), s0 = *(const f32x4*)(sp + pr * 16), s1 = *(const f32x4*)(sp + pr * 16 + 4);
        const bf16x8 a = qrp[pr], b = qrp[2 + pr];
        f32x4 o1l, o1h, o2l, o2h;
#pragma unroll
        for (int j = 0; j < 4; ++j) {
            float t1 = bf2f((unsigned short)a[j]), t2 = bf2f((unsigned short)b[j]);
            o1l[j] = t1 * c0[j] - t2 * s0[j]; o2l[j] = t2 * c0[j] + t1 * s0[j];
            t1 = bf2f((unsigned short)a[4 + j]); t2 = bf2f((unsigned short)b[4 + j]);
            o1h[j] = t1 * c1[j] - t2 * s1[j]; o2h[j] = t2 * c1[j] + t1 * s1[j];
        }
        *(bf16x8*)(qrl + pr * 1024) = pack8(o1l, o1h); *(bf16x8*)(qrl + (2 + pr) * 1024) = pack8(o2l, o2h);
    }
}
__device__ __forceinline__ void causal_block(const BlockRef& cur, char* lds) {
    int tid = threadIdx.x; asm volatile("" : "+v"(tid));
    const int wid = __builtin_amdgcn_readfirstlane(tid >> 6), lane = tid & 63, r32 = lane & 31, hi = lane >> 5;
    const int NT = (cur.P0 + QB - 1) / KVBLK + 1;
    const int qlo = cur.P0 + wid * QBLK, qm = qlo + r32 - 4 * hi;
    char* V_lds = lds; char* K_lds = lds + 2 * SHM_V;
    float* ws = (float*)(lds + 2 * SHM_V + 2 * SHM_K) + wid * 64; float* li_l = ws, * al_l = ws + 32;
    float m_reg = -1e30f, l_reg = 0; f32x16 o[4] = {};
    const int sr = tid >> 4, sc = (tid & 15) * 8, vst0 = v_st(sr, sc), vst1 = v_st(32 + sr, sc), kws = KSWZ(sr, sc * 2);
    const int krr = tid >> 3, krc = (tid & 7) * 8, kwr = KSWZ(krr, (128 + krc) * 2);
    const int vb0 = (int)(uintptr_t)V_lds + v_rd_base(lane);
    unsigned koff = (unsigned)((sr * KVS + sc) * 2), kroff = (unsigned)((krr * KRS + krc) * 2);
    unsigned qoff = (unsigned)(((wid * QBLK + r32) * QS + hi * 8) * 2);
    asm volatile("" : "+v"(koff), "+v"(kroff), "+v"(qoff));
    Stage S; bf16x8 qr[8]; char* qrl = lds + QR_OFF + wid * 4096 + lane * 16;
    { bf16x8 qrp[4];
#pragma unroll
      for (int d0 = 0; d0 < 8; ++d0) qr[d0] = *(const bf16x8*)((const char*)cur.Q + qoff + d0 * 32);
#pragma unroll
      for (int d0 = 0; d0 < 4; ++d0) qrp[d0] = *(const bf16x8*)((const char*)cur.Q + qoff + (8 + d0) * 32);
      SLOAD_H(cur, 0);
      rope_q(cur, qrp, qrl, wid, r32, hi); }
    VMW(); SWRITE_H(0); SBAR();
    SLOAD_H(cur, KVBLK); SBAR();
    __syncthreads();
#define RESC(a) do { if (__any((a) < 1.f)) { if (hi == 0) al_l[r32] = (a); asm volatile("s_waitcnt lgkmcnt(0)" ::: "memory");              \
                     for (int d_ = 0; d_ < 4; ++d_) for (int r = 0; r < 16; ++r) o[d_][r] *= al_l[crow(r, hi)]; } } while (0)
#define KBASE(t) ((t) * KVBLK)
#define MASKT(P0_, P1_, t) do { const int kb_ = KBASE(t); if (kb_ + KVBLK - 1 > qlo) mask_tile(P0_, P1_, qm - kb_); } while (0)
    f32x16 pA0, pA1, pB0, pB1; float mnA, mnB, alA, alB; bf16x8 pa0, pa1, pa2, pa3;
    qkt<0>(pA0, pA1, K_lds, r32, hi, qr, qrl);
    MASKT(pA0, pA1, 0); partialSM(pA0, pA1, m_reg, mnA, alA);
    VMW(); SWRITE_H(1);
    __syncthreads();
#define HALF_STEP(PX0, PX1, mnX, alX, PY0, PY1, alY, t, KB, VB, SB) do {                                                      \
        SBAR(); qkt<KB>(PX0, PX1, K_lds, r32, hi, qr, qrl);                                                                        \
        finishSM(PY0, PY1, alY, l_reg, pa0, pa1, pa2, pa3); SBAR();                                                           \
        if ((t) + 1 < NT) { SLOAD_H(cur, KBASE((t) + 1)); SBAR(); }                                                           \
        pv_tile<VB>(o, vb0, pa0, pa1, pa2, pa3); MASKT(PX0, PX1, (t)); partialSM(PX0, PX1, m_reg, mnX, alX);                  \
        __syncthreads();                                                                                                      \
        if ((t) + 1 < NT) { VMW(); SWRITE_H(SB); }                                                                            \
        RESC(alX); __syncthreads(); } while (0)
    for (int t = 1; t + 1 < NT; t += 2) {
        HALF_STEP(pB0, pB1, mnB, alB, pA0, pA1, alA, t, 1, 0, 0);
        HALF_STEP(pA0, pA1, mnA, alA, pB0, pB1, alB, t + 1, 0, 1, 1);
    }
    SBAR(); qkt<1>(pB0, pB1, K_lds, r32, hi, qr, qrl); SBAR();
    finishSM(pA0, pA1, alA, l_reg, pa0, pa1, pa2, pa3); SBAR();
    pv_tile<0>(o, vb0, pa0, pa1, pa2, pa3);
    MASKT(pB0, pB1, NT - 1); partialSM(pB0, pB1, m_reg, mnB, alB); __syncthreads(); RESC(alB);
    finishSM(pB0, pB1, alB, l_reg, pa0, pa1, pa2, pa3); SBAR(); pv_tile<1>(o, vb0, pa0, pa1, pa2, pa3);
    SBAR();
    if (hi == 0) li_l[r32] = l_reg;
    __syncthreads();
    {
        char* ot = lds + wid * (32 * 272);
        const int wb = 4 * hi * 272 + r32 * 2;
#pragma unroll
        for (int rg = 0; rg < 4; ++rg) {
            const f32x4 lv = *(const f32x4*)(li_l + 8 * rg + 4 * hi);
#pragma unroll
            for (int j = 0; j < 4; ++j) { const int r = rg * 4 + j; const float rl = __builtin_amdgcn_rcpf(lv[j]);
#pragma unroll
                for (int d0 = 0; d0 < 4; ++d0) *(bf16_t*)(ot + wb + (j + 8 * rg) * 272 + d0 * 64) = f2bf(o[d0][r] * rl); }
        }
        asm volatile("s_waitcnt lgkmcnt(0)" ::: "memory");
        const int rr = lane >> 4, c8 = (lane & 15) * 8;
        const unsigned zoff = (unsigned)(((wid * QBLK + rr) * ZS + c8) * 2), ooff = (unsigned)(((wid * QBLK + rr) * OS + c8) * 2);
#pragma unroll
        for (int i = 0; i < 8; ++i) {
            const bf16x8 ov = *(const bf16x8*)(ot + (i * 4 + rr) * 272 + c8 * 2);
            const bf16x8 zv = *(const bf16x8*)((const char*)cur.Z + (size_t)(i * 4 * ZS * 2) + zoff);
            f32x4 a, b;
#pragma unroll
            for (int j = 0; j < 4; ++j) { a[j] = bf2f((unsigned short)ov[j]) * bf2f((unsigned short)zv[j]); b[j] = bf2f((unsigned short)ov[4 + j]) * bf2f((unsigned short)zv[4 + j]); }
            *(bf16x8*)((char*)cur.O + (size_t)(i * 4 * OS * 2) + ooff) = pack8(a, b);
        }
    }
    __syncthreads();
#undef RESC
#undef KBASE
#undef MASKT
#undef HALF_STEP
}
#undef VMW
#undef SLOAD_H
#undef SWRITE_HK
#undef SWRITE_HV
#undef SWRITE_H

struct Item { int bh, qb0, qb1; };
constexpr int NQB = SEQ / QB, NX = NQB / 2, NBH = 64, TOTAL = NX * NBH;
__device__ __forceinline__ Item decode(int L) {
    Item it; const int xcd = L & 7, k = L >> 3, gi = k / NX, r = k - gi * NX;
    it.bh = gi * 8 + xcd; it.qb0 = r; it.qb1 = NQB - 1 - r; return it;
}
struct Tensors { const bf16_t* q; const bf16_t* kv; const bf16_t* krot; bf16_t* og; const bf16_t* proj0; const float* cs; const float* sn; };
__device__ __forceinline__ BlockRef mkref(const Item& it, int pass, const Tensors& T) {
    const int qb = pass ? it.qb1 : it.qb0, b = it.bh >> 5, h = it.bh & 31;
    const size_t tok0 = (size_t)b * SEQ, row0 = tok0 + (size_t)qb * QB;
    BlockRef r;
    r.Q = T.q + row0 * QS + h * DQ; r.K = T.kv + tok0 * KVS + h * 256; r.V = r.K + 128; r.KR = T.krot + tok0 * KRS;
    r.O = T.og + row0 * OS + h * DV; r.Z = T.proj0 + row0 * ZS + 1600 + h * DV; r.CS = T.cs + row0 * 32; r.SN = T.sn + row0 * 32; r.P0 = qb * QB;
    return r;
}
__device__ __forceinline__ void attn_phase(char* lds, const Tensors& T) {
#ifndef PROBE_ATTDUP
#define PROBE_ATTDUP 0
#endif
    for (int i = 0; ; ++i) {
        const int L = blockIdx.x + (i >> PROBE_ATTDUP) * gridDim.x; if (L >= TOTAL) break;
        const Item it = decode(L);
#pragma unroll 1
        for (int pass = 0; pass < 2; ++pass) { const BlockRef cur = mkref(it, pass, T); causal_block(cur, lds); }
    }
}
}
__device__ __forceinline__ void wt_phase(const float* __restrict__ W, int K, int N, const float* __restrict__ scale, bf16_t* __restrict__ out, char* lds) {
    int tid = threadIdx.x; asm volatile("" : "+v"(tid));
    const int lane = tid & 63, wv = tid >> 6, gw = blockIdx.x * 8 + wv, nw = gridDim.x * 8;
    char* img = lds + wv * 8192;
    const int kr = lane >> 4, nq = lane & 15, ntn = N / 64, ntiles = ntn * (K / 64);
    for (int t = gw; t < ntiles; t += nw) {
        const int kb = (t / ntn) * 64, nb = (t % ntn) * 64;
        const float* src = W + (size_t)(kb + kr * 16) * N + nb + nq * 4;
        f32x4 v[16];
#pragma unroll
        for (int i = 0; i < 16; ++i) v[i] = *(const f32x4*)(src + (size_t)i * N);
        if (scale) {
            const float* sp = scale + kb + kr * 16;
#pragma unroll
            for (int i = 0; i < 16; i += 4) { const f32x4 sc = *(const f32x4*)(sp + i); v[i] *= sc[0]; v[i + 1] *= sc[1]; v[i + 2] *= sc[2]; v[i + 3] *= sc[3]; }
        }
#pragma unroll
        for (int j = 0; j < 4; ++j) {
            const int n = nq * 4 + j;
#pragma unroll
            for (int hf = 0; hf < 2; ++hf) {
                const f32x4 a = {v[hf * 8 + 0][j], v[hf * 8 + 1][j], v[hf * 8 + 2][j], v[hf * 8 + 3][j]}, b = {v[hf * 8 + 4][j], v[hf * 8 + 5][j], v[hf * 8 + 6][j], v[hf * 8 + 7][j]};
                *(bf16x8*)(img + n * 128 + (((kr * 2 + hf) ^ (nq & 7)) * 16)) = pack8(a, b);
            }
        }
#pragma unroll
        for (int i = 0; i < 8; ++i) {
            const int n = i * 8 + (lane >> 3), kc = lane & 7;
            const bf16x8 r = *(const bf16x8*)(img + n * 128 + ((kc ^ ((n >> 2) & 7)) * 16));
            *(bf16x8*)(out + (size_t)(nb + n) * K + kb + kc * 8) = r;
        }
    }
}
__device__ __forceinline__ void cast_rstd_phase(const float* __restrict__ src, bf16_t* __restrict__ dst, float* __restrict__ rstd) {
    const int lane = threadIdx.x & 63, gw = blockIdx.x * 8 + (threadIdx.x >> 6), nw = gridDim.x * 8;
    for (int row = gw; row < T_TOK; row += nw) {
        const float* s = src + (size_t)row * DM; bf16_t* d = dst + (size_t)row * DM; float ss = 0.f;
#pragma unroll
        for (int i = 0; i < 8; ++i) { const int c = (i * 64 + lane) * 8; const f32x4 a = *(const f32x4*)(s + c), b = *(const f32x4*)(s + c + 4);
            ss += a[0] * a[0] + a[1] * a[1] + a[2] * a[2] + a[3] * a[3] + b[0] * b[0] + b[1] * b[1] + b[2] * b[2] + b[3] * b[3];
            *(bf16x8*)(d + c) = pack8(a, b); }
        ss = wave_sum(ss);
        if (lane == 0) rstd[row] = 1.0f / sqrtf(ss * (1.0f / DM) + EPS);
    }
}
__device__ __forceinline__ void final_norm_phase(float* __restrict__ io, const float* __restrict__ w) {
    const int lane = threadIdx.x & 63, gw = blockIdx.x * 8 + (threadIdx.x >> 6), nw = gridDim.x * 8;
    for (int row = gw; row < T_TOK; row += nw) {
        float* s = io + (size_t)row * DM; f32x4 v[16]; float ss = 0.f;
#pragma unroll
        for (int i = 0; i < 16; ++i) { v[i] = *(const f32x4*)(s + (i * 64 + lane) * 4); ss += v[i][0] * v[i][0] + v[i][1] * v[i][1] + v[i][2] * v[i][2] + v[i][3] * v[i][3]; }
        ss = wave_sum(ss);
        const float r = 1.0f / sqrtf(ss * (1.0f / DM) + EPS);
#pragma unroll
        for (int i = 0; i < 16; ++i) { const f32x4 g = *(const f32x4*)(w + (i * 64 + lane) * 4); *(f32x4*)(s + (i * 64 + lane) * 4) = v[i] * r * g; }
    }
}
__device__ __forceinline__ void tables_phase(const Params& p, float* cs, float* sn, float* lb) {
    const int gt = blockIdx.x * blockDim.x + threadIdx.x, nt = gridDim.x * blockDim.x;
    for (int i = gt; i < T_TOK * 32; i += nt) {
        const int tok = i >> 5, j = i & 31;
        const float ang = (float)p.pos[tok] * p.inv_freq[j];
        const double rev = (double)ang * 0.15915494309189535; const float fr = (float)(rev - rint(rev));
        cs[i] = __builtin_amdgcn_cosf(fr); sn[i] = __builtin_amdgcn_sinf(fr);
    }
    for (int i = gt; i < 4096; i += nt) { const float l0 = p.lower_bounds[i], l1 = p.lower_bounds[4096 + i]; lb[i] = 1.0f / (1.0f + expf(l0 - l1)); }
}
__device__ __forceinline__ void stats_krot_phase(const bf16_t* __restrict__ proj0, float* __restrict__ rq, float* __restrict__ rkv, const float* __restrict__ cs, const float* __restrict__ sn, bf16_t* __restrict__ krot) {
    const int lane = threadIdx.x & 63, gw = blockIdx.x * 8 + (threadIdx.x >> 6), nw = gridDim.x * 8;
    for (int row = gw; row < T_TOK; row += nw) {
        const bf16_t* s = proj0 + (size_t)row * N0P;
        const bf16x8 a = *(const bf16x8*)(s + lane * 8), b = *(const bf16x8*)(s + 512 + lane * 8), c = *(const bf16x8*)(s + 1024 + lane * 8);
        float sq = 0.f, sk = 0.f;
#pragma unroll
        for (int j = 0; j < 8; ++j) { const float x = bf2f((unsigned short)a[j]), y = bf2f((unsigned short)b[j]), z = bf2f((unsigned short)c[j]); sq += x * x + y * y; sk += z * z; }
        sq = wave_sum(sq); sk = wave_sum(sk);
        if (lane == 0) { rq[row] = 1.0f / sqrtf(sq * (1.0f / 1024.0f) + EPS); rkv[row] = 1.0f / sqrtf(sk * (1.0f / 512.0f) + EPS); }
        if (lane < 32) { const float t1 = bf2f(s[1536 + lane]), t2 = bf2f(s[1568 + lane]); const float cc = cs[(size_t)row * 32 + lane], sv = sn[(size_t)row * 32 + lane];
            krot[(size_t)row * 64 + lane] = f2bf(t1 * cc - t2 * sv); krot[(size_t)row * 64 + 32 + lane] = f2bf(t2 * cc + t1 * sv); }
    }
}
__device__ __forceinline__ void headnorm_phase(bf16_t* __restrict__ proj1, const bf16_t* __restrict__ oraw, const float* __restrict__ gn) {
    int tid = threadIdx.x; asm volatile("" : "+v"(tid));
    const int per = T_TOK / gridDim.x;
    const int h = tid >> 4, vs = (tid & 15) >> 2, c8 = (tid & 3) * 8;
    const int v0 = (tid & 15) * 8; const f32x4 g0 = *(const f32x4*)(gn + v0), g1 = *(const f32x4*)(gn + v0 + 4);
    for (int tok0 = blockIdx.x * per; tok0 < (blockIdx.x + 1) * per; tok0 += 4) {
        bf16x8 o[4], z[4];
#pragma unroll
        for (int u = 0; u < 4; ++u) { const int tok = tok0 + u, b = tok >> 13, sq = tok & (SEQ - 1);
            o[u] = *(const bf16x8*)(oraw + ((size_t)((b * 32 + h) * 4 + vs) * SEQ + sq) * 32 + c8); z[u] = *(const bf16x8*)(proj1 + (size_t)tok * N1 + 12288 + tid * 8); }
#pragma unroll
        for (int u = 0; u < 4; ++u) {
            float f[8], ss = 0.f;
#pragma unroll
            for (int j = 0; j < 8; ++j) { f[j] = bf2f((unsigned short)o[u][j]); ss += f[j] * f[j]; }
            ss += __shfl_xor(ss, 1); ss += __shfl_xor(ss, 2); ss += __shfl_xor(ss, 4); ss += __shfl_xor(ss, 8);
            const float r = 1.0f / sqrtf(ss * (1.0f / 128.0f) + EPS);
            f32x4 a, bb;
#pragma unroll
            for (int j = 0; j < 4; ++j) { a[j] = f[j] * r * g0[j] * bf2f((unsigned short)z[u][j]); bb[j] = f[4 + j] * r * g1[j] * bf2f((unsigned short)z[u][4 + j]); }
            *(bf16x8*)(proj1 + (size_t)(tok0 + u) * N1 + 8192 + tid * 8) = pack8(a, bb);
        }
    }
}

namespace hg {
constexpr int QT_S = 272, KD_S = 144;
constexpr int OFF_QT = 0, OFF_KT = OFF_QT + 64 * QT_S, OFF_QB = OFF_KT + 64 * QT_S, OFF_KD = OFF_QB + 64 * QT_S;
constexpr int OFF_VT = OFF_KD + 128 * KD_S, OFF_ST = OFF_VT + 32 * KD_S, OFF_ATT = OFF_ST + 32 * QT_S;
constexpr int OFF_SEG = OFF_ATT + 64 * KD_S, OFF_G32 = OFF_SEG + 2048, OFF_DEC = OFF_G32 + 512, LDS_BYTES = OFF_DEC + 512;
__device__ __forceinline__ int crow(int r, int hi) { return (r & 3) + 8 * (r >> 2) + 4 * hi; }

__device__ __forceinline__ void hgrn2_phase(char* lds, const bf16_t* __restrict__ proj1, bf16_t* __restrict__ oraw) {
    int tid = threadIdx.x; asm volatile("" : "+v"(tid));
    const int wid = __builtin_amdgcn_readfirstlane(tid >> 6), lane = tid & 63, r32 = lane & 31, hi = lane >> 5;
    const int kch = tid & 127, seg = tid >> 7;
    float* segtot = (float*)(lds + OFF_SEG); float* g32s = (float*)(lds + OFF_G32); float* decay = (float*)(lds + OFF_DEC);
    for (int item = blockIdx.x; item < 256; item += gridDim.x) {
        const int vs = item & 3, bh = item >> 2, b = bh >> 5, h = bh & 31;
        const bf16_t* base = proj1 + (size_t)b * SEQ * N1; bf16_t* ob = oraw + (size_t)item * SEQ * 32;
        const int qcol = h * 128 + kch, gcol = 4096 + h * 128 + kch, vcol = 8192 + h * 128 + vs * 32;
        f32x16 sacc = {};
        for (int i = tid; i < 32 * QT_S / 4; i += 512) ((unsigned*)(lds + OFF_ST))[i] = 0u;
        unsigned short graw[16], qraw[16]; u32x2 vraw;
        { const bf16_t* rp = base + (size_t)(seg * 16) * N1;
#pragma unroll
          for (int i = 0; i < 16; ++i) { graw[i] = rp[(size_t)i * N1 + gcol]; qraw[i] = rp[(size_t)i * N1 + qcol]; }
          vraw = *(const u32x2*)(base + (size_t)(tid >> 3) * N1 + vcol + (tid & 7) * 4); }
        for (int ch = 0; ch < 128; ++ch) {
            const int tok0 = ch * 64;
            float gl[16]; float cum = 0.f;
#pragma unroll
            for (int i = 0; i < 16; ++i) { cum += bf2f(graw[i]); gl[i] = cum; }
            segtot[seg * 128 + kch] = cum; if (seg == 2) g32s[kch] = bf2f(graw[0]);
            __syncthreads();
            { const float s0 = segtot[kch], s1 = segtot[128 + kch], s2 = segtot[256 + kch], s3 = segtot[384 + kch];
              const float off = (seg > 0 ? s0 : 0.f) + (seg > 1 ? s1 : 0.f) + (seg > 2 ? s2 : 0.f);
              const float tot = (s0 + s1) + (s2 + s3), bref = s0 + s1 + g32s[kch];
              if (seg == 0) decay[kch] = fast_exp(tot);
              float kd[16];
#pragma unroll
              for (int i = 0; i < 16; ++i) { const int t = seg * 16 + i; const float bb = off + gl[i], gv = bf2f(graw[i]), qv = bf2f(qraw[i]); const float kk = 1.0f - fast_exp(gv);
                  *(bf16_t*)(lds + OFF_QT + t * QT_S + kch * 2) = f2bf_n(qv * fast_exp(bb - bref));
                  *(bf16_t*)(lds + OFF_KT + t * QT_S + kch * 2) = f2bf_n(kk * fast_exp(bref - bb));
                  *(bf16_t*)(lds + OFF_QB + t * QT_S + kch * 2) = f2bf_n(qv * fast_exp(bb));
                  kd[i] = kk * fast_exp(tot - bb); }
              *(bf16x8*)(lds + OFF_KD + kch * KD_S + seg * 32) = pack8((f32x4){kd[0], kd[1], kd[2], kd[3]}, (f32x4){kd[4], kd[5], kd[6], kd[7]});
              *(bf16x8*)(lds + OFF_KD + kch * KD_S + seg * 32 + 16) = pack8((f32x4){kd[8], kd[9], kd[10], kd[11]}, (f32x4){kd[12], kd[13], kd[14], kd[15]});
              { const int t = tid >> 3, v4 = (tid & 7) * 4;
                *(bf16_t*)(lds + OFF_VT + (v4 + 0) * KD_S + t * 2) = (bf16_t)(vraw.x & 0xffffu); *(bf16_t*)(lds + OFF_VT + (v4 + 1) * KD_S + t * 2) = (bf16_t)(vraw.x >> 16);
                *(bf16_t*)(lds + OFF_VT + (v4 + 2) * KD_S + t * 2) = (bf16_t)(vraw.y & 0xffffu); *(bf16_t*)(lds + OFF_VT + (v4 + 3) * KD_S + t * 2) = (bf16_t)(vraw.y >> 16); }
            }
            if (ch + 1 < 128) { const bf16_t* rp = base + (size_t)(tok0 + 64 + seg * 16) * N1;
#pragma unroll
                for (int i = 0; i < 16; ++i) { graw[i] = rp[(size_t)i * N1 + gcol]; qraw[i] = rp[(size_t)i * N1 + qcol]; }
                vraw = *(const u32x2*)(base + (size_t)(tok0 + 64 + (tid >> 3)) * N1 + vcol + (tid & 7) * 4); }
            __syncthreads();
            f32x16 oacc = {};
            if (wid < 4) {
                const int ci = wid >> 1, si = wid & 1;
                if (!(ci == 0 && si == 1)) {
                    f32x16 aacc = {};
#pragma unroll
                    for (int kk = 0; kk < 8; ++kk) {
                        const bf16x8 af = *(const bf16x8*)(lds + OFF_QT + (32 * ci + r32) * QT_S + kk * 32 + hi * 16);
                        const bf16x8 bfr = *(const bf16x8*)(lds + OFF_KT + (32 * si + r32) * QT_S + kk * 32 + hi * 16);
                        aacc = __builtin_amdgcn_mfma_f32_32x32x16_bf16(af, bfr, aacc, 0, 0, 0); }
#pragma unroll
                    for (int i = 0; i < 16; ++i) { const int c = 32 * ci + crow(i, hi), s = 32 * si + r32; const float v = (c >= s) ? aacc[i] : 0.f;
                        *(bf16_t*)(lds + OFF_ATT + c * KD_S + s * 2) = f2bf_n(v); }
                } else {
#pragma unroll
                    for (int i = 0; i < 16; ++i) { const int c = crow(i, hi), s = 32 + r32; *(bf16_t*)(lds + OFF_ATT + c * KD_S + s * 2) = (bf16_t)0; }
                }
#pragma unroll
                for (int g4 = 0; g4 < 4; ++g4) { const f32x4 d = *(const f32x4*)(decay + 32 * wid + 8 * g4 + 4 * hi);
#pragma unroll
                    for (int j = 0; j < 4; ++j) sacc[g4 * 4 + j] *= d[j]; }
#pragma unroll
                for (int kk = 0; kk < 4; ++kk) {
                    const bf16x8 af = *(const bf16x8*)(lds + OFF_KD + (32 * wid + r32) * KD_S + kk * 32 + hi * 16);
                    const bf16x8 bfr = *(const bf16x8*)(lds + OFF_VT + r32 * KD_S + kk * 32 + hi * 16);
                    sacc = __builtin_amdgcn_mfma_f32_32x32x16_bf16(af, bfr, sacc, 0, 0, 0); }
            } else if (wid < 6) {
                const int ci = wid - 4;
#pragma unroll
                for (int kk = 0; kk < 8; ++kk) {
                    const bf16x8 af = *(const bf16x8*)(lds + OFF_QB + (32 * ci + r32) * QT_S + kk * 32 + hi * 16);
                    const bf16x8 bfr = *(const bf16x8*)(lds + OFF_ST + r32 * QT_S + kk * 32 + hi * 16);
                    oacc = __builtin_amdgcn_mfma_f32_32x32x16_bf16(af, bfr, oacc, 0, 0, 0); }
            }
            __syncthreads();
            if (wid < 4) {
#pragma unroll
                for (int g4 = 0; g4 < 4; ++g4) { u32x2 w; w.x = cvtpk_n(sacc[g4 * 4 + 0], sacc[g4 * 4 + 1]); w.y = cvtpk_n(sacc[g4 * 4 + 2], sacc[g4 * 4 + 3]);
                    *(u32x2*)(lds + OFF_ST + r32 * QT_S + (32 * wid + 8 * g4 + 4 * hi) * 2) = w; }
            } else if (wid < 6) {
                const int ci = wid - 4;
#pragma unroll
                for (int kk = 0; kk < 4; ++kk) {
                    const bf16x8 af = *(const bf16x8*)(lds + OFF_ATT + (32 * ci + r32) * KD_S + kk * 32 + hi * 16);
                    const bf16x8 bfr = *(const bf16x8*)(lds + OFF_VT + r32 * KD_S + kk * 32 + hi * 16);
                    oacc = __builtin_amdgcn_mfma_f32_32x32x16_bf16(af, bfr, oacc, 0, 0, 0); }
#pragma unroll
                for (int i = 0; i < 16; ++i) { const int c = 32 * ci + crow(i, hi); ob[(size_t)(tok0 + c) * 32 + r32] = f2bf_n(oacc[i]); }
            }
        }
        __syncthreads();
    }
}
}
constexpr int LDS_TOTAL = pg8::STAGE_BYTES;
static_assert(att::LDS_BYTES <= LDS_TOTAL && hg::LDS_BYTES <= LDS_TOTAL, "lds");

#ifndef PHMASK
#define PHMASK 0xFFFF
#endif
#define EN(n) (((PHMASK) >> (n)) & 1)
#ifndef PROBE_DUP7
#define PROBE_DUP7 0
#endif

__global__ void __launch_bounds__(512) mla_hgrn2_fwd(Params p) {
    extern __shared__ __attribute__((aligned(16))) unsigned char lds[];
    cg::grid_group grid = cg::this_grid();
    unsigned char* ws = p.ws;
    bf16_t* W0IN = (bf16_t*)(ws + WS_W0IN); bf16_t* WUQ = (bf16_t*)(ws + WS_WUQ); bf16_t* WUKV = (bf16_t*)(ws + WS_WUKV);
    bf16_t* W0O = (bf16_t*)(ws + WS_W0O); bf16_t* W1IN = (bf16_t*)(ws + WS_W1IN); bf16_t* W1O = (bf16_t*)(ws + WS_W1O);
    float* RSTD0 = (float*)(ws + WS_RSTD0); float* RSTDQ = (float*)(ws + WS_RSTDQ); float* RSTDKV = (float*)(ws + WS_RSTDKV); float* RSTD1 = (float*)(ws + WS_RSTD1);
    float* LB = (float*)(ws + WS_LB); float* COS = (float*)(ws + WS_COS); float* SIN = (float*)(ws + WS_SIN);
    bf16_t* KROT = (bf16_t*)(ws + WS_KROT); bf16_t* ACTA = (bf16_t*)(ws + WS_ACTA);
    bf16_t* PROJ0 = (bf16_t*)(ws + WS_PROJ0); bf16_t* QBUF = (bf16_t*)(ws + WS_Q); bf16_t* PROJ1 = (bf16_t*)(ws + WS_PROJ1);
    bf16_t* KVBUF = (bf16_t*)p.out;
    LAS unsigned char* ldsl = (LAS unsigned char*)lds;
    const int G = gridDim.x, c = blockIdx.x;

    if (EN(0))
    {
        char* tile = (char*)lds;
        wt_phase(p.l0_w_in, 4096, N0, p.l0_norm, W0IN, tile);
        wt_phase(p.l0_w_uq, 1024, NQ, p.l0_q_norm, WUQ, tile);
        wt_phase(p.l0_w_ukv, 512, NKV, p.l0_kv_norm, WUKV, tile);
        wt_phase(p.l0_w_o, 4096, 4096, nullptr, W0O, tile);
        wt_phase(p.l1_w_in, 4096, N1, p.l1_norm, W1IN, tile);
        wt_phase(p.l1_w_o, 4096, 4096, nullptr, W1O, tile);
        { u32x4 z = {0u, 0u, 0u, 0u}; u32x4* pad = (u32x4*)(W0IN + (size_t)N0 * 4096); const int n16 = (N0P - N0) * 4096 * 2 / 16;
          for (int i = c * 512 + threadIdx.x; i < n16; i += G * 512) pad[i] = z; }
        cast_rstd_phase(p.x, ACTA, RSTD0);
        tables_phase(p, COS, SIN, LB);
    }
#ifdef PROBE_P02
    {
        char* tile = (char*)lds;
        wt_phase(p.l0_w_in, 4096, N0, p.l0_norm, W0IN, tile);
        wt_phase(p.l0_w_uq, 1024, NQ, p.l0_q_norm, WUQ, tile);
        wt_phase(p.l0_w_ukv, 512, NKV, p.l0_kv_norm, WUKV, tile);
        wt_phase(p.l0_w_o, 4096, 4096, nullptr, W0O, tile);
        wt_phase(p.l1_w_in, 4096, N1, p.l1_norm, W1IN, tile);
        wt_phase(p.l1_w_o, 4096, 4096, nullptr, W1O, tile);
    }
#endif
    grid.sync();
    if (EN(1)) {
        pg8::Gemm g{ACTA, W0IN, T_TOK, N0P, 4096, 4096}; pg8::StaticOrder S; S.init(T_TOK, N0P, G, c);
        pg8::EpiBf16<1> E{PROJ0, N0P, RSTD0, 1600, nullptr};
        pg8::gemm_phase(ldsl, g, S, E);
    }
    grid.sync();
    if (EN(2)) stats_krot_phase(PROJ0, RSTDQ, RSTDKV, COS, SIN, KROT);
    grid.sync();
    if (EN(3)) {
        pg8::Gemm g{PROJ0, WUQ, T_TOK, NQ, 1024, N0P}; pg8::StaticOrder S; S.init(T_TOK, NQ, G, c);
        pg8::EpiBf16<0> E{QBUF, NQ, RSTDQ, 0, nullptr};
        pg8::gemm_phase(ldsl, g, S, E);
    }
    if (EN(3)) {
        pg8::Gemm g{PROJ0 + 1024, WUKV, T_TOK, NKV, 512, N0P}; pg8::StaticOrder S; S.init(T_TOK, NKV, G, c);
        pg8::EpiBf16<0> E{KVBUF, NKV, RSTDKV, 0, nullptr};
        pg8::gemm_phase(ldsl, g, S, E);
    }
    grid.sync();
    if (EN(4)) {
        att::Tensors T{QBUF, KVBUF, KROT, ACTA, PROJ0, COS, SIN};
        att::attn_phase((char*)lds, T);
    }
    grid.sync();
    if (EN(5)) {
        pg8::Gemm g{ACTA, W0O, T_TOK, 4096, 4096, 4096}; pg8::StaticOrder S; S.init(T_TOK, 4096, G, c);
        pg8::EpiResF32 E{p.x, p.out, 4096};
        pg8::gemm_phase(ldsl, g, S, E);
    }
    grid.sync();
    if (EN(6)) cast_rstd_phase(p.out, ACTA, RSTD1);
    grid.sync();
    if (EN(7)) {
        pg8::Gemm g{ACTA, W1IN, T_TOK, N1, 4096, 4096}; pg8::StaticOrder S; S.init(T_TOK, N1, G, c, PROBE_DUP7);
        pg8::EpiBf16<2> E{PROJ1, N1, RSTD1, 0, LB};
        pg8::gemm_phase(ldsl, g, S, E);
    }
    grid.sync();
    if (EN(8)) hg::hgrn2_phase((char*)lds, PROJ1, ACTA);
#ifdef PROBE_HG2
    __syncthreads(); hg::hgrn2_phase((char*)lds, PROJ1, ACTA);
#endif
    grid.sync();
    if (EN(9)) headnorm_phase(PROJ1, ACTA, p.l1_g_norm);
    grid.sync();
    if (EN(10)) {
        pg8::Gemm g{PROJ1 + 8192, W1O, T_TOK, 4096, 4096, N1}; pg8::StaticOrder S; S.init(T_TOK, 4096, G, c);
        pg8::EpiResF32 E{p.out, p.out, 4096};
        pg8::gemm_phase(ldsl, g, S, E);
    }
    grid.sync();
    if (EN(11)) final_norm_phase(p.out, p.final_norm);
}

extern "C" void kernel_launch(void* const* d_in, const int* in_sizes, int n_in, void* d_out, int out_size, void* d_ws, size_t ws_size, hipStream_t stream) {
    static int grid = 0;
    if (grid == 0) {
        if (n_in != 15 || ws_size < WS_END) { fprintf(stderr, "kernel_launch: unexpected inputs (n_in %d, ws %zu, need %zu)\n", n_in, ws_size, (size_t)WS_END); grid = -1; return; }
        int dev = 0, cus = 0, per_cu = 0;
        (void)hipGetDevice(&dev); (void)hipDeviceGetAttribute(&cus, hipDeviceAttributeMultiprocessorCount, dev);
        if (hipFuncSetAttribute((const void*)mla_hgrn2_fwd, hipFuncAttributeMaxDynamicSharedMemorySize, LDS_TOTAL) != hipSuccess) { fprintf(stderr, "kernel_launch: hipFuncSetAttribute failed\n"); grid = -1; return; }
        if (hipOccupancyMaxActiveBlocksPerMultiprocessor(&per_cu, (const void*)mla_hgrn2_fwd, 512, LDS_TOTAL) != hipSuccess || per_cu < 1) { fprintf(stderr, "kernel_launch: occupancy query gave %d\n", per_cu); per_cu = 1; }
        (void)hipGetLastError();
        if (cus <= 0) cus = 256;
        grid = cus * per_cu;
        fprintf(stderr, "kernel_launch: grid %d (cus %d x %d)\n", grid, cus, per_cu);
    }
    if (grid < 0) return;
    Params p{};
    p.x = (const float*)d_in[0]; p.pos = (const int*)d_in[1]; p.l0_norm = (const float*)d_in[2]; p.l0_w_in = (const float*)d_in[3]; p.l0_q_norm = (const float*)d_in[4];
    p.l0_w_uq = (const float*)d_in[5]; p.l0_kv_norm = (const float*)d_in[6]; p.l0_w_ukv = (const float*)d_in[7]; p.l0_w_o = (const float*)d_in[8]; p.l1_norm = (const float*)d_in[9];
    p.l1_w_in = (const float*)d_in[10]; p.l1_g_norm = (const float*)d_in[11]; p.l1_w_o = (const float*)d_in[12]; p.lower_bounds = (const float*)d_in[13]; p.final_norm = (const float*)d_in[14];
    p.out = (float*)d_out; p.ws = (unsigned char*)d_ws;
    for (int j = 0; j < 32; ++j) p.inv_freq[j] = (float)(1.0 / pow(10000.0, (double)(2 * j) / 64.0));
    void* args[] = {&p};
    hipError_t e = hipLaunchCooperativeKernel((const void*)mla_hgrn2_fwd, dim3(grid), dim3(512), args, LDS_TOTAL, stream);
    if (e != hipSuccess) fprintf(stderr, "kernel_launch: cooperative launch failed: %s (grid %d)\n", hipGetErrorString(e), grid);
}
```

```cpp
#include <hip/hip_runtime.h>
#include <hip/hip_cooperative_groups.h>
#include <cstdio>
#include <cstdint>
#include <cmath>
namespace cg = cooperative_groups;

typedef unsigned short bf16_t;
typedef short bf16x8 __attribute__((ext_vector_type(8)));
typedef short s16x4 __attribute__((ext_vector_type(4)));
typedef float f32x4 __attribute__((ext_vector_type(4)));
typedef float f32x16 __attribute__((ext_vector_type(16)));
typedef unsigned u32x4 __attribute__((ext_vector_type(4)));
typedef unsigned u32x2 __attribute__((ext_vector_type(2)));
#define LAS __attribute__((address_space(3)))

constexpr int T_TOK = 16384, SEQ = 8192, DM = 4096;
constexpr int N0 = 5696, N0P = 5888;
constexpr int NQ = 6144, NKV = 8192, N1 = 16384;
constexpr float EPS = 1e-6f;

constexpr size_t WS_W0IN = 0;
constexpr size_t WS_WUQ  = WS_W0IN + (size_t)N0P * 4096 * 2;
constexpr size_t WS_WUKV = WS_WUQ + (size_t)NQ * 1024 * 2;
constexpr size_t WS_W0O  = WS_WUKV + (size_t)NKV * 512 * 2;
constexpr size_t WS_W1IN = WS_W0O + (size_t)4096 * 4096 * 2;
constexpr size_t WS_W1O  = WS_W1IN + (size_t)N1 * 4096 * 2;
constexpr size_t WS_RSTD0 = WS_W1O + (size_t)4096 * 4096 * 2;
constexpr size_t WS_RSTDQ = WS_RSTD0 + 65536;
constexpr size_t WS_RSTDKV = WS_RSTDQ + 65536;
constexpr size_t WS_RSTD1 = WS_RSTDKV + 65536;
constexpr size_t WS_LB = WS_RSTD1 + 65536;
constexpr size_t WS_COS = WS_LB + 16384;
constexpr size_t WS_SIN = WS_COS + (size_t)T_TOK * 32 * 4;
constexpr size_t WS_KROT = WS_SIN + (size_t)T_TOK * 32 * 4;
constexpr size_t WS_ACTA = WS_KROT + (size_t)T_TOK * 64 * 2;
constexpr size_t WS_R = WS_ACTA + (size_t)T_TOK * 4096 * 2;
constexpr size_t WS_PROJ0 = WS_R;
constexpr size_t WS_Q = WS_PROJ0 + (size_t)T_TOK * N0P * 2;
constexpr size_t WS_PROJ1 = WS_R;
constexpr size_t WS_END = WS_R + (size_t)T_TOK * N1 * 2;

struct Params {
    const float* x; const int* pos; const float* l0_norm; const float* l0_w_in; const float* l0_q_norm; const float* l0_w_uq;
    const float* l0_kv_norm; const float* l0_w_ukv; const float* l0_w_o; const float* l1_norm; const float* l1_w_in;
    const float* l1_g_norm; const float* l1_w_o; const float* lower_bounds; const float* final_norm;
    float* out; unsigned char* ws;
    float inv_freq[32];
};

__device__ __forceinline__ unsigned cvtpk(float lo, float hi) { unsigned r; asm volatile("v_cvt_pk_bf16_f32 %0, %1, %2" : "=v"(r) : "v"(lo), "v"(hi)); return r; }
typedef float f32x2 __attribute__((ext_vector_type(2)));
typedef __bf16 bf16x2_t __attribute__((ext_vector_type(2)));
__device__ __forceinline__ unsigned cvtpk_n(float lo, float hi) { f32x2 v = {lo, hi}; bf16x2_t h = __builtin_convertvector(v, bf16x2_t); return __builtin_bit_cast(unsigned, h); }
__device__ __forceinline__ bf16_t f2bf_n(float f) { return (bf16_t)(cvtpk_n(f, 0.f) & 0xffffu); }
__device__ __forceinline__ bf16_t f2bf(float f) { return (bf16_t)(cvtpk(f, 0.f) & 0xffffu); }
__device__ __forceinline__ float bf2f(unsigned short h) { return __uint_as_float((unsigned)h << 16); }
__device__ __forceinline__ float bflo(unsigned w) { return __uint_as_float(w << 16); }
__device__ __forceinline__ float bfhi(unsigned w) { return __uint_as_float(w & 0xffff0000u); }
__device__ __forceinline__ bf16x8 pack8(f32x4 a, f32x4 b) {
    u32x4 w = {cvtpk(a[0], a[1]), cvtpk(a[2], a[3]), cvtpk(b[0], b[1]), cvtpk(b[2], b[3])};
    return *reinterpret_cast<bf16x8*>(&w);
}
__device__ __forceinline__ float fast_exp(float x) { return __builtin_amdgcn_exp2f(x * 1.4426950408889634f); }
__device__ __forceinline__ float silu_f(float v) { return v * __builtin_amdgcn_rcpf(1.0f + fast_exp(-v)); }
__device__ __forceinline__ float wave_sum(float v) {
#pragma unroll
    for (int o = 32; o > 0; o >>= 1) v += __shfl_xor(v, o);
    return v;
}

namespace pg8 {
constexpr int BM = 256, BK = 64, HALF = 128, HTB = HALF * BK * 2, STAGE_BYTES = 8 * HTB, NXCD = 8, WGM = 8;
__host__ __device__ __forceinline__ int lds_byte(int r, int c) { const int st = (r >> 4) * 2 + (c >> 5), rr = r & 15, cc = c & 31, ob = rr * 64 + cc * 2; return st * 1024 + (ob ^ (((ob >> 9) & 1) << 5)); }
__host__ __device__ __forceinline__ void stage_rc(int b, int& R, int& C) { const int st = b / 1024, sb = b % 1024, swz = sb ^ (((sb >> 9) & 1) << 5); R = (st >> 1) * 16 + swz / 64; C = (st & 1) * 32 + (swz % 64) / 2; }
__host__ __device__ __forceinline__ int perm32(int rho) { const int n = rho >> 4, i = rho & 15; return 8 * (i >> 2) + 4 * n + (i & 3); }
struct Unit { int pm, pn; };
struct Gemm { const bf16_t* A; const bf16_t* Bt; int M, N, K, lda; };
struct StaticOrder {
    int nM, nN, nwg, G, c, dup;
    __device__ void init(int M, int N, int G_, int c_, int dup_ = 0) { nM = M / BM; nN = N / BM; nwg = nM * nN; G = G_; c = c_; dup = dup_; }
    __device__ bool next(int i, Unit& u) const {
        const long L = (long)(i >> dup) * G + c; if (L >= nwg) return false;
        int wgid = (int)L; { const int q = nwg / NXCD, r = nwg % NXCD, xcd = wgid % NXCD, off = wgid / NXCD; wgid = (xcd < r ? xcd * (q + 1) : r * (q + 1) + (xcd - r) * q) + off; }
        const int nig = WGM * nN, gid = wgid / nig, fm = gid * WGM, gsz = (nM - fm) < WGM ? (nM - fm) : WGM;
        u.pm = fm + ((wgid % nig) % gsz); u.pn = (wgid % nig) / gsz; return true;
    }
};

template <int MODE> struct EpiBf16 {
    static constexpr bool PERM = true;
    bf16_t* O; int ldc; const float* rs; int thr; const float* lb;
    __device__ __forceinline__ void operator()(const f32x4 (&acc)[2][2][4][2], const Unit& u, int wr, int wc, int fr, int fq) const {
        const int row0 = u.pm * BM + wr * 64 + fr, col0 = u.pn * BM + wc * 32 + 8 * fq;
        const int sec = (u.pn * BM) >> 12;
        f32x4 lbv[2][2] = {};
        if (MODE == 2) { if (sec == 1) {
#pragma unroll
            for (int bj = 0; bj < 2; ++bj) { lbv[bj][0] = *(const f32x4*)(lb + col0 + bj * HALF - 4096); lbv[bj][1] = *(const f32x4*)(lb + col0 + bj * HALF - 4096 + 4); } } }
        float rsv[2][4];
#pragma unroll
        for (int ai = 0; ai < 2; ++ai)
#pragma unroll
            for (int m = 0; m < 4; ++m) rsv[ai][m] = rs[row0 + ai * HALF + m * 16];
#pragma unroll
        for (int ai = 0; ai < 2; ++ai)
#pragma unroll
            for (int m = 0; m < 4; ++m) {
                const int row = row0 + ai * HALF + m * 16; const float s = rsv[ai][m];
                bf16_t* rowp = O + (size_t)row * ldc + col0;
#pragma unroll
                for (int bj = 0; bj < 2; ++bj) {
                    f32x4 v0 = acc[ai][bj][m][0] * s, v1 = acc[ai][bj][m][1] * s;
                    const int col = col0 + bj * HALF;
                    if (MODE == 1) { if (col >= thr) {
#pragma unroll
                        for (int j = 0; j < 4; ++j) { v0[j] = silu_f(v0[j]); v1[j] = silu_f(v1[j]); } } }
                    if (MODE == 2) {
                        if (sec == 0 || sec == 3) {
#pragma unroll
                            for (int j = 0; j < 4; ++j) { v0[j] = silu_f(v0[j]); v1[j] = silu_f(v1[j]); } }
                        else if (sec == 1) {
                            const f32x4 l0 = lbv[bj][0], l1 = lbv[bj][1];
#pragma unroll
                            for (int j = 0; j < 4; ++j) {
                                float sg = __builtin_amdgcn_rcpf(1.0f + fast_exp(-v0[j])); float fg = l0[j] + (1.0f - l0[j]) * sg; v0[j] = __logf(fg);
                                sg = __builtin_amdgcn_rcpf(1.0f + fast_exp(-v1[j])); fg = l1[j] + (1.0f - l1[j]) * sg; v1[j] = __logf(fg); }
                        }
                    }
                    u32x4 w; w.x = cvtpk(v0[0], v0[1]); w.y = cvtpk(v0[2], v0[3]); w.z = cvtpk(v1[0], v1[1]); w.w = cvtpk(v1[2], v1[3]);
                    *(u32x4*)(rowp + bj * HALF) = w;
                }
            }
    }
};
struct EpiResF32 {
    static constexpr bool PERM = false;
    const float* base; float* out; int ldc;
    __device__ __forceinline__ void operator()(const f32x4 (&acc)[2][2][4][2], const Unit& u, int wr, int wc, int fr, int fq) const {
        const int row0 = u.pm * BM + wr * 64 + fr, col0 = u.pn * BM + wc * 32 + 4 * fq;
        f32x4 bs[2][4];
#define RES_LOAD(g, slot) do { const size_t off_ = (size_t)(row0 + ((g) >> 2) * HALF + ((g) & 3) * 16) * ldc + col0; \
        _Pragma("unroll") for (int bj = 0; bj < 2; ++bj) _Pragma("unroll") for (int n = 0; n < 2; ++n) bs[slot][bj * 2 + n] = *(const f32x4*)(base + off_ + bj * HALF + n * 16); } while (0)
        RES_LOAD(0, 0);
#pragma unroll
        for (int g = 0; g < 8; ++g) {
            if (g + 1 < 8) RES_LOAD(g + 1, (g + 1) & 1);
            const int ai = g >> 2, m = g & 3; const size_t off = (size_t)(row0 + ai * HALF + m * 16) * ldc + col0;
#pragma unroll
            for (int bj = 0; bj < 2; ++bj)
#pragma unroll
                for (int n = 0; n < 2; ++n) *(f32x4*)(out + off + bj * HALF + n * 16) = bs[g & 1][bj * 2 + n] + acc[ai][bj][m][n];
        }
#undef RES_LOAD
    }
};

template <class Epi, class Sched>
__device__ __forceinline__ void gemm_phase(LAS unsigned char* lds, const Gemm g, const Sched& S, const Epi& E) {
    int tid = threadIdx.x; asm volatile("" : "+v"(tid));
    const int wid = __builtin_amdgcn_readfirstlane(tid >> 6), lane = tid & 63, wr = wid >> 2, wc = wid & 3, fr = lane & 15, fq = lane >> 4;
    const int K = g.K, nt = K / BK, lda = g.lda;
    unsigned voffA[2], voffB[2];
#pragma unroll
    for (int i = 0; i < 2; ++i) { int R, C; stage_rc(tid * 16 + i * 8192, R, C); const int Rb = Epi::PERM ? ((R & ~31) + perm32(R & 31)) : R;
        voffA[i] = (unsigned)(R * lda + C) * 2u; voffB[i] = (unsigned)(Rb * K + C) * 2u; }
    const size_t kstep = (size_t)(BK * 2);
    const size_t hstepA = (size_t)HALF * lda * 2, hstepB = (size_t)HALF * K * 2;
    const size_t tstepA = 2 * hstepA, tstepB = 2 * hstepB;
    const unsigned ldsw = (unsigned)wid * 1024u;
    const int aoff = lds_byte(wr * 64 + fr, fq * 8), boff = lds_byte(wc * 32 + fr, fq * 8);
#define PG8_SA(b, h) (((b) * 2 + (h)) * HTB)
#define PG8_SB(b, h) ((4 + (b) * 2 + (h)) * HTB)
#define PG8_STAGE(bufoff, gbase, voff) do { _Pragma("unroll") for (int _i = 0; _i < 2; ++_i) \
        __builtin_amdgcn_global_load_lds((const unsigned*)((const char*)(gbase) + (voff)[_i]), (LAS unsigned*)(lds + (bufoff) + ldsw + _i * 8192), 16, 0, 0); } while (0)
#define PG8_LDA(dst, b, h) do { _Pragma("unroll") for (int m = 0; m < 4; ++m) _Pragma("unroll") for (int k = 0; k < 2; ++k) dst[m][k] = *(const LAS bf16x8*)(lds + PG8_SA(b, h) + aoff + m * 2048 + k * 1024); } while (0)
#define PG8_LDB(dst, b, h) do { _Pragma("unroll") for (int n = 0; n < 2; ++n) _Pragma("unroll") for (int k = 0; k < 2; ++k) dst[n][k] = *(const LAS bf16x8*)(lds + PG8_SB(b, h) + boff + n * 2048 + k * 1024); } while (0)
#define PG8_MMA(ai, bj, At, Bt) do { __builtin_amdgcn_s_setprio(1); _Pragma("unroll") for (int m = 0; m < 4; ++m) _Pragma("unroll") for (int n = 0; n < 2; ++n) _Pragma("unroll") for (int k = 0; k < 2; ++k) \
        acc[ai][bj][m][n] = __builtin_amdgcn_mfma_f32_16x16x32_bf16(Bt[n][k], At[m][k], acc[ai][bj][m][n], 0, 0, 0); __builtin_amdgcn_s_setprio(0); } while (0)
#define PG8_WAIT_V(n) asm volatile("s_waitcnt vmcnt(" #n ")" ::: "memory")
#define PG8_WAIT_L(n) asm volatile("s_waitcnt lgkmcnt(" #n ")" ::: "memory")
#define PG8_BAR __builtin_amdgcn_s_barrier()
#define PG8_SCHED __builtin_amdgcn_sched_barrier(0)
    Unit cur, nxt; int ui = 0;
    if (!S.next(0, cur)) return;
    f32x4 acc[2][2][4][2];
#pragma unroll
    for (int a = 0; a < 2; ++a)
#pragma unroll
        for (int b = 0; b < 2; ++b)
#pragma unroll
            for (int m = 0; m < 4; ++m)
#pragma unroll
                for (int n = 0; n < 2; ++n) acc[a][b][m][n] = (f32x4){0.f, 0.f, 0.f, 0.f};
    bf16x8 At[4][2], B0[2][2], B1[2][2];
    const char* cA = (const char*)g.A + (size_t)cur.pm * tstepA; const char* cB = (const char*)g.Bt + (size_t)cur.pn * tstepB;
    PG8_STAGE(PG8_SB(0, 0), cB, voffB); PG8_STAGE(PG8_SA(0, 0), cA, voffA); PG8_STAGE(PG8_SB(0, 1), cB + hstepB, voffB); PG8_STAGE(PG8_SA(0, 1), cA + hstepA, voffA);
    if (wr == 1) PG8_BAR;
    PG8_WAIT_V(4); PG8_BAR;
    PG8_STAGE(PG8_SB(1, 0), cB + kstep, voffB); PG8_STAGE(PG8_SA(1, 0), cA + kstep, voffA); PG8_STAGE(PG8_SB(1, 1), cB + hstepB + kstep, voffB);
    PG8_WAIT_V(6); PG8_BAR;
    for (;;) {
        const bool has_next = S.next(ui + 1, nxt);
        const char* nA = has_next ? (const char*)g.A + (size_t)nxt.pm * tstepA : cA; const char* nB = has_next ? (const char*)g.Bt + (size_t)nxt.pn * tstepB : cB;
        for (int t = 0; t < nt; t += 2) {
            const bool last = (t == nt - 2);
            const char* a1 = cA + (size_t)(t + 1) * kstep;
            const char* a2 = last ? nA : cA + (size_t)(t + 2) * kstep; const char* b2 = last ? nB : cB + (size_t)(t + 2) * kstep;
            const char* a3 = a2 + kstep; const char* b3 = b2 + kstep;
            PG8_LDB(B0, 0, 0); PG8_SCHED; PG8_LDA(At, 0, 0); PG8_STAGE(PG8_SA(1, 1), a1 + hstepA, voffA);
            PG8_WAIT_L(8); PG8_BAR; PG8_WAIT_L(0); PG8_MMA(0, 0, At, B0); PG8_BAR; PG8_SCHED;
            PG8_LDB(B1, 0, 1); PG8_STAGE(PG8_SB(0, 0), b2, voffB);
            PG8_BAR; PG8_WAIT_L(0); PG8_MMA(0, 1, At, B1); PG8_BAR;
            PG8_LDA(At, 0, 1); PG8_STAGE(PG8_SA(0, 0), a2, voffA);
            PG8_BAR; PG8_WAIT_L(0); PG8_MMA(1, 0, At, B0); PG8_BAR; PG8_SCHED;
            PG8_STAGE(PG8_SB(0, 1), b2 + hstepB, voffB);
            PG8_WAIT_V(6); PG8_BAR; PG8_MMA(1, 1, At, B1); PG8_BAR;
            PG8_LDB(B0, 1, 0); PG8_SCHED; PG8_LDA(At, 1, 0); PG8_STAGE(PG8_SA(0, 1), a2 + hstepA, voffA);
            PG8_WAIT_L(8); PG8_BAR; PG8_WAIT_L(0); PG8_MMA(0, 0, At, B0); PG8_BAR; PG8_SCHED;
            PG8_LDB(B1, 1, 1); PG8_STAGE(PG8_SB(1, 0), b3, voffB);
            PG8_BAR; PG8_WAIT_L(0); PG8_MMA(0, 1, At, B1); PG8_BAR;
            PG8_LDA(At, 1, 1); PG8_STAGE(PG8_SA(1, 0), a3, voffA);
            PG8_BAR; PG8_WAIT_L(0); PG8_MMA(1, 0, At, B0); PG8_BAR; PG8_SCHED;
            PG8_STAGE(PG8_SB(1, 1), b3 + hstepB, voffB);
            PG8_WAIT_V(6); PG8_BAR; PG8_MMA(1, 1, At, B1); PG8_BAR;
        }
        E(acc, cur, wr, wc, fr, fq);
        if (!has_next) break;
#pragma unroll
        for (int a = 0; a < 2; ++a)
#pragma unroll
            for (int b = 0; b < 2; ++b)
#pragma unroll
                for (int m = 0; m < 4; ++m)
#pragma unroll
                    for (int n = 0; n < 2; ++n) acc[a][b][m][n] = (f32x4){0.f, 0.f, 0.f, 0.f};
        cur = nxt; cA = nA; cB = nB; ++ui;
    }
    PG8_WAIT_V(0);
    if (wr == 0) PG8_BAR;
    PG8_BAR;
#undef PG8_SA
#undef PG8_SB
#undef PG8_STAGE
#undef PG8_LDA
#undef PG8_LDB
#undef PG8_MMA
#undef PG8_WAIT_V
#undef PG8_WAIT_L
#undef PG8_BAR
#undef PG8_SCHED
}
}
namespace att {
constexpr int NW = 8, QBLK = 32, KVBLK = 64, QB = NW * QBLK;
constexpr int DQ = 192, DV = 128;
constexpr int QS = NQ, KVS = NKV, KRS = 64, OS = 4096, ZS = N0P;
constexpr int SHM_V = KVBLK * DV * 2, SHM_K = KVBLK * DQ * 2;
constexpr int QR_OFF = 2 * SHM_V + 2 * SHM_K + NW * 64 * 4;
constexpr int LDS_BYTES = QR_OFF + NW * 4096;
constexpr float SCALE = 0.07216878364870322f;
constexpr float THR = 8.f;
constexpr unsigned WBIG = 0x40000000u;

#define KSWZ(row, colB) ((row) * 384 + ((colB) ^ (((row) & 7) << 4)))
#define SBAR() __builtin_amdgcn_sched_barrier(0)
__device__ __forceinline__ int v_st(int k, int c) { const int kk = (k & ~0xC) | ((k & 4) << 1) | ((k & 8) >> 1); return ((kk >> 3) * 4 + (c >> 5)) * 512 + ((kk & 7) * 32 + (c & 31)) * 2; }
__device__ __forceinline__ int v_rd_base(int lane) { return ((lane & 3) << 3) | (((lane >> 2) & 3) << 6) | (((lane >> 4) & 1) << 5) | (((lane >> 5) & 1) << 8); }
constexpr int v_rd_off(int d0, int ks, int half) { return d0 * 512 + ks * 4096 + half * 2048; }
__device__ __forceinline__ int crow(int r, int hi) { return (r & 3) + 8 * (r >> 2) + 4 * hi; }
__device__ __forceinline__ bf16x8 load8(const bf16_t* p) { return *reinterpret_cast<const bf16x8*>(p); }

__device__ __forceinline__ void mask_tile(f32x16& p0, f32x16& p1, int dq) {
    const float NEG = -__builtin_inff();
#pragma unroll
    for (int r = 0; r < 16; ++r) {
        const int c = (r & 3) + 8 * (r >> 2);
        if ((unsigned)(dq - c) >= WBIG) p0[r] = NEG;
        if ((unsigned)(dq - c - 32) >= WBIG) p1[r] = NEG;
    }
}
__device__ __forceinline__ void partialSM(f32x16& p0, f32x16& p1, float& m_reg, float& mn, float& alpha) {
    float pmax = p0[0];
#pragma unroll
    for (int r = 1; r < 16; ++r) pmax = fmaxf(pmax, p0[r]);
#pragma unroll
    for (int r = 0; r < 16; ++r) pmax = fmaxf(pmax, p1[r]);
    { auto rr = __builtin_amdgcn_permlane32_swap(__float_as_uint(pmax), __float_as_uint(pmax), false, false);
      pmax = fmaxf(__uint_as_float(rr[0]), __uint_as_float(rr[1])); }
    constexpr float C2 = 1.4426950408889634f * SCALE;
    if (__builtin_expect(__all((pmax - m_reg) * SCALE <= THR), 1)) { mn = m_reg; alpha = 1.f; }
    else { mn = fmaxf(m_reg, pmax); alpha = __builtin_amdgcn_exp2f((m_reg - mn) * C2); m_reg = mn; }
    const float mnL = -mn * C2;
#pragma unroll
    for (int r = 0; r < 16; ++r) p0[r] = fmaf(p0[r], C2, mnL);
#pragma unroll
    for (int r = 0; r < 16; ++r) p1[r] = fmaf(p1[r], C2, mnL);
#pragma unroll
    for (int r = 0; r < 16; ++r) p0[r] = __builtin_amdgcn_exp2f(p0[r]);
}
__device__ __forceinline__ void finishSM(f32x16& p0, f32x16& p1, float alpha, float& l_reg, bf16x8& pa0, bf16x8& pa1, bf16x8& pa2, bf16x8& pa3) {
#pragma unroll
    for (int r = 0; r < 16; ++r) p1[r] = __builtin_amdgcn_exp2f(p1[r]);
    float ps = 0;
#pragma unroll
    for (int r = 0; r < 16; ++r) ps += p0[r];
#pragma unroll
    for (int r = 0; r < 16; ++r) ps += p1[r];
    { auto rr = __builtin_amdgcn_permlane32_swap(__float_as_uint(ps), __float_as_uint(ps), false, false);
      ps = __uint_as_float(rr[0]) + __uint_as_float(rr[1]); }
    l_reg = l_reg * alpha + ps;
#define PK4(P, B_, OUT) do { unsigned a0 = cvtpk(P[B_+0], P[B_+1]), a1 = cvtpk(P[B_+2], P[B_+3]);                          \
        unsigned b0 = cvtpk(P[B_+4], P[B_+5]), b1 = cvtpk(P[B_+6], P[B_+7]);                                             \
        auto r0 = __builtin_amdgcn_permlane32_swap(a0, b0, false, false); auto r1 = __builtin_amdgcn_permlane32_swap(a1, b1, false, false); \
        u32x4 w = {r0[0], r1[0], r0[1], r1[1]}; OUT = *reinterpret_cast<bf16x8*>(&w); } while (0)
    PK4(p0, 0, pa0); PK4(p0, 8, pa1); PK4(p1, 0, pa2); PK4(p1, 8, pa3);
#undef PK4
}
template <int KB>
__device__ __forceinline__ void qkt(f32x16& p0, f32x16& p1, const char* K_lds, int r32, int hi, const bf16x8* qr, const char* qrl) {
    p0 = f32x16{}; p1 = f32x16{};
    const char* kb[4];
#pragma unroll
    for (int dd = 0; dd < 4; ++dd) kb[dd] = K_lds + KB * SHM_K + KSWZ(r32, (dd * 16 + hi * 8) * 2);
#pragma unroll
    for (int d0 = 0; d0 < 12; ++d0) { const char* a = kb[d0 & 3] + (d0 >> 2) * 128;
        bf16x8 b0 = *reinterpret_cast<const bf16x8*>(a);
        bf16x8 b1 = *reinterpret_cast<const bf16x8*>(a + 32 * 384);
        bf16x8 qf; if (d0 < 8) qf = qr[d0]; else qf = *reinterpret_cast<const bf16x8*>(qrl + (d0 - 8) * 1024);
        p0 = __builtin_amdgcn_mfma_f32_32x32x16_bf16(b0, qf, p0, 0, 0, 0);
        p1 = __builtin_amdgcn_mfma_f32_32x32x16_bf16(b1, qf, p1, 0, 0, 0);
    }
}
template <int VB>
__device__ __forceinline__ void pv_tile(f32x16* o, int vb0, bf16x8 pa0, bf16x8 pa1, bf16x8 pa2, bf16x8 pa3) {
#define TRRD(dst, off) asm volatile("ds_read_b64_tr_b16 %0, %1 offset:%2" : "=&v"(dst) : "v"(vb0), "i"(off) : "memory")
#define PV_D0(d0) do { s16x4 l0, l1, l2, l3, h0, h1, h2, h3; constexpr int b_ = VB * SHM_V + v_rd_off(d0, 0, 0); \
        TRRD(l0, b_); TRRD(h0, b_ + 2048); TRRD(l1, b_ + 4096); TRRD(h1, b_ + 6144); TRRD(l2, b_ + 8192); TRRD(h2, b_ + 10240); TRRD(l3, b_ + 12288); TRRD(h3, b_ + 14336); \
        asm volatile("s_waitcnt lgkmcnt(0)" ::: "memory"); SBAR();   \
        o[d0] = __builtin_amdgcn_mfma_f32_32x32x16_bf16(pa0, (bf16x8){l0[0], l0[1], l0[2], l0[3], h0[0], h0[1], h0[2], h0[3]}, o[d0], 0, 0, 0);   \
        o[d0] = __builtin_amdgcn_mfma_f32_32x32x16_bf16(pa1, (bf16x8){l1[0], l1[1], l1[2], l1[3], h1[0], h1[1], h1[2], h1[3]}, o[d0], 0, 0, 0);   \
        o[d0] = __builtin_amdgcn_mfma_f32_32x32x16_bf16(pa2, (bf16x8){l2[0], l2[1], l2[2], l2[3], h2[0], h2[1], h2[2], h2[3]}, o[d0], 0, 0, 0);   \
        o[d0] = __builtin_amdgcn_mfma_f32_32x32x16_bf16(pa3, (bf16x8){l3[0], l3[1], l3[2], l3[3], h3[0], h3[1], h3[2], h3[3]}, o[d0], 0, 0, 0); } while (0)
    PV_D0(0); PV_D0(1); PV_D0(2); PV_D0(3);
#undef PV_D0
#undef TRRD
}

struct BlockRef { const bf16_t* Q; const bf16_t* K; const bf16_t* KR; const bf16_t* V; bf16_t* O; const bf16_t* Z; const float* CS; const float* SN; int P0; };
struct Stage { bf16x8 st_v0, st_v1, st_k0, st_k1, st_kr; };
#define VMW() asm volatile("s_waitcnt vmcnt(0)" ::: "memory")
#define SLOAD_H(R, k0) do { const char* kt_ = (const char*)(R).K + (size_t)(k0) * (KVS * 2); const char* kt2_ = kt_ + 32 * KVS * 2; const char* krt_ = (const char*)(R).KR + (size_t)(k0) * (KRS * 2); \
                            S.st_v0 = *(const bf16x8*)(kt_ + koff + 256); S.st_v1 = *(const bf16x8*)(kt2_ + koff + 256);  \
                            S.st_k0 = *(const bf16x8*)(kt_ + koff); S.st_k1 = *(const bf16x8*)(kt2_ + koff);  \
                            S.st_kr = *(const bf16x8*)(krt_ + kroff); } while (0)
#define SWRITE_HK(bf) do { *(bf16x8*)(K_lds + (bf) * SHM_K + kws) = S.st_k0; *(bf16x8*)(K_lds + (bf) * SHM_K + kws + 32 * 384) = S.st_k1; \
                           *(bf16x8*)(K_lds + (bf) * SHM_K + kwr) = S.st_kr; } while (0)
#define SWRITE_HV(bf) do { *(bf16x8*)(V_lds + (bf) * SHM_V + vst0) = S.st_v0; *(bf16x8*)(V_lds + (bf) * SHM_V + vst1) = S.st_v1; } while (0)
#define SWRITE_H(bf) do { SWRITE_HV(bf); SWRITE_HK(bf); } while (0)

__device__ __forceinline__ void rope_q(const BlockRef& cur, const bf16x8* qrp, char* qrl, int wid, int r32, int hi) {
    const int row = wid * QBLK + r32;
    const unsigned toff = (unsigned)((row * 32 + hi * 8) * 4);
    const float* cp = (const float*)((const char*)cur.CS + toff); const float* sp = (const float*)((const char*)cur.SN + toff);
#pragma unroll
    for (int pr = 0; pr < 2; ++pr) {
        const f32x4 c0 = *(const f32x4*)(cp + pr * 16), c1 = *(const f32x4*)(cp + pr * 16 + 4), s0 = *(const f32x4*)(sp + pr * 16), s1 = *(const f32x4*)(sp + pr * 16 + 4);
        const bf16x8 a = qrp[pr], b = qrp[2 + pr];
        f32x4 o1l, o1h, o2l, o2h;
#pragma unroll
        for (int j = 0; j < 4; ++j) {
            float t1 = bf2f((unsigned short)a[j]), t2 = bf2f((unsigned short)b[j]);
            o1l[j] = t1 * c0[j] - t2 * s0[j]; o2l[j] = t2 * c0[j] + t1 * s0[j];
            t1 = bf2f((unsigned short)a[4 + j]); t2 = bf2f((unsigned short)b[4 + j]);
            o1h[j] = t1 * c1[j] - t2 * s1[j]; o2h[j] = t2 * c1[j] + t1 * s1[j];
        }
        *(bf16x8*)(qrl + pr * 1024) = pack8(o1l, o1h); *(bf16x8*)(qrl + (2 + pr) * 1024) = pack8(o2l, o2h);
    }
}
__device__ __forceinline__ void causal_block(const BlockRef& cur, char* lds) {
    int tid = threadIdx.x; asm volatile("" : "+v"(tid));
    const int wid = __builtin_amdgcn_readfirstlane(tid >> 6), lane = tid & 63, r32 = lane & 31, hi = lane >> 5;
    const int NT = (cur.P0 + QB - 1) / KVBLK + 1;
    const int qlo = cur.P0 + wid * QBLK, qm = qlo + r32 - 4 * hi;
    char* V_lds = lds; char* K_lds = lds + 2 * SHM_V;
    float* ws = (float*)(lds + 2 * SHM_V + 2 * SHM_K) + wid * 64; float* li_l = ws, * al_l = ws + 32;
    float m_reg = -1e30f, l_reg = 0; f32x16 o[4] = {};
    const int sr = tid >> 4, sc = (tid & 15) * 8, vst0 = v_st(sr, sc), vst1 = v_st(32 + sr, sc), kws = KSWZ(sr, sc * 2);
    const int krr = tid >> 3, krc = (tid & 7) * 8, kwr = KSWZ(krr, (128 + krc) * 2);
    const int vb0 = (int)(uintptr_t)V_lds + v_rd_base(lane);
    unsigned koff = (unsigned)((sr * KVS + sc) * 2), kroff = (unsigned)((krr * KRS + krc) * 2);
    unsigned qoff = (unsigned)(((wid * QBLK + r32) * QS + hi * 8) * 2);
    asm volatile("" : "+v"(koff), "+v"(kroff), "+v"(qoff));
    Stage S; bf16x8 qr[8]; char* qrl = lds + QR_OFF + wid * 4096 + lane * 16;
    { bf16x8 qrp[4];
#pragma unroll
      for (int d0 = 0; d0 < 8; ++d0) qr[d0] = *(const bf16x8*)((const char*)cur.Q + qoff + d0 * 32);
#pragma unroll
      for (int d0 = 0; d0 < 4; ++d0) qrp[d0] = *(const bf16x8*)((const char*)cur.Q + qoff + (8 + d0) * 32);
      SLOAD_H(cur, 0);
      rope_q(cur, qrp, qrl, wid, r32, hi); }
    VMW(); SWRITE_H(0); SBAR();
    SLOAD_H(cur, KVBLK); SBAR();
    __syncthreads();
#define RESC(a) do { if (__any((a) < 1.f)) { if (hi == 0) al_l[r32] = (a); asm volatile("s_waitcnt lgkmcnt(0)" ::: "memory");              \
                     for (int d_ = 0; d_ < 4; ++d_) for (int r = 0; r < 16; ++r) o[d_][r] *= al_l[crow(r, hi)]; } } while (0)
#define KBASE(t) ((t) * KVBLK)
#define MASKT(P0_, P1_, t) do { const int kb_ = KBASE(t); if (kb_ + KVBLK - 1 > qlo) mask_tile(P0_, P1_, qm - kb_); } while (0)
    f32x16 pA0, pA1, pB0, pB1; float mnA, mnB, alA, alB; bf16x8 pa0, pa1, pa2, pa3;
    qkt<0>(pA0, pA1, K_lds, r32, hi, qr, qrl);
    MASKT(pA0, pA1, 0); partialSM(pA0, pA1, m_reg, mnA, alA);
    VMW(); SWRITE_H(1);
    __syncthreads();
#define HALF_STEP(PX0, PX1, mnX, alX, PY0, PY1, alY, t, KB, VB, SB) do {                                                      \
        SBAR(); qkt<KB>(PX0, PX1, K_lds, r32, hi, qr, qrl);                                                                        \
        finishSM(PY0, PY1, alY, l_reg, pa0, pa1, pa2, pa3); SBAR();                                                           \
        if ((t) + 1 < NT) { SLOAD_H(cur, KBASE((t) + 1)); SBAR(); }                                                           \
        pv_tile<VB>(o, vb0, pa0, pa1, pa2, pa3); MASKT(PX0, PX1, (t)); partialSM(PX0, PX1, m_reg, mnX, alX);                  \
        __syncthreads();                                                                                                      \
        if ((t) + 1 < NT) { VMW(); SWRITE_H(SB); }                                                                            \
        RESC(alX); __syncthreads(); } while (0)
    for (int t = 1; t + 1 < NT; t += 2) {
        HALF_STEP(pB0, pB1, mnB, alB, pA0, pA1, alA, t, 1, 0, 0);
        HALF_STEP(pA0, pA1, mnA, alA, pB0, pB1, alB, t + 1, 0, 1, 1);
    }
    SBAR(); qkt<1>(pB0, pB1, K_lds, r32, hi, qr, qrl); SBAR();
    finishSM(pA0, pA1, alA, l_reg, pa0, pa1, pa2, pa3); SBAR();
    pv_tile<0>(o, vb0, pa0, pa1, pa2, pa3);
    MASKT(pB0, pB1, NT - 1); partialSM(pB0, pB1, m_reg, mnB, alB); __syncthreads(); RESC(alB);
    finishSM(pB0, pB1, alB, l_reg, pa0, pa1, pa2, pa3); SBAR(); pv_tile<1>(o, vb0, pa0, pa1, pa2, pa3);
    SBAR();
    if (hi == 0) li_l[r32] = l_reg;
    __syncthreads();
    {
        char* ot = lds + wid * (32 * 272);
        const int wb = 4 * hi * 272 + r32 * 2;
#pragma unroll
        for (int rg = 0; rg < 4; ++rg) {
            const f32x4 lv = *(const f32x4*)(li_l + 8 * rg + 4 * hi);
#pragma unroll
            for (int j = 0; j < 4; ++j) { const int r = rg * 4 + j; const float rl = __builtin_amdgcn_rcpf(lv[j]);
#pragma unroll
                for (int d0 = 0; d0 < 4; ++d0) *(bf16_t*)(ot + wb + (j + 8 * rg) * 272 + d0 * 64) = f2bf(o[d0][r] * rl); }
        }
        asm volatile("s_waitcnt lgkmcnt(0)" ::: "memory");
        const int rr = lane >> 4, c8 = (lane & 15) * 8;
        const unsigned zoff = (unsigned)(((wid * QBLK + rr) * ZS + c8) * 2), ooff = (unsigned)(((wid * QBLK + rr) * OS + c8) * 2);
#pragma unroll
        for (int i = 0; i < 8; ++i) {
            const bf16x8 ov = *(const bf16x8*)(ot + (i * 4 + rr) * 272 + c8 * 2);
            const bf16x8 zv = *(const bf16x8*)((const char*)cur.Z + (size_t)(i * 4 * ZS * 2) + zoff);
            f32x4 a, b;
#pragma unroll
            for (int j = 0; j < 4; ++j) { a[j] = bf2f((unsigned short)ov[j]) * bf2f((unsigned short)zv[j]); b[j] = bf2f((unsigned short)ov[4 + j]) * bf2f((unsigned short)zv[4 + j]); }
            *(bf16x8*)((char*)cur.O + (size_t)(i * 4 * OS * 2) + ooff) = pack8(a, b);
        }
    }
    __syncthreads();
#undef RESC
#undef KBASE
#undef MASKT
#undef HALF_STEP
}
#undef VMW
#undef SLOAD_H
#undef SWRITE_HK
#undef SWRITE_HV
#undef SWRITE_H

struct Item { int bh, qb0, qb1; };
constexpr int NQB = SEQ / QB, NX = NQB / 2, NBH = 64, TOTAL = NX * NBH;
__device__ __forceinline__ Item decode(int L) {
    Item it; const int xcd = L & 7, k = L >> 3, gi = k / NX, r = k - gi * NX;
    it.bh = gi * 8 + xcd; it.qb0 = r; it.qb1 = NQB - 1 - r; return it;
}
struct Tensors { const bf16_t* q; const bf16_t* kv; const bf16_t* krot; bf16_t* og; const bf16_t* proj0; const float* cs; const float* sn; };
__device__ __forceinline__ BlockRef mkref(const Item& it, int pass, const Tensors& T) {
    const int qb = pass ? it.qb1 : it.qb0, b = it.bh >> 5, h = it.bh & 31;
    const size_t tok0 = (size_t)b * SEQ, row0 = tok0 + (size_t)qb * QB;
    BlockRef r;
    r.Q = T.q + row0 * QS + h * DQ; r.K = T.kv + tok0 * KVS + h * 256; r.V = r.K + 128; r.KR = T.krot + tok0 * KRS;
    r.O = T.og + row0 * OS + h * DV; r.Z = T.proj0 + row0 * ZS + 1600 + h * DV; r.CS = T.cs + row0 * 32; r.SN = T.sn + row0 * 32; r.P0 = qb * QB;
    return r;
}
__device__ __forceinline__ void attn_phase(char* lds, const Tensors& T) {
#ifndef PROBE_ATTDUP
#define PROBE_ATTDUP 0
#endif
    for (int i = 0; ; ++i) {
        const int L = blockIdx.x + (i >> PROBE_ATTDUP) * gridDim.x; if (L >= TOTAL) break;
        const Item it = decode(L);
#pragma unroll 1
        for (int pass = 0; pass < 2; ++pass) { const BlockRef cur = mkref(it, pass, T); causal_block(cur, lds); }
    }
}
}
__device__ __forceinline__ void wt_phase(const float* __restrict__ W, int K, int N, const float* __restrict__ scale, bf16_t* __restrict__ out, char* lds) {
    int tid = threadIdx.x; asm volatile("" : "+v"(tid));
    const int lane = tid & 63, wv = tid >> 6, gw = blockIdx.x * 8 + wv, nw = gridDim.x * 8;
    char* img = lds + wv * 8192;
    const int kr = lane >> 4, nq = lane & 15, ntn = N / 64, ntiles = ntn * (K / 64);
    for (int t = gw; t < ntiles; t += nw) {
        const int kb = (t / ntn) * 64, nb = (t % ntn) * 64;
        const float* src = W + (size_t)(kb + kr * 16) * N + nb + nq * 4;
        f32x4 v[16];
#pragma unroll
        for (int i = 0; i < 16; ++i) v[i] = *(const f32x4*)(src + (size_t)i * N);
        if (scale) {
            const float* sp = scale + kb + kr * 16;
#pragma unroll
            for (int i = 0; i < 16; i += 4) { const f32x4 sc = *(const f32x4*)(sp + i); v[i] *= sc[0]; v[i + 1] *= sc[1]; v[i + 2] *= sc[2]; v[i + 3] *= sc[3]; }
        }
#pragma unroll
        for (int j = 0; j < 4; ++j) {
            const int n = nq * 4 + j;
#pragma unroll
            for (int hf = 0; hf < 2; ++hf) {
                const f32x4 a = {v[hf * 8 + 0][j], v[hf * 8 + 1][j], v[hf * 8 + 2][j], v[hf * 8 + 3][j]}, b = {v[hf * 8 + 4][j], v[hf * 8 + 5][j], v[hf * 8 + 6][j], v[hf * 8 + 7][j]};
                *(bf16x8*)(img + n * 128 + (((kr * 2 + hf) ^ (nq & 7)) * 16)) = pack8(a, b);
            }
        }
#pragma unroll
        for (int i = 0; i < 8; ++i) {
            const int n = i * 8 + (lane >> 3), kc = lane & 7;
            const bf16x8 r = *(const bf16x8*)(img + n * 128 + ((kc ^ ((n >> 2) & 7)) * 16));
            *(bf16x8*)(out + (size_t)(nb + n) * K + kb + kc * 8) = r;
        }
    }
}
__device__ __forceinline__ void cast_rstd_phase(const float* __restrict__ src, bf16_t* __restrict__ dst, float* __restrict__ rstd) {
    const int lane = threadIdx.x & 63, gw = blockIdx.x * 8 + (threadIdx.x >> 6), nw = gridDim.x * 8;
    for (int row = gw; row < T_TOK; row += nw) {
        const float* s = src + (size_t)row * DM; bf16_t* d = dst + (size_t)row * DM; float ss = 0.f;
#pragma unroll
        for (int i = 0; i < 8; ++i) { const int c = (i * 64 + lane) * 8; const f32x4 a = *(const f32x4*)(s + c), b = *(const f32x4*)(s + c + 4);
            ss += a[0] * a[0] + a[1] * a[1] + a[2] * a[2] + a[3] * a[3] + b[0] * b[0] + b[1] * b[1] + b[2] * b[2] + b[3] * b[3];
            *(bf16x8*)(d + c) = pack8(a, b); }
        ss = wave_sum(ss);
        if (lane == 0) rstd[row] = 1.0f / sqrtf(ss * (1.0f / DM) + EPS);
    }
}
__device__ __forceinline__ void final_norm_phase(float* __restrict__ io, const float* __restrict__ w) {
    const int lane = threadIdx.x & 63, gw = blockIdx.x * 8 + (threadIdx.x >> 6), nw = gridDim.x * 8;
    for (int row = gw; row < T_TOK; row += nw) {
        float* s = io + (size_t)row * DM; f32x4 v[16]; float ss = 0.f;
#pragma unroll
        for (int i = 0; i < 16; ++i) { v[i] = *(const f32x4*)(s + (i * 64 + lane) * 4); ss += v[i][0] * v[i][0] + v[i][1] * v[i][1] + v[i][2] * v[i][2] + v[i][3] * v[i][3]; }
        ss = wave_sum(ss);
        const float r = 1.0f / sqrtf(ss * (1.0f / DM) + EPS);
#pragma unroll
        for (int i = 0; i < 16; ++i) { const f32x4 g = *(const f32x4*)(w + (i * 64 + lane) * 4); *(f32x4*)(s + (i * 64 + lane) * 4) = v[i] * r * g; }
    }
}
__device__ __forceinline__ void tables_phase(const Params& p, float* cs, float* sn, float* lb) {
    const int gt = blockIdx.x * blockDim.x + threadIdx.x, nt = gridDim.x * blockDim.x;
    for (int i = gt; i < T_TOK * 32; i += nt) {
        const int tok = i >> 5, j = i & 31;
        const float ang = (float)p.pos[tok] * p.inv_freq[j];
        const double rev = (double)ang * 0.15915494309189535; const float fr = (float)(rev - rint(rev));
        cs[i] = __builtin_amdgcn_cosf(fr); sn[i] = __builtin_amdgcn_sinf(fr);
    }
    for (int i = gt; i < 4096; i += nt) { const float l0 = p.lower_bounds[i], l1 = p.lower_bounds[4096 + i]; lb[i] = 1.0f / (1.0f + expf(l0 - l1)); }
}
__device__ __forceinline__ void stats_krot_phase(const bf16_t* __restrict__ proj0, float* __restrict__ rq, float* __restrict__ rkv, const float* __restrict__ cs, const float* __restrict__ sn, bf16_t* __restrict__ krot) {
    const int lane = threadIdx.x & 63, gw = blockIdx.x * 8 + (threadIdx.x >> 6), nw = gridDim.x * 8;
    for (int row = gw; row < T_TOK; row += nw) {
        const bf16_t* s = proj0 + (size_t)row * N0P;
        const bf16x8 a = *(const bf16x8*)(s + lane * 8), b = *(const bf16x8*)(s + 512 + lane * 8), c = *(const bf16x8*)(s + 1024 + lane * 8);
        float sq = 0.f, sk = 0.f;
#pragma unroll
        for (int j = 0; j < 8; ++j) { const float x = bf2f((unsigned short)a[j]), y = bf2f((unsigned short)b[j]), z = bf2f((unsigned short)c[j]); sq += x * x + y * y; sk += z * z; }
        sq = wave_sum(sq); sk = wave_sum(sk);
        if (lane == 0) { rq[row] = 1.0f / sqrtf(sq * (1.0f / 1024.0f) + EPS); rkv[row] = 1.0f / sqrtf(sk * (1.0f / 512.0f) + EPS); }
        if (lane < 32) { const float t1 = bf2f(s[1536 + lane]), t2 = bf2f(s[1568 + lane]); const float cc = cs[(size_t)row * 32 + lane], sv = sn[(size_t)row * 32 + lane];
            krot[(size_t)row * 64 + lane] = f2bf(t1 * cc - t2 * sv); krot[(size_t)row * 64 + 32 + lane] = f2bf(t2 * cc + t1 * sv); }
    }
}
__device__ __forceinline__ void headnorm_phase(bf16_t* __restrict__ proj1, const bf16_t* __restrict__ oraw, const float* __restrict__ gn) {
    int tid = threadIdx.x; asm volatile("" : "+v"(tid));
    const int per = T_TOK / gridDim.x;
    const int h = tid >> 4, vs = (tid & 15) >> 2, c8 = (tid & 3) * 8;
    const int v0 = (tid & 15) * 8; const f32x4 g0 = *(const f32x4*)(gn + v0), g1 = *(const f32x4*)(gn + v0 + 4);
    for (int tok0 = blockIdx.x * per; tok0 < (blockIdx.x + 1) * per; tok0 += 4) {
        bf16x8 o[4], z[4];
#pragma unroll
        for (int u = 0; u < 4; ++u) { const int tok = tok0 + u, b = tok >> 13, sq = tok & (SEQ - 1);
            o[u] = *(const bf16x8*)(oraw + ((size_t)((b * 32 + h) * 4 + vs) * SEQ + sq) * 32 + c8); z[u] = *(const bf16x8*)(proj1 + (size_t)tok * N1 + 12288 + tid * 8); }
#pragma unroll
        for (int u = 0; u < 4; ++u) {
            float f[8], ss = 0.f;
#pragma unroll
            for (int j = 0; j < 8; ++j) { f[j] = bf2f((unsigned short)o[u][j]); ss += f[j] * f[j]; }
            ss += __shfl_xor(ss, 1); ss += __shfl_xor(ss, 2); ss += __shfl_xor(ss, 4); ss += __shfl_xor(ss, 8);
            const float r = 1.0f / sqrtf(ss * (1.0f / 128.0f) + EPS);
            f32x4 a, bb;
#pragma unroll
            for (int j = 0; j < 4; ++j) { a[j] = f[j] * r * g0[j] * bf2f((unsigned short)z[u][j]); bb[j] = f[4 + j] * r * g1[j] * bf2f((unsigned short)z[u][4 + j]); }
            *(bf16x8*)(proj1 + (size_t)(tok0 + u) * N1 + 8192 + tid * 8) = pack8(a, bb);
        }
    }
}

namespace hg {
constexpr int QT_S = 272, KD_S = 144;
constexpr int OFF_QT = 0, OFF_KT = OFF_QT + 64 * QT_S, OFF_QB = OFF_KT + 64 * QT_S, OFF_KD = OFF_QB + 64 * QT_S;
constexpr int OFF_VT = OFF_KD + 128 * KD_S, OFF_ST = OFF_VT + 32 * KD_S, OFF_ATT = OFF_ST + 32 * QT_S;
constexpr int OFF_SEG = OFF_ATT + 64 * KD_S, OFF_G32 = OFF_SEG + 2048, OFF_DEC = OFF_G32 + 512, LDS_BYTES = OFF_DEC + 512;
__device__ __forceinline__ int crow(int r, int hi) { return (r & 3) + 8 * (r >> 2) + 4 * hi; }

__device__ __forceinline__ void hgrn2_phase(char* lds, const bf16_t* __restrict__ proj1, bf16_t* __restrict__ oraw) {
    int tid = threadIdx.x; asm volatile("" : "+v"(tid));
    const int wid = __builtin_amdgcn_readfirstlane(tid >> 6), lane = tid & 63, r32 = lane & 31, hi = lane >> 5;
    const int kch = tid & 127, seg = tid >> 7;
    float* segtot = (float*)(lds + OFF_SEG); float* g32s = (float*)(lds + OFF_G32); float* decay = (float*)(lds + OFF_DEC);
    for (int item = blockIdx.x; item < 256; item += gridDim.x) {
        const int vs = item & 3, bh = item >> 2, b = bh >> 5, h = bh & 31;
        const bf16_t* base = proj1 + (size_t)b * SEQ * N1; bf16_t* ob = oraw + (size_t)item * SEQ * 32;
        const int qcol = h * 128 + kch, gcol = 4096 + h * 128 + kch, vcol = 8192 + h * 128 + vs * 32;
        f32x16 sacc = {};
        for (int i = tid; i < 32 * QT_S / 4; i += 512) ((unsigned*)(lds + OFF_ST))[i] = 0u;
        unsigned short graw[16], qraw[16]; u32x2 vraw;
        { const bf16_t* rp = base + (size_t)(seg * 16) * N1;
#pragma unroll
          for (int i = 0; i < 16; ++i) { graw[i] = rp[(size_t)i * N1 + gcol]; qraw[i] = rp[(size_t)i * N1 + qcol]; }
          vraw = *(const u32x2*)(base + (size_t)(tid >> 3) * N1 + vcol + (tid & 7) * 4); }
        for (int ch = 0; ch < 128; ++ch) {
            const int tok0 = ch * 64;
            float gl[16]; float cum = 0.f;
#pragma unroll
            for (int i = 0; i < 16; ++i) { cum += bf2f(graw[i]); gl[i] = cum; }
            segtot[seg * 128 + kch] = cum; if (seg == 2) g32s[kch] = bf2f(graw[0]);
            __syncthreads();
            { const float s0 = segtot[kch], s1 = segtot[128 + kch], s2 = segtot[256 + kch], s3 = segtot[384 + kch];
              const float off = (seg > 0 ? s0 : 0.f) + (seg > 1 ? s1 : 0.f) + (seg > 2 ? s2 : 0.f);
              const float tot = (s0 + s1) + (s2 + s3), bref = s0 + s1 + g32s[kch];
              if (seg == 0) decay[kch] = fast_exp(tot);
              float kd[16];
#pragma unroll
              for (int i = 0; i < 16; ++i) { const int t = seg * 16 + i; const float bb = off + gl[i], gv = bf2f(graw[i]), qv = bf2f(qraw[i]); const float kk = 1.0f - fast_exp(gv);
                  *(bf16_t*)(lds + OFF_QT + t * QT_S + kch * 2) = f2bf_n(qv * fast_exp(bb - bref));
                  *(bf16_t*)(lds + OFF_KT + t * QT_S + kch * 2) = f2bf_n(kk * fast_exp(bref - bb));
                  *(bf16_t*)(lds + OFF_QB + t * QT_S + kch * 2) = f2bf_n(qv * fast_exp(bb));
                  kd[i] = kk * fast_exp(tot - bb); }
              *(bf16x8*)(lds + OFF_KD + kch * KD_S + seg * 32) = pack8((f32x4){kd[0], kd[1], kd[2], kd[3]}, (f32x4){kd[4], kd[5], kd[6], kd[7]});
              *(bf16x8*)(lds + OFF_KD + kch * KD_S + seg * 32 + 16) = pack8((f32x4){kd[8], kd[9], kd[10], kd[11]}, (f32x4){kd[12], kd[13], kd[14], kd[15]});
              { const int t = tid >> 3, v4 = (tid & 7) * 4;
                *(bf16_t*)(lds + OFF_VT + (v4 + 0) * KD_S + t * 2) = (bf16_t)(vraw.x & 0xffffu); *(bf16_t*)(lds + OFF_VT + (v4 + 1) * KD_S + t * 2) = (bf16_t)(vraw.x >> 16);
                *(bf16_t*)(lds + OFF_VT + (v4 + 2) * KD_S + t * 2) = (bf16_t)(vraw.y & 0xffffu); *(bf16_t*)(lds + OFF_VT + (v4 + 3) * KD_S + t * 2) = (bf16_t)(vraw.y >> 16); }
            }
            if (ch + 1 < 128) { const bf16_t* rp = base + (size_t)(tok0 + 64 + seg * 16) * N1;
#pragma unroll
                for (int i = 0; i < 16; ++i) { graw[i] = rp[(size_t)i * N1 + gcol]; qraw[i] = rp[(size_t)i * N1 + qcol]; }
                vraw = *(const u32x2*)(base + (size_t)(tok0 + 64 + (tid >> 3)) * N1 + vcol + (tid & 7) * 4); }
            __syncthreads();
            f32x16 oacc = {};
            if (wid < 4) {
                const int ci = wid >> 1, si = wid & 1;
                if (!(ci == 0 && si == 1)) {
                    f32x16 aacc = {};
#pragma unroll
                    for (int kk = 0; kk < 8; ++kk) {
                        const bf16x8 af = *(const bf16x8*)(lds + OFF_QT + (32 * ci + r32) * QT_S + kk * 32 + hi * 16);
                        const bf16x8 bfr = *(const bf16x8*)(lds + OFF_KT + (32 * si + r32) * QT_S + kk * 32 + hi * 16);
                        aacc = __builtin_amdgcn_mfma_f32_32x32x16_bf16(af, bfr, aacc, 0, 0, 0); }
#pragma unroll
                    for (int i = 0; i < 16; ++i) { const int c = 32 * ci + crow(i, hi), s = 32 * si + r32; const float v = (c >= s) ? aacc[i] : 0.f;
                        *(bf16_t*)(lds + OFF_ATT + c * KD_S + s * 2) = f2bf_n(v); }
                } else {
#pragma unroll
                    for (int i = 0; i < 16; ++i) { const int c = crow(i, hi), s = 32 + r32; *(bf16_t*)(lds + OFF_ATT + c * KD_S + s * 2) = (bf16_t)0; }
                }
#pragma unroll
                for (int g4 = 0; g4 < 4; ++g4) { const f32x4 d = *(const f32x4*)(decay + 32 * wid + 8 * g4 + 4 * hi);
#pragma unroll
                    for (int j = 0; j < 4; ++j) sacc[g4 * 4 + j] *= d[j]; }
#pragma unroll
                for (int kk = 0; kk < 4; ++kk) {
                    const bf16x8 af = *(const bf16x8*)(lds + OFF_KD + (32 * wid + r32) * KD_S + kk * 32 + hi * 16);
                    const bf16x8 bfr = *(const bf16x8*)(lds + OFF_VT + r32 * KD_S + kk * 32 + hi * 16);
                    sacc = __builtin_amdgcn_mfma_f32_32x32x16_bf16(af, bfr, sacc, 0, 0, 0); }
            } else if (wid < 6) {
                const int ci = wid - 4;
#pragma unroll
                for (int kk = 0; kk < 8; ++kk) {
                    const bf16x8 af = *(const bf16x8*)(lds + OFF_QB + (32 * ci + r32) * QT_S + kk * 32 + hi * 16);
                    const bf16x8 bfr = *(const bf16x8*)(lds + OFF_ST + r32 * QT_S + kk * 32 + hi * 16);
                    oacc = __builtin_amdgcn_mfma_f32_32x32x16_bf16(af, bfr, oacc, 0, 0, 0); }
            }
            __syncthreads();
            if (wid < 4) {
#pragma unroll
                for (int g4 = 0; g4 < 4; ++g4) { u32x2 w; w.x = cvtpk_n(sacc[g4 * 4 + 0], sacc[g4 * 4 + 1]); w.y = cvtpk_n(sacc[g4 * 4 + 2], sacc[g4 * 4 + 3]);
                    *(u32x2*)(lds + OFF_ST + r32 * QT_S + (32 * wid + 8 * g4 + 4 * hi) * 2) = w; }
            } else if (wid < 6) {
                const int ci = wid - 4;
#pragma unroll
                for (int kk = 0; kk < 4; ++kk) {
                    const bf16x8 af = *(const bf16x8*)(lds + OFF_ATT + (32 * ci + r32) * KD_S + kk * 32 + hi * 16);
                    const bf16x8 bfr = *(const bf16x8*)(lds + OFF_VT + r32 * KD_S + kk * 32 + hi * 16);
                    oacc = __builtin_amdgcn_mfma_f32_32x32x16_bf16(af, bfr, oacc, 0, 0, 0); }
#pragma unroll
                for (int i = 0; i < 16; ++i) { const int c = 32 * ci + crow(i, hi); ob[(size_t)(tok0 + c) * 32 + r32] = f2bf_n(oacc[i]); }
            }
        }
        __syncthreads();
    }
}
}
namespace hg2 {
constexpr int QT_S = 272, KD_S = 144;
constexpr int OFF_QT = 0, OFF_KT = OFF_QT + 64 * QT_S, OFF_QB = OFF_KT + 64 * QT_S, OFF_KD = OFF_QB + 64 * QT_S;
constexpr int OFF_VT4 = OFF_KD + 128 * KD_S, OFF_ATT = OFF_VT4 + 128 * KD_S;
constexpr int OFF_SEG = OFF_ATT + 64 * KD_S, OFF_G32 = OFF_SEG + 2048, OFF_DEC = OFF_G32 + 512, LDS_BYTES = OFF_DEC + 512;
constexpr int ST_BYTES = 32 * QT_S;
__device__ __forceinline__ int crow(int r, int hi) { return (r & 3) + 8 * (r >> 2) + 4 * hi; }

__device__ __forceinline__ void prepass(char* lds, bf16_t* __restrict__ proj1, char* __restrict__ attbuf, float* __restrict__ decbuf) {
    int tid = threadIdx.x; asm volatile("" : "+v"(tid));
    const int wid = __builtin_amdgcn_readfirstlane(tid >> 6), lane = tid & 63, r32 = lane & 31, hi = lane >> 5;
    const int kch = tid & 127, seg = tid >> 7;
    float* segtot = (float*)(lds + OFF_SEG); float* g32s = (float*)(lds + OFF_G32); float* decay = (float*)(lds + OFF_DEC);
    unsigned short graw[16], qraw[16]; bf16x8 vr0, vr1;
#define PRE_LOAD(it_) do { const int bh_ = (it_) >> 7, ch_ = (it_) & 127, b_ = bh_ >> 5, h_ = bh_ & 31;                                   \
        const bf16_t* bs_ = proj1 + ((size_t)b_ * SEQ + ch_ * 64) * N1; const bf16_t* rp_ = bs_ + (size_t)(seg * 16) * N1 + h_ * 128 + kch; \
        _Pragma("unroll") for (int i = 0; i < 16; ++i) { graw[i] = rp_[(size_t)i * N1 + 4096]; qraw[i] = rp_[(size_t)i * N1]; }                \
        const bf16_t* vp_ = bs_ + (size_t)(tid >> 4) * N1 + 8192 + h_ * 128 + (tid & 15) * 8;                                                 \
        vr0 = *(const bf16x8*)vp_; vr1 = *(const bf16x8*)(vp_ + (size_t)32 * N1); } while (0)
    if (blockIdx.x < 8192) PRE_LOAD(blockIdx.x);
    for (int item = blockIdx.x; item < 8192; item += gridDim.x) {
        const int bh = item >> 7, ch = item & 127, b = bh >> 5, h = bh & 31;
        bf16_t* base = proj1 + ((size_t)b * SEQ + ch * 64) * N1;
        const int qcol = h * 128, gcol = 4096 + h * 128, vcol = 8192 + h * 128;
        float gl[16]; float cum = 0.f;
#pragma unroll
        for (int i = 0; i < 16; ++i) { cum += bf2f(graw[i]); gl[i] = cum; }
        segtot[seg * 128 + kch] = cum; if (seg == 2) g32s[kch] = bf2f(graw[0]);
        __syncthreads();
        { const float s0 = segtot[kch], s1 = segtot[128 + kch], s2 = segtot[256 + kch], s3 = segtot[384 + kch];
          const float off = (seg > 0 ? s0 : 0.f) + (seg > 1 ? s1 : 0.f) + (seg > 2 ? s2 : 0.f);
          const float tot = (s0 + s1) + (s2 + s3), bref = s0 + s1 + g32s[kch];
          if (seg == 0) decay[kch] = fast_exp(tot);
          float kd[16];
#pragma unroll
          for (int i = 0; i < 16; ++i) { const int t = seg * 16 + i; const float bb = off + gl[i], gv = bf2f(graw[i]), qv = bf2f(qraw[i]); const float kk = 1.0f - fast_exp(gv);
              *(bf16_t*)(lds + OFF_QT + t * QT_S + kch * 2) = f2bf_n(qv * fast_exp(bb - bref));
              *(bf16_t*)(lds + OFF_KT + t * QT_S + kch * 2) = f2bf_n(kk * fast_exp(bref - bb));
              *(bf16_t*)(lds + OFF_QB + t * QT_S + kch * 2) = f2bf_n(qv * fast_exp(bb));
              kd[i] = kk * fast_exp(tot - bb); }
          *(bf16x8*)(lds + OFF_KD + kch * KD_S + seg * 32) = pack8((f32x4){kd[0], kd[1], kd[2], kd[3]}, (f32x4){kd[4], kd[5], kd[6], kd[7]});
          *(bf16x8*)(lds + OFF_KD + kch * KD_S + seg * 32 + 16) = pack8((f32x4){kd[8], kd[9], kd[10], kd[11]}, (f32x4){kd[12], kd[13], kd[14], kd[15]});
          { const int t = tid >> 4, v8 = (tid & 15) * 8;
#pragma unroll
            for (int j = 0; j < 8; ++j) { *(bf16_t*)(lds + OFF_VT4 + (v8 + j) * KD_S + t * 2) = (bf16_t)vr0[j]; *(bf16_t*)(lds + OFF_VT4 + (v8 + j) * KD_S + (t + 32) * 2) = (bf16_t)vr1[j]; } }
        }
        if (item + (int)gridDim.x < 8192) PRE_LOAD(item + gridDim.x);
        __syncthreads();
        if (wid < 4) {
            const int ci = wid >> 1, si = wid & 1;
            if (!(ci == 0 && si == 1)) {
                f32x16 aacc = {};
#pragma unroll
                for (int kk = 0; kk < 8; ++kk) {
                    const bf16x8 af = *(const bf16x8*)(lds + OFF_QT + (32 * ci + r32) * QT_S + kk * 32 + hi * 16);
                    const bf16x8 bfr = *(const bf16x8*)(lds + OFF_KT + (32 * si + r32) * QT_S + kk * 32 + hi * 16);
                    aacc = __builtin_amdgcn_mfma_f32_32x32x16_bf16(af, bfr, aacc, 0, 0, 0); }
#pragma unroll
                for (int i = 0; i < 16; ++i) { const int c = 32 * ci + crow(i, hi), s = 32 * si + r32; const float v = (c >= s) ? aacc[i] : 0.f;
                    *(bf16_t*)(lds + OFF_ATT + c * KD_S + s * 2) = f2bf_n(v); }
            } else {
#pragma unroll
                for (int i = 0; i < 16; ++i) { const int c = crow(i, hi), s = 32 + r32; *(bf16_t*)(lds + OFF_ATT + c * KD_S + s * 2) = (bf16_t)0; }
            }
        }
        __syncthreads();
        { const size_t lrow = (size_t)(lane >> 4) * N1 + (lane & 15) * 8;
#pragma unroll
          for (int e = 0; e < 2; ++e) { const int f = 2 * wid + e;
              { const int ci = f >> 3, kk = f & 7; const bf16x8 fr = *(const bf16x8*)(lds + OFF_QB + (32 * ci + r32) * QT_S + kk * 32 + hi * 16);
                *(bf16x8*)(base + (size_t)(4 * f) * N1 + qcol + lrow) = fr; }
              { const int kt = f >> 2, kk = f & 3; const bf16x8 fr = *(const bf16x8*)(lds + OFF_KD + (32 * kt + r32) * KD_S + kk * 32 + hi * 16);
                *(bf16x8*)(base + (size_t)(4 * f) * N1 + gcol + lrow) = fr; }
              { const int vs = f >> 2, kk = f & 3; const bf16x8 fr = *(const bf16x8*)(lds + OFF_VT4 + (32 * vs + r32) * KD_S + kk * 32 + hi * 16);
                *(bf16x8*)(base + (size_t)(4 * f) * N1 + vcol + lrow) = fr; } }
          { const int f = wid, ci = f >> 2, kk = f & 3; const bf16x8 fr = *(const bf16x8*)(lds + OFF_ATT + (32 * ci + r32) * KD_S + kk * 32 + hi * 16);
            *(bf16x8*)(attbuf + ((size_t)item * 8 + f) * 1024 + lane * 16) = fr; }
          if (tid < 32) *(f32x4*)(decbuf + (size_t)item * 128 + tid * 4) = *(const f32x4*)(decay + tid * 4);
        }
    }
#undef PRE_LOAD
    __syncthreads();
}

__device__ __forceinline__ void seqpass(char* lds, const bf16_t* __restrict__ proj1, const char* __restrict__ attbuf, const float* __restrict__ decbuf, bf16_t* __restrict__ oraw) {
    int tid = threadIdx.x; asm volatile("" : "+v"(tid));
    const int wid = __builtin_amdgcn_readfirstlane(tid >> 6), lane = tid & 63, r32 = lane & 31, hi = lane >> 5;
    for (int item = blockIdx.x; item < 256; item += gridDim.x) {
        const int vs = item & 3, bh = item >> 2, b = bh >> 5, h = bh & 31;
        const char* base0 = (const char*)(proj1 + (size_t)b * SEQ * N1);
        const unsigned lrow = (unsigned)(((lane >> 4) * N1 + (lane & 15) * 8) * 2);
        constexpr size_t CHB = (size_t)64 * N1 * 2, FRB = (size_t)4 * N1 * 2;
        for (int i = tid; i < 2 * ST_BYTES / 4; i += 512) ((unsigned*)lds)[i] = 0u;
        __syncthreads();
        if (wid < 4) {
            f32x16 sacc = {};
            const char* gb = base0 + (size_t)(4096 + h * 128) * 2 + (size_t)(wid * 4) * FRB;
            const char* vb = base0 + (size_t)(8192 + h * 128) * 2 + (size_t)(vs * 4) * FRB;
            const float* db = decbuf + (size_t)bh * 128 * 128 + 32 * wid + 4 * hi;
            bf16x8 nK[4], nV[4]; f32x4 nd[4];
#define ST_LOAD(ch_) do { _Pragma("unroll") for (int kk = 0; kk < 4; ++kk) { nK[kk] = *(const bf16x8*)(gb + (size_t)(ch_) * CHB + kk * FRB + lrow);          \
                                                                             nV[kk] = *(const bf16x8*)(vb + (size_t)(ch_) * CHB + kk * FRB + lrow);          \
                                                                             nd[kk] = *(const f32x4*)(db + (size_t)(ch_) * 128 + 8 * kk); } } while (0)
            ST_LOAD(0);
            for (int ch = 0; ch < 128; ++ch) {
                bf16x8 K4[4], V4[4]; f32x4 dc[4];
#pragma unroll
                for (int k = 0; k < 4; ++k) { K4[k] = nK[k]; V4[k] = nV[k]; dc[k] = nd[k]; }
                if (ch + 1 < 128) ST_LOAD(ch + 1);
                char* st_nxt = lds + ((ch + 1) & 1) * ST_BYTES;
#pragma unroll
                for (int g4 = 0; g4 < 4; ++g4)
#pragma unroll
                    for (int j = 0; j < 4; ++j) sacc[g4 * 4 + j] *= dc[g4][j];
#pragma unroll
                for (int kk = 0; kk < 4; ++kk) sacc = __builtin_amdgcn_mfma_f32_32x32x16_bf16(K4[kk], V4[kk], sacc, 0, 0, 0);
#pragma unroll
                for (int g4 = 0; g4 < 4; ++g4) { u32x2 w; w.x = cvtpk_n(sacc[g4 * 4 + 0], sacc[g4 * 4 + 1]); w.y = cvtpk_n(sacc[g4 * 4 + 2], sacc[g4 * 4 + 3]);
                    *(u32x2*)(st_nxt + r32 * QT_S + (32 * wid + 8 * g4 + 4 * hi) * 2) = w; }
                __syncthreads();
            }
#undef ST_LOAD
        } else if (wid < 6) {
            const int ci = wid - 4;
            const char* qb = base0 + (size_t)(h * 128) * 2 + (size_t)(ci * 8) * FRB;
            const char* vb = base0 + (size_t)(8192 + h * 128) * 2 + (size_t)(vs * 4) * FRB;
            const char* ab = attbuf + ((size_t)bh * 128 * 8 + ci * 4) * 1024;
            char* ob = (char*)(oraw + (size_t)item * SEQ * 32) + (size_t)(32 * ci) * 64;
            const unsigned ooff = (unsigned)((4 * hi * 32 + r32) * 2), aoff = (unsigned)(lane * 16);
            bf16x8 nQ[8], nA[4], nV[4];
#define O_LOAD(ch_) do { _Pragma("unroll") for (int kk = 0; kk < 8; ++kk) nQ[kk] = *(const bf16x8*)(qb + (size_t)(ch_) * CHB + kk * FRB + lrow);              \
                         _Pragma("unroll") for (int kk = 0; kk < 4; ++kk) { nA[kk] = *(const bf16x8*)(ab + (size_t)(ch_) * 8192 + kk * 1024 + aoff);           \
                                                                            nV[kk] = *(const bf16x8*)(vb + (size_t)(ch_) * CHB + kk * FRB + lrow); } } while (0)
            O_LOAD(0);
            for (int ch = 0; ch < 128; ++ch) {
                bf16x8 Q8[8], A4[4], V4[4];
#pragma unroll
                for (int k = 0; k < 8; ++k) Q8[k] = nQ[k];
#pragma unroll
                for (int k = 0; k < 4; ++k) { A4[k] = nA[k]; V4[k] = nV[k]; }
                if (ch + 1 < 128) O_LOAD(ch + 1);
                const char* st_cur = lds + (ch & 1) * ST_BYTES;
                f32x16 oacc = {};
#pragma unroll
                for (int kk = 0; kk < 8; ++kk) { const bf16x8 sf = *(const bf16x8*)(st_cur + r32 * QT_S + kk * 32 + hi * 16);
                    oacc = __builtin_amdgcn_mfma_f32_32x32x16_bf16(Q8[kk], sf, oacc, 0, 0, 0); }
#pragma unroll
                for (int kk = 0; kk < 4; ++kk) oacc = __builtin_amdgcn_mfma_f32_32x32x16_bf16(A4[kk], V4[kk], oacc, 0, 0, 0);
                char* oc = ob + (size_t)ch * (64 * 64);
#pragma unroll
                for (int i = 0; i < 16; ++i) *(bf16_t*)(oc + ((i & 3) + 8 * (i >> 2)) * 64 + ooff) = f2bf_n(oacc[i]);
                __syncthreads();
            }
#undef O_LOAD
        } else {
            for (int ch = 0; ch < 128; ++ch) __syncthreads();
        }
    }
}
}
constexpr int LDS_TOTAL = pg8::STAGE_BYTES;
static_assert(att::LDS_BYTES <= LDS_TOTAL && hg::LDS_BYTES <= LDS_TOTAL && hg2::LDS_BYTES <= LDS_TOTAL, "lds");
static_assert((size_t)8192 * 8192 + (size_t)8192 * 512 <= WS_W1O, "attbuf/decbuf must fit in the dead weight region");

#ifndef PHMASK
#define PHMASK 0xFFFF
#endif
#define EN(n) (((PHMASK) >> (n)) & 1)
#ifndef SKIP_SEQ
#define SKIP_SEQ 0
#endif
#ifndef SKIP_PRE
#define SKIP_PRE 0
#endif
#ifndef PROBE_DUP7
#define PROBE_DUP7 0
#endif

__global__ void __launch_bounds__(512) mla_hgrn2_fwd(Params p) {
    extern __shared__ __attribute__((aligned(16))) unsigned char lds[];
    cg::grid_group grid = cg::this_grid();
    unsigned char* ws = p.ws;
    bf16_t* W0IN = (bf16_t*)(ws + WS_W0IN); bf16_t* WUQ = (bf16_t*)(ws + WS_WUQ); bf16_t* WUKV = (bf16_t*)(ws + WS_WUKV);
    bf16_t* W0O = (bf16_t*)(ws + WS_W0O); bf16_t* W1IN = (bf16_t*)(ws + WS_W1IN); bf16_t* W1O = (bf16_t*)(ws + WS_W1O);
    float* RSTD0 = (float*)(ws + WS_RSTD0); float* RSTDQ = (float*)(ws + WS_RSTDQ); float* RSTDKV = (float*)(ws + WS_RSTDKV); float* RSTD1 = (float*)(ws + WS_RSTD1);
    float* LB = (float*)(ws + WS_LB); float* COS = (float*)(ws + WS_COS); float* SIN = (float*)(ws + WS_SIN);
    bf16_t* KROT = (bf16_t*)(ws + WS_KROT); bf16_t* ACTA = (bf16_t*)(ws + WS_ACTA);
    bf16_t* PROJ0 = (bf16_t*)(ws + WS_PROJ0); bf16_t* QBUF = (bf16_t*)(ws + WS_Q); bf16_t* PROJ1 = (bf16_t*)(ws + WS_PROJ1);
    bf16_t* KVBUF = (bf16_t*)p.out;
    LAS unsigned char* ldsl = (LAS unsigned char*)lds;
    const int G = gridDim.x, c = blockIdx.x;

    if (EN(0))
    {
        char* tile = (char*)lds;
        wt_phase(p.l0_w_in, 4096, N0, p.l0_norm, W0IN, tile);
        wt_phase(p.l0_w_uq, 1024, NQ, p.l0_q_norm, WUQ, tile);
        wt_phase(p.l0_w_ukv, 512, NKV, p.l0_kv_norm, WUKV, tile);
        wt_phase(p.l0_w_o, 4096, 4096, nullptr, W0O, tile);
        wt_phase(p.l1_w_in, 4096, N1, p.l1_norm, W1IN, tile);
        wt_phase(p.l1_w_o, 4096, 4096, nullptr, W1O, tile);
        { u32x4 z = {0u, 0u, 0u, 0u}; u32x4* pad = (u32x4*)(W0IN + (size_t)N0 * 4096); const int n16 = (N0P - N0) * 4096 * 2 / 16;
          for (int i = c * 512 + threadIdx.x; i < n16; i += G * 512) pad[i] = z; }
        cast_rstd_phase(p.x, ACTA, RSTD0);
        tables_phase(p, COS, SIN, LB);
    }
#ifdef PROBE_P02
    {
        char* tile = (char*)lds;
        wt_phase(p.l0_w_in, 4096, N0, p.l0_norm, W0IN, tile);
        wt_phase(p.l0_w_uq, 1024, NQ, p.l0_q_norm, WUQ, tile);
        wt_phase(p.l0_w_ukv, 512, NKV, p.l0_kv_norm, WUKV, tile);
        wt_phase(p.l0_w_o, 4096, 4096, nullptr, W0O, tile);
        wt_phase(p.l1_w_in, 4096, N1, p.l1_norm, W1IN, tile);
        wt_phase(p.l1_w_o, 4096, 4096, nullptr, W1O, tile);
    }
#endif
    grid.sync();
    if (EN(1)) {
        pg8::Gemm g{ACTA, W0IN, T_TOK, N0P, 4096, 4096}; pg8::StaticOrder S; S.init(T_TOK, N0P, G, c);
        pg8::EpiBf16<1> E{PROJ0, N0P, RSTD0, 1600, nullptr};
        pg8::gemm_phase(ldsl, g, S, E);
    }
    grid.sync();
    if (EN(2)) stats_krot_phase(PROJ0, RSTDQ, RSTDKV, COS, SIN, KROT);
    grid.sync();
    if (EN(3)) {
        pg8::Gemm g{PROJ0, WUQ, T_TOK, NQ, 1024, N0P}; pg8::StaticOrder S; S.init(T_TOK, NQ, G, c);
        pg8::EpiBf16<0> E{QBUF, NQ, RSTDQ, 0, nullptr};
        pg8::gemm_phase(ldsl, g, S, E);
    }
    if (EN(3)) {
        pg8::Gemm g{PROJ0 + 1024, WUKV, T_TOK, NKV, 512, N0P}; pg8::StaticOrder S; S.init(T_TOK, NKV, G, c);
        pg8::EpiBf16<0> E{KVBUF, NKV, RSTDKV, 0, nullptr};
        pg8::gemm_phase(ldsl, g, S, E);
    }
    grid.sync();
    if (EN(4)) {
        att::Tensors T{QBUF, KVBUF, KROT, ACTA, PROJ0, COS, SIN};
        att::attn_phase((char*)lds, T);
    }
    grid.sync();
    if (EN(5)) {
        pg8::Gemm g{ACTA, W0O, T_TOK, 4096, 4096, 4096}; pg8::StaticOrder S; S.init(T_TOK, 4096, G, c);
        pg8::EpiResF32 E{p.x, p.out, 4096};
        pg8::gemm_phase(ldsl, g, S, E);
    }
    grid.sync();
    if (EN(6)) cast_rstd_phase(p.out, ACTA, RSTD1);
    grid.sync();
    if (EN(7)) {
        pg8::Gemm g{ACTA, W1IN, T_TOK, N1, 4096, 4096}; pg8::StaticOrder S; S.init(T_TOK, N1, G, c, PROBE_DUP7);
        pg8::EpiBf16<2> E{PROJ1, N1, RSTD1, 0, LB};
        pg8::gemm_phase(ldsl, g, S, E);
    }
    grid.sync();
#ifdef HG_OLD
    if (EN(8)) hg::hgrn2_phase((char*)lds, PROJ1, ACTA);
#else
    if (EN(8) && !SKIP_PRE) hg2::prepass((char*)lds, PROJ1, (char*)(ws + WS_W0IN), (float*)(ws + WS_W0IN + (size_t)8192 * 8192));
    grid.sync();
    if (EN(8) && !SKIP_SEQ) hg2::seqpass((char*)lds, PROJ1, (const char*)(ws + WS_W0IN), (const float*)(ws + WS_W0IN + (size_t)8192 * 8192), ACTA);
#endif
#ifdef PROBE_HG2
    __syncthreads(); hg::hgrn2_phase((char*)lds, PROJ1, ACTA);
#endif
    grid.sync();
    if (EN(9)) headnorm_phase(PROJ1, ACTA, p.l1_g_norm);
    grid.sync();
    if (EN(10)) {
        pg8::Gemm g{PROJ1 + 8192, W1O, T_TOK, 4096, 4096, N1}; pg8::StaticOrder S; S.init(T_TOK, 4096, G, c);
        pg8::EpiResF32 E{p.out, p.out, 4096};
        pg8::gemm_phase(ldsl, g, S, E);
    }
    grid.sync();
    if (EN(11)) final_norm_phase(p.out, p.final_norm);
}

extern "C" void kernel_launch(void* const* d_in, const int* in_sizes, int n_in, void* d_out, int out_size, void* d_ws, size_t ws_size, hipStream_t stream) {
    static int grid = 0;
    if (grid == 0) {
        if (n_in != 15 || ws_size < WS_END) { fprintf(stderr, "kernel_launch: unexpected inputs (n_in %d, ws %zu, need %zu)\n", n_in, ws_size, (size_t)WS_END); grid = -1; return; }
        int dev = 0, cus = 0, per_cu = 0;
        (void)hipGetDevice(&dev); (void)hipDeviceGetAttribute(&cus, hipDeviceAttributeMultiprocessorCount, dev);
        if (hipFuncSetAttribute((const void*)mla_hgrn2_fwd, hipFuncAttributeMaxDynamicSharedMemorySize, LDS_TOTAL) != hipSuccess) { fprintf(stderr, "kernel_launch: hipFuncSetAttribute failed\n"); grid = -1; return; }
        if (hipOccupancyMaxActiveBlocksPerMultiprocessor(&per_cu, (const void*)mla_hgrn2_fwd, 512, LDS_TOTAL) != hipSuccess || per_cu < 1) { fprintf(stderr, "kernel_launch: occupancy query gave %d\n", per_cu); per_cu = 1; }
        (void)hipGetLastError();
        if (cus <= 0) cus = 256;
        grid = cus * per_cu;
        fprintf(stderr, "kernel_launch: grid %d (cus %d x %d)\n", grid, cus, per_cu);
    }
    if (grid < 0) return;
    Params p{};
    p.x = (const float*)d_in[0]; p.pos = (const int*)d_in[1]; p.l0_norm = (const float*)d_in[2]; p.l0_w_in = (const float*)d_in[3]; p.l0_q_norm = (const float*)d_in[4];
    p.l0_w_uq = (const float*)d_in[5]; p.l0_kv_norm = (const float*)d_in[6]; p.l0_w_ukv = (const float*)d_in[7]; p.l0_w_o = (const float*)d_in[8]; p.l1_norm = (const float*)d_in[9];
    p.l1_w_in = (const float*)d_in[10]; p.l1_g_norm = (const float*)d_in[11]; p.l1_w_o = (const float*)d_in[12]; p.lower_bounds = (const float*)d_in[13]; p.final_norm = (const float*)d_in[14];
    p.out = (float*)d_out; p.ws = (unsigned char*)d_ws;
    for (int j = 0; j < 32; ++j) p.inv_freq[j] = (float)(1.0 / pow(10000.0, (double)(2 * j) / 64.0));
    void* args[] = {&p};
    hipError_t e = hipLaunchCooperativeKernel((const void*)mla_hgrn2_fwd, dim3(grid), dim3(512), args, LDS_TOTAL, stream);
    if (e != hipSuccess) fprintf(stderr, "kernel_launch: cooperative launch failed: %s (grid %d)\n", hipGetErrorString(e), grid);
}
```

```cpp
#include <hip/hip_runtime.h>
#include <hip/hip_cooperative_groups.h>
#include <cstdio>
#include <cstdint>
#include <cmath>
namespace cg = cooperative_groups;

typedef unsigned short bf16_t;
typedef short bf16x8 __attribute__((ext_vector_type(8)));
typedef short s16x4 __attribute__((ext_vector_type(4)));
typedef float f32x4 __attribute__((ext_vector_type(4)));
typedef float f32x16 __attribute__((ext_vector_type(16)));
typedef unsigned u32x4 __attribute__((ext_vector_type(4)));
typedef unsigned u32x2 __attribute__((ext_vector_type(2)));
#define LAS __attribute__((address_space(3)))

constexpr int T_TOK = 16384, SEQ = 8192, DM = 4096;
constexpr int N0 = 5696, N0P = 5888;
constexpr int NQ = 6144, NKV = 8192, N1 = 16384;
constexpr float EPS = 1e-6f;

constexpr size_t WS_W0IN = 0;
constexpr size_t WS_WUQ  = WS_W0IN + (size_t)N0P * 4096 * 2;
constexpr size_t WS_WUKV = WS_WUQ + (size_t)NQ * 1024 * 2;
constexpr size_t WS_W0O  = WS_WUKV + (size_t)NKV * 512 * 2;
constexpr size_t WS_W1IN = WS_W0O + (size_t)4096 * 4096 * 2;
constexpr size_t WS_W1O  = WS_W1IN + (size_t)N1 * 4096 * 2;
constexpr size_t WS_RSTD0 = WS_W1O + (size_t)4096 * 4096 * 2;
constexpr size_t WS_RSTDQ = WS_RSTD0 + 65536;
constexpr size_t WS_RSTDKV = WS_RSTDQ + 65536;
constexpr size_t WS_RSTD1 = WS_RSTDKV + 65536;
constexpr size_t WS_LB = WS_RSTD1 + 65536;
constexpr size_t WS_COS = WS_LB + 16384;
constexpr size_t WS_SIN = WS_COS + (size_t)T_TOK * 32 * 4;
constexpr size_t WS_KROT = WS_SIN + (size_t)T_TOK * 32 * 4;
constexpr size_t WS_ACTA = WS_KROT + (size_t)T_TOK * 64 * 2;
constexpr size_t WS_R = WS_ACTA + (size_t)T_TOK * 4096 * 2;
constexpr size_t WS_PROJ0 = WS_R;
constexpr size_t WS_Q = WS_PROJ0 + (size_t)T_TOK * N0P * 2;
constexpr size_t WS_PROJ1 = WS_R;
constexpr size_t WS_END = WS_R + (size_t)T_TOK * N1 * 2;

struct Params {
    const float* x; const int* pos; const float* l0_norm; const float* l0_w_in; const float* l0_q_norm; const float* l0_w_uq;
    const float* l0_kv_norm; const float* l0_w_ukv; const float* l0_w_o; const float* l1_norm; const float* l1_w_in;
    const float* l1_g_norm; const float* l1_w_o; const float* lower_bounds; const float* final_norm;
    float* out; unsigned char* ws;
    float inv_freq[32];
};

__device__ __forceinline__ unsigned cvtpk(float lo, float hi) { unsigned r; asm volatile("v_cvt_pk_bf16_f32 %0, %1, %2" : "=v"(r) : "v"(lo), "v"(hi)); return r; }
typedef float f32x2 __attribute__((ext_vector_type(2)));
typedef __bf16 bf16x2_t __attribute__((ext_vector_type(2)));
__device__ __forceinline__ unsigned cvtpk_n(float lo, float hi) { f32x2 v = {lo, hi}; bf16x2_t h = __builtin_convertvector(v, bf16x2_t); return __builtin_bit_cast(unsigned, h); }
__device__ __forceinline__ bf16_t f2bf_n(float f) { return (bf16_t)(cvtpk_n(f, 0.f) & 0xffffu); }
__device__ __forceinline__ bf16_t f2bf(float f) { return (bf16_t)(cvtpk(f, 0.f) & 0xffffu); }
__device__ __forceinline__ float bf2f(unsigned short h) { return __uint_as_float((unsigned)h << 16); }
__device__ __forceinline__ float bflo(unsigned w) { return __uint_as_float(w << 16); }
__device__ __forceinline__ float bfhi(unsigned w) { return __uint_as_float(w & 0xffff0000u); }
__device__ __forceinline__ bf16x8 pack8(f32x4 a, f32x4 b) {
    u32x4 w = {cvtpk(a[0], a[1]), cvtpk(a[2], a[3]), cvtpk(b[0], b[1]), cvtpk(b[2], b[3])};
    return *reinterpret_cast<bf16x8*>(&w);
}
__device__ __forceinline__ float fast_exp(float x) { return __builtin_amdgcn_exp2f(x * 1.4426950408889634f); }
__device__ __forceinline__ float silu_f(float v) { return v * __builtin_amdgcn_rcpf(1.0f + fast_exp(-v)); }
__device__ __forceinline__ float wave_sum(float v) {
#pragma unroll
    for (int o = 32; o > 0; o >>= 1) v += __shfl_xor(v, o);
    return v;
}

namespace pg8 {
constexpr int BM = 256, BK = 64, HALF = 128, HTB = HALF * BK * 2, STAGE_BYTES = 8 * HTB, NXCD = 8, WGM = 8;
__host__ __device__ __forceinline__ int lds_byte(int r, int c) { const int st = (r >> 4) * 2 + (c >> 5), rr = r & 15, cc = c & 31, ob = rr * 64 + cc * 2; return st * 1024 + (ob ^ (((ob >> 9) & 1) << 5)); }
__host__ __device__ __forceinline__ void stage_rc(int b, int& R, int& C) { const int st = b / 1024, sb = b % 1024, swz = sb ^ (((sb >> 9) & 1) << 5); R = (st >> 1) * 16 + swz / 64; C = (st & 1) * 32 + (swz % 64) / 2; }
__host__ __device__ __forceinline__ int perm32(int rho) { const int n = rho >> 4, i = rho & 15; return 8 * (i >> 2) + 4 * n + (i & 3); }
struct Unit { int pm, pn; };
struct Gemm { const bf16_t* A; const bf16_t* Bt; int M, N, K, lda; };
struct StaticOrder {
    int nM, nN, nwg, G, c, dup;
    __device__ void init(int M, int N, int G_, int c_, int dup_ = 0) { nM = M / BM; nN = N / BM; nwg = nM * nN; G = G_; c = c_; dup = dup_; }
    __device__ bool next(int i, Unit& u) const {
        const long L = (long)(i >> dup) * G + c; if (L >= nwg) return false;
        int wgid = (int)L; { const int q = nwg / NXCD, r = nwg % NXCD, xcd = wgid % NXCD, off = wgid / NXCD; wgid = (xcd < r ? xcd * (q + 1) : r * (q + 1) + (xcd - r) * q) + off; }
        const int nig = WGM * nN, gid = wgid / nig, fm = gid * WGM, gsz = (nM - fm) < WGM ? (nM - fm) : WGM;
        u.pm = fm + ((wgid % nig) % gsz); u.pn = (wgid % nig) / gsz; return true;
    }
};

template <int MODE> struct EpiBf16 {
    static constexpr bool PERM = true;
    bf16_t* O; int ldc; const float* rs; int thr; const float* lb;
    __device__ __forceinline__ void operator()(const f32x4 (&acc)[2][2][4][2], const Unit& u, int wr, int wc, int fr, int fq) const {
        const int row0 = u.pm * BM + wr * 64 + fr, col0 = u.pn * BM + wc * 32 + 8 * fq;
        const int sec = (u.pn * BM) >> 12;
        f32x4 lbv[2][2] = {};
        if (MODE == 2) { if (sec == 1) {
#pragma unroll
            for (int bj = 0; bj < 2; ++bj) { lbv[bj][0] = *(const f32x4*)(lb + col0 + bj * HALF - 4096); lbv[bj][1] = *(const f32x4*)(lb + col0 + bj * HALF - 4096 + 4); } } }
        float rsv[2][4];
#pragma unroll
        for (int ai = 0; ai < 2; ++ai)
#pragma unroll
            for (int m = 0; m < 4; ++m) rsv[ai][m] = rs[row0 + ai * HALF + m * 16];
#pragma unroll
        for (int ai = 0; ai < 2; ++ai)
#pragma unroll
            for (int m = 0; m < 4; ++m) {
                const int row = row0 + ai * HALF + m * 16; const float s = rsv[ai][m];
                bf16_t* rowp = O + (size_t)row * ldc + col0;
#pragma unroll
                for (int bj = 0; bj < 2; ++bj) {
                    f32x4 v0 = acc[ai][bj][m][0] * s, v1 = acc[ai][bj][m][1] * s;
                    const int col = col0 + bj * HALF;
                    if (MODE == 1) { if (col >= thr) {
#pragma unroll
                        for (int j = 0; j < 4; ++j) { v0[j] = silu_f(v0[j]); v1[j] = silu_f(v1[j]); } } }
                    if (MODE == 2) {
                        if (sec == 0 || sec == 3) {
#pragma unroll
                            for (int j = 0; j < 4; ++j) { v0[j] = silu_f(v0[j]); v1[j] = silu_f(v1[j]); } }
                        else if (sec == 1) {
                            const f32x4 l0 = lbv[bj][0], l1 = lbv[bj][1];
#pragma unroll
                            for (int j = 0; j < 4; ++j) {
                                float sg = __builtin_amdgcn_rcpf(1.0f + fast_exp(-v0[j])); float fg = l0[j] + (1.0f - l0[j]) * sg; v0[j] = __logf(fg);
                                sg = __builtin_amdgcn_rcpf(1.0f + fast_exp(-v1[j])); fg = l1[j] + (1.0f - l1[j]) * sg; v1[j] = __logf(fg); }
                        }
                    }
                    u32x4 w; w.x = cvtpk(v0[0], v0[1]); w.y = cvtpk(v0[2], v0[3]); w.z = cvtpk(v1[0], v1[1]); w.w = cvtpk(v1[2], v1[3]);
                    *(u32x4*)(rowp + bj * HALF) = w;
                }
            }
    }
};
struct EpiResF32 {
    static constexpr bool PERM = false;
    const float* base; float* out; int ldc;
    __device__ __forceinline__ void operator()(const f32x4 (&acc)[2][2][4][2], const Unit& u, int wr, int wc, int fr, int fq) const {
        const int row0 = u.pm * BM + wr * 64 + fr, col0 = u.pn * BM + wc * 32 + 4 * fq;
        f32x4 bs[2][4];
#define RES_LOAD(g, slot) do { const size_t off_ = (size_t)(row0 + ((g) >> 2) * HALF + ((g) & 3) * 16) * ldc + col0; \
        _Pragma("unroll") for (int bj = 0; bj < 2; ++bj) _Pragma("unroll") for (int n = 0; n < 2; ++n) bs[slot][bj * 2 + n] = *(const f32x4*)(base + off_ + bj * HALF + n * 16); } while (0)
        RES_LOAD(0, 0);
#pragma unroll
        for (int g = 0; g < 8; ++g) {
            if (g + 1 < 8) RES_LOAD(g + 1, (g + 1) & 1);
            const int ai = g >> 2, m = g & 3; const size_t off = (size_t)(row0 + ai * HALF + m * 16) * ldc + col0;
#pragma unroll
            for (int bj = 0; bj < 2; ++bj)
#pragma unroll
                for (int n = 0; n < 2; ++n) *(f32x4*)(out + off + bj * HALF + n * 16) = bs[g & 1][bj * 2 + n] + acc[ai][bj][m][n];
        }
#undef RES_LOAD
    }
};

template <class Epi, class Sched>
__device__ __forceinline__ void gemm_phase(LAS unsigned char* lds, const Gemm g, const Sched& S, const Epi& E) {
    int tid = threadIdx.x; asm volatile("" : "+v"(tid));
    const int wid = __builtin_amdgcn_readfirstlane(tid >> 6), lane = tid & 63, wr = wid >> 2, wc = wid & 3, fr = lane & 15, fq = lane >> 4;
    const int K = g.K, nt = K / BK, lda = g.lda;
    unsigned voffA[2], voffB[2];
#pragma unroll
    for (int i = 0; i < 2; ++i) { int R, C; stage_rc(tid * 16 + i * 8192, R, C); const int Rb = Epi::PERM ? ((R & ~31) + perm32(R & 31)) : R;
        voffA[i] = (unsigned)(R * lda + C) * 2u; voffB[i] = (unsigned)(Rb * K + C) * 2u; }
    const size_t kstep = (size_t)(BK * 2);
    const size_t hstepA = (size_t)HALF * lda * 2, hstepB = (size_t)HALF * K * 2;
    const size_t tstepA = 2 * hstepA, tstepB = 2 * hstepB;
    const unsigned ldsw = (unsigned)wid * 1024u;
    const int aoff = lds_byte(wr * 64 + fr, fq * 8), boff = lds_byte(wc * 32 + fr, fq * 8);
#define PG8_SA(b, h) (((b) * 2 + (h)) * HTB)
#define PG8_SB(b, h) ((4 + (b) * 2 + (h)) * HTB)
#define PG8_STAGE(bufoff, gbase, voff) do { _Pragma("unroll") for (int _i = 0; _i < 2; ++_i) \
        __builtin_amdgcn_global_load_lds((const unsigned*)((const char*)(gbase) + (voff)[_i]), (LAS unsigned*)(lds + (bufoff) + ldsw + _i * 8192), 16, 0, 0); } while (0)
#define PG8_LDA(dst, b, h) do { _Pragma("unroll") for (int m = 0; m < 4; ++m) _Pragma("unroll") for (int k = 0; k < 2; ++k) dst[m][k] = *(const LAS bf16x8*)(lds + PG8_SA(b, h) + aoff + m * 2048 + k * 1024); } while (0)
#define PG8_LDB(dst, b, h) do { _Pragma("unroll") for (int n = 0; n < 2; ++n) _Pragma("unroll") for (int k = 0; k < 2; ++k) dst[n][k] = *(const LAS bf16x8*)(lds + PG8_SB(b, h) + boff + n * 2048 + k * 1024); } while (0)
#define PG8_MMA(ai, bj, At, Bt) do { __builtin_amdgcn_s_setprio(1); _Pragma("unroll") for (int m = 0; m < 4; ++m) _Pragma("unroll") for (int n = 0; n < 2; ++n) _Pragma("unroll") for (int k = 0; k < 2; ++k) \
        acc[ai][bj][m][n] = __builtin_amdgcn_mfma_f32_16x16x32_bf16(Bt[n][k], At[m][k], acc[ai][bj][m][n], 0, 0, 0); __builtin_amdgcn_s_setprio(0); } while (0)
#define PG8_WAIT_V(n) asm volatile("s_waitcnt vmcnt(" #n ")" ::: "memory")
#define PG8_WAIT_L(n) asm volatile("s_waitcnt lgkmcnt(" #n ")" ::: "memory")
#define PG8_BAR __builtin_amdgcn_s_barrier()
#define PG8_SCHED __builtin_amdgcn_sched_barrier(0)
    Unit cur, nxt; int ui = 0;
    if (!S.next(0, cur)) return;
    f32x4 acc[2][2][4][2];
#pragma unroll
    for (int a = 0; a < 2; ++a)
#pragma unroll
        for (int b = 0; b < 2; ++b)
#pragma unroll
            for (int m = 0; m < 4; ++m)
#pragma unroll
                for (int n = 0; n < 2; ++n) acc[a][b][m][n] = (f32x4){0.f, 0.f, 0.f, 0.f};
    bf16x8 At[4][2], B0[2][2], B1[2][2];
    const char* cA = (const char*)g.A + (size_t)cur.pm * tstepA; const char* cB = (const char*)g.Bt + (size_t)cur.pn * tstepB;
    PG8_STAGE(PG8_SB(0, 0), cB, voffB); PG8_STAGE(PG8_SA(0, 0), cA, voffA); PG8_STAGE(PG8_SB(0, 1), cB + hstepB, voffB); PG8_STAGE(PG8_SA(0, 1), cA + hstepA, voffA);
    if (wr == 1) PG8_BAR;
    PG8_WAIT_V(4); PG8_BAR;
    PG8_STAGE(PG8_SB(1, 0), cB + kstep, voffB); PG8_STAGE(PG8_SA(1, 0), cA + kstep, voffA); PG8_STAGE(PG8_SB(1, 1), cB + hstepB + kstep, voffB);
    PG8_WAIT_V(6); PG8_BAR;
    for (;;) {
        const bool has_next = S.next(ui + 1, nxt);
        const char* nA = has_next ? (const char*)g.A + (size_t)nxt.pm * tstepA : cA; const char* nB = has_next ? (const char*)g.Bt + (size_t)nxt.pn * tstepB : cB;
        for (int t = 0; t < nt; t += 2) {
            const bool last = (t == nt - 2);
            const char* a1 = cA + (size_t)(t + 1) * kstep;
            const char* a2 = last ? nA : cA + (size_t)(t + 2) * kstep; const char* b2 = last ? nB : cB + (size_t)(t + 2) * kstep;
            const char* a3 = a2 + kstep; const char* b3 = b2 + kstep;
            PG8_LDB(B0, 0, 0); PG8_SCHED; PG8_LDA(At, 0, 0); PG8_STAGE(PG8_SA(1, 1), a1 + hstepA, voffA);
            PG8_WAIT_L(8); PG8_BAR; PG8_WAIT_L(0); PG8_MMA(0, 0, At, B0); PG8_BAR; PG8_SCHED;
            PG8_LDB(B1, 0, 1); PG8_STAGE(PG8_SB(0, 0), b2, voffB);
            PG8_BAR; PG8_WAIT_L(0); PG8_MMA(0, 1, At, B1); PG8_BAR;
            PG8_LDA(At, 0, 1); PG8_STAGE(PG8_SA(0, 0), a2, voffA);
            PG8_BAR; PG8_WAIT_L(0); PG8_MMA(1, 0, At, B0); PG8_BAR; PG8_SCHED;
            PG8_STAGE(PG8_SB(0, 1), b2 + hstepB, voffB);
            PG8_WAIT_V(6); PG8_BAR; PG8_MMA(1, 1, At, B1); PG8_BAR;
            PG8_LDB(B0, 1, 0); PG8_SCHED; PG8_LDA(At, 1, 0); PG8_STAGE(PG8_SA(0, 1), a2 + hstepA, voffA);
            PG8_WAIT_L(8); PG8_BAR; PG8_WAIT_L(0); PG8_MMA(0, 0, At, B0); PG8_BAR; PG8_SCHED;
            PG8_LDB(B1, 1, 1); PG8_STAGE(PG8_SB(1, 0), b3, voffB);
            PG8_BAR; PG8_WAIT_L(0); PG8_MMA(0, 1, At, B1); PG8_BAR;
            PG8_LDA(At, 1, 1); PG8_STAGE(PG8_SA(1, 0), a3, voffA);
            PG8_BAR; PG8_WAIT_L(0); PG8_MMA(1, 0, At, B0); PG8_BAR; PG8_SCHED;
            PG8_STAGE(PG8_SB(1, 1), b3 + hstepB, voffB);
            PG8_WAIT_V(6); PG8_BAR; PG8_MMA(1, 1, At, B1); PG8_BAR;
        }
        E(acc, cur, wr, wc, fr, fq);
        if (!has_next) break;
#pragma unroll
        for (int a = 0; a < 2; ++a)
#pragma unroll
            for (int b = 0; b < 2; ++b)
#pragma unroll
                for (int m = 0; m < 4; ++m)
#pragma unroll
                    for (int n = 0; n < 2; ++n) acc[a][b][m][n] = (f32x4){0.f, 0.f, 0.f, 0.f};
        cur = nxt; cA = nA; cB = nB; ++ui;
    }
    PG8_WAIT_V(0);
    if (wr == 0) PG8_BAR;
    PG8_BAR;
#undef PG8_SA
#undef PG8_SB
#undef PG8_STAGE
#undef PG8_LDA
#undef PG8_LDB
#undef PG8_MMA
#undef PG8_WAIT_V
#undef PG8_WAIT_L
#undef PG8_BAR
#undef PG8_SCHED
}
}
namespace att {
constexpr int NW = 8, QBLK = 32, KVBLK = 64, QB = NW * QBLK;
constexpr int DQ = 192, DV = 128;
constexpr int QS = NQ, KVS = NKV, KRS = 64, OS = 4096, ZS = N0P;
constexpr int SHM_V = KVBLK * DV * 2, SHM_K = KVBLK * DQ * 2;
constexpr int QR_OFF = 2 * SHM_V + 2 * SHM_K + NW * 64 * 4;
constexpr int LDS_BYTES = QR_OFF + NW * 4096;
constexpr float SCALE = 0.07216878364870322f;
constexpr float THR = 8.f;
constexpr unsigned WBIG = 0x40000000u;

#define KSWZ(row, colB) ((row) * 384 + ((colB) ^ (((row) & 7) << 4)))
#define SBAR() __builtin_amdgcn_sched_barrier(0)
__device__ __forceinline__ int v_st(int k, int c) { const int kk = (k & ~0xC) | ((k & 4) << 1) | ((k & 8) >> 1); return ((kk >> 3) * 4 + (c >> 5)) * 512 + ((kk & 7) * 32 + (c & 31)) * 2; }
__device__ __forceinline__ int v_rd_base(int lane) { return ((lane & 3) << 3) | (((lane >> 2) & 3) << 6) | (((lane >> 4) & 1) << 5) | (((lane >> 5) & 1) << 8); }
constexpr int v_rd_off(int d0, int ks, int half) { return d0 * 512 + ks * 4096 + half * 2048; }
__device__ __forceinline__ int crow(int r, int hi) { return (r & 3) + 8 * (r >> 2) + 4 * hi; }
__device__ __forceinline__ bf16x8 load8(const bf16_t* p) { return *reinterpret_cast<const bf16x8*>(p); }

__device__ __forceinline__ void mask_tile(f32x16& p0, f32x16& p1, int dq) {
    const float NEG = -__builtin_inff();
#pragma unroll
    for (int r = 0; r < 16; ++r) {
        const int c = (r & 3) + 8 * (r >> 2);
        if ((unsigned)(dq - c) >= WBIG) p0[r] = NEG;
        if ((unsigned)(dq - c - 32) >= WBIG) p1[r] = NEG;
    }
}
__device__ __forceinline__ void partialSM(f32x16& p0, f32x16& p1, float& m_reg, float& mn, float& alpha) {
    float pmax = p0[0];
#pragma unroll
    for (int r = 1; r < 16; ++r) pmax = fmaxf(pmax, p0[r]);
#pragma unroll
    for (int r = 0; r < 16; ++r) pmax = fmaxf(pmax, p1[r]);
    { auto rr = __builtin_amdgcn_permlane32_swap(__float_as_uint(pmax), __float_as_uint(pmax), false, false);
      pmax = fmaxf(__uint_as_float(rr[0]), __uint_as_float(rr[1])); }
    constexpr float C2 = 1.4426950408889634f * SCALE;
    if (__builtin_expect(__all((pmax - m_reg) * SCALE <= THR), 1)) { mn = m_reg; alpha = 1.f; }
    else { mn = fmaxf(m_reg, pmax); alpha = __builtin_amdgcn_exp2f((m_reg - mn) * C2); m_reg = mn; }
    const float mnL = -mn * C2;
#pragma unroll
    for (int r = 0; r < 16; ++r) p0[r] = fmaf(p0[r], C2, mnL);
#pragma unroll
    for (int r = 0; r < 16; ++r) p1[r] = fmaf(p1[r], C2, mnL);
#pragma unroll
    for (int r = 0; r < 16; ++r) p0[r] = __builtin_amdgcn_exp2f(p0[r]);
}
__device__ __forceinline__ void finishSM(f32x16& p0, f32x16& p1, float alpha, float& l_reg, bf16x8& pa0, bf16x8& pa1, bf16x8& pa2, bf16x8& pa3) {
#pragma unroll
    for (int r = 0; r < 16; ++r) p1[r] = __builtin_amdgcn_exp2f(p1[r]);
    float ps = 0;
#pragma unroll
    for (int r = 0; r < 16; ++r) ps += p0[r];
#pragma unroll
    for (int r = 0; r < 16; ++r) ps += p1[r];
    { auto rr = __builtin_amdgcn_permlane32_swap(__float_as_uint(ps), __float_as_uint(ps), false, false);
      ps = __uint_as_float(rr[0]) + __uint_as_float(rr[1]); }
    l_reg = l_reg * alpha + ps;
#define PK4(P, B_, OUT) do { unsigned a0 = cvtpk(P[B_+0], P[B_+1]), a1 = cvtpk(P[B_+2], P[B_+3]);                          \
        unsigned b0 = cvtpk(P[B_+4], P[B_+5]), b1 = cvtpk(P[B_+6], P[B_+7]);                                             \
        auto r0 = __builtin_amdgcn_permlane32_swap(a0, b0, false, false); auto r1 = __builtin_amdgcn_permlane32_swap(a1, b1, false, false); \
        u32x4 w = {r0[0], r1[0], r0[1], r1[1]}; OUT = *reinterpret_cast<bf16x8*>(&w); } while (0)
    PK4(p0, 0, pa0); PK4(p0, 8, pa1); PK4(p1, 0, pa2); PK4(p1, 8, pa3);
#undef PK4
}
template <int KB>
__device__ __forceinline__ void qkt(f32x16& p0, f32x16& p1, const char* K_lds, int r32, int hi, const bf16x8* qr, const char* qrl) {
    p0 = f32x16{}; p1 = f32x16{};
    const char* kb[4];
#pragma unroll
    for (int dd = 0; dd < 4; ++dd) kb[dd] = K_lds + KB * SHM_K + KSWZ(r32, (dd * 16 + hi * 8) * 2);
#pragma unroll
    for (int d0 = 0; d0 < 12; ++d0) { const char* a = kb[d0 & 3] + (d0 >> 2) * 128;
        bf16x8 b0 = *reinterpret_cast<const bf16x8*>(a);
        bf16x8 b1 = *reinterpret_cast<const bf16x8*>(a + 32 * 384);
        bf16x8 qf; if (d0 < 8) qf = qr[d0]; else qf = *reinterpret_cast<const bf16x8*>(qrl + (d0 - 8) * 1024);
        p0 = __builtin_amdgcn_mfma_f32_32x32x16_bf16(b0, qf, p0, 0, 0, 0);
        p1 = __builtin_amdgcn_mfma_f32_32x32x16_bf16(b1, qf, p1, 0, 0, 0);
    }
}
template <int VB>
__device__ __forceinline__ void pv_tile(f32x16* o, int vb0, bf16x8 pa0, bf16x8 pa1, bf16x8 pa2, bf16x8 pa3) {
#define TRRD(dst, off) asm volatile("ds_read_b64_tr_b16 %0, %1 offset:%2" : "=&v"(dst) : "v"(vb0), "i"(off) : "memory")
#define PV_D0(d0) do { s16x4 l0, l1, l2, l3, h0, h1, h2, h3; constexpr int b_ = VB * SHM_V + v_rd_off(d0, 0, 0); \
        TRRD(l0, b_); TRRD(h0, b_ + 2048); TRRD(l1, b_ + 4096); TRRD(h1, b_ + 6144); TRRD(l2, b_ + 8192); TRRD(h2, b_ + 10240); TRRD(l3, b_ + 12288); TRRD(h3, b_ + 14336); \
        asm volatile("s_waitcnt lgkmcnt(0)" ::: "memory"); SBAR();   \
        o[d0] = __builtin_amdgcn_mfma_f32_32x32x16_bf16(pa0, (bf16x8){l0[0], l0[1], l0[2], l0[3], h0[0], h0[1], h0[2], h0[3]}, o[d0], 0, 0, 0);   \
        o[d0] = __builtin_amdgcn_mfma_f32_32x32x16_bf16(pa1, (bf16x8){l1[0], l1[1], l1[2], l1[3], h1[0], h1[1], h1[2], h1[3]}, o[d0], 0, 0, 0);   \
        o[d0] = __builtin_amdgcn_mfma_f32_32x32x16_bf16(pa2, (bf16x8){l2[0], l2[1], l2[2], l2[3], h2[0], h2[1], h2[2], h2[3]}, o[d0], 0, 0, 0);   \
        o[d0] = __builtin_amdgcn_mfma_f32_32x32x16_bf16(pa3, (bf16x8){l3[0], l3[1], l3[2], l3[3], h3[0], h3[1], h3[2], h3[3]}, o[d0], 0, 0, 0); } while (0)
    PV_D0(0); PV_D0(1); PV_D0(2); PV_D0(3);
#undef PV_D0
#undef TRRD
}

struct BlockRef { const bf16_t* Q; const bf16_t* K; const bf16_t* KR; const bf16_t* V; bf16_t* O; const bf16_t* Z; const float* CS; const float* SN; int P0; };
struct Stage { bf16x8 st_v0, st_v1, st_k0, st_k1, st_kr; };
#define VMW() asm volatile("s_waitcnt vmcnt(0)" ::: "memory")
#define SLOAD_H(R, k0) do { const char* kt_ = (const char*)(R).K + (size_t)(k0) * (KVS * 2); const char* kt2_ = kt_ + 32 * KVS * 2; const char* krt_ = (const char*)(R).KR + (size_t)(k0) * (KRS * 2); \
                            S.st_v0 = *(const bf16x8*)(kt_ + koff + 256); S.st_v1 = *(const bf16x8*)(kt2_ + koff + 256);  \
                            S.st_k0 = *(const bf16x8*)(kt_ + koff); S.st_k1 = *(const bf16x8*)(kt2_ + koff);  \
                            S.st_kr = *(const bf16x8*)(krt_ + kroff); } while (0)
#define SWRITE_HK(bf) do { *(bf16x8*)(K_lds + (bf) * SHM_K + kws) = S.st_k0; *(bf16x8*)(K_lds + (bf) * SHM_K + kws + 32 * 384) = S.st_k1; \
                           *(bf16x8*)(K_lds + (bf) * SHM_K + kwr) = S.st_kr; } while (0)
#define SWRITE_HV(bf) do { *(bf16x8*)(V_lds + (bf) * SHM_V + vst0) = S.st_v0; *(bf16x8*)(V_lds + (bf) * SHM_V + vst1) = S.st_v1; } while (0)
#define SWRITE_H(bf) do { SWRITE_HV(bf); SWRITE_HK(bf); } while (0)

__device__ __forceinline__ void rope_q(const BlockRef& cur, const bf16x8* qrp, char* qrl, int wid, int r32, int hi) {
    const int row = wid * QBLK + r32;
    const unsigned toff = (unsigned)((row * 32 + hi * 8) * 4);
    const float* cp = (const float*)((const char*)cur.CS + toff); const float* sp = (const float*)((const char*)cur.SN + toff);
#pragma unroll
    for (int pr = 0; pr < 2; ++pr) {
        const f32x4 c0 = *(const f32x4*)(cp + pr * 16), c1 = *(const f32x4*)(cp + pr * 16 + 4), s0 = *(const f32x4*)(sp + pr * 16), s1 = *(const f32x4*)(sp + pr * 16 + 4);
        const bf16x8 a = qrp[pr], b = qrp[2 + pr];
        f32x4 o1l, o1h, o2l, o2h;
#pragma unroll
        for (int j = 0; j < 4; ++j) {
            float t1 = bf2f((unsigned short)a[j]), t2 = bf2f((unsigned short)b[j]);
            o1l[j] = t1 * c0[j] - t2 * s0[j]; o2l[j] = t2 * c0[j] + t1 * s0[j];
            t1 = bf2f((unsigned short)a[4 + j]); t2 = bf2f((unsigned short)b[4 + j]);
            o1h[j] = t1 * c1[j] - t2 * s1[j]; o2h[j] = t2 * c1[j] + t1 * s1[j];
        }
        *(bf16x8*)(qrl + pr * 1024) = pack8(o1l, o1h); *(bf16x8*)(qrl + (2 + pr) * 1024) = pack8(o2l, o2h);
    }
}
__device__ __forceinline__ void causal_block(const BlockRef& cur, char* lds) {
    int tid = threadIdx.x; asm volatile("" : "+v"(tid));
    const int wid = __builtin_amdgcn_readfirstlane(tid >> 6), lane = tid & 63, r32 = lane & 31, hi = lane >> 5;
    const int NT = (cur.P0 + QB - 1) / KVBLK + 1;
    const int qlo = cur.P0 + wid * QBLK, qm = qlo + r32 - 4 * hi;
    char* V_lds = lds; char* K_lds = lds + 2 * SHM_V;
    float* ws = (float*)(lds + 2 * SHM_V + 2 * SHM_K) + wid * 64; float* li_l = ws, * al_l = ws + 32;
    float m_reg = -1e30f, l_reg = 0; f32x16 o[4] = {};
    const int sr = tid >> 4, sc = (tid & 15) * 8, vst0 = v_st(sr, sc), vst1 = v_st(32 + sr, sc), kws = KSWZ(sr, sc * 2);
    const int krr = tid >> 3, krc = (tid & 7) * 8, kwr = KSWZ(krr, (128 + krc) * 2);
    const int vb0 = (int)(uintptr_t)V_lds + v_rd_base(lane);
    unsigned koff = (unsigned)((sr * KVS + sc) * 2), kroff = (unsigned)((krr * KRS + krc) * 2);
    unsigned qoff = (unsigned)(((wid * QBLK + r32) * QS + hi * 8) * 2);
    asm volatile("" : "+v"(koff), "+v"(kroff), "+v"(qoff));
    Stage S; bf16x8 qr[8]; char* qrl = lds + QR_OFF + wid * 4096 + lane * 16;
    { bf16x8 qrp[4];
#pragma unroll
      for (int d0 = 0; d0 < 8; ++d0) qr[d0] = *(const bf16x8*)((const char*)cur.Q + qoff + d0 * 32);
#pragma unroll
      for (int d0 = 0; d0 < 4; ++d0) qrp[d0] = *(const bf16x8*)((const char*)cur.Q + qoff + (8 + d0) * 32);
      SLOAD_H(cur, 0);
      rope_q(cur, qrp, qrl, wid, r32, hi); }
    VMW(); SWRITE_H(0); SBAR();
    SLOAD_H(cur, KVBLK); SBAR();
    __syncthreads();
#define RESC(a) do { if (__any((a) < 1.f)) { if (hi == 0) al_l[r32] = (a); asm volatile("s_waitcnt lgkmcnt(0)" ::: "memory");              \
                     for (int d_ = 0; d_ < 4; ++d_) for (int r = 0; r < 16; ++r) o[d_][r] *= al_l[crow(r, hi)]; } } while (0)
#define KBASE(t) ((t) * KVBLK)
#define MASKT(P0_, P1_, t) do { const int kb_ = KBASE(t); if (kb_ + KVBLK - 1 > qlo) mask_tile(P0_, P1_, qm - kb_); } while (0)
    f32x16 pA0, pA1, pB0, pB1; float mnA, mnB, alA, alB; bf16x8 pa0, pa1, pa2, pa3;
    qkt<0>(pA0, pA1, K_lds, r32, hi, qr, qrl);
    MASKT(pA0, pA1, 0); partialSM(pA0, pA1, m_reg, mnA, alA);
    VMW(); SWRITE_H(1);
    __syncthreads();
#define HALF_STEP(PX0, PX1, mnX, alX, PY0, PY1, alY, t, KB, VB, SB) do {                                                      \
        SBAR(); qkt<KB>(PX0, PX1, K_lds, r32, hi, qr, qrl);                                                                        \
        finishSM(PY0, PY1, alY, l_reg, pa0, pa1, pa2, pa3); SBAR();                                                           \
        if ((t) + 1 < NT) { SLOAD_H(cur, KBASE((t) + 1)); SBAR(); }                                                           \
        pv_tile<VB>(o, vb0, pa0, pa1, pa2, pa3); MASKT(PX0, PX1, (t)); partialSM(PX0, PX1, m_reg, mnX, alX);                  \
        __syncthreads();                                                                                                      \
        if ((t) + 1 < NT) { VMW(); SWRITE_H(SB); }                                                                            \
        RESC(alX); __syncthreads(); } while (0)
    for (int t = 1; t + 1 < NT; t += 2) {
        HALF_STEP(pB0, pB1, mnB, alB, pA0, pA1, alA, t, 1, 0, 0);
        HALF_STEP(pA0, pA1, mnA, alA, pB0, pB1, alB, t + 1, 0, 1, 1);
    }
    SBAR(); qkt<1>(pB0, pB1, K_lds, r32, hi, qr, qrl); SBAR();
    finishSM(pA0, pA1, alA, l_reg, pa0, pa1, pa2, pa3); SBAR();
    pv_tile<0>(o, vb0, pa0, pa1, pa2, pa3);
    MASKT(pB0, pB1, NT - 1); partialSM(pB0, pB1, m_reg, mnB, alB); __syncthreads(); RESC(alB);
    finishSM(pB0, pB1, alB, l_reg, pa0, pa1, pa2, pa3); SBAR(); pv_tile<1>(o, vb0, pa0, pa1, pa2, pa3);
    SBAR();
    if (hi == 0) li_l[r32] = l_reg;
    __syncthreads();
    {
        char* ot = lds + wid * (32 * 272);
        const int wb = 4 * hi * 272 + r32 * 2;
#pragma unroll
        for (int rg = 0; rg < 4; ++rg) {
            const f32x4 lv = *(const f32x4*)(li_l + 8 * rg + 4 * hi);
#pragma unroll
            for (int j = 0; j < 4; ++j) { const int r = rg * 4 + j; const float rl = __builtin_amdgcn_rcpf(lv[j]);
#pragma unroll
                for (int d0 = 0; d0 < 4; ++d0) *(bf16_t*)(ot + wb + (j + 8 * rg) * 272 + d0 * 64) = f2bf(o[d0][r] * rl); }
        }
        asm volatile("s_waitcnt lgkmcnt(0)" ::: "memory");
        const int rr = lane >> 4, c8 = (lane & 15) * 8;
        const unsigned zoff = (unsigned)(((wid * QBLK + rr) * ZS + c8) * 2), ooff = (unsigned)(((wid * QBLK + rr) * OS + c8) * 2);
#pragma unroll
        for (int i = 0; i < 8; ++i) {
            const bf16x8 ov = *(const bf16x8*)(ot + (i * 4 + rr) * 272 + c8 * 2);
            const bf16x8 zv = *(const bf16x8*)((const char*)cur.Z + (size_t)(i * 4 * ZS * 2) + zoff);
            f32x4 a, b;
#pragma unroll
            for (int j = 0; j < 4; ++j) { a[j] = bf2f((unsigned short)ov[j]) * bf2f((unsigned short)zv[j]); b[j] = bf2f((unsigned short)ov[4 + j]) * bf2f((unsigned short)zv[4 + j]); }
            *(bf16x8*)((char*)cur.O + (size_t)(i * 4 * OS * 2) + ooff) = pack8(a, b);
        }
    }
    __syncthreads();
#undef RESC
#undef KBASE
#undef MASKT
#undef HALF_STEP
}
#undef VMW
#undef SLOAD_H
#undef SWRITE_HK
#undef SWRITE_HV
#undef SWRITE_H

struct Item { int bh, qb0, qb1; };
constexpr int NQB = SEQ / QB, NX = NQB / 2, NBH = 64, TOTAL = NX * NBH;
__device__ __forceinline__ Item decode(int L) {
    Item it; const int xcd = L & 7, k = L >> 3, gi = k / NX, r = k - gi * NX;
    it.bh = gi * 8 + xcd; it.qb0 = r; it.qb1 = NQB - 1 - r; return it;
}
struct Tensors { const bf16_t* q; const bf16_t* kv; const bf16_t* krot; bf16_t* og; const bf16_t* proj0; const float* cs; const float* sn; };
__device__ __forceinline__ BlockRef mkref(const Item& it, int pass, const Tensors& T) {
    const int qb = pass ? it.qb1 : it.qb0, b = it.bh >> 5, h = it.bh & 31;
    const size_t tok0 = (size_t)b * SEQ, row0 = tok0 + (size_t)qb * QB;
    BlockRef r;
    r.Q = T.q + row0 * QS + h * DQ; r.K = T.kv + tok0 * KVS + h * 256; r.V = r.K + 128; r.KR = T.krot + tok0 * KRS;
    r.O = T.og + row0 * OS + h * DV; r.Z = T.proj0 + row0 * ZS + 1600 + h * DV; r.CS = T.cs + row0 * 32; r.SN = T.sn + row0 * 32; r.P0 = qb * QB;
    return r;
}
__device__ __forceinline__ void attn_phase(char* lds, const Tensors& T) {
#ifndef PROBE_ATTDUP
#define PROBE_ATTDUP 0
#endif
    for (int i = 0; ; ++i) {
        const int L = blockIdx.x + (i >> PROBE_ATTDUP) * gridDim.x; if (L >= TOTAL) break;
        const Item it = decode(L);
#pragma unroll 1
        for (int pass = 0; pass < 2; ++pass) { const BlockRef cur = mkref(it, pass, T); causal_block(cur, lds); }
    }
}
}
__device__ __forceinline__ void wt_phase(const float* __restrict__ W, int K, int N, const float* __restrict__ scale, bf16_t* __restrict__ out, char* lds) {
    int tid = threadIdx.x; asm volatile("" : "+v"(tid));
    const int lane = tid & 63, wv = tid >> 6, gw = blockIdx.x * 8 + wv, nw = gridDim.x * 8;
    char* img = lds + wv * 8192;
    const int kr = lane >> 4, nq = lane & 15, ntn = N / 64, ntiles = ntn * (K / 64);
    for (int t = gw; t < ntiles; t += nw) {
        const int kb = (t / ntn) * 64, nb = (t % ntn) * 64;
        const float* src = W + (size_t)(kb + kr * 16) * N + nb + nq * 4;
        f32x4 v[16];
#pragma unroll
        for (int i = 0; i < 16; ++i) v[i] = *(const f32x4*)(src + (size_t)i * N);
        if (scale) {
            const float* sp = scale + kb + kr * 16;
#pragma unroll
            for (int i = 0; i < 16; i += 4) { const f32x4 sc = *(const f32x4*)(sp + i); v[i] *= sc[0]; v[i + 1] *= sc[1]; v[i + 2] *= sc[2]; v[i + 3] *= sc[3]; }
        }
#pragma unroll
        for (int j = 0; j < 4; ++j) {
            const int n = nq * 4 + j;
#pragma unroll
            for (int hf = 0; hf < 2; ++hf) {
                const f32x4 a = {v[hf * 8 + 0][j], v[hf * 8 + 1][j], v[hf * 8 + 2][j], v[hf * 8 + 3][j]}, b = {v[hf * 8 + 4][j], v[hf * 8 + 5][j], v[hf * 8 + 6][j], v[hf * 8 + 7][j]};
                *(bf16x8*)(img + n * 128 + (((kr * 2 + hf) ^ (nq & 7)) * 16)) = pack8(a, b);
            }
        }
#pragma unroll
        for (int i = 0; i < 8; ++i) {
            const int n = i * 8 + (lane >> 3), kc = lane & 7;
            const bf16x8 r = *(const bf16x8*)(img + n * 128 + ((kc ^ ((n >> 2) & 7)) * 16));
            *(bf16x8*)(out + (size_t)(nb + n) * K + kb + kc * 8) = r;
        }
    }
}
__device__ __forceinline__ void cast_rstd_phase(const float* __restrict__ src, bf16_t* __restrict__ dst, float* __restrict__ rstd) {
    const int lane = threadIdx.x & 63, gw = blockIdx.x * 8 + (threadIdx.x >> 6), nw = gridDim.x * 8;
    for (int row = gw; row < T_TOK; row += nw) {
        const float* s = src + (size_t)row * DM; bf16_t* d = dst + (size_t)row * DM; float ss = 0.f;
#pragma unroll
        for (int i = 0; i < 8; ++i) { const int c = (i * 64 + lane) * 8; const f32x4 a = *(const f32x4*)(s + c), b = *(const f32x4*)(s + c + 4);
            ss += a[0] * a[0] + a[1] * a[1] + a[2] * a[2] + a[3] * a[3] + b[0] * b[0] + b[1] * b[1] + b[2] * b[2] + b[3] * b[3];
            *(bf16x8*)(d + c) = pack8(a, b); }
        ss = wave_sum(ss);
        if (lane == 0) rstd[row] = 1.0f / sqrtf(ss * (1.0f / DM) + EPS);
    }
}
__device__ __forceinline__ void final_norm_phase(float* __restrict__ io, const float* __restrict__ w) {
    const int lane = threadIdx.x & 63, gw = blockIdx.x * 8 + (threadIdx.x >> 6), nw = gridDim.x * 8;
    for (int row = gw; row < T_TOK; row += nw) {
        float* s = io + (size_t)row * DM; f32x4 v[16]; float ss = 0.f;
#pragma unroll
        for (int i = 0; i < 16; ++i) { v[i] = *(const f32x4*)(s + (i * 64 + lane) * 4); ss += v[i][0] * v[i][0] + v[i][1] * v[i][1] + v[i][2] * v[i][2] + v[i][3] * v[i][3]; }
        ss = wave_sum(ss);
        const float r = 1.0f / sqrtf(ss * (1.0f / DM) + EPS);
#pragma unroll
        for (int i = 0; i < 16; ++i) { const f32x4 g = *(const f32x4*)(w + (i * 64 + lane) * 4); *(f32x4*)(s + (i * 64 + lane) * 4) = v[i] * r * g; }
    }
}
__device__ __forceinline__ void tables_phase(const Params& p, float* cs, float* sn, float* lb) {
    const int gt = blockIdx.x * blockDim.x + threadIdx.x, nt = gridDim.x * blockDim.x;
    for (int i = gt; i < T_TOK * 32; i += nt) {
        const int tok = i >> 5, j = i & 31;
        const float ang = (float)p.pos[tok] * p.inv_freq[j];
        const double rev = (double)ang * 0.15915494309189535; const float fr = (float)(rev - rint(rev));
        cs[i] = __builtin_amdgcn_cosf(fr); sn[i] = __builtin_amdgcn_sinf(fr);
    }
    for (int i = gt; i < 4096; i += nt) { const float l0 = p.lower_bounds[i], l1 = p.lower_bounds[4096 + i]; lb[i] = 1.0f / (1.0f + expf(l0 - l1)); }
}
__device__ __forceinline__ void stats_krot_phase(const bf16_t* __restrict__ proj0, float* __restrict__ rq, float* __restrict__ rkv, const float* __restrict__ cs, const float* __restrict__ sn, bf16_t* __restrict__ krot) {
    const int lane = threadIdx.x & 63, gw = blockIdx.x * 8 + (threadIdx.x >> 6), nw = gridDim.x * 8;
    for (int row = gw; row < T_TOK; row += nw) {
        const bf16_t* s = proj0 + (size_t)row * N0P;
        const bf16x8 a = *(const bf16x8*)(s + lane * 8), b = *(const bf16x8*)(s + 512 + lane * 8), c = *(const bf16x8*)(s + 1024 + lane * 8);
        float sq = 0.f, sk = 0.f;
#pragma unroll
        for (int j = 0; j < 8; ++j) { const float x = bf2f((unsigned short)a[j]), y = bf2f((unsigned short)b[j]), z = bf2f((unsigned short)c[j]); sq += x * x + y * y; sk += z * z; }
        sq = wave_sum(sq); sk = wave_sum(sk);
        if (lane == 0) { rq[row] = 1.0f / sqrtf(sq * (1.0f / 1024.0f) + EPS); rkv[row] = 1.0f / sqrtf(sk * (1.0f / 512.0f) + EPS); }
        if (lane < 32) { const float t1 = bf2f(s[1536 + lane]), t2 = bf2f(s[1568 + lane]); const float cc = cs[(size_t)row * 32 + lane], sv = sn[(size_t)row * 32 + lane];
            krot[(size_t)row * 64 + lane] = f2bf(t1 * cc - t2 * sv); krot[(size_t)row * 64 + 32 + lane] = f2bf(t2 * cc + t1 * sv); }
    }
}
__device__ __forceinline__ void headnorm_phase(bf16_t* __restrict__ proj1, const bf16_t* __restrict__ oraw, const float* __restrict__ gn) {
    int tid = threadIdx.x; asm volatile("" : "+v"(tid));
    const int per = T_TOK / gridDim.x;
    const int h = tid >> 4, vs = (tid & 15) >> 2, c8 = (tid & 3) * 8;
    const int v0 = (tid & 15) * 8; const f32x4 g0 = *(const f32x4*)(gn + v0), g1 = *(const f32x4*)(gn + v0 + 4);
    for (int tok0 = blockIdx.x * per; tok0 < (blockIdx.x + 1) * per; tok0 += 4) {
        bf16x8 o[4], z[4];
#pragma unroll
        for (int u = 0; u < 4; ++u) { const int tok = tok0 + u, b = tok >> 13, sq = tok & (SEQ - 1);
            o[u] = *(const bf16x8*)(oraw + ((size_t)((b * 32 + h) * 4 + vs) * SEQ + sq) * 32 + c8); z[u] = *(const bf16x8*)(proj1 + (size_t)tok * N1 + 12288 + tid * 8); }
#pragma unroll
        for (int u = 0; u < 4; ++u) {
            float f[8], ss = 0.f;
#pragma unroll
            for (int j = 0; j < 8; ++j) { f[j] = bf2f((unsigned short)o[u][j]); ss += f[j] * f[j]; }
            ss += __shfl_xor(ss, 1); ss += __shfl_xor(ss, 2); ss += __shfl_xor(ss, 4); ss += __shfl_xor(ss, 8);
            const float r = 1.0f / sqrtf(ss * (1.0f / 128.0f) + EPS);
            f32x4 a, bb;
#pragma unroll
            for (int j = 0; j < 4; ++j) { a[j] = f[j] * r * g0[j] * bf2f((unsigned short)z[u][j]); bb[j] = f[4 + j] * r * g1[j] * bf2f((unsigned short)z[u][4 + j]); }
            *(bf16x8*)(proj1 + (size_t)(tok0 + u) * N1 + 8192 + tid * 8) = pack8(a, bb);
        }
    }
}

namespace hg {
constexpr int QT_S = 272, KD_S = 144;
constexpr int OFF_QT = 0, OFF_KT = OFF_QT + 64 * QT_S, OFF_QB = OFF_KT + 64 * QT_S, OFF_KD = OFF_QB + 64 * QT_S;
constexpr int OFF_VT = OFF_KD + 128 * KD_S, OFF_ST = OFF_VT + 32 * KD_S, OFF_ATT = OFF_ST + 32 * QT_S;
constexpr int OFF_SEG = OFF_ATT + 64 * KD_S, OFF_G32 = OFF_SEG + 2048, OFF_DEC = OFF_G32 + 512, LDS_BYTES = OFF_DEC + 512;
__device__ __forceinline__ int crow(int r, int hi) { return (r & 3) + 8 * (r >> 2) + 4 * hi; }

__device__ __forceinline__ void hgrn2_phase(char* lds, const bf16_t* __restrict__ proj1, bf16_t* __restrict__ oraw) {
    int tid = threadIdx.x; asm volatile("" : "+v"(tid));
    const int wid = __builtin_amdgcn_readfirstlane(tid >> 6), lane = tid & 63, r32 = lane & 31, hi = lane >> 5;
    const int kch = tid & 127, seg = tid >> 7;
    float* segtot = (float*)(lds + OFF_SEG); float* g32s = (float*)(lds + OFF_G32); float* decay = (float*)(lds + OFF_DEC);
    for (int item = blockIdx.x; item < 256; item += gridDim.x) {
        const int vs = item & 3, bh = item >> 2, b = bh >> 5, h = bh & 31;
        const bf16_t* base = proj1 + (size_t)b * SEQ * N1; bf16_t* ob = oraw + (size_t)item * SEQ * 32;
        const int qcol = h * 128 + kch, gcol = 4096 + h * 128 + kch, vcol = 8192 + h * 128 + vs * 32;
        f32x16 sacc = {};
        for (int i = tid; i < 32 * QT_S / 4; i += 512) ((unsigned*)(lds + OFF_ST))[i] = 0u;
        unsigned short graw[16], qraw[16]; u32x2 vraw;
        { const bf16_t* rp = base + (size_t)(seg * 16) * N1;
#pragma unroll
          for (int i = 0; i < 16; ++i) { graw[i] = rp[(size_t)i * N1 + gcol]; qraw[i] = rp[(size_t)i * N1 + qcol]; }
          vraw = *(const u32x2*)(base + (size_t)(tid >> 3) * N1 + vcol + (tid & 7) * 4); }
        for (int ch = 0; ch < 128; ++ch) {
            const int tok0 = ch * 64;
            float gl[16]; float cum = 0.f;
#pragma unroll
            for (int i = 0; i < 16; ++i) { cum += bf2f(graw[i]); gl[i] = cum; }
            segtot[seg * 128 + kch] = cum; if (seg == 2) g32s[kch] = bf2f(graw[0]);
            __syncthreads();
            { const float s0 = segtot[kch], s1 = segtot[128 + kch], s2 = segtot[256 + kch], s3 = segtot[384 + kch];
              const float off = (seg > 0 ? s0 : 0.f) + (seg > 1 ? s1 : 0.f) + (seg > 2 ? s2 : 0.f);
              const float tot = (s0 + s1) + (s2 + s3), bref = s0 + s1 + g32s[kch];
              if (seg == 0) decay[kch] = fast_exp(tot);
              float kd[16];
#pragma unroll
              for (int i = 0; i < 16; ++i) { const int t = seg * 16 + i; const float bb = off + gl[i], gv = bf2f(graw[i]), qv = bf2f(qraw[i]); const float kk = 1.0f - fast_exp(gv);
                  *(bf16_t*)(lds + OFF_QT + t * QT_S + kch * 2) = f2bf_n(qv * fast_exp(bb - bref));
                  *(bf16_t*)(lds + OFF_KT + t * QT_S + kch * 2) = f2bf_n(kk * fast_exp(bref - bb));
                  *(bf16_t*)(lds + OFF_QB + t * QT_S + kch * 2) = f2bf_n(qv * fast_exp(bb));
                  kd[i] = kk * fast_exp(tot - bb); }
              *(bf16x8*)(lds + OFF_KD + kch * KD_S + seg * 32) = pack8((f32x4){kd[0], kd[1], kd[2], kd[3]}, (f32x4){kd[4], kd[5], kd[6], kd[7]});
              *(bf16x8*)(lds + OFF_KD + kch * KD_S + seg * 32 + 16) = pack8((f32x4){kd[8], kd[9], kd[10], kd[11]}, (f32x4){kd[12], kd[13], kd[14], kd[15]});
              { const int t = tid >> 3, v4 = (tid & 7) * 4;
                *(bf16_t*)(lds + OFF_VT + (v4 + 0) * KD_S + t * 2) = (bf16_t)(vraw.x & 0xffffu); *(bf16_t*)(lds + OFF_VT + (v4 + 1) * KD_S + t * 2) = (bf16_t)(vraw.x >> 16);
                *(bf16_t*)(lds + OFF_VT + (v4 + 2) * KD_S + t * 2) = (bf16_t)(vraw.y & 0xffffu); *(bf16_t*)(lds + OFF_VT + (v4 + 3) * KD_S + t * 2) = (bf16_t)(vraw.y >> 16); }
            }
            if (ch + 1 < 128) { const bf16_t* rp = base + (size_t)(tok0 + 64 + seg * 16) * N1;
#pragma unroll
                for (int i = 0; i < 16; ++i) { graw[i] = rp[(size_t)i * N1 + gcol]; qraw[i] = rp[(size_t)i * N1 + qcol]; }
                vraw = *(const u32x2*)(base + (size_t)(tok0 + 64 + (tid >> 3)) * N1 + vcol + (tid & 7) * 4); }
            __syncthreads();
            f32x16 oacc = {};
            if (wid < 4) {
                const int ci = wid >> 1, si = wid & 1;
                if (!(ci == 0 && si == 1)) {
                    f32x16 aacc = {};
#pragma unroll
                    for (int kk = 0; kk < 8; ++kk) {
                        const bf16x8 af = *(const bf16x8*)(lds + OFF_QT + (32 * ci + r32) * QT_S + kk * 32 + hi * 16);
                        const bf16x8 bfr = *(const bf16x8*)(lds + OFF_KT + (32 * si + r32) * QT_S + kk * 32 + hi * 16);
                        aacc = __builtin_amdgcn_mfma_f32_32x32x16_bf16(af, bfr, aacc, 0, 0, 0); }
#pragma unroll
                    for (int i = 0; i < 16; ++i) { const int c = 32 * ci + crow(i, hi), s = 32 * si + r32; const float v = (c >= s) ? aacc[i] : 0.f;
                        *(bf16_t*)(lds + OFF_ATT + c * KD_S + s * 2) = f2bf_n(v); }
                } else {
#pragma unroll
                    for (int i = 0; i < 16; ++i) { const int c = crow(i, hi), s = 32 + r32; *(bf16_t*)(lds + OFF_ATT + c * KD_S + s * 2) = (bf16_t)0; }
                }
#pragma unroll
                for (int g4 = 0; g4 < 4; ++g4) { const f32x4 d = *(const f32x4*)(decay + 32 * wid + 8 * g4 + 4 * hi);
#pragma unroll
                    for (int j = 0; j < 4; ++j) sacc[g4 * 4 + j] *= d[j]; }
#pragma unroll
                for (int kk = 0; kk < 4; ++kk) {
                    const bf16x8 af = *(const bf16x8*)(lds + OFF_KD + (32 * wid + r32) * KD_S + kk * 32 + hi * 16);
                    const bf16x8 bfr = *(const bf16x8*)(lds + OFF_VT + r32 * KD_S + kk * 32 + hi * 16);
                    sacc = __builtin_amdgcn_mfma_f32_32x32x16_bf16(af, bfr, sacc, 0, 0, 0); }
            } else if (wid < 6) {
                const int ci = wid - 4;
#pragma unroll
                for (int kk = 0; kk < 8; ++kk) {
                    const bf16x8 af = *(const bf16x8*)(lds + OFF_QB + (32 * ci + r32) * QT_S + kk * 32 + hi * 16);
                    const bf16x8 bfr = *(const bf16x8*)(lds + OFF_ST + r32 * QT_S + kk * 32 + hi * 16);
                    oacc = __builtin_amdgcn_mfma_f32_32x32x16_bf16(af, bfr, oacc, 0, 0, 0); }
            }
            __syncthreads();
            if (wid < 4) {
#pragma unroll
                for (int g4 = 0; g4 < 4; ++g4) { u32x2 w; w.x = cvtpk_n(sacc[g4 * 4 + 0], sacc[g4 * 4 + 1]); w.y = cvtpk_n(sacc[g4 * 4 + 2], sacc[g4 * 4 + 3]);
                    *(u32x2*)(lds + OFF_ST + r32 * QT_S + (32 * wid + 8 * g4 + 4 * hi) * 2) = w; }
            } else if (wid < 6) {
                const int ci = wid - 4;
#pragma unroll
                for (int kk = 0; kk < 4; ++kk) {
                    const bf16x8 af = *(const bf16x8*)(lds + OFF_ATT + (32 * ci + r32) * KD_S + kk * 32 + hi * 16);
                    const bf16x8 bfr = *(const bf16x8*)(lds + OFF_VT + r32 * KD_S + kk * 32 + hi * 16);
                    oacc = __builtin_amdgcn_mfma_f32_32x32x16_bf16(af, bfr, oacc, 0, 0, 0); }
#pragma unroll
                for (int i = 0; i < 16; ++i) { const int c = 32 * ci + crow(i, hi); ob[(size_t)(tok0 + c) * 32 + r32] = f2bf_n(oacc[i]); }
            }
        }
        __syncthreads();
    }
}
}
namespace hg2 {
#define LBAR() do { asm volatile("s_waitcnt lgkmcnt(0)" ::: "memory"); __builtin_amdgcn_s_barrier(); asm volatile("" ::: "memory"); } while (0)
constexpr int QT_S = 272, KD_S = 144;
constexpr int OFF_QT = 0, OFF_KT = OFF_QT + 64 * QT_S, OFF_QB = OFF_KT + 64 * QT_S, OFF_KD = OFF_QB + 64 * QT_S;
constexpr int OFF_VT4 = OFF_KD + 128 * KD_S, OFF_ATT = OFF_VT4 + 128 * KD_S;
constexpr int OFF_SEG = OFF_ATT + 64 * KD_S, OFF_G32 = OFF_SEG + 2048, OFF_DEC = OFF_G32 + 512, LDS_BYTES = OFF_DEC + 512;
constexpr int ST_BYTES = 32 * QT_S;
__device__ __forceinline__ int crow(int r, int hi) { return (r & 3) + 8 * (r >> 2) + 4 * hi; }

__device__ __forceinline__ void prepass(char* lds, bf16_t* __restrict__ proj1, char* __restrict__ attbuf, float* __restrict__ decbuf) {
    int tid = threadIdx.x; asm volatile("" : "+v"(tid));
    const int wid = __builtin_amdgcn_readfirstlane(tid >> 6), lane = tid & 63, r32 = lane & 31, hi = lane >> 5;
    const int kch = tid & 127, seg = tid >> 7;
    float* segtot = (float*)(lds + OFF_SEG); float* g32s = (float*)(lds + OFF_G32); float* decay = (float*)(lds + OFF_DEC);
    unsigned short graw[16], qraw[16]; bf16x8 vr0, vr1;
#define PRE_LOAD(it_) do { const int bh_ = (it_) >> 7, ch_ = (it_) & 127, b_ = bh_ >> 5, h_ = bh_ & 31;                                   \
        const bf16_t* bs_ = proj1 + ((size_t)b_ * SEQ + ch_ * 64) * N1; const bf16_t* rp_ = bs_ + (size_t)(seg * 16) * N1 + h_ * 128 + kch; \
        _Pragma("unroll") for (int i = 0; i < 16; ++i) { graw[i] = rp_[(size_t)i * N1 + 4096]; qraw[i] = rp_[(size_t)i * N1]; }                \
        const bf16_t* vp_ = bs_ + (size_t)(tid & 63) * N1 + 8192 + h_ * 128 + (tid >> 6) * 16;                                                \
        vr0 = *(const bf16x8*)vp_; vr1 = *(const bf16x8*)(vp_ + 8); } while (0)
    if (blockIdx.x < 8192) PRE_LOAD(blockIdx.x);
    for (int item = blockIdx.x; item < 8192; item += gridDim.x) {
        const int bh = item >> 7, ch = item & 127, b = bh >> 5, h = bh & 31;
        bf16_t* base = proj1 + ((size_t)b * SEQ + ch * 64) * N1;
        const int qcol = h * 128, gcol = 4096 + h * 128, vcol = 8192 + h * 128;
        float gl[16]; float cum = 0.f;
#pragma unroll
        for (int i = 0; i < 16; ++i) { cum += bf2f(graw[i]); gl[i] = cum; }
        segtot[seg * 128 + kch] = cum; if (seg == 2) g32s[kch] = bf2f(graw[0]);
        LBAR();
        { const float s0 = segtot[kch], s1 = segtot[128 + kch], s2 = segtot[256 + kch], s3 = segtot[384 + kch];
          const float off = (seg > 0 ? s0 : 0.f) + (seg > 1 ? s1 : 0.f) + (seg > 2 ? s2 : 0.f);
          const float tot = (s0 + s1) + (s2 + s3), bref = s0 + s1 + g32s[kch];
          if (seg == 0) decay[kch] = fast_exp(tot);
          float kd[16];
#pragma unroll
          for (int i = 0; i < 16; ++i) { const int t = seg * 16 + i; const float bb = off + gl[i], gv = bf2f(graw[i]), qv = bf2f(qraw[i]); const float kk = 1.0f - fast_exp(gv);
              *(bf16_t*)(lds + OFF_QT + t * QT_S + kch * 2) = f2bf_n(qv * fast_exp(bb - bref));
              *(bf16_t*)(lds + OFF_KT + t * QT_S + kch * 2) = f2bf_n(kk * fast_exp(bref - bb));
              *(bf16_t*)(lds + OFF_QB + t * QT_S + kch * 2) = f2bf_n(qv * fast_exp(bb));
              kd[i] = kk * fast_exp(tot - bb); }
          *(bf16x8*)(lds + OFF_KD + kch * KD_S + seg * 32) = pack8((f32x4){kd[0], kd[1], kd[2], kd[3]}, (f32x4){kd[4], kd[5], kd[6], kd[7]});
          *(bf16x8*)(lds + OFF_KD + kch * KD_S + seg * 32 + 16) = pack8((f32x4){kd[8], kd[9], kd[10], kd[11]}, (f32x4){kd[12], kd[13], kd[14], kd[15]});
          { const int t = tid & 63, v16 = (tid >> 6) * 16;
#pragma unroll
            for (int j = 0; j < 8; ++j) { *(bf16_t*)(lds + OFF_VT4 + (v16 + j) * KD_S + t * 2) = (bf16_t)vr0[j]; *(bf16_t*)(lds + OFF_VT4 + (v16 + 8 + j) * KD_S + t * 2) = (bf16_t)vr1[j]; } }
        }
        if (item + (int)gridDim.x < 8192) PRE_LOAD(item + gridDim.x);
        LBAR();
        if (wid < 4) {
            const int ci = wid >> 1, si = wid & 1;
            if (!(ci == 0 && si == 1)) {
                f32x16 aacc = {};
#pragma unroll
                for (int kk = 0; kk < 8; ++kk) {
                    const bf16x8 af = *(const bf16x8*)(lds + OFF_QT + (32 * ci + r32) * QT_S + kk * 32 + hi * 16);
                    const bf16x8 bfr = *(const bf16x8*)(lds + OFF_KT + (32 * si + r32) * QT_S + kk * 32 + hi * 16);
                    aacc = __builtin_amdgcn_mfma_f32_32x32x16_bf16(af, bfr, aacc, 0, 0, 0); }
#pragma unroll
                for (int i = 0; i < 16; ++i) { const int c = 32 * ci + crow(i, hi), s = 32 * si + r32; const float v = (c >= s) ? aacc[i] : 0.f;
                    *(bf16_t*)(lds + OFF_ATT + c * KD_S + s * 2) = f2bf_n(v); }
            } else {
#pragma unroll
                for (int i = 0; i < 16; ++i) { const int c = crow(i, hi), s = 32 + r32; *(bf16_t*)(lds + OFF_ATT + c * KD_S + s * 2) = (bf16_t)0; }
            }
        }
        LBAR();
        { const size_t lrow = (size_t)(lane >> 4) * N1 + (lane & 15) * 8;
#pragma unroll
          for (int e = 0; e < 2; ++e) { const int f = 2 * wid + e;
              { const int ci = f >> 3, kk = f & 7; const bf16x8 fr = *(const bf16x8*)(lds + OFF_QB + (32 * ci + r32) * QT_S + kk * 32 + hi * 16);
                *(bf16x8*)(base + (size_t)(4 * f) * N1 + qcol + lrow) = fr; }
              { const int kt = f >> 2, kk = f & 3; const bf16x8 fr = *(const bf16x8*)(lds + OFF_KD + (32 * kt + r32) * KD_S + kk * 32 + hi * 16);
                *(bf16x8*)(base + (size_t)(4 * f) * N1 + gcol + lrow) = fr; }
              { const int vs = f >> 2, kk = f & 3; const bf16x8 fr = *(const bf16x8*)(lds + OFF_VT4 + (32 * vs + r32) * KD_S + kk * 32 + hi * 16);
                *(bf16x8*)(base + (size_t)(4 * f) * N1 + vcol + lrow) = fr; } }
          { const int f = wid, ci = f >> 2, kk = f & 3; const bf16x8 fr = *(const bf16x8*)(lds + OFF_ATT + (32 * ci + r32) * KD_S + kk * 32 + hi * 16);
            *(bf16x8*)(attbuf + ((size_t)item * 8 + f) * 1024 + lane * 16) = fr; }
          if (tid < 32) *(f32x4*)(decbuf + (size_t)item * 128 + tid * 4) = *(const f32x4*)(decay + tid * 4);
        }
    }
#undef PRE_LOAD
    LBAR();
}

__device__ __forceinline__ void seqpass(char* lds, const bf16_t* __restrict__ proj1, const char* __restrict__ attbuf, const float* __restrict__ decbuf, bf16_t* __restrict__ oraw) {
    int tid = threadIdx.x; asm volatile("" : "+v"(tid));
    const int wid = __builtin_amdgcn_readfirstlane(tid >> 6), lane = tid & 63, r32 = lane & 31, hi = lane >> 5;
    constexpr int OFF_AV = 2 * ST_BYTES;
#ifndef PROBE_SEQDUP
#define PROBE_SEQDUP 0
#endif
    for (int it2 = blockIdx.x; it2 < (1 + PROBE_SEQDUP) * 256; it2 += gridDim.x) {
        const int w_ = it2 & 255;
        const int bh = (w_ & 7) * 8 + (w_ >> 5), vs = (w_ >> 3) & 3, item = bh * 4 + vs, b = bh >> 5, h = bh & 31;
        const char* base0 = (const char*)(proj1 + (size_t)b * SEQ * N1);
        const unsigned lrow = (unsigned)(((lane >> 4) * N1 + (lane & 15) * 8) * 2);
        constexpr size_t CHB = (size_t)64 * N1 * 2, FRB = (size_t)4 * N1 * 2;
        for (int i = tid; i < 2 * ST_BYTES / 4; i += 512) ((unsigned*)lds)[i] = 0u;
        if (wid < 4) {
            f32x16 sacc = {};
            const char* gb = base0 + (size_t)(4096 + h * 128) * 2 + (size_t)(wid * 4) * FRB;
            const char* vb = base0 + (size_t)(8192 + h * 128) * 2 + (size_t)(vs * 4) * FRB;
            const float* db = decbuf + (size_t)bh * 128 * 128 + 32 * wid + 4 * hi;
            bf16x8 K0[4], V0[4], K1[4], V1[4], K2[4], V2[4]; f32x4 D0[4], D1[4], D2[4];
#define ST_LOAD(K_, V_, d_, ch_) do { _Pragma("unroll") for (int kk = 0; kk < 4; ++kk) { K_[kk] = *(const bf16x8*)(gb + (size_t)(ch_) * CHB + kk * FRB + lrow);  \
                                                                                         V_[kk] = *(const bf16x8*)(vb + (size_t)(ch_) * CHB + kk * FRB + lrow);  \
                                                                                         d_[kk] = *(const f32x4*)(db + (size_t)(ch_) * 128 + 8 * kk); } } while (0)
#define ST_STEP(c_, K_, V_, d_, LK_, LV_, Ld_) do { if ((c_) + 2 < 128) ST_LOAD(LK_, LV_, Ld_, (c_) + 2);                                                      \
                char* st_nxt = lds + (((c_) + 1) & 1) * ST_BYTES;                                                                                                \
                _Pragma("unroll") for (int g4 = 0; g4 < 4; ++g4) _Pragma("unroll") for (int j = 0; j < 4; ++j) sacc[g4 * 4 + j] *= d_[g4][j];                    \
                _Pragma("unroll") for (int kk = 0; kk < 4; ++kk) sacc = __builtin_amdgcn_mfma_f32_32x32x16_bf16(K_[kk], V_[kk], sacc, 0, 0, 0);                  \
                _Pragma("unroll") for (int g4 = 0; g4 < 4; ++g4) { u32x2 w; w.x = cvtpk_n(sacc[g4 * 4 + 0], sacc[g4 * 4 + 1]); w.y = cvtpk_n(sacc[g4 * 4 + 2], sacc[g4 * 4 + 3]); \
                    *(u32x2*)(st_nxt + r32 * QT_S + (32 * wid + 8 * g4 + 4 * hi) * 2) = w; }                                                                    \
                LBAR(); } while (0)
            ST_LOAD(K0, V0, D0, 0); ST_LOAD(K1, V1, D1, 1);
            LBAR();
            for (int ch = 0; ch < 126; ch += 3) { ST_STEP(ch, K0, V0, D0, K2, V2, D2); ST_STEP(ch + 1, K1, V1, D1, K0, V0, D0); ST_STEP(ch + 2, K2, V2, D2, K1, V1, D1); }
            ST_STEP(126, K0, V0, D0, K2, V2, D2); ST_STEP(127, K1, V1, D1, K0, V0, D0);
#undef ST_STEP
#undef ST_LOAD
        } else if (wid < 6) {
            const int ci = wid - 4;
            const char* qb = base0 + (size_t)(h * 128) * 2 + (size_t)(ci * 8) * FRB;
            char* ob = (char*)(oraw + (size_t)item * SEQ * 32) + (size_t)(32 * ci) * 64;
            const unsigned ooff = (unsigned)((4 * hi * 32 + r32) * 2);
            bf16x8 Q0[8], Q1[8], Q2[8];
#define O_LOAD(Q_, ch_) do { _Pragma("unroll") for (int kk = 0; kk < 8; ++kk) Q_[kk] = *(const bf16x8*)(qb + (size_t)(ch_) * CHB + kk * FRB + lrow); } while (0)
#define O_STEP(c_, Q_, LQ_) do { if ((c_) + 2 < 128) O_LOAD(LQ_, (c_) + 2);                                                                                      \
                const char* st_cur = lds + ((c_) & 1) * ST_BYTES; const char* av = lds + OFF_AV + ((((c_) & 1) * 2 + ci) * 4) * 1024 + lane * 16;               \
                f32x16 oacc;                                                                                                                                     \
                _Pragma("unroll") for (int q = 0; q < 4; ++q) { const f32x4 t4 = *(const f32x4*)(av + q * 1024); oacc[q * 4 + 0] = t4[0]; oacc[q * 4 + 1] = t4[1]; oacc[q * 4 + 2] = t4[2]; oacc[q * 4 + 3] = t4[3]; } \
                _Pragma("unroll") for (int kk = 0; kk < 8; ++kk) { const bf16x8 sf = *(const bf16x8*)(st_cur + r32 * QT_S + kk * 32 + hi * 16);                  \
                    oacc = __builtin_amdgcn_mfma_f32_32x32x16_bf16(Q_[kk], sf, oacc, 0, 0, 0); }                                                                \
                char* oc = ob + (size_t)(c_) * (64 * 64);                                                                                                        \
                _Pragma("unroll") for (int i = 0; i < 16; ++i) *(bf16_t*)(oc + ((i & 3) + 8 * (i >> 2)) * 64 + ooff) = f2bf_n(oacc[i]);                          \
                LBAR(); } while (0)
            O_LOAD(Q0, 0); O_LOAD(Q1, 1);
            LBAR();
            for (int ch = 0; ch < 126; ch += 3) { O_STEP(ch, Q0, Q2); O_STEP(ch + 1, Q1, Q0); O_STEP(ch + 2, Q2, Q1); }
            O_STEP(126, Q0, Q2); O_STEP(127, Q1, Q0);
#undef O_STEP
#undef O_LOAD
        } else {
            const int ci = wid - 6;
            const char* vb = base0 + (size_t)(8192 + h * 128) * 2 + (size_t)(vs * 4) * FRB;
            const char* ab = attbuf + ((size_t)bh * 128 * 8 + ci * 4) * 1024 + lane * 16;
            bf16x8 A0[4], V0[4], A1[4], V1[4], A2[4], V2[4];
#define AV_LOAD(A_, V_, ch_) do { _Pragma("unroll") for (int kk = 0; kk < 4; ++kk) { A_[kk] = *(const bf16x8*)(ab + (size_t)(ch_) * 8192 + kk * 1024);          \
                                                                                     V_[kk] = *(const bf16x8*)(vb + (size_t)(ch_) * CHB + kk * FRB + lrow); } } while (0)
#define AV_DO(A_, V_, slot_) do { f32x16 acc_ = {}; _Pragma("unroll") for (int kk = 0; kk < 4; ++kk) acc_ = __builtin_amdgcn_mfma_f32_32x32x16_bf16(A_[kk], V_[kk], acc_, 0, 0, 0); \
        char* av_ = lds + OFF_AV + ((((slot_) & 1) * 2 + ci) * 4) * 1024 + lane * 16;                                                                                   \
        _Pragma("unroll") for (int q = 0; q < 4; ++q) *(f32x4*)(av_ + q * 1024) = (f32x4){acc_[q * 4 + 0], acc_[q * 4 + 1], acc_[q * 4 + 2], acc_[q * 4 + 3]}; } while (0)
            AV_LOAD(A0, V0, 0); AV_LOAD(A1, V1, 1); AV_LOAD(A2, V2, 2);
            AV_DO(A0, V0, 0);
            LBAR();
#define AV_STEP(c_, A_, V_, LA_, LV_) do { if ((c_) + 3 < 128) AV_LOAD(LA_, LV_, (c_) + 3); if ((c_) + 1 < 128) AV_DO(A_, V_, (c_) + 1); LBAR(); } while (0)
            for (int ch = 0; ch < 126; ch += 3) { AV_STEP(ch, A1, V1, A0, V0); AV_STEP(ch + 1, A2, V2, A1, V1); AV_STEP(ch + 2, A0, V0, A2, V2); }
            AV_STEP(126, A1, V1, A0, V0); AV_STEP(127, A2, V2, A1, V1);
#undef AV_STEP
#undef AV_LOAD
#undef AV_DO
        }
    }
}
#undef LBAR
}
constexpr int LDS_TOTAL = pg8::STAGE_BYTES;
static_assert(att::LDS_BYTES <= LDS_TOTAL && hg::LDS_BYTES <= LDS_TOTAL && hg2::LDS_BYTES <= LDS_TOTAL, "lds");
static_assert((size_t)8192 * 8192 + (size_t)8192 * 512 <= WS_W1O, "attbuf/decbuf must fit in the dead weight region");

#ifndef PHMASK
#define PHMASK 0xFFFF
#endif
#define EN(n) (((PHMASK) >> (n)) & 1)
#ifndef SKIP_SEQ
#define SKIP_SEQ 0
#endif
#ifndef SKIP_PRE
#define SKIP_PRE 0
#endif
#ifndef PROBE_DUP7
#define PROBE_DUP7 0
#endif

__global__ void __launch_bounds__(512) mla_hgrn2_fwd(Params p) {
    extern __shared__ __attribute__((aligned(16))) unsigned char lds[];
    cg::grid_group grid = cg::this_grid();
    unsigned char* ws = p.ws;
    bf16_t* W0IN = (bf16_t*)(ws + WS_W0IN); bf16_t* WUQ = (bf16_t*)(ws + WS_WUQ); bf16_t* WUKV = (bf16_t*)(ws + WS_WUKV);
    bf16_t* W0O = (bf16_t*)(ws + WS_W0O); bf16_t* W1IN = (bf16_t*)(ws + WS_W1IN); bf16_t* W1O = (bf16_t*)(ws + WS_W1O);
    float* RSTD0 = (float*)(ws + WS_RSTD0); float* RSTDQ = (float*)(ws + WS_RSTDQ); float* RSTDKV = (float*)(ws + WS_RSTDKV); float* RSTD1 = (float*)(ws + WS_RSTD1);
    float* LB = (float*)(ws + WS_LB); float* COS = (float*)(ws + WS_COS); float* SIN = (float*)(ws + WS_SIN);
    bf16_t* KROT = (bf16_t*)(ws + WS_KROT); bf16_t* ACTA = (bf16_t*)(ws + WS_ACTA);
    bf16_t* PROJ0 = (bf16_t*)(ws + WS_PROJ0); bf16_t* QBUF = (bf16_t*)(ws + WS_Q); bf16_t* PROJ1 = (bf16_t*)(ws + WS_PROJ1);
    bf16_t* KVBUF = (bf16_t*)p.out;
    LAS unsigned char* ldsl = (LAS unsigned char*)lds;
    const int G = gridDim.x, c = blockIdx.x;

    if (EN(0))
    {
        char* tile = (char*)lds;
        wt_phase(p.l0_w_in, 4096, N0, p.l0_norm, W0IN, tile);
        wt_phase(p.l0_w_uq, 1024, NQ, p.l0_q_norm, WUQ, tile);
        wt_phase(p.l0_w_ukv, 512, NKV, p.l0_kv_norm, WUKV, tile);
        wt_phase(p.l0_w_o, 4096, 4096, nullptr, W0O, tile);
        wt_phase(p.l1_w_in, 4096, N1, p.l1_norm, W1IN, tile);
        wt_phase(p.l1_w_o, 4096, 4096, nullptr, W1O, tile);
        { u32x4 z = {0u, 0u, 0u, 0u}; u32x4* pad = (u32x4*)(W0IN + (size_t)N0 * 4096); const int n16 = (N0P - N0) * 4096 * 2 / 16;
          for (int i = c * 512 + threadIdx.x; i < n16; i += G * 512) pad[i] = z; }
        cast_rstd_phase(p.x, ACTA, RSTD0);
        tables_phase(p, COS, SIN, LB);
    }
#ifdef PROBE_P02
    {
        char* tile = (char*)lds;
        wt_phase(p.l0_w_in, 4096, N0, p.l0_norm, W0IN, tile);
        wt_phase(p.l0_w_uq, 1024, NQ, p.l0_q_norm, WUQ, tile);
        wt_phase(p.l0_w_ukv, 512, NKV, p.l0_kv_norm, WUKV, tile);
        wt_phase(p.l0_w_o, 4096, 4096, nullptr, W0O, tile);
        wt_phase(p.l1_w_in, 4096, N1, p.l1_norm, W1IN, tile);
        wt_phase(p.l1_w_o, 4096, 4096, nullptr, W1O, tile);
    }
#endif
    grid.sync();
    if (EN(1)) {
        pg8::Gemm g{ACTA, W0IN, T_TOK, N0P, 4096, 4096}; pg8::StaticOrder S; S.init(T_TOK, N0P, G, c);
        pg8::EpiBf16<1> E{PROJ0, N0P, RSTD0, 1600, nullptr};
        pg8::gemm_phase(ldsl, g, S, E);
    }
    grid.sync();
    if (EN(2)) stats_krot_phase(PROJ0, RSTDQ, RSTDKV, COS, SIN, KROT);
    grid.sync();
    if (EN(3)) {
        pg8::Gemm g{PROJ0, WUQ, T_TOK, NQ, 1024, N0P}; pg8::StaticOrder S; S.init(T_TOK, NQ, G, c);
        pg8::EpiBf16<0> E{QBUF, NQ, RSTDQ, 0, nullptr};
        pg8::gemm_phase(ldsl, g, S, E);
    }
    if (EN(3)) {
        pg8::Gemm g{PROJ0 + 1024, WUKV, T_TOK, NKV, 512, N0P}; pg8::StaticOrder S; S.init(T_TOK, NKV, G, c);
        pg8::EpiBf16<0> E{KVBUF, NKV, RSTDKV, 0, nullptr};
        pg8::gemm_phase(ldsl, g, S, E);
    }
    grid.sync();
    if (EN(4)) {
        att::Tensors T{QBUF, KVBUF, KROT, ACTA, PROJ0, COS, SIN};
        att::attn_phase((char*)lds, T);
    }
    grid.sync();
    if (EN(5)) {
        pg8::Gemm g{ACTA, W0O, T_TOK, 4096, 4096, 4096}; pg8::StaticOrder S; S.init(T_TOK, 4096, G, c);
        pg8::EpiResF32 E{p.x, p.out, 4096};
        pg8::gemm_phase(ldsl, g, S, E);
    }
    grid.sync();
    if (EN(6)) cast_rstd_phase(p.out, ACTA, RSTD1);
    grid.sync();
    if (EN(7)) {
        pg8::Gemm g{ACTA, W1IN, T_TOK, N1, 4096, 4096}; pg8::StaticOrder S; S.init(T_TOK, N1, G, c, PROBE_DUP7);
        pg8::EpiBf16<2> E{PROJ1, N1, RSTD1, 0, LB};
        pg8::gemm_phase(ldsl, g, S, E);
    }
    grid.sync();
#ifdef HG_OLD
    if (EN(8)) hg::hgrn2_phase((char*)lds, PROJ1, ACTA);
#else
    if (EN(8) && !SKIP_PRE) hg2::prepass((char*)lds, PROJ1, (char*)(ws + WS_W0IN), (float*)(ws + WS_W0IN + (size_t)8192 * 8192));
    grid.sync();
    if (EN(8) && !SKIP_SEQ) hg2::seqpass((char*)lds, PROJ1, (const char*)(ws + WS_W0IN), (const float*)(ws + WS_W0IN + (size_t)8192 * 8192), ACTA);
#endif
#ifdef PROBE_HG2
    __syncthreads(); hg::hgrn2_phase((char*)lds, PROJ1, ACTA);
#endif
    grid.sync();
    if (EN(9)) headnorm_phase(PROJ1, ACTA, p.l1_g_norm);
    grid.sync();
    if (EN(10)) {
        pg8::Gemm g{PROJ1 + 8192, W1O, T_TOK, 4096, 4096, N1}; pg8::StaticOrder S; S.init(T_TOK, 4096, G, c);
        pg8::EpiResF32 E{p.out, p.out, 4096};
        pg8::gemm_phase(ldsl, g, S, E);
    }
    grid.sync();
    if (EN(11)) final_norm_phase(p.out, p.final_norm);
}

extern "C" void kernel_launch(void* const* d_in, const int* in_sizes, int n_in, void* d_out, int out_size, void* d_ws, size_t ws_size, hipStream_t stream) {
    static int grid = 0;
    if (grid == 0) {
        if (n_in != 15 || ws_size < WS_END) { fprintf(stderr, "kernel_launch: unexpected inputs (n_in %d, ws %zu, need %zu)\n", n_in, ws_size, (size_t)WS_END); grid = -1; return; }
        int dev = 0, cus = 0, per_cu = 0;
        (void)hipGetDevice(&dev); (void)hipDeviceGetAttribute(&cus, hipDeviceAttributeMultiprocessorCount, dev);
        if (hipFuncSetAttribute((const void*)mla_hgrn2_fwd, hipFuncAttributeMaxDynamicSharedMemorySize, LDS_TOTAL) != hipSuccess) { fprintf(stderr, "kernel_launch: hipFuncSetAttribute failed\n"); grid = -1; return; }
        if (hipOccupancyMaxActiveBlocksPerMultiprocessor(&per_cu, (const void*)mla_hgrn2_fwd, 512, LDS_TOTAL) != hipSuccess || per_cu < 1) { fprintf(stderr, "kernel_launch: occupancy query gave %d\n", per_cu); per_cu = 1; }
        (void)hipGetLastError();
        if (cus <= 0) cus = 256;
        grid = cus * per_cu;
        fprintf(stderr, "kernel_launch: grid %d (cus %d x %d)\n", grid, cus, per_cu);
    }
    if (grid < 0) return;
    Params p{};
    p.x = (const float*)d_in[0]; p.pos = (const int*)d_in[1]; p.l0_norm = (const float*)d_in[2]; p.l0_w_in = (const float*)d_in[3]; p.l0_q_norm = (const float*)d_in[4];
    p.l0_w_uq = (const float*)d_in[5]; p.l0_kv_norm = (const float*)d_in[6]; p.l0_w_ukv = (const float*)d_in[7]; p.l0_w_o = (const float*)d_in[8]; p.l1_norm = (const float*)d_in[9];
    p.l1_w_in = (const float*)d_in[10]; p.l1_g_norm = (const float*)d_in[11]; p.l1_w_o = (const float*)d_in[12]; p.lower_bounds = (const float*)d_in[13]; p.final_norm = (const float*)d_in[14];
    p.out = (float*)d_out; p.ws = (unsigned char*)d_ws;
    for (int j = 0; j < 32; ++j) p.inv_freq[j] = (float)(1.0 / pow(10000.0, (double)(2 * j) / 64.0));
    void* args[] = {&p};
    hipError_t e = hipLaunchCooperativeKernel((const void*)mla_hgrn2_fwd, dim3(grid), dim3(512), args, LDS_TOTAL, stream);
    if (e != hipSuccess) fprintf(stderr, "kernel_launch: cooperative launch failed: %s (grid %d)\n", hipGetErrorString(e), grid);
}
```

```cpp
#include <hip/hip_runtime.h>
#include <hip/hip_cooperative_groups.h>
#include <cstdio>
#include <cstdint>
#include <cmath>
namespace cg = cooperative_groups;

typedef unsigned short bf16_t;
typedef short bf16x8 __attribute__((ext_vector_type(8)));
typedef short s16x4 __attribute__((ext_vector_type(4)));
typedef float f32x4 __attribute__((ext_vector_type(4)));
typedef float f32x16 __attribute__((ext_vector_type(16)));
typedef unsigned u32x4 __attribute__((ext_vector_type(4)));
typedef unsigned u32x2 __attribute__((ext_vector_type(2)));
#define LAS __attribute__((address_space(3)))

constexpr int T_TOK = 16384, SEQ = 8192, DM = 4096;
constexpr int N0 = 5696, N0P = 5888;
constexpr int NQ = 6144, NKV = 8192, N1 = 16384;
constexpr float EPS = 1e-6f;

constexpr size_t WS_W0IN = 0;
constexpr size_t WS_WUQ  = WS_W0IN + (size_t)N0P * 4096 * 2;
constexpr size_t WS_WUKV = WS_WUQ + (size_t)NQ * 1024 * 2;
constexpr size_t WS_W0O  = WS_WUKV + (size_t)NKV * 512 * 2;
constexpr size_t WS_W1IN = WS_W0O + (size_t)4096 * 4096 * 2;
constexpr size_t WS_W1O  = WS_W1IN + (size_t)N1 * 4096 * 2;
constexpr size_t WS_RSTD0 = WS_W1O + (size_t)4096 * 4096 * 2;
constexpr size_t WS_RSTDQ = WS_RSTD0 + 65536;
constexpr size_t WS_RSTDKV = WS_RSTDQ + 65536;
constexpr size_t WS_RSTD1 = WS_RSTDKV + 65536;
constexpr size_t WS_LB = WS_RSTD1 + 65536;
constexpr size_t WS_COS = WS_LB + 16384;
constexpr size_t WS_SIN = WS_COS + (size_t)T_TOK * 32 * 4;
constexpr size_t WS_KROT = WS_SIN + (size_t)T_TOK * 32 * 4;
constexpr size_t WS_ACTA = WS_KROT + (size_t)T_TOK * 64 * 2;
constexpr size_t WS_R = WS_ACTA + (size_t)T_TOK * 4096 * 2;
constexpr size_t WS_PROJ0 = WS_R;
constexpr size_t WS_Q = WS_PROJ0 + (size_t)T_TOK * N0P * 2;
constexpr size_t WS_PROJ1 = WS_R;
constexpr size_t WS_END = WS_R + (size_t)T_TOK * N1 * 2;

struct Params {
    const float* x; const int* pos; const float* l0_norm; const float* l0_w_in; const float* l0_q_norm; const float* l0_w_uq;
    const float* l0_kv_norm; const float* l0_w_ukv; const float* l0_w_o; const float* l1_norm; const float* l1_w_in;
    const float* l1_g_norm; const float* l1_w_o; const float* lower_bounds; const float* final_norm;
    float* out; unsigned char* ws;
    float inv_freq[32];
};

__device__ __forceinline__ unsigned cvtpk(float lo, float hi) { unsigned r; asm volatile("v_cvt_pk_bf16_f32 %0, %1, %2" : "=v"(r) : "v"(lo), "v"(hi)); return r; }
typedef float f32x2 __attribute__((ext_vector_type(2)));
typedef __bf16 bf16x2_t __attribute__((ext_vector_type(2)));
__device__ __forceinline__ unsigned cvtpk_n(float lo, float hi) { f32x2 v = {lo, hi}; bf16x2_t h = __builtin_convertvector(v, bf16x2_t); return __builtin_bit_cast(unsigned, h); }
__device__ __forceinline__ bf16_t f2bf_n(float f) { return (bf16_t)(cvtpk_n(f, 0.f) & 0xffffu); }
__device__ __forceinline__ bf16_t f2bf(float f) { return (bf16_t)(cvtpk(f, 0.f) & 0xffffu); }
__device__ __forceinline__ float bf2f(unsigned short h) { return __uint_as_float((unsigned)h << 16); }
__device__ __forceinline__ float bflo(unsigned w) { return __uint_as_float(w << 16); }
__device__ __forceinline__ float bfhi(unsigned w) { return __uint_as_float(w & 0xffff0000u); }
__device__ __forceinline__ bf16x8 pack8(f32x4 a, f32x4 b) {
    u32x4 w = {cvtpk(a[0], a[1]), cvtpk(a[2], a[3]), cvtpk(b[0], b[1]), cvtpk(b[2], b[3])};
    return *reinterpret_cast<bf16x8*>(&w);
}
__device__ __forceinline__ float fast_exp(float x) { return __builtin_amdgcn_exp2f(x * 1.4426950408889634f); }
__device__ __forceinline__ float silu_f(float v) { return v * __builtin_amdgcn_rcpf(1.0f + fast_exp(-v)); }
__device__ __forceinline__ float wave_sum(float v) {
#pragma unroll
    for (int o = 32; o > 0; o >>= 1) v += __shfl_xor(v, o);
    return v;
}

namespace pg8 {
constexpr int BM = 256, BK = 64, HALF = 128, HTB = HALF * BK * 2, STAGE_BYTES = 8 * HTB, NXCD = 8, WGM = 8;
__host__ __device__ __forceinline__ int lds_byte(int r, int c) { const int st = (r >> 4) * 2 + (c >> 5), rr = r & 15, cc = c & 31, ob = rr * 64 + cc * 2; return st * 1024 + (ob ^ (((ob >> 9) & 1) << 5)); }
__host__ __device__ __forceinline__ void stage_rc(int b, int& R, int& C) { const int st = b / 1024, sb = b % 1024, swz = sb ^ (((sb >> 9) & 1) << 5); R = (st >> 1) * 16 + swz / 64; C = (st & 1) * 32 + (swz % 64) / 2; }
__host__ __device__ __forceinline__ int perm32(int rho) { const int n = rho >> 4, i = rho & 15; return 8 * (i >> 2) + 4 * n + (i & 3); }
struct Unit { int pm, pn; };
struct Gemm { const bf16_t* A; const bf16_t* Bt; int M, N, K, lda; };
struct StaticOrder {
    int nM, nN, nwg, G, c, dup;
    __device__ void init(int M, int N, int G_, int c_, int dup_ = 0) { nM = M / BM; nN = N / BM; nwg = nM * nN; G = G_; c = c_; dup = dup_; }
    __device__ bool next(int i, Unit& u) const {
        const long L = (long)(i >> dup) * G + c; if (L >= nwg) return false;
        int wgid = (int)L; { const int q = nwg / NXCD, r = nwg % NXCD, xcd = wgid % NXCD, off = wgid / NXCD; wgid = (xcd < r ? xcd * (q + 1) : r * (q + 1) + (xcd - r) * q) + off; }
        const int nig = WGM * nN, gid = wgid / nig, fm = gid * WGM, gsz = (nM - fm) < WGM ? (nM - fm) : WGM;
        u.pm = fm + ((wgid % nig) % gsz); u.pn = (wgid % nig) / gsz; return true;
    }
};

template <int MODE> struct EpiBf16 {
    static constexpr bool PERM = true;
    bf16_t* O; int ldc; const float* rs; int thr; const float* lb; int ssqmode;
    __device__ __forceinline__ void operator()(const f32x4 (&acc)[2][2][4][2], const Unit& u, int wr, int wc, int fr, int fq) const {
        const int row0 = u.pm * BM + wr * 64 + fr, col0 = u.pn * BM + wc * 32 + 8 * fq;
        const int sec = (u.pn * BM) >> 12;
        f32x4 lbv[2][2] = {};
        if (MODE == 2) { if (sec == 1) {
#pragma unroll
            for (int bj = 0; bj < 2; ++bj) { lbv[bj][0] = *(const f32x4*)(lb + col0 + bj * HALF - 4096); lbv[bj][1] = *(const f32x4*)(lb + col0 + bj * HALF - 4096 + 4); } } }
        float rsv[2][4];
#pragma unroll
        for (int ai = 0; ai < 2; ++ai)
#pragma unroll
            for (int m = 0; m < 4; ++m) { float t_ = rs[row0 + ai * HALF + m * 16]; if (ssqmode) t_ = 1.0f / sqrtf(t_ * (1.0f / 4096.0f) + EPS); rsv[ai][m] = t_; }
#pragma unroll
        for (int ai = 0; ai < 2; ++ai)
#pragma unroll
            for (int m = 0; m < 4; ++m) {
                const int row = row0 + ai * HALF + m * 16; const float s = rsv[ai][m];
                bf16_t* rowp = O + (size_t)row * ldc + col0;
#pragma unroll
                for (int bj = 0; bj < 2; ++bj) {
                    f32x4 v0 = acc[ai][bj][m][0] * s, v1 = acc[ai][bj][m][1] * s;
                    const int col = col0 + bj * HALF;
                    if (MODE == 1) { if (col >= thr) {
#pragma unroll
                        for (int j = 0; j < 4; ++j) { v0[j] = silu_f(v0[j]); v1[j] = silu_f(v1[j]); } } }
                    if (MODE == 2) {
                        if (sec == 0 || sec == 3) {
#pragma unroll
                            for (int j = 0; j < 4; ++j) { v0[j] = silu_f(v0[j]); v1[j] = silu_f(v1[j]); } }
                        else if (sec == 1) {
                            const f32x4 l0 = lbv[bj][0], l1 = lbv[bj][1];
#pragma unroll
                            for (int j = 0; j < 4; ++j) {
                                float sg = __builtin_amdgcn_rcpf(1.0f + fast_exp(-v0[j])); float fg = l0[j] + (1.0f - l0[j]) * sg; v0[j] = __logf(fg);
                                sg = __builtin_amdgcn_rcpf(1.0f + fast_exp(-v1[j])); fg = l1[j] + (1.0f - l1[j]) * sg; v1[j] = __logf(fg); }
                        }
                    }
                    u32x4 w; w.x = cvtpk(v0[0], v0[1]); w.y = cvtpk(v0[2], v0[3]); w.z = cvtpk(v1[0], v1[1]); w.w = cvtpk(v1[2], v1[3]);
                    *(u32x4*)(rowp + bj * HALF) = w;
                }
            }
    }
};
struct EpiResF32 {
    static constexpr bool PERM = false;
    const float* base; float* out; int ldc;
    __device__ __forceinline__ void operator()(const f32x4 (&acc)[2][2][4][2], const Unit& u, int wr, int wc, int fr, int fq) const {
        const int row0 = u.pm * BM + wr * 64 + fr, col0 = u.pn * BM + wc * 32 + 4 * fq;
        f32x4 bs[2][4];
#define RES_LOAD(g, slot) do { const size_t off_ = (size_t)(row0 + ((g) >> 2) * HALF + ((g) & 3) * 16) * ldc + col0; \
        _Pragma("unroll") for (int bj = 0; bj < 2; ++bj) _Pragma("unroll") for (int n = 0; n < 2; ++n) bs[slot][bj * 2 + n] = *(const f32x4*)(base + off_ + bj * HALF + n * 16); } while (0)
        RES_LOAD(0, 0);
#pragma unroll
        for (int g = 0; g < 8; ++g) {
            if (g + 1 < 8) RES_LOAD(g + 1, (g + 1) & 1);
            const int ai = g >> 2, m = g & 3; const size_t off = (size_t)(row0 + ai * HALF + m * 16) * ldc + col0;
#pragma unroll
            for (int bj = 0; bj < 2; ++bj)
#pragma unroll
                for (int n = 0; n < 2; ++n) *(f32x4*)(out + off + bj * HALF + n * 16) = bs[g & 1][bj * 2 + n] + acc[ai][bj][m][n];
        }
#undef RES_LOAD
    }
};

struct EpiResBf16Stat {
    static constexpr bool PERM = true;
    const float* base; bf16_t* O; int ldc; float* ssq;
    __device__ __forceinline__ void operator()(const f32x4 (&acc)[2][2][4][2], const Unit& u, int wr, int wc, int fr, int fq) const {
        const int row0 = u.pm * BM + wr * 64 + fr, col0 = u.pn * BM + wc * 32 + 8 * fq;
        f32x4 bs[2][4];
#define RES_LOAD(g, slot) do { const size_t off_ = (size_t)(row0 + ((g) >> 2) * HALF + ((g) & 3) * 16) * ldc + col0; \
        _Pragma("unroll") for (int bj = 0; bj < 2; ++bj) { bs[slot][bj * 2] = *(const f32x4*)(base + off_ + bj * HALF); bs[slot][bj * 2 + 1] = *(const f32x4*)(base + off_ + bj * HALF + 4); } } while (0)
        RES_LOAD(0, 0);
#pragma unroll
        for (int g = 0; g < 8; ++g) {
            if (g + 1 < 8) RES_LOAD(g + 1, (g + 1) & 1);
            const int ai = g >> 2, m = g & 3, row = row0 + ai * HALF + m * 16; float ss = 0.f;
#pragma unroll
            for (int bj = 0; bj < 2; ++bj) {
                const f32x4 v0 = acc[ai][bj][m][0] + bs[g & 1][bj * 2], v1 = acc[ai][bj][m][1] + bs[g & 1][bj * 2 + 1];
                ss += (v0[0] * v0[0] + v0[1] * v0[1]) + (v0[2] * v0[2] + v0[3] * v0[3]) + (v1[0] * v1[0] + v1[1] * v1[1]) + (v1[2] * v1[2] + v1[3] * v1[3]);
                u32x4 w; w.x = cvtpk(v0[0], v0[1]); w.y = cvtpk(v0[2], v0[3]); w.z = cvtpk(v1[0], v1[1]); w.w = cvtpk(v1[2], v1[3]);
                *(u32x4*)(O + (size_t)row * ldc + col0 + bj * HALF) = w;
            }
            ss += __shfl_xor(ss, 16); ss += __shfl_xor(ss, 32);
            if (fq == 0) atomicAdd(ssq + row, ss);
        }
#undef RES_LOAD
    }
};
struct EpiResBf16F32 {
    static constexpr bool PERM = false;
    const bf16_t* base; int ldb; float* out; int ldo;
    __device__ __forceinline__ void operator()(const f32x4 (&acc)[2][2][4][2], const Unit& u, int wr, int wc, int fr, int fq) const {
        const int row0 = u.pm * BM + wr * 64 + fr, col0 = u.pn * BM + wc * 32 + 4 * fq;
        u32x2 bs[2][4];
#define RES_LOAD(g, slot) do { const size_t off_ = (size_t)(row0 + ((g) >> 2) * HALF + ((g) & 3) * 16) * ldb + col0; \
        _Pragma("unroll") for (int bj = 0; bj < 2; ++bj) _Pragma("unroll") for (int n = 0; n < 2; ++n) bs[slot][bj * 2 + n] = *(const u32x2*)(base + off_ + bj * HALF + n * 16); } while (0)
        RES_LOAD(0, 0);
#pragma unroll
        for (int g = 0; g < 8; ++g) {
            if (g + 1 < 8) RES_LOAD(g + 1, (g + 1) & 1);
            const int ai = g >> 2, m = g & 3; const size_t off = (size_t)(row0 + ai * HALF + m * 16) * ldo + col0;
#pragma unroll
            for (int bj = 0; bj < 2; ++bj)
#pragma unroll
                for (int n = 0; n < 2; ++n) { const u32x2 b2 = bs[g & 1][bj * 2 + n]; const f32x4 bv = {bflo(b2.x), bfhi(b2.x), bflo(b2.y), bfhi(b2.y)};
                    *(f32x4*)(out + off + bj * HALF + n * 16) = bv + acc[ai][bj][m][n]; }
        }
#undef RES_LOAD
    }
};

template <class Epi, class Sched>
__device__ __forceinline__ void gemm_phase(LAS unsigned char* lds, const Gemm g, const Sched& S, const Epi& E) {
    int tid = threadIdx.x; asm volatile("" : "+v"(tid));
    const int wid = __builtin_amdgcn_readfirstlane(tid >> 6), lane = tid & 63, wr = wid >> 2, wc = wid & 3, fr = lane & 15, fq = lane >> 4;
    const int K = g.K, nt = K / BK, lda = g.lda;
    unsigned voffA[2], voffB[2];
#pragma unroll
    for (int i = 0; i < 2; ++i) { int R, C; stage_rc(tid * 16 + i * 8192, R, C); const int Rb = Epi::PERM ? ((R & ~31) + perm32(R & 31)) : R;
        voffA[i] = (unsigned)(R * lda + C) * 2u; voffB[i] = (unsigned)(Rb * K + C) * 2u; }
    const size_t kstep = (size_t)(BK * 2);
    const size_t hstepA = (size_t)HALF * lda * 2, hstepB = (size_t)HALF * K * 2;
    const size_t tstepA = 2 * hstepA, tstepB = 2 * hstepB;
    const unsigned ldsw = (unsigned)wid * 1024u;
    const int aoff = lds_byte(wr * 64 + fr, fq * 8), boff = lds_byte(wc * 32 + fr, fq * 8);
#define PG8_SA(b, h) (((b) * 2 + (h)) * HTB)
#define PG8_SB(b, h) ((4 + (b) * 2 + (h)) * HTB)
#define PG8_STAGE(bufoff, gbase, voff) do { _Pragma("unroll") for (int _i = 0; _i < 2; ++_i) \
        __builtin_amdgcn_global_load_lds((const unsigned*)((const char*)(gbase) + (voff)[_i]), (LAS unsigned*)(lds + (bufoff) + ldsw + _i * 8192), 16, 0, 0); } while (0)
#define PG8_LDA(dst, b, h) do { _Pragma("unroll") for (int m = 0; m < 4; ++m) _Pragma("unroll") for (int k = 0; k < 2; ++k) dst[m][k] = *(const LAS bf16x8*)(lds + PG8_SA(b, h) + aoff + m * 2048 + k * 1024); } while (0)
#define PG8_LDB(dst, b, h) do { _Pragma("unroll") for (int n = 0; n < 2; ++n) _Pragma("unroll") for (int k = 0; k < 2; ++k) dst[n][k] = *(const LAS bf16x8*)(lds + PG8_SB(b, h) + boff + n * 2048 + k * 1024); } while (0)
#define PG8_MMA(ai, bj, At, Bt) do { __builtin_amdgcn_s_setprio(1); _Pragma("unroll") for (int m = 0; m < 4; ++m) _Pragma("unroll") for (int n = 0; n < 2; ++n) _Pragma("unroll") for (int k = 0; k < 2; ++k) \
        acc[ai][bj][m][n] = __builtin_amdgcn_mfma_f32_16x16x32_bf16(Bt[n][k], At[m][k], acc[ai][bj][m][n], 0, 0, 0); __builtin_amdgcn_s_setprio(0); } while (0)
#define PG8_WAIT_V(n) asm volatile("s_waitcnt vmcnt(" #n ")" ::: "memory")
#define PG8_WAIT_L(n) asm volatile("s_waitcnt lgkmcnt(" #n ")" ::: "memory")
#define PG8_BAR __builtin_amdgcn_s_barrier()
#define PG8_SCHED __builtin_amdgcn_sched_barrier(0)
    Unit cur, nxt; int ui = 0;
    if (!S.next(0, cur)) return;
    f32x4 acc[2][2][4][2];
#pragma unroll
    for (int a = 0; a < 2; ++a)
#pragma unroll
        for (int b = 0; b < 2; ++b)
#pragma unroll
            for (int m = 0; m < 4; ++m)
#pragma unroll
                for (int n = 0; n < 2; ++n) acc[a][b][m][n] = (f32x4){0.f, 0.f, 0.f, 0.f};
    bf16x8 At[4][2], B0[2][2], B1[2][2];
    const char* cA = (const char*)g.A + (size_t)cur.pm * tstepA; const char* cB = (const char*)g.Bt + (size_t)cur.pn * tstepB;
    PG8_STAGE(PG8_SB(0, 0), cB, voffB); PG8_STAGE(PG8_SA(0, 0), cA, voffA); PG8_STAGE(PG8_SB(0, 1), cB + hstepB, voffB); PG8_STAGE(PG8_SA(0, 1), cA + hstepA, voffA);
    if (wr == 1) PG8_BAR;
    PG8_WAIT_V(4); PG8_BAR;
    PG8_STAGE(PG8_SB(1, 0), cB + kstep, voffB); PG8_STAGE(PG8_SA(1, 0), cA + kstep, voffA); PG8_STAGE(PG8_SB(1, 1), cB + hstepB + kstep, voffB);
    PG8_WAIT_V(6); PG8_BAR;
    for (;;) {
        const bool has_next = S.next(ui + 1, nxt);
        const char* nA = has_next ? (const char*)g.A + (size_t)nxt.pm * tstepA : cA; const char* nB = has_next ? (const char*)g.Bt + (size_t)nxt.pn * tstepB : cB;
        for (int t = 0; t < nt; t += 2) {
            const bool last = (t == nt - 2);
            const char* a1 = cA + (size_t)(t + 1) * kstep;
            const char* a2 = last ? nA : cA + (size_t)(t + 2) * kstep; const char* b2 = last ? nB : cB + (size_t)(t + 2) * kstep;
            const char* a3 = a2 + kstep; const char* b3 = b2 + kstep;
            PG8_LDB(B0, 0, 0); PG8_SCHED; PG8_LDA(At, 0, 0); PG8_STAGE(PG8_SA(1, 1), a1 + hstepA, voffA);
            PG8_WAIT_L(8); PG8_BAR; PG8_WAIT_L(0); PG8_MMA(0, 0, At, B0); PG8_BAR; PG8_SCHED;
            PG8_LDB(B1, 0, 1); PG8_STAGE(PG8_SB(0, 0), b2, voffB);
            PG8_BAR; PG8_WAIT_L(0); PG8_MMA(0, 1, At, B1); PG8_BAR;
            PG8_LDA(At, 0, 1); PG8_STAGE(PG8_SA(0, 0), a2, voffA);
            PG8_BAR; PG8_WAIT_L(0); PG8_MMA(1, 0, At, B0); PG8_BAR; PG8_SCHED;
            PG8_STAGE(PG8_SB(0, 1), b2 + hstepB, voffB);
            PG8_WAIT_V(6); PG8_BAR; PG8_MMA(1, 1, At, B1); PG8_BAR;
            PG8_LDB(B0, 1, 0); PG8_SCHED; PG8_LDA(At, 1, 0); PG8_STAGE(PG8_SA(0, 1), a2 + hstepA, voffA);
            PG8_WAIT_L(8); PG8_BAR; PG8_WAIT_L(0); PG8_MMA(0, 0, At, B0); PG8_BAR; PG8_SCHED;
            PG8_LDB(B1, 1, 1); PG8_STAGE(PG8_SB(1, 0), b3, voffB);
            PG8_BAR; PG8_WAIT_L(0); PG8_MMA(0, 1, At, B1); PG8_BAR;
            PG8_LDA(At, 1, 1); PG8_STAGE(PG8_SA(1, 0), a3, voffA);
            PG8_BAR; PG8_WAIT_L(0); PG8_MMA(1, 0, At, B0); PG8_BAR; PG8_SCHED;
            PG8_STAGE(PG8_SB(1, 1), b3 + hstepB, voffB);
            PG8_WAIT_V(6); PG8_BAR; PG8_MMA(1, 1, At, B1); PG8_BAR;
        }
        E(acc, cur, wr, wc, fr, fq);
        if (!has_next) break;
#pragma unroll
        for (int a = 0; a < 2; ++a)
#pragma unroll
            for (int b = 0; b < 2; ++b)
#pragma unroll
                for (int m = 0; m < 4; ++m)
#pragma unroll
                    for (int n = 0; n < 2; ++n) acc[a][b][m][n] = (f32x4){0.f, 0.f, 0.f, 0.f};
        cur = nxt; cA = nA; cB = nB; ++ui;
    }
    PG8_WAIT_V(0);
    if (wr == 0) PG8_BAR;
    PG8_BAR;
#undef PG8_SA
#undef PG8_SB
#undef PG8_STAGE
#undef PG8_LDA
#undef PG8_LDB
#undef PG8_MMA
#undef PG8_WAIT_V
#undef PG8_WAIT_L
#undef PG8_BAR
#undef PG8_SCHED
}
}
namespace att {
constexpr int NW = 8, QBLK = 32, KVBLK = 64, QB = NW * QBLK;
constexpr int DQ = 192, DV = 128;
constexpr int QS = NQ, KVS = NKV, KRS = 64, OS = 4096, ZS = N0P;
constexpr int SHM_V = KVBLK * DV * 2, SHM_K = KVBLK * DQ * 2;
constexpr int QR_OFF = 2 * SHM_V + 2 * SHM_K + NW * 64 * 4;
constexpr int LDS_BYTES = QR_OFF + NW * 4096;
constexpr float SCALE = 0.07216878364870322f;
constexpr float THR = 8.f;
constexpr unsigned WBIG = 0x40000000u;

#define KSWZ(row, colB) ((row) * 384 + ((colB) ^ (((row) & 7) << 4)))
#define SBAR() __builtin_amdgcn_sched_barrier(0)
__device__ __forceinline__ int v_st(int k, int c) { const int kk = (k & ~0xC) | ((k & 4) << 1) | ((k & 8) >> 1); return ((kk >> 3) * 4 + (c >> 5)) * 512 + ((kk & 7) * 32 + (c & 31)) * 2; }
__device__ __forceinline__ int v_rd_base(int lane) { return ((lane & 3) << 3) | (((lane >> 2) & 3) << 6) | (((lane >> 4) & 1) << 5) | (((lane >> 5) & 1) << 8); }
constexpr int v_rd_off(int d0, int ks, int half) { return d0 * 512 + ks * 4096 + half * 2048; }
__device__ __forceinline__ int crow(int r, int hi) { return (r & 3) + 8 * (r >> 2) + 4 * hi; }
__device__ __forceinline__ bf16x8 load8(const bf16_t* p) { return *reinterpret_cast<const bf16x8*>(p); }

__device__ __forceinline__ void mask_tile(f32x16& p0, f32x16& p1, int dq) {
    const float NEG = -__builtin_inff();
#pragma unroll
    for (int r = 0; r < 16; ++r) {
        const int c = (r & 3) + 8 * (r >> 2);
        if ((unsigned)(dq - c) >= WBIG) p0[r] = NEG;
        if ((unsigned)(dq - c - 32) >= WBIG) p1[r] = NEG;
    }
}
__device__ __forceinline__ void partialSM(f32x16& p0, f32x16& p1, float& m_reg, float& mn, float& alpha) {
    float pmax = p0[0];
#pragma unroll
    for (int r = 1; r < 16; ++r) pmax = fmaxf(pmax, p0[r]);
#pragma unroll
    for (int r = 0; r < 16; ++r) pmax = fmaxf(pmax, p1[r]);
    { auto rr = __builtin_amdgcn_permlane32_swap(__float_as_uint(pmax), __float_as_uint(pmax), false, false);
      pmax = fmaxf(__uint_as_float(rr[0]), __uint_as_float(rr[1])); }
    constexpr float C2 = 1.4426950408889634f * SCALE;
    if (__builtin_expect(__all((pmax - m_reg) * SCALE <= THR), 1)) { mn = m_reg; alpha = 1.f; }
    else { mn = fmaxf(m_reg, pmax); alpha = __builtin_amdgcn_exp2f((m_reg - mn) * C2); m_reg = mn; }
    const float mnL = -mn * C2;
#pragma unroll
    for (int r = 0; r < 16; ++r) p0[r] = fmaf(p0[r], C2, mnL);
#pragma unroll
    for (int r = 0; r < 16; ++r) p1[r] = fmaf(p1[r], C2, mnL);
#pragma unroll
    for (int r = 0; r < 16; ++r) p0[r] = __builtin_amdgcn_exp2f(p0[r]);
}
__device__ __forceinline__ void finishSM(f32x16& p0, f32x16& p1, float alpha, float& l_reg, bf16x8& pa0, bf16x8& pa1, bf16x8& pa2, bf16x8& pa3) {
#pragma unroll
    for (int r = 0; r < 16; ++r) p1[r] = __builtin_amdgcn_exp2f(p1[r]);
    float ps = 0;
#pragma unroll
    for (int r = 0; r < 16; ++r) ps += p0[r];
#pragma unroll
    for (int r = 0; r < 16; ++r) ps += p1[r];
    { auto rr = __builtin_amdgcn_permlane32_swap(__float_as_uint(ps), __float_as_uint(ps), false, false);
      ps = __uint_as_float(rr[0]) + __uint_as_float(rr[1]); }
    l_reg = l_reg * alpha + ps;
#define PK4(P, B_, OUT) do { unsigned a0 = cvtpk(P[B_+0], P[B_+1]), a1 = cvtpk(P[B_+2], P[B_+3]);                          \
        unsigned b0 = cvtpk(P[B_+4], P[B_+5]), b1 = cvtpk(P[B_+6], P[B_+7]);                                             \
        auto r0 = __builtin_amdgcn_permlane32_swap(a0, b0, false, false); auto r1 = __builtin_amdgcn_permlane32_swap(a1, b1, false, false); \
        u32x4 w = {r0[0], r1[0], r0[1], r1[1]}; OUT = *reinterpret_cast<bf16x8*>(&w); } while (0)
    PK4(p0, 0, pa0); PK4(p0, 8, pa1); PK4(p1, 0, pa2); PK4(p1, 8, pa3);
#undef PK4
}
template <int KB>
__device__ __forceinline__ void qkt(f32x16& p0, f32x16& p1, const char* K_lds, int r32, int hi, const bf16x8* qr, const char* qrl) {
    p0 = f32x16{}; p1 = f32x16{};
    const char* kb[4];
#pragma unroll
    for (int dd = 0; dd < 4; ++dd) kb[dd] = K_lds + KB * SHM_K + KSWZ(r32, (dd * 16 + hi * 8) * 2);
#pragma unroll
    for (int d0 = 0; d0 < 12; ++d0) { const char* a = kb[d0 & 3] + (d0 >> 2) * 128;
        bf16x8 b0 = *reinterpret_cast<const bf16x8*>(a);
        bf16x8 b1 = *reinterpret_cast<const bf16x8*>(a + 32 * 384);
        bf16x8 qf; if (d0 < 8) qf = qr[d0]; else qf = *reinterpret_cast<const bf16x8*>(qrl + (d0 - 8) * 1024);
        p0 = __builtin_amdgcn_mfma_f32_32x32x16_bf16(b0, qf, p0, 0, 0, 0);
        p1 = __builtin_amdgcn_mfma_f32_32x32x16_bf16(b1, qf, p1, 0, 0, 0);
    }
}
template <int VB>
__device__ __forceinline__ void pv_tile(f32x16* o, int vb0, bf16x8 pa0, bf16x8 pa1, bf16x8 pa2, bf16x8 pa3) {
#define TRRD(dst, off) asm volatile("ds_read_b64_tr_b16 %0, %1 offset:%2" : "=&v"(dst) : "v"(vb0), "i"(off) : "memory")
#define PV_D0(d0) do { s16x4 l0, l1, l2, l3, h0, h1, h2, h3; constexpr int b_ = VB * SHM_V + v_rd_off(d0, 0, 0); \
        TRRD(l0, b_); TRRD(h0, b_ + 2048); TRRD(l1, b_ + 4096); TRRD(h1, b_ + 6144); TRRD(l2, b_ + 8192); TRRD(h2, b_ + 10240); TRRD(l3, b_ + 12288); TRRD(h3, b_ + 14336); \
        asm volatile("s_waitcnt lgkmcnt(0)" ::: "memory"); SBAR();   \
        o[d0] = __builtin_amdgcn_mfma_f32_32x32x16_bf16(pa0, (bf16x8){l0[0], l0[1], l0[2], l0[3], h0[0], h0[1], h0[2], h0[3]}, o[d0], 0, 0, 0);   \
        o[d0] = __builtin_amdgcn_mfma_f32_32x32x16_bf16(pa1, (bf16x8){l1[0], l1[1], l1[2], l1[3], h1[0], h1[1], h1[2], h1[3]}, o[d0], 0, 0, 0);   \
        o[d0] = __builtin_amdgcn_mfma_f32_32x32x16_bf16(pa2, (bf16x8){l2[0], l2[1], l2[2], l2[3], h2[0], h2[1], h2[2], h2[3]}, o[d0], 0, 0, 0);   \
        o[d0] = __builtin_amdgcn_mfma_f32_32x32x16_bf16(pa3, (bf16x8){l3[0], l3[1], l3[2], l3[3], h3[0], h3[1], h3[2], h3[3]}, o[d0], 0, 0, 0); } while (0)
    PV_D0(0); PV_D0(1); PV_D0(2); PV_D0(3);
#undef PV_D0
#undef TRRD
}

struct BlockRef { const bf16_t* Q; const bf16_t* K; const bf16_t* KR; const bf16_t* V; bf16_t* O; const bf16_t* Z; const float* CS; const float* SN; int P0; };
struct Stage { bf16x8 st_v0, st_v1, st_k0, st_k1, st_kr; };
#define VMW() asm volatile("s_waitcnt vmcnt(0)" ::: "memory")
#define SLOAD_H(R, k0) do { const char* kt_ = (const char*)(R).K + (size_t)(k0) * (KVS * 2); const char* kt2_ = kt_ + 32 * KVS * 2; const char* krt_ = (const char*)(R).KR + (size_t)(k0) * (KRS * 2); \
                            S.st_v0 = *(const bf16x8*)(kt_ + koff + 256); S.st_v1 = *(const bf16x8*)(kt2_ + koff + 256);  \
                            S.st_k0 = *(const bf16x8*)(kt_ + koff); S.st_k1 = *(const bf16x8*)(kt2_ + koff);  \
                            S.st_kr = *(const bf16x8*)(krt_ + kroff); } while (0)
#define SWRITE_HK(bf) do { *(bf16x8*)(K_lds + (bf) * SHM_K + kws) = S.st_k0; *(bf16x8*)(K_lds + (bf) * SHM_K + kws + 32 * 384) = S.st_k1; \
                           *(bf16x8*)(K_lds + (bf) * SHM_K + kwr) = S.st_kr; } while (0)
#define SWRITE_HV(bf) do { *(bf16x8*)(V_lds + (bf) * SHM_V + vst0) = S.st_v0; *(bf16x8*)(V_lds + (bf) * SHM_V + vst1) = S.st_v1; } while (0)
#define SWRITE_H(bf) do { SWRITE_HV(bf); SWRITE_HK(bf); } while (0)

__device__ __forceinline__ void rope_q(const BlockRef& cur, const bf16x8* qrp, char* qrl, int wid, int r32, int hi) {
    const int row = wid * QBLK + r32;
    const unsigned toff = (unsigned)((row * 32 + hi * 8) * 4);
    const float* cp = (const float*)((const char*)cur.CS + toff); const float* sp = (const float*)((const char*)cur.SN + toff);
#pragma unroll
    for (int pr = 0; pr < 2; ++pr) {
        const f32x4 c0 = *(const f32x4*)(cp + pr * 16), c1 = *(const f32x4*)(cp + pr * 16 + 4), s0 = *(const f32x4*)(sp + pr * 16), s1 = *(const f32x4*)(sp + pr * 16 + 4);
        const bf16x8 a = qrp[pr], b = qrp[2 + pr];
        f32x4 o1l, o1h, o2l, o2h;
#pragma unroll
        for (int j = 0; j < 4; ++j) {
            float t1 = bf2f((unsigned short)a[j]), t2 = bf2f((unsigned short)b[j]);
            o1l[j] = t1 * c0[j] - t2 * s0[j]; o2l[j] = t2 * c0[j] + t1 * s0[j];
            t1 = bf2f((unsigned short)a[4 + j]); t2 = bf2f((unsigned short)b[4 + j]);
            o1h[j] = t1 * c1[j] - t2 * s1[j]; o2h[j] = t2 * c1[j] + t1 * s1[j];
        }
        *(bf16x8*)(qrl + pr * 1024) = pack8(o1l, o1h); *(bf16x8*)(qrl + (2 + pr) * 1024) = pack8(o2l, o2h);
    }
}
__device__ __forceinline__ void causal_block(const BlockRef& cur, char* lds) {
    int tid = threadIdx.x; asm volatile("" : "+v"(tid));
    const int wid = __builtin_amdgcn_readfirstlane(tid >> 6), lane = tid & 63, r32 = lane & 31, hi = lane >> 5;
    const int NT = (cur.P0 + QB - 1) / KVBLK + 1;
    const int qlo = cur.P0 + wid * QBLK, qm = qlo + r32 - 4 * hi;
    char* V_lds = lds; char* K_lds = lds + 2 * SHM_V;
    float* ws = (float*)(lds + 2 * SHM_V + 2 * SHM_K) + wid * 64; float* li_l = ws, * al_l = ws + 32;
    float m_reg = -1e30f, l_reg = 0; f32x16 o[4] = {};
    const int sr = tid >> 4, sc = (tid & 15) * 8, vst0 = v_st(sr, sc), vst1 = v_st(32 + sr, sc), kws = KSWZ(sr, sc * 2);
    const int krr = tid >> 3, krc = (tid & 7) * 8, kwr = KSWZ(krr, (128 + krc) * 2);
    const int vb0 = (int)(uintptr_t)V_lds + v_rd_base(lane);
    unsigned koff = (unsigned)((sr * KVS + sc) * 2), kroff = (unsigned)((krr * KRS + krc) * 2);
    unsigned qoff = (unsigned)(((wid * QBLK + r32) * QS + hi * 8) * 2);
    asm volatile("" : "+v"(koff), "+v"(kroff), "+v"(qoff));
    Stage S; bf16x8 qr[8]; char* qrl = lds + QR_OFF + wid * 4096 + lane * 16;
    { bf16x8 qrp[4];
#pragma unroll
      for (int d0 = 0; d0 < 8; ++d0) qr[d0] = *(const bf16x8*)((const char*)cur.Q + qoff + d0 * 32);
#pragma unroll
      for (int d0 = 0; d0 < 4; ++d0) qrp[d0] = *(const bf16x8*)((const char*)cur.Q + qoff + (8 + d0) * 32);
      SLOAD_H(cur, 0);
      rope_q(cur, qrp, qrl, wid, r32, hi); }
    VMW(); SWRITE_H(0); SBAR();
    SLOAD_H(cur, KVBLK); SBAR();
    __syncthreads();
#define RESC(a) do { if (__any((a) < 1.f)) { if (hi == 0) al_l[r32] = (a); asm volatile("s_waitcnt lgkmcnt(0)" ::: "memory");              \
                     for (int d_ = 0; d_ < 4; ++d_) for (int r = 0; r < 16; ++r) o[d_][r] *= al_l[crow(r, hi)]; } } while (0)
#define KBASE(t) ((t) * KVBLK)
#define MASKT(P0_, P1_, t) do { const int kb_ = KBASE(t); if (kb_ + KVBLK - 1 > qlo) mask_tile(P0_, P1_, qm - kb_); } while (0)
    f32x16 pA0, pA1, pB0, pB1; float mnA, mnB, alA, alB; bf16x8 pa0, pa1, pa2, pa3;
    qkt<0>(pA0, pA1, K_lds, r32, hi, qr, qrl);
    MASKT(pA0, pA1, 0); partialSM(pA0, pA1, m_reg, mnA, alA);
    VMW(); SWRITE_H(1);
    __syncthreads();
#define HALF_STEP(PX0, PX1, mnX, alX, PY0, PY1, alY, t, KB, VB, SB) do {                                                      \
        SBAR(); qkt<KB>(PX0, PX1, K_lds, r32, hi, qr, qrl);                                                                        \
        finishSM(PY0, PY1, alY, l_reg, pa0, pa1, pa2, pa3); SBAR();                                                           \
        if ((t) + 1 < NT) { SLOAD_H(cur, KBASE((t) + 1)); SBAR(); }                                                           \
        pv_tile<VB>(o, vb0, pa0, pa1, pa2, pa3); MASKT(PX0, PX1, (t)); partialSM(PX0, PX1, m_reg, mnX, alX);                  \
        __syncthreads();                                                                                                      \
        if ((t) + 1 < NT) { VMW(); SWRITE_H(SB); }                                                                            \
        RESC(alX); __syncthreads(); } while (0)
    for (int t = 1; t + 1 < NT; t += 2) {
        HALF_STEP(pB0, pB1, mnB, alB, pA0, pA1, alA, t, 1, 0, 0);
        HALF_STEP(pA0, pA1, mnA, alA, pB0, pB1, alB, t + 1, 0, 1, 1);
    }
    SBAR(); qkt<1>(pB0, pB1, K_lds, r32, hi, qr, qrl); SBAR();
    finishSM(pA0, pA1, alA, l_reg, pa0, pa1, pa2, pa3); SBAR();
    pv_tile<0>(o, vb0, pa0, pa1, pa2, pa3);
    MASKT(pB0, pB1, NT - 1); partialSM(pB0, pB1, m_reg, mnB, alB); __syncthreads(); RESC(alB);
    finishSM(pB0, pB1, alB, l_reg, pa0, pa1, pa2, pa3); SBAR(); pv_tile<1>(o, vb0, pa0, pa1, pa2, pa3);
    SBAR();
    if (hi == 0) li_l[r32] = l_reg;
    __syncthreads();
    {
        char* ot = lds + wid * (32 * 272);
        const int wb = 4 * hi * 272 + r32 * 2;
#pragma unroll
        for (int rg = 0; rg < 4; ++rg) {
            const f32x4 lv = *(const f32x4*)(li_l + 8 * rg + 4 * hi);
#pragma unroll
            for (int j = 0; j < 4; ++j) { const int r = rg * 4 + j; const float rl = __builtin_amdgcn_rcpf(lv[j]);
#pragma unroll
                for (int d0 = 0; d0 < 4; ++d0) *(bf16_t*)(ot + wb + (j + 8 * rg) * 272 + d0 * 64) = f2bf(o[d0][r] * rl); }
        }
        asm volatile("s_waitcnt lgkmcnt(0)" ::: "memory");
        const int rr = lane >> 4, c8 = (lane & 15) * 8;
        const unsigned zoff = (unsigned)(((wid * QBLK + rr) * ZS + c8) * 2), ooff = (unsigned)(((wid * QBLK + rr) * OS + c8) * 2);
#pragma unroll
        for (int i = 0; i < 8; ++i) {
            const bf16x8 ov = *(const bf16x8*)(ot + (i * 4 + rr) * 272 + c8 * 2);
            const bf16x8 zv = *(const bf16x8*)((const char*)cur.Z + (size_t)(i * 4 * ZS * 2) + zoff);
            f32x4 a, b;
#pragma unroll
            for (int j = 0; j < 4; ++j) { a[j] = bf2f((unsigned short)ov[j]) * bf2f((unsigned short)zv[j]); b[j] = bf2f((unsigned short)ov[4 + j]) * bf2f((unsigned short)zv[4 + j]); }
            *(bf16x8*)((char*)cur.O + (size_t)(i * 4 * OS * 2) + ooff) = pack8(a, b);
        }
    }
    __syncthreads();
#undef RESC
#undef KBASE
#undef MASKT
#undef HALF_STEP
}
#undef VMW
#undef SLOAD_H
#undef SWRITE_HK
#undef SWRITE_HV
#undef SWRITE_H

struct Item { int bh, qb0, qb1; };
constexpr int NQB = SEQ / QB, NX = NQB / 2, NBH = 64, TOTAL = NX * NBH;
__device__ __forceinline__ Item decode(int L) {
    Item it; const int xcd = L & 7, k = L >> 3, gi = k / NX, r = k - gi * NX;
    it.bh = gi * 8 + xcd; it.qb0 = r; it.qb1 = NQB - 1 - r; return it;
}
struct Tensors { const bf16_t* q; const bf16_t* kv; const bf16_t* krot; bf16_t* og; const bf16_t* proj0; const float* cs; const float* sn; };
__device__ __forceinline__ BlockRef mkref(const Item& it, int pass, const Tensors& T) {
    const int qb = pass ? it.qb1 : it.qb0, b = it.bh >> 5, h = it.bh & 31;
    const size_t tok0 = (size_t)b * SEQ, row0 = tok0 + (size_t)qb * QB;
    BlockRef r;
    r.Q = T.q + row0 * QS + h * DQ; r.K = T.kv + tok0 * KVS + h * 256; r.V = r.K + 128; r.KR = T.krot + tok0 * KRS;
    r.O = T.og + row0 * OS + h * DV; r.Z = T.proj0 + row0 * ZS + 1600 + h * DV; r.CS = T.cs + row0 * 32; r.SN = T.sn + row0 * 32; r.P0 = qb * QB;
    return r;
}
__device__ __forceinline__ void attn_phase(char* lds, const Tensors& T) {
#ifndef PROBE_ATTDUP
#define PROBE_ATTDUP 0
#endif
    for (int i = 0; ; ++i) {
        const int L = blockIdx.x + (i >> PROBE_ATTDUP) * gridDim.x; if (L >= TOTAL) break;
        const Item it = decode(L);
#pragma unroll 1
        for (int pass = 0; pass < 2; ++pass) { const BlockRef cur = mkref(it, pass, T); causal_block(cur, lds); }
    }
}
}
__device__ __forceinline__ void wt_phase(const float* __restrict__ W, int K, int N, const float* __restrict__ scale, bf16_t* __restrict__ out, char* lds) {
    int tid = threadIdx.x; asm volatile("" : "+v"(tid));
    const int lane = tid & 63, wv = tid >> 6, gw = blockIdx.x * 8 + wv, nw = gridDim.x * 8;
    char* img = lds + wv * 8192;
    const int kr = lane >> 4, nq = lane & 15, ntn = N / 64, ntiles = ntn * (K / 64);
    for (int t = gw; t < ntiles; t += nw) {
        const int kb = (t / ntn) * 64, nb = (t % ntn) * 64;
        const float* src = W + (size_t)(kb + kr * 16) * N + nb + nq * 4;
        f32x4 v[16];
#pragma unroll
        for (int i = 0; i < 16; ++i) v[i] = *(const f32x4*)(src + (size_t)i * N);
        if (scale) {
            const float* sp = scale + kb + kr * 16;
#pragma unroll
            for (int i = 0; i < 16; i += 4) { const f32x4 sc = *(const f32x4*)(sp + i); v[i] *= sc[0]; v[i + 1] *= sc[1]; v[i + 2] *= sc[2]; v[i + 3] *= sc[3]; }
        }
#pragma unroll
        for (int j = 0; j < 4; ++j) {
            const int n = nq * 4 + j;
#pragma unroll
            for (int hf = 0; hf < 2; ++hf) {
                const f32x4 a = {v[hf * 8 + 0][j], v[hf * 8 + 1][j], v[hf * 8 + 2][j], v[hf * 8 + 3][j]}, b = {v[hf * 8 + 4][j], v[hf * 8 + 5][j], v[hf * 8 + 6][j], v[hf * 8 + 7][j]};
                *(bf16x8*)(img + n * 128 + (((kr * 2 + hf) ^ (nq & 7)) * 16)) = pack8(a, b);
            }
        }
#pragma unroll
        for (int i = 0; i < 8; ++i) {
            const int n = i * 8 + (lane >> 3), kc = lane & 7;
            const bf16x8 r = *(const bf16x8*)(img + n * 128 + ((kc ^ ((n >> 2) & 7)) * 16));
            *(bf16x8*)(out + (size_t)(nb + n) * K + kb + kc * 8) = r;
        }
    }
}
__device__ __forceinline__ void cast_rstd_phase(const float* __restrict__ src, bf16_t* __restrict__ dst, float* __restrict__ rstd) {
    const int lane = threadIdx.x & 63, gw = blockIdx.x * 8 + (threadIdx.x >> 6), nw = gridDim.x * 8;
    for (int row = gw; row < T_TOK; row += nw) {
        const float* s = src + (size_t)row * DM; bf16_t* d = dst + (size_t)row * DM; float ss = 0.f;
#pragma unroll
        for (int i = 0; i < 8; ++i) { const int c = (i * 64 + lane) * 8; const f32x4 a = *(const f32x4*)(s + c), b = *(const f32x4*)(s + c + 4);
            ss += a[0] * a[0] + a[1] * a[1] + a[2] * a[2] + a[3] * a[3] + b[0] * b[0] + b[1] * b[1] + b[2] * b[2] + b[3] * b[3];
            *(bf16x8*)(d + c) = pack8(a, b); }
        ss = wave_sum(ss);
        if (lane == 0) rstd[row] = 1.0f / sqrtf(ss * (1.0f / DM) + EPS);
    }
}
__device__ __forceinline__ void final_norm_phase(const float* __restrict__ src, size_t lds_, float* __restrict__ dst, const float* __restrict__ w) {
    const int lane = threadIdx.x & 63, gw = blockIdx.x * 8 + (threadIdx.x >> 6), nw = gridDim.x * 8;
    for (int row = gw; row < T_TOK; row += nw) {
        const float* s = src + (size_t)row * lds_; float* d = dst + (size_t)row * DM; f32x4 v[16]; float ss = 0.f;
#pragma unroll
        for (int i = 0; i < 16; ++i) { v[i] = *(const f32x4*)(s + (i * 64 + lane) * 4); ss += v[i][0] * v[i][0] + v[i][1] * v[i][1] + v[i][2] * v[i][2] + v[i][3] * v[i][3]; }
        ss = wave_sum(ss);
        const float r = 1.0f / sqrtf(ss * (1.0f / DM) + EPS);
#pragma unroll
        for (int i = 0; i < 16; ++i) { const f32x4 g = *(const f32x4*)(w + (i * 64 + lane) * 4); *(f32x4*)(d + (i * 64 + lane) * 4) = v[i] * r * g; }
    }
}
__device__ __forceinline__ void tables_phase(const Params& p, float* cs, float* sn, float* lb) {
    const int gt = blockIdx.x * blockDim.x + threadIdx.x, nt = gridDim.x * blockDim.x;
    for (int i = gt; i < T_TOK * 32; i += nt) {
        const int tok = i >> 5, j = i & 31;
        const float ang = (float)p.pos[tok] * p.inv_freq[j];
        const double rev = (double)ang * 0.15915494309189535; const float fr = (float)(rev - rint(rev));
        cs[i] = __builtin_amdgcn_cosf(fr); sn[i] = __builtin_amdgcn_sinf(fr);
    }
    for (int i = gt; i < 4096; i += nt) { const float l0 = p.lower_bounds[i], l1 = p.lower_bounds[4096 + i]; lb[i] = 1.0f / (1.0f + expf(l0 - l1)); }
}
__device__ __forceinline__ void stats_krot_phase(const bf16_t* __restrict__ proj0, float* __restrict__ rq, float* __restrict__ rkv, const float* __restrict__ cs, const float* __restrict__ sn, bf16_t* __restrict__ krot) {
    const int lane = threadIdx.x & 63, gw = blockIdx.x * 8 + (threadIdx.x >> 6), nw = gridDim.x * 8;
    for (int row = gw; row < T_TOK; row += nw) {
        const bf16_t* s = proj0 + (size_t)row * N0P;
        const bf16x8 a = *(const bf16x8*)(s + lane * 8), b = *(const bf16x8*)(s + 512 + lane * 8), c = *(const bf16x8*)(s + 1024 + lane * 8);
        float sq = 0.f, sk = 0.f;
#pragma unroll
        for (int j = 0; j < 8; ++j) { const float x = bf2f((unsigned short)a[j]), y = bf2f((unsigned short)b[j]), z = bf2f((unsigned short)c[j]); sq += x * x + y * y; sk += z * z; }
        sq = wave_sum(sq); sk = wave_sum(sk);
        if (lane == 0) { rq[row] = 1.0f / sqrtf(sq * (1.0f / 1024.0f) + EPS); rkv[row] = 1.0f / sqrtf(sk * (1.0f / 512.0f) + EPS); }
        if (lane < 32) { const float t1 = bf2f(s[1536 + lane]), t2 = bf2f(s[1568 + lane]); const float cc = cs[(size_t)row * 32 + lane], sv = sn[(size_t)row * 32 + lane];
            krot[(size_t)row * 64 + lane] = f2bf(t1 * cc - t2 * sv); krot[(size_t)row * 64 + 32 + lane] = f2bf(t2 * cc + t1 * sv); }
    }
}
__device__ __forceinline__ void headnorm_phase(bf16_t* __restrict__ proj1, const bf16_t* __restrict__ oraw, const float* __restrict__ gn) {
    int tid = threadIdx.x; asm volatile("" : "+v"(tid));
    const int per = T_TOK / gridDim.x;
    const int h = tid >> 4, vs = (tid & 15) >> 2, c8 = (tid & 3) * 8;
    const int v0 = (tid & 15) * 8; const f32x4 g0 = *(const f32x4*)(gn + v0), g1 = *(const f32x4*)(gn + v0 + 4);
    for (int tok0 = blockIdx.x * per; tok0 < (blockIdx.x + 1) * per; tok0 += 4) {
        bf16x8 o[4], z[4];
#pragma unroll
        for (int u = 0; u < 4; ++u) { const int tok = tok0 + u, b = tok >> 13, sq = tok & (SEQ - 1);
            o[u] = *(const bf16x8*)(oraw + ((size_t)((b * 32 + h) * 4 + vs) * SEQ + sq) * 32 + c8); z[u] = *(const bf16x8*)(proj1 + (size_t)tok * N1 + 12288 + tid * 8); }
#pragma unroll
        for (int u = 0; u < 4; ++u) {
            float f[8], ss = 0.f;
#pragma unroll
            for (int j = 0; j < 8; ++j) { f[j] = bf2f((unsigned short)o[u][j]); ss += f[j] * f[j]; }
            ss += __shfl_xor(ss, 1); ss += __shfl_xor(ss, 2); ss += __shfl_xor(ss, 4); ss += __shfl_xor(ss, 8);
            const float r = 1.0f / sqrtf(ss * (1.0f / 128.0f) + EPS);
            f32x4 a, bb;
#pragma unroll
            for (int j = 0; j < 4; ++j) { a[j] = f[j] * r * g0[j] * bf2f((unsigned short)z[u][j]); bb[j] = f[4 + j] * r * g1[j] * bf2f((unsigned short)z[u][4 + j]); }
            *(bf16x8*)(proj1 + (size_t)(tok0 + u) * N1 + 8192 + tid * 8) = pack8(a, bb);
        }
    }
}

namespace hg {
constexpr int QT_S = 272, KD_S = 144;
constexpr int OFF_QT = 0, OFF_KT = OFF_QT + 64 * QT_S, OFF_QB = OFF_KT + 64 * QT_S, OFF_KD = OFF_QB + 64 * QT_S;
constexpr int OFF_VT = OFF_KD + 128 * KD_S, OFF_ST = OFF_VT + 32 * KD_S, OFF_ATT = OFF_ST + 32 * QT_S;
constexpr int OFF_SEG = OFF_ATT + 64 * KD_S, OFF_G32 = OFF_SEG + 2048, OFF_DEC = OFF_G32 + 512, LDS_BYTES = OFF_DEC + 512;
__device__ __forceinline__ int crow(int r, int hi) { return (r & 3) + 8 * (r >> 2) + 4 * hi; }

__device__ __forceinline__ void hgrn2_phase(char* lds, const bf16_t* __restrict__ proj1, bf16_t* __restrict__ oraw) {
    int tid = threadIdx.x; asm volatile("" : "+v"(tid));
    const int wid = __builtin_amdgcn_readfirstlane(tid >> 6), lane = tid & 63, r32 = lane & 31, hi = lane >> 5;
    const int kch = tid & 127, seg = tid >> 7;
    float* segtot = (float*)(lds + OFF_SEG); float* g32s = (float*)(lds + OFF_G32); float* decay = (float*)(lds + OFF_DEC);
    for (int item = blockIdx.x; item < 256; item += gridDim.x) {
        const int vs = item & 3, bh = item >> 2, b = bh >> 5, h = bh & 31;
        const bf16_t* base = proj1 + (size_t)b * SEQ * N1; bf16_t* ob = oraw + (size_t)item * SEQ * 32;
        const int qcol = h * 128 + kch, gcol = 4096 + h * 128 + kch, vcol = 8192 + h * 128 + vs * 32;
        f32x16 sacc = {};
        for (int i = tid; i < 32 * QT_S / 4; i += 512) ((unsigned*)(lds + OFF_ST))[i] = 0u;
        unsigned short graw[16], qraw[16]; u32x2 vraw;
        { const bf16_t* rp = base + (size_t)(seg * 16) * N1;
#pragma unroll
          for (int i = 0; i < 16; ++i) { graw[i] = rp[(size_t)i * N1 + gcol]; qraw[i] = rp[(size_t)i * N1 + qcol]; }
          vraw = *(const u32x2*)(base + (size_t)(tid >> 3) * N1 + vcol + (tid & 7) * 4); }
        for (int ch = 0; ch < 128; ++ch) {
            const int tok0 = ch * 64;
            float gl[16]; float cum = 0.f;
#pragma unroll
            for (int i = 0; i < 16; ++i) { cum += bf2f(graw[i]); gl[i] = cum; }
            segtot[seg * 128 + kch] = cum; if (seg == 2) g32s[kch] = bf2f(graw[0]);
            __syncthreads();
            { const float s0 = segtot[kch], s1 = segtot[128 + kch], s2 = segtot[256 + kch], s3 = segtot[384 + kch];
              const float off = (seg > 0 ? s0 : 0.f) + (seg > 1 ? s1 : 0.f) + (seg > 2 ? s2 : 0.f);
              const float tot = (s0 + s1) + (s2 + s3), bref = s0 + s1 + g32s[kch];
              if (seg == 0) decay[kch] = fast_exp(tot);
              float kd[16];
#pragma unroll
              for (int i = 0; i < 16; ++i) { const int t = seg * 16 + i; const float bb = off + gl[i], gv = bf2f(graw[i]), qv = bf2f(qraw[i]); const float kk = 1.0f - fast_exp(gv);
                  *(bf16_t*)(lds + OFF_QT + t * QT_S + kch * 2) = f2bf_n(qv * fast_exp(bb - bref));
                  *(bf16_t*)(lds + OFF_KT + t * QT_S + kch * 2) = f2bf_n(kk * fast_exp(bref - bb));
                  *(bf16_t*)(lds + OFF_QB + t * QT_S + kch * 2) = f2bf_n(qv * fast_exp(bb));
                  kd[i] = kk * fast_exp(tot - bb); }
              *(bf16x8*)(lds + OFF_KD + kch * KD_S + seg * 32) = pack8((f32x4){kd[0], kd[1], kd[2], kd[3]}, (f32x4){kd[4], kd[5], kd[6], kd[7]});
              *(bf16x8*)(lds + OFF_KD + kch * KD_S + seg * 32 + 16) = pack8((f32x4){kd[8], kd[9], kd[10], kd[11]}, (f32x4){kd[12], kd[13], kd[14], kd[15]});
              { const int t = tid >> 3, v4 = (tid & 7) * 4;
                *(bf16_t*)(lds + OFF_VT + (v4 + 0) * KD_S + t * 2) = (bf16_t)(vraw.x & 0xffffu); *(bf16_t*)(lds + OFF_VT + (v4 + 1) * KD_S + t * 2) = (bf16_t)(vraw.x >> 16);
                *(bf16_t*)(lds + OFF_VT + (v4 + 2) * KD_S + t * 2) = (bf16_t)(vraw.y & 0xffffu); *(bf16_t*)(lds + OFF_VT + (v4 + 3) * KD_S + t * 2) = (bf16_t)(vraw.y >> 16); }
            }
            if (ch + 1 < 128) { const bf16_t* rp = base + (size_t)(tok0 + 64 + seg * 16) * N1;
#pragma unroll
                for (int i = 0; i < 16; ++i) { graw[i] = rp[(size_t)i * N1 + gcol]; qraw[i] = rp[(size_t)i * N1 + qcol]; }
                vraw = *(const u32x2*)(base + (size_t)(tok0 + 64 + (tid >> 3)) * N1 + vcol + (tid & 7) * 4); }
            __syncthreads();
            f32x16 oacc = {};
            if (wid < 4) {
                const int ci = wid >> 1, si = wid & 1;
                if (!(ci == 0 && si == 1)) {
                    f32x16 aacc = {};
#pragma unroll
                    for (int kk = 0; kk < 8; ++kk) {
                        const bf16x8 af = *(const bf16x8*)(lds + OFF_QT + (32 * ci + r32) * QT_S + kk * 32 + hi * 16);
                        const bf16x8 bfr = *(const bf16x8*)(lds + OFF_KT + (32 * si + r32) * QT_S + kk * 32 + hi * 16);
                        aacc = __builtin_amdgcn_mfma_f32_32x32x16_bf16(af, bfr, aacc, 0, 0, 0); }
#pragma unroll
                    for (int i = 0; i < 16; ++i) { const int c = 32 * ci + crow(i, hi), s = 32 * si + r32; const float v = (c >= s) ? aacc[i] : 0.f;
                        *(bf16_t*)(lds + OFF_ATT + c * KD_S + s * 2) = f2bf_n(v); }
                } else {
#pragma unroll
                    for (int i = 0; i < 16; ++i) { const int c = crow(i, hi), s = 32 + r32; *(bf16_t*)(lds + OFF_ATT + c * KD_S + s * 2) = (bf16_t)0; }
                }
#pragma unroll
                for (int g4 = 0; g4 < 4; ++g4) { const f32x4 d = *(const f32x4*)(decay + 32 * wid + 8 * g4 + 4 * hi);
#pragma unroll
                    for (int j = 0; j < 4; ++j) sacc[g4 * 4 + j] *= d[j]; }
#pragma unroll
                for (int kk = 0; kk < 4; ++kk) {
                    const bf16x8 af = *(const bf16x8*)(lds + OFF_KD + (32 * wid + r32) * KD_S + kk * 32 + hi * 16);
                    const bf16x8 bfr = *(const bf16x8*)(lds + OFF_VT + r32 * KD_S + kk * 32 + hi * 16);
                    sacc = __builtin_amdgcn_mfma_f32_32x32x16_bf16(af, bfr, sacc, 0, 0, 0); }
            } else if (wid < 6) {
                const int ci = wid - 4;
#pragma unroll
                for (int kk = 0; kk < 8; ++kk) {
                    const bf16x8 af = *(const bf16x8*)(lds + OFF_QB + (32 * ci + r32) * QT_S + kk * 32 + hi * 16);
                    const bf16x8 bfr = *(const bf16x8*)(lds + OFF_ST + r32 * QT_S + kk * 32 + hi * 16);
                    oacc = __builtin_amdgcn_mfma_f32_32x32x16_bf16(af, bfr, oacc, 0, 0, 0); }
            }
            __syncthreads();
            if (wid < 4) {
#pragma unroll
                for (int g4 = 0; g4 < 4; ++g4) { u32x2 w; w.x = cvtpk_n(sacc[g4 * 4 + 0], sacc[g4 * 4 + 1]); w.y = cvtpk_n(sacc[g4 * 4 + 2], sacc[g4 * 4 + 3]);
                    *(u32x2*)(lds + OFF_ST + r32 * QT_S + (32 * wid + 8 * g4 + 4 * hi) * 2) = w; }
            } else if (wid < 6) {
                const int ci = wid - 4;
#pragma unroll
                for (int kk = 0; kk < 4; ++kk) {
                    const bf16x8 af = *(const bf16x8*)(lds + OFF_ATT + (32 * ci + r32) * KD_S + kk * 32 + hi * 16);
                    const bf16x8 bfr = *(const bf16x8*)(lds + OFF_VT + r32 * KD_S + kk * 32 + hi * 16);
                    oacc = __builtin_amdgcn_mfma_f32_32x32x16_bf16(af, bfr, oacc, 0, 0, 0); }
#pragma unroll
                for (int i = 0; i < 16; ++i) { const int c = 32 * ci + crow(i, hi); ob[(size_t)(tok0 + c) * 32 + r32] = f2bf_n(oacc[i]); }
            }
        }
        __syncthreads();
    }
}
}
namespace hg2 {
#define LBAR() do { asm volatile("s_waitcnt lgkmcnt(0)" ::: "memory"); __builtin_amdgcn_s_barrier(); asm volatile("" ::: "memory"); } while (0)
constexpr int QT_S = 272, KD_S = 144;
constexpr int OFF_QT = 0, OFF_KT = OFF_QT + 64 * QT_S, OFF_QB = OFF_KT + 64 * QT_S, OFF_KD = OFF_QB + 64 * QT_S;
constexpr int OFF_VT4 = OFF_KD + 128 * KD_S, OFF_ATT = OFF_VT4 + 128 * KD_S;
constexpr int OFF_SEG = OFF_ATT + 64 * KD_S, OFF_G32 = OFF_SEG + 2048, OFF_DEC = OFF_G32 + 512, LDS_BYTES = OFF_DEC + 512;
constexpr int ST_BYTES = 32 * QT_S;
__device__ __forceinline__ int crow(int r, int hi) { return (r & 3) + 8 * (r >> 2) + 4 * hi; }

__device__ __forceinline__ void prepass(char* lds, bf16_t* __restrict__ proj1, char* __restrict__ attbuf, float* __restrict__ decbuf) {
    int tid = threadIdx.x; asm volatile("" : "+v"(tid));
    const int wid = __builtin_amdgcn_readfirstlane(tid >> 6), lane = tid & 63, r32 = lane & 31, hi = lane >> 5;
    const int kch = tid & 127, seg = tid >> 7;
    float* segtot = (float*)(lds + OFF_SEG); float* g32s = (float*)(lds + OFF_G32); float* decay = (float*)(lds + OFF_DEC);
    unsigned short graw[16], qraw[16]; bf16x8 vr0, vr1;
#define PRE_LOAD(it_) do { const int bh_ = (it_) >> 7, ch_ = (it_) & 127, b_ = bh_ >> 5, h_ = bh_ & 31;                                   \
        const bf16_t* bs_ = proj1 + ((size_t)b_ * SEQ + ch_ * 64) * N1; const bf16_t* rp_ = bs_ + (size_t)(seg * 16) * N1 + h_ * 128 + kch; \
        _Pragma("unroll") for (int i = 0; i < 16; ++i) { graw[i] = rp_[(size_t)i * N1 + 4096]; qraw[i] = rp_[(size_t)i * N1]; }                \
        const bf16_t* vp_ = bs_ + (size_t)(tid & 63) * N1 + 8192 + h_ * 128 + (tid >> 6) * 16;                                                \
        vr0 = *(const bf16x8*)vp_; vr1 = *(const bf16x8*)(vp_ + 8); } while (0)
    if (blockIdx.x < 8192) PRE_LOAD(blockIdx.x);
    for (int item = blockIdx.x; item < 8192; item += gridDim.x) {
        const int bh = item >> 7, ch = item & 127, b = bh >> 5, h = bh & 31;
        bf16_t* base = proj1 + ((size_t)b * SEQ + ch * 64) * N1;
        const int qcol = h * 128, gcol = 4096 + h * 128, vcol = 8192 + h * 128;
        float gl[16]; float cum = 0.f;
#pragma unroll
        for (int i = 0; i < 16; ++i) { cum += bf2f(graw[i]); gl[i] = cum; }
        segtot[seg * 128 + kch] = cum; if (seg == 2) g32s[kch] = bf2f(graw[0]);
        LBAR();
        { const float s0 = segtot[kch], s1 = segtot[128 + kch], s2 = segtot[256 + kch], s3 = segtot[384 + kch];
          const float off = (seg > 0 ? s0 : 0.f) + (seg > 1 ? s1 : 0.f) + (seg > 2 ? s2 : 0.f);
          const float tot = (s0 + s1) + (s2 + s3), bref = s0 + s1 + g32s[kch];
          if (seg == 0) decay[kch] = fast_exp(tot);
          float kd[16];
#pragma unroll
          for (int i = 0; i < 16; ++i) { const int t = seg * 16 + i; const float bb = off + gl[i], gv = bf2f(graw[i]), qv = bf2f(qraw[i]); const float kk = 1.0f - fast_exp(gv);
              *(bf16_t*)(lds + OFF_QT + t * QT_S + kch * 2) = f2bf_n(qv * fast_exp(bb - bref));
              *(bf16_t*)(lds + OFF_KT + t * QT_S + kch * 2) = f2bf_n(kk * fast_exp(bref - bb));
              *(bf16_t*)(lds + OFF_QB + t * QT_S + kch * 2) = f2bf_n(qv * fast_exp(bb));
              kd[i] = kk * fast_exp(tot - bb); }
          *(bf16x8*)(lds + OFF_KD + kch * KD_S + seg * 32) = pack8((f32x4){kd[0], kd[1], kd[2], kd[3]}, (f32x4){kd[4], kd[5], kd[6], kd[7]});
          *(bf16x8*)(lds + OFF_KD + kch * KD_S + seg * 32 + 16) = pack8((f32x4){kd[8], kd[9], kd[10], kd[11]}, (f32x4){kd[12], kd[13], kd[14], kd[15]});
          { const int t = tid & 63, v16 = (tid >> 6) * 16;
#pragma unroll
            for (int j = 0; j < 8; ++j) { *(bf16_t*)(lds + OFF_VT4 + (v16 + j) * KD_S + t * 2) = (bf16_t)vr0[j]; *(bf16_t*)(lds + OFF_VT4 + (v16 + 8 + j) * KD_S + t * 2) = (bf16_t)vr1[j]; } }
        }
        if (item + (int)gridDim.x < 8192) PRE_LOAD(item + gridDim.x);
        LBAR();
        if (wid < 4) {
            const int ci = wid >> 1, si = wid & 1;
            if (!(ci == 0 && si == 1)) {
                f32x16 aacc = {};
#pragma unroll
                for (int kk = 0; kk < 8; ++kk) {
                    const bf16x8 af = *(const bf16x8*)(lds + OFF_QT + (32 * ci + r32) * QT_S + kk * 32 + hi * 16);
                    const bf16x8 bfr = *(const bf16x8*)(lds + OFF_KT + (32 * si + r32) * QT_S + kk * 32 + hi * 16);
                    aacc = __builtin_amdgcn_mfma_f32_32x32x16_bf16(af, bfr, aacc, 0, 0, 0); }
#pragma unroll
                for (int i = 0; i < 16; ++i) { const int c = 32 * ci + crow(i, hi), s = 32 * si + r32; const float v = (c >= s) ? aacc[i] : 0.f;
                    *(bf16_t*)(lds + OFF_ATT + c * KD_S + s * 2) = f2bf_n(v); }
            } else {
#pragma unroll
                for (int i = 0; i < 16; ++i) { const int c = crow(i, hi), s = 32 + r32; *(bf16_t*)(lds + OFF_ATT + c * KD_S + s * 2) = (bf16_t)0; }
            }
        }
        LBAR();
        { const size_t lrow = (size_t)(lane >> 4) * N1 + (lane & 15) * 8;
#pragma unroll
          for (int e = 0; e < 2; ++e) { const int f = 2 * wid + e;
              { const int ci = f >> 3, kk = f & 7; const bf16x8 fr = *(const bf16x8*)(lds + OFF_QB + (32 * ci + r32) * QT_S + kk * 32 + hi * 16);
                *(bf16x8*)(base + (size_t)(4 * f) * N1 + qcol + lrow) = fr; }
              { const int kt = f >> 2, kk = f & 3; const bf16x8 fr = *(const bf16x8*)(lds + OFF_KD + (32 * kt + r32) * KD_S + kk * 32 + hi * 16);
                *(bf16x8*)(base + (size_t)(4 * f) * N1 + gcol + lrow) = fr; }
              { const int vs = f >> 2, kk = f & 3; const bf16x8 fr = *(const bf16x8*)(lds + OFF_VT4 + (32 * vs + r32) * KD_S + kk * 32 + hi * 16);
                *(bf16x8*)(base + (size_t)(4 * f) * N1 + vcol + lrow) = fr; } }
          { const int f = wid, ci = f >> 2, kk = f & 3; const bf16x8 fr = *(const bf16x8*)(lds + OFF_ATT + (32 * ci + r32) * KD_S + kk * 32 + hi * 16);
            *(bf16x8*)(attbuf + ((size_t)item * 8 + f) * 1024 + lane * 16) = fr; }
          if (tid < 32) *(f32x4*)(decbuf + (size_t)item * 128 + tid * 4) = *(const f32x4*)(decay + tid * 4);
        }
    }
#undef PRE_LOAD
    LBAR();
}

__device__ __forceinline__ void seqpass(char* lds, const bf16_t* __restrict__ proj1, const char* __restrict__ attbuf, const float* __restrict__ decbuf, bf16_t* __restrict__ oraw) {
    int tid = threadIdx.x; asm volatile("" : "+v"(tid));
    const int wid = __builtin_amdgcn_readfirstlane(tid >> 6), lane = tid & 63, r32 = lane & 31, hi = lane >> 5;
    constexpr int OFF_AV = 2 * ST_BYTES;
#ifndef PROBE_SEQDUP
#define PROBE_SEQDUP 0
#endif
    for (int it2 = blockIdx.x; it2 < (1 + PROBE_SEQDUP) * 256; it2 += gridDim.x) {
        const int w_ = it2 & 255;
        const int bh = (w_ & 7) * 8 + (w_ >> 5), vs = (w_ >> 3) & 3, item = bh * 4 + vs, b = bh >> 5, h = bh & 31;
        const char* base0 = (const char*)(proj1 + (size_t)b * SEQ * N1);
        const unsigned lrow = (unsigned)(((lane >> 4) * N1 + (lane & 15) * 8) * 2);
        constexpr size_t CHB = (size_t)64 * N1 * 2, FRB = (size_t)4 * N1 * 2;
        for (int i = tid; i < 2 * ST_BYTES / 4; i += 512) ((unsigned*)lds)[i] = 0u;
        if (wid < 4) {
            f32x16 sacc = {};
            const char* gb = base0 + (size_t)(4096 + h * 128) * 2 + (size_t)(wid * 4) * FRB;
            const char* vb = base0 + (size_t)(8192 + h * 128) * 2 + (size_t)(vs * 4) * FRB;
            const float* db = decbuf + (size_t)bh * 128 * 128 + 32 * wid + 4 * hi;
            bf16x8 K0[4], V0[4], K1[4], V1[4], K2[4], V2[4]; f32x4 D0[4], D1[4], D2[4];
#define ST_LOAD(K_, V_, d_, ch_) do { _Pragma("unroll") for (int kk = 0; kk < 4; ++kk) { K_[kk] = *(const bf16x8*)(gb + (size_t)(ch_) * CHB + kk * FRB + lrow);  \
                                                                                         V_[kk] = *(const bf16x8*)(vb + (size_t)(ch_) * CHB + kk * FRB + lrow);  \
                                                                                         d_[kk] = *(const f32x4*)(db + (size_t)(ch_) * 128 + 8 * kk); } } while (0)
#define ST_STEP(c_, K_, V_, d_, LK_, LV_, Ld_) do { if ((c_) + 2 < 128) ST_LOAD(LK_, LV_, Ld_, (c_) + 2);                                                      \
                char* st_nxt = lds + (((c_) + 1) & 1) * ST_BYTES;                                                                                                \
                _Pragma("unroll") for (int g4 = 0; g4 < 4; ++g4) _Pragma("unroll") for (int j = 0; j < 4; ++j) sacc[g4 * 4 + j] *= d_[g4][j];                    \
                _Pragma("unroll") for (int kk = 0; kk < 4; ++kk) sacc = __builtin_amdgcn_mfma_f32_32x32x16_bf16(K_[kk], V_[kk], sacc, 0, 0, 0);                  \
                _Pragma("unroll") for (int g4 = 0; g4 < 4; ++g4) { u32x2 w; w.x = cvtpk_n(sacc[g4 * 4 + 0], sacc[g4 * 4 + 1]); w.y = cvtpk_n(sacc[g4 * 4 + 2], sacc[g4 * 4 + 3]); \
                    *(u32x2*)(st_nxt + r32 * QT_S + (32 * wid + 8 * g4 + 4 * hi) * 2) = w; }                                                                    \
                LBAR(); } while (0)
            ST_LOAD(K0, V0, D0, 0); ST_LOAD(K1, V1, D1, 1);
            LBAR();
            for (int ch = 0; ch < 126; ch += 3) { ST_STEP(ch, K0, V0, D0, K2, V2, D2); ST_STEP(ch + 1, K1, V1, D1, K0, V0, D0); ST_STEP(ch + 2, K2, V2, D2, K1, V1, D1); }
            ST_STEP(126, K0, V0, D0, K2, V2, D2); ST_STEP(127, K1, V1, D1, K0, V0, D0);
#undef ST_STEP
#undef ST_LOAD
        } else if (wid < 6) {
            const int ci = wid - 4;
            const char* qb = base0 + (size_t)(h * 128) * 2 + (size_t)(ci * 8) * FRB;
            char* ob = (char*)(oraw + (size_t)item * SEQ * 32) + (size_t)(32 * ci) * 64;
            const unsigned ooff = (unsigned)((4 * hi * 32 + r32) * 2);
            bf16x8 Q0[8], Q1[8], Q2[8];
#define O_LOAD(Q_, ch_) do { _Pragma("unroll") for (int kk = 0; kk < 8; ++kk) Q_[kk] = *(const bf16x8*)(qb + (size_t)(ch_) * CHB + kk * FRB + lrow); } while (0)
#define O_STEP(c_, Q_, LQ_) do { if ((c_) + 2 < 128) O_LOAD(LQ_, (c_) + 2);                                                                                      \
                const char* st_cur = lds + ((c_) & 1) * ST_BYTES; const char* av = lds + OFF_AV + ((((c_) & 1) * 2 + ci) * 4) * 1024 + lane * 16;               \
                f32x16 oacc;                                                                                                                                     \
                _Pragma("unroll") for (int q = 0; q < 4; ++q) { const f32x4 t4 = *(const f32x4*)(av + q * 1024); oacc[q * 4 + 0] = t4[0]; oacc[q * 4 + 1] = t4[1]; oacc[q * 4 + 2] = t4[2]; oacc[q * 4 + 3] = t4[3]; } \
                _Pragma("unroll") for (int kk = 0; kk < 8; ++kk) { const bf16x8 sf = *(const bf16x8*)(st_cur + r32 * QT_S + kk * 32 + hi * 16);                  \
                    oacc = __builtin_amdgcn_mfma_f32_32x32x16_bf16(Q_[kk], sf, oacc, 0, 0, 0); }                                                                \
                char* oc = ob + (size_t)(c_) * (64 * 64);                                                                                                        \
                _Pragma("unroll") for (int i = 0; i < 16; ++i) *(bf16_t*)(oc + ((i & 3) + 8 * (i >> 2)) * 64 + ooff) = f2bf_n(oacc[i]);                          \
                LBAR(); } while (0)
            O_LOAD(Q0, 0); O_LOAD(Q1, 1);
            LBAR();
            for (int ch = 0; ch < 126; ch += 3) { O_STEP(ch, Q0, Q2); O_STEP(ch + 1, Q1, Q0); O_STEP(ch + 2, Q2, Q1); }
            O_STEP(126, Q0, Q2); O_STEP(127, Q1, Q0);
#undef O_STEP
#undef O_LOAD
        } else {
            const int ci = wid - 6;
            const char* vb = base0 + (size_t)(8192 + h * 128) * 2 + (size_t)(vs * 4) * FRB;
            const char* ab = attbuf + ((size_t)bh * 128 * 8 + ci * 4) * 1024 + lane * 16;
            bf16x8 A0[4], V0[4], A1[4], V1[4], A2[4], V2[4];
#define AV_LOAD(A_, V_, ch_) do { _Pragma("unroll") for (int kk = 0; kk < 4; ++kk) { A_[kk] = *(const bf16x8*)(ab + (size_t)(ch_) * 8192 + kk * 1024);          \
                                                                                     V_[kk] = *(const bf16x8*)(vb + (size_t)(ch_) * CHB + kk * FRB + lrow); } } while (0)
#define AV_DO(A_, V_, slot_) do { f32x16 acc_ = {}; _Pragma("unroll") for (int kk = 0; kk < 4; ++kk) acc_ = __builtin_amdgcn_mfma_f32_32x32x16_bf16(A_[kk], V_[kk], acc_, 0, 0, 0); \
        char* av_ = lds + OFF_AV + ((((slot_) & 1) * 2 + ci) * 4) * 1024 + lane * 16;                                                                                   \
        _Pragma("unroll") for (int q = 0; q < 4; ++q) *(f32x4*)(av_ + q * 1024) = (f32x4){acc_[q * 4 + 0], acc_[q * 4 + 1], acc_[q * 4 + 2], acc_[q * 4 + 3]}; } while (0)
            AV_LOAD(A0, V0, 0); AV_LOAD(A1, V1, 1); AV_LOAD(A2, V2, 2);
            AV_DO(A0, V0, 0);
            LBAR();
#define AV_STEP(c_, A_, V_, LA_, LV_) do { if ((c_) + 3 < 128) AV_LOAD(LA_, LV_, (c_) + 3); if ((c_) + 1 < 128) AV_DO(A_, V_, (c_) + 1); LBAR(); } while (0)
            for (int ch = 0; ch < 126; ch += 3) { AV_STEP(ch, A1, V1, A0, V0); AV_STEP(ch + 1, A2, V2, A1, V1); AV_STEP(ch + 2, A0, V0, A2, V2); }
            AV_STEP(126, A1, V1, A0, V0); AV_STEP(127, A2, V2, A1, V1);
#undef AV_STEP
#undef AV_LOAD
#undef AV_DO
        }
    }
}
#undef LBAR
}
constexpr int LDS_TOTAL = pg8::STAGE_BYTES;
static_assert(att::LDS_BYTES <= LDS_TOTAL && hg::LDS_BYTES <= LDS_TOTAL && hg2::LDS_BYTES <= LDS_TOTAL, "lds");
static_assert((size_t)8192 * 8192 + (size_t)8192 * 512 <= WS_W1O, "attbuf/decbuf must fit in the dead weight region");

#ifndef PHMASK
#define PHMASK 0xFFFF
#endif
#define EN(n) (((PHMASK) >> (n)) & 1)
#ifndef SKIP_SEQ
#define SKIP_SEQ 0
#endif
#ifndef SKIP_PRE
#define SKIP_PRE 0
#endif
#ifndef PROBE_DUP7
#define PROBE_DUP7 0
#endif

__global__ void __launch_bounds__(512) mla_hgrn2_fwd(Params p) {
    extern __shared__ __attribute__((aligned(16))) unsigned char lds[];
    cg::grid_group grid = cg::this_grid();
    unsigned char* ws = p.ws;
    bf16_t* W0IN = (bf16_t*)(ws + WS_W0IN); bf16_t* WUQ = (bf16_t*)(ws + WS_WUQ); bf16_t* WUKV = (bf16_t*)(ws + WS_WUKV);
    bf16_t* W0O = (bf16_t*)(ws + WS_W0O); bf16_t* W1IN = (bf16_t*)(ws + WS_W1IN); bf16_t* W1O = (bf16_t*)(ws + WS_W1O);
    float* RSTD0 = (float*)(ws + WS_RSTD0); float* RSTDQ = (float*)(ws + WS_RSTDQ); float* RSTDKV = (float*)(ws + WS_RSTDKV); float* RSTD1 = (float*)(ws + WS_RSTD1);
    float* LB = (float*)(ws + WS_LB); float* COS = (float*)(ws + WS_COS); float* SIN = (float*)(ws + WS_SIN);
    bf16_t* KROT = (bf16_t*)(ws + WS_KROT); bf16_t* ACTA = (bf16_t*)(ws + WS_ACTA);
    bf16_t* PROJ0 = (bf16_t*)(ws + WS_PROJ0); bf16_t* QBUF = (bf16_t*)(ws + WS_Q); bf16_t* PROJ1 = (bf16_t*)(ws + WS_PROJ1);
    bf16_t* X1B = (bf16_t*)p.out;
    bf16_t* KVBUF = (bf16_t*)p.out;
    LAS unsigned char* ldsl = (LAS unsigned char*)lds;
    const int G = gridDim.x, c = blockIdx.x;

    if (EN(0))
    {
        char* tile = (char*)lds;
        wt_phase(p.l0_w_in, 4096, N0, p.l0_norm, W0IN, tile);
        wt_phase(p.l0_w_uq, 1024, NQ, p.l0_q_norm, WUQ, tile);
        wt_phase(p.l0_w_ukv, 512, NKV, p.l0_kv_norm, WUKV, tile);
        wt_phase(p.l0_w_o, 4096, 4096, nullptr, W0O, tile);
        wt_phase(p.l1_w_in, 4096, N1, p.l1_norm, W1IN, tile);
        wt_phase(p.l1_w_o, 4096, 4096, nullptr, W1O, tile);
        { u32x4 z = {0u, 0u, 0u, 0u}; u32x4* pad = (u32x4*)(W0IN + (size_t)N0 * 4096); const int n16 = (N0P - N0) * 4096 * 2 / 16;
          for (int i = c * 512 + threadIdx.x; i < n16; i += G * 512) pad[i] = z; }
        cast_rstd_phase(p.x, ACTA, RSTD0);
        tables_phase(p, COS, SIN, LB);
        for (int i = c * 512 + threadIdx.x; i < T_TOK; i += G * 512) RSTD1[i] = 0.f;
    }
#ifdef PROBE_P02
    {
        char* tile = (char*)lds;
        wt_phase(p.l0_w_in, 4096, N0, p.l0_norm, W0IN, tile);
        wt_phase(p.l0_w_uq, 1024, NQ, p.l0_q_norm, WUQ, tile);
        wt_phase(p.l0_w_ukv, 512, NKV, p.l0_kv_norm, WUKV, tile);
        wt_phase(p.l0_w_o, 4096, 4096, nullptr, W0O, tile);
        wt_phase(p.l1_w_in, 4096, N1, p.l1_norm, W1IN, tile);
        wt_phase(p.l1_w_o, 4096, 4096, nullptr, W1O, tile);
    }
#endif
    grid.sync();
#ifdef PROBE_SYNC8
    grid.sync(); grid.sync(); grid.sync(); grid.sync(); grid.sync(); grid.sync(); grid.sync(); grid.sync();
#endif
    if (EN(1)) {
        pg8::Gemm g{ACTA, W0IN, T_TOK, N0P, 4096, 4096}; pg8::StaticOrder S; S.init(T_TOK, N0P, G, c);
        pg8::EpiBf16<1> E{PROJ0, N0P, RSTD0, 1600, nullptr};
        pg8::gemm_phase(ldsl, g, S, E);
    }
    grid.sync();
    if (EN(2)) stats_krot_phase(PROJ0, RSTDQ, RSTDKV, COS, SIN, KROT);
    grid.sync();
    if (EN(3)) {
        pg8::Gemm g{PROJ0, WUQ, T_TOK, NQ, 1024, N0P}; pg8::StaticOrder S; S.init(T_TOK, NQ, G, c);
        pg8::EpiBf16<0> E{QBUF, NQ, RSTDQ, 0, nullptr};
        pg8::gemm_phase(ldsl, g, S, E);
    }
    if (EN(3)) {
        pg8::Gemm g{PROJ0 + 1024, WUKV, T_TOK, NKV, 512, N0P}; pg8::StaticOrder S; S.init(T_TOK, NKV, G, c);
        pg8::EpiBf16<0> E{KVBUF, NKV, RSTDKV, 0, nullptr};
        pg8::gemm_phase(ldsl, g, S, E);
    }
    grid.sync();
    if (EN(4)) {
        att::Tensors T{QBUF, KVBUF, KROT, ACTA, PROJ0, COS, SIN};
        att::attn_phase((char*)lds, T);
    }
    grid.sync();
    if (EN(5)) {
        pg8::Gemm g{ACTA, W0O, T_TOK, 4096, 4096, 4096}; pg8::StaticOrder S; S.init(T_TOK, 4096, G, c);
        pg8::EpiResBf16Stat E{p.x, X1B, 4096, RSTD1};
        pg8::gemm_phase(ldsl, g, S, E);
    }
    grid.sync();
    if (EN(7)) {
        pg8::Gemm g{X1B, W1IN, T_TOK, N1, 4096, 4096}; pg8::StaticOrder S; S.init(T_TOK, N1, G, c, PROBE_DUP7);
        pg8::EpiBf16<2> E{PROJ1, N1, RSTD1, 0, LB, 1};
        pg8::gemm_phase(ldsl, g, S, E);
    }
    grid.sync();
#ifdef HG_OLD
    if (EN(8)) hg::hgrn2_phase((char*)lds, PROJ1, ACTA);
#else
    if (EN(8) && !SKIP_PRE) hg2::prepass((char*)lds, PROJ1, (char*)(ws + WS_W0IN), (float*)(ws + WS_W0IN + (size_t)8192 * 8192));
    grid.sync();
    if (EN(8) && !SKIP_SEQ) hg2::seqpass((char*)lds, PROJ1, (const char*)(ws + WS_W0IN), (const float*)(ws + WS_W0IN + (size_t)8192 * 8192), ACTA);
#endif
#ifdef PROBE_HG2
    __syncthreads(); hg::hgrn2_phase((char*)lds, PROJ1, ACTA);
#endif
    grid.sync();
    if (EN(9)) headnorm_phase(PROJ1, ACTA, p.l1_g_norm);
    grid.sync();
    if (EN(10)) {
        pg8::Gemm g{PROJ1 + 8192, W1O, T_TOK, 4096, 4096, N1}; pg8::StaticOrder S; S.init(T_TOK, 4096, G, c);
        pg8::EpiResBf16F32 E{X1B, 4096, (float*)PROJ1, N1 / 2};
        pg8::gemm_phase(ldsl, g, S, E);
    }
    grid.sync();
    if (EN(11)) final_norm_phase((const float*)PROJ1, (size_t)(N1 / 2), p.out, p.final_norm);
}

extern "C" void kernel_launch(void* const* d_in, const int* in_sizes, int n_in, void* d_out, int out_size, void* d_ws, size_t ws_size, hipStream_t stream) {
    static int grid = 0;
    if (grid == 0) {
        if (n_in != 15 || ws_size < WS_END) { fprintf(stderr, "kernel_launch: unexpected inputs (n_in %d, ws %zu, need %zu)\n", n_in, ws_size, (size_t)WS_END); grid = -1; return; }
        int dev = 0, cus = 0, per_cu = 0;
        (void)hipGetDevice(&dev); (void)hipDeviceGetAttribute(&cus, hipDeviceAttributeMultiprocessorCount, dev);
        if (hipFuncSetAttribute((const void*)mla_hgrn2_fwd, hipFuncAttributeMaxDynamicSharedMemorySize, LDS_TOTAL) != hipSuccess) { fprintf(stderr, "kernel_launch: hipFuncSetAttribute failed\n"); grid = -1; return; }
        if (hipOccupancyMaxActiveBlocksPerMultiprocessor(&per_cu, (const void*)mla_hgrn2_fwd, 512, LDS_TOTAL) != hipSuccess || per_cu < 1) { fprintf(stderr, "kernel_launch: occupancy query gave %d\n", per_cu); per_cu = 1; }
        (void)hipGetLastError();
        if (cus <= 0) cus = 256;
        grid = cus * per_cu;
        fprintf(stderr, "kernel_launch: grid %d (cus %d x %d)\n", grid, cus, per_cu);
    }
    if (grid < 0) return;
    Params p{};
    p.x = (const float*)d_in[0]; p.pos = (const int*)d_in[1]; p.l0_norm = (const float*)d_in[2]; p.l0_w_in = (const float*)d_in[3]; p.l0_q_norm = (const float*)d_in[4];
    p.l0_w_uq = (const float*)d_in[5]; p.l0_kv_norm = (const float*)d_in[6]; p.l0_w_ukv = (const float*)d_in[7]; p.l0_w_o = (const float*)d_in[8]; p.l1_norm = (const float*)d_in[9];
    p.l1_w_in = (const float*)d_in[10]; p.l1_g_norm = (const float*)d_in[11]; p.l1_w_o = (const float*)d_in[12]; p.lower_bounds = (const float*)d_in[13]; p.final_norm = (const float*)d_in[14];
    p.out = (float*)d_out; p.ws = (unsigned char*)d_ws;
    for (int j = 0; j < 32; ++j) p.inv_freq[j] = (float)(1.0 / pow(10000.0, (double)(2 * j) / 64.0));
    void* args[] = {&p};
    hipError_t e = hipLaunchCooperativeKernel((const void*)mla_hgrn2_fwd, dim3(grid), dim3(512), args, LDS_TOTAL, stream);
    if (e != hipSuccess) fprintf(stderr, "kernel_launch: cooperative launch failed: %s (grid %d)\n", hipGetErrorString(e), grid);
}
```

```cpp
#include <hip/hip_runtime.h>
#include <hip/hip_cooperative_groups.h>
#include <cstdio>
#include <cstdint>
#include <cmath>
namespace cg = cooperative_groups;

typedef unsigned short bf16_t;
typedef short bf16x8 __attribute__((ext_vector_type(8)));
typedef short s16x4 __attribute__((ext_vector_type(4)));
typedef float f32x4 __attribute__((ext_vector_type(4)));
typedef float f32x16 __attribute__((ext_vector_type(16)));
typedef unsigned u32x4 __attribute__((ext_vector_type(4)));
typedef unsigned u32x2 __attribute__((ext_vector_type(2)));
#define LAS __attribute__((address_space(3)))

constexpr int T_TOK = 16384, SEQ = 8192, DM = 4096;
constexpr int N0 = 5696, N0P = 5888;
constexpr int NQ = 6144, NKV = 8192, N1 = 16384;
constexpr float EPS = 1e-6f;

constexpr size_t WS_W0IN = 0;
constexpr size_t WS_WUQ  = WS_W0IN + (size_t)N0P * 4096 * 2;
constexpr size_t WS_WUKV = WS_WUQ + (size_t)NQ * 1024 * 2;
constexpr size_t WS_W0O  = WS_WUKV + (size_t)NKV * 512 * 2;
constexpr size_t WS_W1IN = WS_W0O + (size_t)4096 * 4096 * 2;
constexpr size_t WS_W1O  = WS_W1IN + (size_t)N1 * 4096 * 2;
constexpr size_t WS_RSTD0 = WS_W1O + (size_t)4096 * 4096 * 2;
constexpr size_t WS_RSTDQ = WS_RSTD0 + 65536;
constexpr size_t WS_RSTDKV = WS_RSTDQ + 65536;
constexpr size_t WS_RSTD1 = WS_RSTDKV + 65536;
constexpr size_t WS_LB = WS_RSTD1 + 65536;
constexpr size_t WS_COS = WS_LB + 16384;
constexpr size_t WS_SIN = WS_COS + (size_t)T_TOK * 32 * 4;
constexpr size_t WS_KROT = WS_SIN + (size_t)T_TOK * 32 * 4;
constexpr size_t WS_ACTA = WS_KROT + (size_t)T_TOK * 64 * 2;
constexpr size_t WS_R = WS_ACTA + (size_t)T_TOK * 4096 * 2;
constexpr size_t WS_PROJ0 = WS_R;
constexpr size_t WS_Q = WS_PROJ0 + (size_t)T_TOK * N0P * 2;
constexpr size_t WS_PROJ1 = WS_R;
constexpr size_t WS_END = WS_R + (size_t)T_TOK * N1 * 2;

struct Params {
    const float* x; const int* pos; const float* l0_norm; const float* l0_w_in; const float* l0_q_norm; const float* l0_w_uq;
    const float* l0_kv_norm; const float* l0_w_ukv; const float* l0_w_o; const float* l1_norm; const float* l1_w_in;
    const float* l1_g_norm; const float* l1_w_o; const float* lower_bounds; const float* final_norm;
    float* out; unsigned char* ws;
    float inv_freq[32];
};

__device__ __forceinline__ unsigned cvtpk(float lo, float hi) { unsigned r; asm volatile("v_cvt_pk_bf16_f32 %0, %1, %2" : "=v"(r) : "v"(lo), "v"(hi)); return r; }
typedef float f32x2 __attribute__((ext_vector_type(2)));
typedef __bf16 bf16x2_t __attribute__((ext_vector_type(2)));
__device__ __forceinline__ unsigned cvtpk_n(float lo, float hi) { f32x2 v = {lo, hi}; bf16x2_t h = __builtin_convertvector(v, bf16x2_t); return __builtin_bit_cast(unsigned, h); }
__device__ __forceinline__ bf16_t f2bf_n(float f) { return (bf16_t)(cvtpk_n(f, 0.f) & 0xffffu); }
__device__ __forceinline__ bf16_t f2bf(float f) { return (bf16_t)(cvtpk(f, 0.f) & 0xffffu); }
__device__ __forceinline__ float bf2f(unsigned short h) { return __uint_as_float((unsigned)h << 16); }
__device__ __forceinline__ float bflo(unsigned w) { return __uint_as_float(w << 16); }
__device__ __forceinline__ float bfhi(unsigned w) { return __uint_as_float(w & 0xffff0000u); }
__device__ __forceinline__ bf16x8 pack8(f32x4 a, f32x4 b) {
    u32x4 w = {cvtpk(a[0], a[1]), cvtpk(a[2], a[3]), cvtpk(b[0], b[1]), cvtpk(b[2], b[3])};
    return *reinterpret_cast<bf16x8*>(&w);
}
__device__ __forceinline__ float fast_exp(float x) { return __builtin_amdgcn_exp2f(x * 1.4426950408889634f); }
__device__ __forceinline__ float silu_f(float v) { return v * __builtin_amdgcn_rcpf(1.0f + fast_exp(-v)); }
__device__ __forceinline__ float wave_sum(float v) {
#pragma unroll
    for (int o = 32; o > 0; o >>= 1) v += __shfl_xor(v, o);
    return v;
}

namespace pg8 {
constexpr int BM = 256, BK = 64, HALF = 128, HTB = HALF * BK * 2, STAGE_BYTES = 8 * HTB, NXCD = 8, WGM = 8;
__host__ __device__ __forceinline__ int lds_byte(int r, int c) { const int st = (r >> 4) * 2 + (c >> 5), rr = r & 15, cc = c & 31, ob = rr * 64 + cc * 2; return st * 1024 + (ob ^ (((ob >> 9) & 1) << 5)); }
__host__ __device__ __forceinline__ void stage_rc(int b, int& R, int& C) { const int st = b / 1024, sb = b % 1024, swz = sb ^ (((sb >> 9) & 1) << 5); R = (st >> 1) * 16 + swz / 64; C = (st & 1) * 32 + (swz % 64) / 2; }
__host__ __device__ __forceinline__ int perm32(int rho) { const int n = rho >> 4, i = rho & 15; return 8 * (i >> 2) + 4 * n + (i & 3); }
struct Unit { int pm, pn; };
struct Gemm { const bf16_t* A; const bf16_t* Bt; int M, N, K, lda; };
struct StaticOrder {
    int nM, nN, nwg, G, c, dup;
    __device__ void init(int M, int N, int G_, int c_, int dup_ = 0) { nM = M / BM; nN = N / BM; nwg = nM * nN; G = G_; c = c_; dup = dup_; }
    __device__ bool next(int i, Unit& u) const {
        const long L = (long)(i >> dup) * G + c; if (L >= nwg) return false;
        int wgid = (int)L; { const int q = nwg / NXCD, r = nwg % NXCD, xcd = wgid % NXCD, off = wgid / NXCD; wgid = (xcd < r ? xcd * (q + 1) : r * (q + 1) + (xcd - r) * q) + off; }
        const int nig = WGM * nN, gid = wgid / nig, fm = gid * WGM, gsz = (nM - fm) < WGM ? (nM - fm) : WGM;
        u.pm = fm + ((wgid % nig) % gsz); u.pn = (wgid % nig) / gsz; return true;
    }
};

template <int MODE> struct EpiBf16 {
    static constexpr bool PERM = true;
    bf16_t* O; int ldc; const float* rs; int thr; const float* lb; int ssqmode;
    __device__ __forceinline__ void operator()(const f32x4 (&acc)[2][2][4][2], const Unit& u, int wr, int wc, int fr, int fq) const {
        const int row0 = u.pm * BM + wr * 64 + fr, col0 = u.pn * BM + wc * 32 + 8 * fq;
        const int sec = (u.pn * BM) >> 12;
        f32x4 lbv[2][2] = {};
        if (MODE == 2) { if (sec == 1) {
#pragma unroll
            for (int bj = 0; bj < 2; ++bj) { lbv[bj][0] = *(const f32x4*)(lb + col0 + bj * HALF - 4096); lbv[bj][1] = *(const f32x4*)(lb + col0 + bj * HALF - 4096 + 4); } } }
        float rsv[2][4];
#pragma unroll
        for (int ai = 0; ai < 2; ++ai)
#pragma unroll
            for (int m = 0; m < 4; ++m) { float t_ = rs[row0 + ai * HALF + m * 16]; if (ssqmode) t_ = 1.0f / sqrtf(t_ * (1.0f / 4096.0f) + EPS); rsv[ai][m] = t_; }
#pragma unroll
        for (int ai = 0; ai < 2; ++ai)
#pragma unroll
            for (int m = 0; m < 4; ++m) {
                const int row = row0 + ai * HALF + m * 16; const float s = rsv[ai][m];
                bf16_t* rowp = O + (size_t)row * ldc + col0;
#pragma unroll
                for (int bj = 0; bj < 2; ++bj) {
                    f32x4 v0 = acc[ai][bj][m][0] * s, v1 = acc[ai][bj][m][1] * s;
                    const int col = col0 + bj * HALF;
                    if (MODE == 1) { if (col >= thr) {
#pragma unroll
                        for (int j = 0; j < 4; ++j) { v0[j] = silu_f(v0[j]); v1[j] = silu_f(v1[j]); } } }
                    if (MODE == 2) {
                        if (sec == 0 || sec == 3) {
#pragma unroll
                            for (int j = 0; j < 4; ++j) { v0[j] = silu_f(v0[j]); v1[j] = silu_f(v1[j]); } }
                        else if (sec == 1) {
                            const f32x4 l0 = lbv[bj][0], l1 = lbv[bj][1];
#pragma unroll
                            for (int j = 0; j < 4; ++j) {
                                float sg = __builtin_amdgcn_rcpf(1.0f + fast_exp(-v0[j])); float fg = l0[j] + (1.0f - l0[j]) * sg; v0[j] = __logf(fg);
                                sg = __builtin_amdgcn_rcpf(1.0f + fast_exp(-v1[j])); fg = l1[j] + (1.0f - l1[j]) * sg; v1[j] = __logf(fg); }
                        }
                    }
                    u32x4 w; w.x = cvtpk(v0[0], v0[1]); w.y = cvtpk(v0[2], v0[3]); w.z = cvtpk(v1[0], v1[1]); w.w = cvtpk(v1[2], v1[3]);
                    *(u32x4*)(rowp + bj * HALF) = w;
                }
            }
    }
};
struct EpiResF32 {
    static constexpr bool PERM = false;
    const float* base; float* out; int ldc;
    __device__ __forceinline__ void operator()(const f32x4 (&acc)[2][2][4][2], const Unit& u, int wr, int wc, int fr, int fq) const {
        const int row0 = u.pm * BM + wr * 64 + fr, col0 = u.pn * BM + wc * 32 + 4 * fq;
        f32x4 bs[2][4];
#define RES_LOAD(g, slot) do { const size_t off_ = (size_t)(row0 + ((g) >> 2) * HALF + ((g) & 3) * 16) * ldc + col0; \
        _Pragma("unroll") for (int bj = 0; bj < 2; ++bj) _Pragma("unroll") for (int n = 0; n < 2; ++n) bs[slot][bj * 2 + n] = *(const f32x4*)(base + off_ + bj * HALF + n * 16); } while (0)
        RES_LOAD(0, 0);
#pragma unroll
        for (int g = 0; g < 8; ++g) {
            if (g + 1 < 8) RES_LOAD(g + 1, (g + 1) & 1);
            const int ai = g >> 2, m = g & 3; const size_t off = (size_t)(row0 + ai * HALF + m * 16) * ldc + col0;
#pragma unroll
            for (int bj = 0; bj < 2; ++bj)
#pragma unroll
                for (int n = 0; n < 2; ++n) *(f32x4*)(out + off + bj * HALF + n * 16) = bs[g & 1][bj * 2 + n] + acc[ai][bj][m][n];
        }
#undef RES_LOAD
    }
};

struct EpiResBf16Stat {
    static constexpr bool PERM = true;
    const float* base; bf16_t* O; int ldc; float* ssq;
    __device__ __forceinline__ void operator()(const f32x4 (&acc)[2][2][4][2], const Unit& u, int wr, int wc, int fr, int fq) const {
        const int row0 = u.pm * BM + wr * 64 + fr, col0 = u.pn * BM + wc * 32 + 8 * fq;
        f32x4 bs[2][4];
#define RES_LOAD(g, slot) do { const size_t off_ = (size_t)(row0 + ((g) >> 2) * HALF + ((g) & 3) * 16) * ldc + col0; \
        _Pragma("unroll") for (int bj = 0; bj < 2; ++bj) { bs[slot][bj * 2] = *(const f32x4*)(base + off_ + bj * HALF); bs[slot][bj * 2 + 1] = *(const f32x4*)(base + off_ + bj * HALF + 4); } } while (0)
        RES_LOAD(0, 0);
#pragma unroll
        for (int g = 0; g < 8; ++g) {
            if (g + 1 < 8) RES_LOAD(g + 1, (g + 1) & 1);
            const int ai = g >> 2, m = g & 3, row = row0 + ai * HALF + m * 16; float ss = 0.f;
#pragma unroll
            for (int bj = 0; bj < 2; ++bj) {
                const f32x4 v0 = acc[ai][bj][m][0] + bs[g & 1][bj * 2], v1 = acc[ai][bj][m][1] + bs[g & 1][bj * 2 + 1];
                ss += (v0[0] * v0[0] + v0[1] * v0[1]) + (v0[2] * v0[2] + v0[3] * v0[3]) + (v1[0] * v1[0] + v1[1] * v1[1]) + (v1[2] * v1[2] + v1[3] * v1[3]);
                u32x4 w; w.x = cvtpk(v0[0], v0[1]); w.y = cvtpk(v0[2], v0[3]); w.z = cvtpk(v1[0], v1[1]); w.w = cvtpk(v1[2], v1[3]);
                *(u32x4*)(O + (size_t)row * ldc + col0 + bj * HALF) = w;
            }
            ss += __shfl_xor(ss, 16); ss += __shfl_xor(ss, 32);
            if (fq == 0) atomicAdd(ssq + row, ss);
        }
#undef RES_LOAD
    }
};
struct EpiResBf16F32 {
    static constexpr bool PERM = false;
    const bf16_t* base; int ldb; float* out; int ldo;
    __device__ __forceinline__ void operator()(const f32x4 (&acc)[2][2][4][2], const Unit& u, int wr, int wc, int fr, int fq) const {
        const int row0 = u.pm * BM + wr * 64 + fr, col0 = u.pn * BM + wc * 32 + 4 * fq;
        u32x2 bs[2][4];
#define RES_LOAD(g, slot) do { const size_t off_ = (size_t)(row0 + ((g) >> 2) * HALF + ((g) & 3) * 16) * ldb + col0; \
        _Pragma("unroll") for (int bj = 0; bj < 2; ++bj) _Pragma("unroll") for (int n = 0; n < 2; ++n) bs[slot][bj * 2 + n] = *(const u32x2*)(base + off_ + bj * HALF + n * 16); } while (0)
        RES_LOAD(0, 0);
#pragma unroll
        for (int g = 0; g < 8; ++g) {
            if (g + 1 < 8) RES_LOAD(g + 1, (g + 1) & 1);
            const int ai = g >> 2, m = g & 3; const size_t off = (size_t)(row0 + ai * HALF + m * 16) * ldo + col0;
#pragma unroll
            for (int bj = 0; bj < 2; ++bj)
#pragma unroll
                for (int n = 0; n < 2; ++n) { const u32x2 b2 = bs[g & 1][bj * 2 + n]; const f32x4 bv = {bflo(b2.x), bfhi(b2.x), bflo(b2.y), bfhi(b2.y)};
                    *(f32x4*)(out + off + bj * HALF + n * 16) = bv + acc[ai][bj][m][n]; }
        }
#undef RES_LOAD
    }
};

struct EpiBf16ResBf16Stat {
    static constexpr bool PERM = true;
    const bf16_t* base; int ldb; bf16_t* O; int ldo; float* ssq;
    __device__ __forceinline__ void operator()(const f32x4 (&acc)[2][2][4][2], const Unit& u, int wr, int wc, int fr, int fq) const {
        const int row0 = u.pm * BM + wr * 64 + fr, col0 = u.pn * BM + wc * 32 + 8 * fq;
        u32x4 bs[2][2];
#define RES_LOAD(g, slot) do { const size_t off_ = (size_t)(row0 + ((g) >> 2) * HALF + ((g) & 3) * 16) * ldb + col0; \
        _Pragma("unroll") for (int bj = 0; bj < 2; ++bj) bs[slot][bj] = *(const u32x4*)(base + off_ + bj * HALF); } while (0)
        RES_LOAD(0, 0);
#pragma unroll
        for (int g = 0; g < 8; ++g) {
            if (g + 1 < 8) RES_LOAD(g + 1, (g + 1) & 1);
            const int ai = g >> 2, m = g & 3, row = row0 + ai * HALF + m * 16; float ss = 0.f;
#pragma unroll
            for (int bj = 0; bj < 2; ++bj) {
                const u32x4 b4 = bs[g & 1][bj];
                const f32x4 v0 = acc[ai][bj][m][0] + (f32x4){bflo(b4.x), bfhi(b4.x), bflo(b4.y), bfhi(b4.y)}, v1 = acc[ai][bj][m][1] + (f32x4){bflo(b4.z), bfhi(b4.z), bflo(b4.w), bfhi(b4.w)};
                ss += (v0[0] * v0[0] + v0[1] * v0[1]) + (v0[2] * v0[2] + v0[3] * v0[3]) + (v1[0] * v1[0] + v1[1] * v1[1]) + (v1[2] * v1[2] + v1[3] * v1[3]);
                u32x4 w; w.x = cvtpk(v0[0], v0[1]); w.y = cvtpk(v0[2], v0[3]); w.z = cvtpk(v1[0], v1[1]); w.w = cvtpk(v1[2], v1[3]);
                *(u32x4*)(O + (size_t)row * ldo + col0 + bj * HALF) = w;
            }
            ss += __shfl_xor(ss, 16); ss += __shfl_xor(ss, 32);
            if (fq == 0) atomicAdd(ssq + row, ss);
        }
#undef RES_LOAD
    }
};

template <class Epi, class Sched>
__device__ __forceinline__ void gemm_phase(LAS unsigned char* lds, const Gemm g, const Sched& S, const Epi& E) {
    int tid = threadIdx.x; asm volatile("" : "+v"(tid));
    const int wid = __builtin_amdgcn_readfirstlane(tid >> 6), lane = tid & 63, wr = wid >> 2, wc = wid & 3, fr = lane & 15, fq = lane >> 4;
    const int K = g.K, nt = K / BK, lda = g.lda;
    unsigned voffA[2], voffB[2];
#pragma unroll
    for (int i = 0; i < 2; ++i) { int R, C; stage_rc(tid * 16 + i * 8192, R, C); const int Rb = Epi::PERM ? ((R & ~31) + perm32(R & 31)) : R;
        voffA[i] = (unsigned)(R * lda + C) * 2u; voffB[i] = (unsigned)(Rb * K + C) * 2u; }
    const size_t kstep = (size_t)(BK * 2);
    const size_t hstepA = (size_t)HALF * lda * 2, hstepB = (size_t)HALF * K * 2;
    const size_t tstepA = 2 * hstepA, tstepB = 2 * hstepB;
    const unsigned ldsw = (unsigned)wid * 1024u;
    const int aoff = lds_byte(wr * 64 + fr, fq * 8), boff = lds_byte(wc * 32 + fr, fq * 8);
#define PG8_SA(b, h) (((b) * 2 + (h)) * HTB)
#define PG8_SB(b, h) ((4 + (b) * 2 + (h)) * HTB)
#define PG8_STAGE(bufoff, gbase, voff) do { _Pragma("unroll") for (int _i = 0; _i < 2; ++_i) \
        __builtin_amdgcn_global_load_lds((const unsigned*)((const char*)(gbase) + (voff)[_i]), (LAS unsigned*)(lds + (bufoff) + ldsw + _i * 8192), 16, 0, 0); } while (0)
#define PG8_LDA(dst, b, h) do { _Pragma("unroll") for (int m = 0; m < 4; ++m) _Pragma("unroll") for (int k = 0; k < 2; ++k) dst[m][k] = *(const LAS bf16x8*)(lds + PG8_SA(b, h) + aoff + m * 2048 + k * 1024); } while (0)
#define PG8_LDB(dst, b, h) do { _Pragma("unroll") for (int n = 0; n < 2; ++n) _Pragma("unroll") for (int k = 0; k < 2; ++k) dst[n][k] = *(const LAS bf16x8*)(lds + PG8_SB(b, h) + boff + n * 2048 + k * 1024); } while (0)
#define PG8_MMA(ai, bj, At, Bt) do { __builtin_amdgcn_s_setprio(1); _Pragma("unroll") for (int m = 0; m < 4; ++m) _Pragma("unroll") for (int n = 0; n < 2; ++n) _Pragma("unroll") for (int k = 0; k < 2; ++k) \
        acc[ai][bj][m][n] = __builtin_amdgcn_mfma_f32_16x16x32_bf16(Bt[n][k], At[m][k], acc[ai][bj][m][n], 0, 0, 0); __builtin_amdgcn_s_setprio(0); } while (0)
#define PG8_WAIT_V(n) asm volatile("s_waitcnt vmcnt(" #n ")" ::: "memory")
#define PG8_WAIT_L(n) asm volatile("s_waitcnt lgkmcnt(" #n ")" ::: "memory")
#define PG8_BAR __builtin_amdgcn_s_barrier()
#define PG8_SCHED __builtin_amdgcn_sched_barrier(0)
    Unit cur, nxt; int ui = 0;
    if (!S.next(0, cur)) return;
    f32x4 acc[2][2][4][2];
#pragma unroll
    for (int a = 0; a < 2; ++a)
#pragma unroll
        for (int b = 0; b < 2; ++b)
#pragma unroll
            for (int m = 0; m < 4; ++m)
#pragma unroll
                for (int n = 0; n < 2; ++n) acc[a][b][m][n] = (f32x4){0.f, 0.f, 0.f, 0.f};
    bf16x8 At[4][2], B0[2][2], B1[2][2];
    const char* cA = (const char*)g.A + (size_t)cur.pm * tstepA; const char* cB = (const char*)g.Bt + (size_t)cur.pn * tstepB;
    PG8_STAGE(PG8_SB(0, 0), cB, voffB); PG8_STAGE(PG8_SA(0, 0), cA, voffA); PG8_STAGE(PG8_SB(0, 1), cB + hstepB, voffB); PG8_STAGE(PG8_SA(0, 1), cA + hstepA, voffA);
    if (wr == 1) PG8_BAR;
    PG8_WAIT_V(4); PG8_BAR;
    PG8_STAGE(PG8_SB(1, 0), cB + kstep, voffB); PG8_STAGE(PG8_SA(1, 0), cA + kstep, voffA); PG8_STAGE(PG8_SB(1, 1), cB + hstepB + kstep, voffB);
    PG8_WAIT_V(6); PG8_BAR;
    for (;;) {
        const bool has_next = S.next(ui + 1, nxt);
        const char* nA = has_next ? (const char*)g.A + (size_t)nxt.pm * tstepA : cA; const char* nB = has_next ? (const char*)g.Bt + (size_t)nxt.pn * tstepB : cB;
        for (int t = 0; t < nt; t += 2) {
            const bool last = (t == nt - 2);
            const char* a1 = cA + (size_t)(t + 1) * kstep;
            const char* a2 = last ? nA : cA + (size_t)(t + 2) * kstep; const char* b2 = last ? nB : cB + (size_t)(t + 2) * kstep;
            const char* a3 = a2 + kstep; const char* b3 = b2 + kstep;
            PG8_LDB(B0, 0, 0); PG8_SCHED; PG8_LDA(At, 0, 0); PG8_STAGE(PG8_SA(1, 1), a1 + hstepA, voffA);
            PG8_WAIT_L(8); PG8_BAR; PG8_WAIT_L(0); PG8_MMA(0, 0, At, B0); PG8_BAR; PG8_SCHED;
            PG8_LDB(B1, 0, 1); PG8_STAGE(PG8_SB(0, 0), b2, voffB);
            PG8_BAR; PG8_WAIT_L(0); PG8_MMA(0, 1, At, B1); PG8_BAR;
            PG8_LDA(At, 0, 1); PG8_STAGE(PG8_SA(0, 0), a2, voffA);
            PG8_BAR; PG8_WAIT_L(0); PG8_MMA(1, 0, At, B0); PG8_BAR; PG8_SCHED;
            PG8_STAGE(PG8_SB(0, 1), b2 + hstepB, voffB);
            PG8_WAIT_V(6); PG8_BAR; PG8_MMA(1, 1, At, B1); PG8_BAR;
            PG8_LDB(B0, 1, 0); PG8_SCHED; PG8_LDA(At, 1, 0); PG8_STAGE(PG8_SA(0, 1), a2 + hstepA, voffA);
            PG8_WAIT_L(8); PG8_BAR; PG8_WAIT_L(0); PG8_MMA(0, 0, At, B0); PG8_BAR; PG8_SCHED;
            PG8_LDB(B1, 1, 1); PG8_STAGE(PG8_SB(1, 0), b3, voffB);
            PG8_BAR; PG8_WAIT_L(0); PG8_MMA(0, 1, At, B1); PG8_BAR;
            PG8_LDA(At, 1, 1); PG8_STAGE(PG8_SA(1, 0), a3, voffA);
            PG8_BAR; PG8_WAIT_L(0); PG8_MMA(1, 0, At, B0); PG8_BAR; PG8_SCHED;
            PG8_STAGE(PG8_SB(1, 1), b3 + hstepB, voffB);
            PG8_WAIT_V(6); PG8_BAR; PG8_MMA(1, 1, At, B1); PG8_BAR;
        }
        E(acc, cur, wr, wc, fr, fq);
        if (!has_next) break;
#pragma unroll
        for (int a = 0; a < 2; ++a)
#pragma unroll
            for (int b = 0; b < 2; ++b)
#pragma unroll
                for (int m = 0; m < 4; ++m)
#pragma unroll
                    for (int n = 0; n < 2; ++n) acc[a][b][m][n] = (f32x4){0.f, 0.f, 0.f, 0.f};
        cur = nxt; cA = nA; cB = nB; ++ui;
    }
    PG8_WAIT_V(0);
    if (wr == 0) PG8_BAR;
    PG8_BAR;
#undef PG8_SA
#undef PG8_SB
#undef PG8_STAGE
#undef PG8_LDA
#undef PG8_LDB
#undef PG8_MMA
#undef PG8_WAIT_V
#undef PG8_WAIT_L
#undef PG8_BAR
#undef PG8_SCHED
}
}
namespace att {
constexpr int NW = 8, QBLK = 32, KVBLK = 64, QB = NW * QBLK;
constexpr int DQ = 192, DV = 128;
constexpr int QS = NQ, KVS = NKV, KRS = 64, OS = 4096, ZS = N0P;
constexpr int SHM_V = KVBLK * DV * 2, SHM_K = KVBLK * DQ * 2;
constexpr int QR_OFF = 2 * SHM_V + 2 * SHM_K + NW * 64 * 4;
constexpr int LDS_BYTES = QR_OFF + NW * 4096;
constexpr float SCALE = 0.07216878364870322f;
constexpr float THR = 8.f;
constexpr unsigned WBIG = 0x40000000u;

#define KSWZ(row, colB) ((row) * 384 + ((colB) ^ (((row) & 7) << 4)))
#define SBAR() __builtin_amdgcn_sched_barrier(0)
__device__ __forceinline__ int v_st(int k, int c) { const int kk = (k & ~0xC) | ((k & 4) << 1) | ((k & 8) >> 1); return ((kk >> 3) * 4 + (c >> 5)) * 512 + ((kk & 7) * 32 + (c & 31)) * 2; }
__device__ __forceinline__ int v_rd_base(int lane) { return ((lane & 3) << 3) | (((lane >> 2) & 3) << 6) | (((lane >> 4) & 1) << 5) | (((lane >> 5) & 1) << 8); }
constexpr int v_rd_off(int d0, int ks, int half) { return d0 * 512 + ks * 4096 + half * 2048; }
__device__ __forceinline__ int crow(int r, int hi) { return (r & 3) + 8 * (r >> 2) + 4 * hi; }
__device__ __forceinline__ bf16x8 load8(const bf16_t* p) { return *reinterpret_cast<const bf16x8*>(p); }

__device__ __forceinline__ void mask_tile(f32x16& p0, f32x16& p1, int dq) {
    const float NEG = -__builtin_inff();
#pragma unroll
    for (int r = 0; r < 16; ++r) {
        const int c = (r & 3) + 8 * (r >> 2);
        if ((unsigned)(dq - c) >= WBIG) p0[r] = NEG;
        if ((unsigned)(dq - c - 32) >= WBIG) p1[r] = NEG;
    }
}
__device__ __forceinline__ void partialSM(f32x16& p0, f32x16& p1, float& m_reg, float& mn, float& alpha) {
    float pmax = p0[0];
#pragma unroll
    for (int r = 1; r < 16; ++r) pmax = fmaxf(pmax, p0[r]);
#pragma unroll
    for (int r = 0; r < 16; ++r) pmax = fmaxf(pmax, p1[r]);
    { auto rr = __builtin_amdgcn_permlane32_swap(__float_as_uint(pmax), __float_as_uint(pmax), false, false);
      pmax = fmaxf(__uint_as_float(rr[0]), __uint_as_float(rr[1])); }
    constexpr float C2 = 1.4426950408889634f * SCALE;
    if (__builtin_expect(__all((pmax - m_reg) * SCALE <= THR), 1)) { mn = m_reg; alpha = 1.f; }
    else { mn = fmaxf(m_reg, pmax); alpha = __builtin_amdgcn_exp2f((m_reg - mn) * C2); m_reg = mn; }
    const float mnL = -mn * C2;
#pragma unroll
    for (int r = 0; r < 16; ++r) p0[r] = fmaf(p0[r], C2, mnL);
#pragma unroll
    for (int r = 0; r < 16; ++r) p1[r] = fmaf(p1[r], C2, mnL);
#pragma unroll
    for (int r = 0; r < 16; ++r) p0[r] = __builtin_amdgcn_exp2f(p0[r]);
}
__device__ __forceinline__ void finishSM(f32x16& p0, f32x16& p1, float alpha, float& l_reg, bf16x8& pa0, bf16x8& pa1, bf16x8& pa2, bf16x8& pa3) {
#pragma unroll
    for (int r = 0; r < 16; ++r) p1[r] = __builtin_amdgcn_exp2f(p1[r]);
    float ps = 0;
#pragma unroll
    for (int r = 0; r < 16; ++r) ps += p0[r];
#pragma unroll
    for (int r = 0; r < 16; ++r) ps += p1[r];
    { auto rr = __builtin_amdgcn_permlane32_swap(__float_as_uint(ps), __float_as_uint(ps), false, false);
      ps = __uint_as_float(rr[0]) + __uint_as_float(rr[1]); }
    l_reg = l_reg * alpha + ps;
#define PK4(P, B_, OUT) do { unsigned a0 = cvtpk(P[B_+0], P[B_+1]), a1 = cvtpk(P[B_+2], P[B_+3]);                          \
        unsigned b0 = cvtpk(P[B_+4], P[B_+5]), b1 = cvtpk(P[B_+6], P[B_+7]);                                             \
        auto r0 = __builtin_amdgcn_permlane32_swap(a0, b0, false, false); auto r1 = __builtin_amdgcn_permlane32_swap(a1, b1, false, false); \
        u32x4 w = {r0[0], r1[0], r0[1], r1[1]}; OUT = *reinterpret_cast<bf16x8*>(&w); } while (0)
    PK4(p0, 0, pa0); PK4(p0, 8, pa1); PK4(p1, 0, pa2); PK4(p1, 8, pa3);
#undef PK4
}
template <int KB>
__device__ __forceinline__ void qkt(f32x16& p0, f32x16& p1, const char* K_lds, int r32, int hi, const bf16x8* qr, const char* qrl) {
    p0 = f32x16{}; p1 = f32x16{};
    const char* kb[4];
#pragma unroll
    for (int dd = 0; dd < 4; ++dd) kb[dd] = K_lds + KB * SHM_K + KSWZ(r32, (dd * 16 + hi * 8) * 2);
#pragma unroll
    for (int d0 = 0; d0 < 12; ++d0) { const char* a = kb[d0 & 3] + (d0 >> 2) * 128;
        bf16x8 b0 = *reinterpret_cast<const bf16x8*>(a);
        bf16x8 b1 = *reinterpret_cast<const bf16x8*>(a + 32 * 384);
        bf16x8 qf; if (d0 < 8) qf = qr[d0]; else qf = *reinterpret_cast<const bf16x8*>(qrl + (d0 - 8) * 1024);
        p0 = __builtin_amdgcn_mfma_f32_32x32x16_bf16(b0, qf, p0, 0, 0, 0);
        p1 = __builtin_amdgcn_mfma_f32_32x32x16_bf16(b1, qf, p1, 0, 0, 0);
    }
}
template <int VB>
__device__ __forceinline__ void pv_tile(f32x16* o, int vb0, bf16x8 pa0, bf16x8 pa1, bf16x8 pa2, bf16x8 pa3) {
#define TRRD(dst, off) asm volatile("ds_read_b64_tr_b16 %0, %1 offset:%2" : "=&v"(dst) : "v"(vb0), "i"(off) : "memory")
#define PV_D0(d0) do { s16x4 l0, l1, l2, l3, h0, h1, h2, h3; constexpr int b_ = VB * SHM_V + v_rd_off(d0, 0, 0); \
        TRRD(l0, b_); TRRD(h0, b_ + 2048); TRRD(l1, b_ + 4096); TRRD(h1, b_ + 6144); TRRD(l2, b_ + 8192); TRRD(h2, b_ + 10240); TRRD(l3, b_ + 12288); TRRD(h3, b_ + 14336); \
        asm volatile("s_waitcnt lgkmcnt(0)" ::: "memory"); SBAR();   \
        o[d0] = __builtin_amdgcn_mfma_f32_32x32x16_bf16(pa0, (bf16x8){l0[0], l0[1], l0[2], l0[3], h0[0], h0[1], h0[2], h0[3]}, o[d0], 0, 0, 0);   \
        o[d0] = __builtin_amdgcn_mfma_f32_32x32x16_bf16(pa1, (bf16x8){l1[0], l1[1], l1[2], l1[3], h1[0], h1[1], h1[2], h1[3]}, o[d0], 0, 0, 0);   \
        o[d0] = __builtin_amdgcn_mfma_f32_32x32x16_bf16(pa2, (bf16x8){l2[0], l2[1], l2[2], l2[3], h2[0], h2[1], h2[2], h2[3]}, o[d0], 0, 0, 0);   \
        o[d0] = __builtin_amdgcn_mfma_f32_32x32x16_bf16(pa3, (bf16x8){l3[0], l3[1], l3[2], l3[3], h3[0], h3[1], h3[2], h3[3]}, o[d0], 0, 0, 0); } while (0)
    PV_D0(0); PV_D0(1); PV_D0(2); PV_D0(3);
#undef PV_D0
#undef TRRD
}

struct BlockRef { const bf16_t* Q; const bf16_t* K; const bf16_t* KR; const bf16_t* V; bf16_t* O; const bf16_t* Z; const float* CS; const float* SN; int P0; };
struct Stage { bf16x8 st_v0, st_v1, st_k0, st_k1, st_kr; };
#define VMW() asm volatile("s_waitcnt vmcnt(0)" ::: "memory")
#define SLOAD_H(R, k0) do { const char* kt_ = (const char*)(R).K + (size_t)(k0) * (KVS * 2); const char* kt2_ = kt_ + 32 * KVS * 2; const char* krt_ = (const char*)(R).KR + (size_t)(k0) * (KRS * 2); \
                            S.st_v0 = *(const bf16x8*)(kt_ + koff + 256); S.st_v1 = *(const bf16x8*)(kt2_ + koff + 256);  \
                            S.st_k0 = *(const bf16x8*)(kt_ + koff); S.st_k1 = *(const bf16x8*)(kt2_ + koff);  \
                            S.st_kr = *(const bf16x8*)(krt_ + kroff); } while (0)
#define SWRITE_HK(bf) do { *(bf16x8*)(K_lds + (bf) * SHM_K + kws) = S.st_k0; *(bf16x8*)(K_lds + (bf) * SHM_K + kws + 32 * 384) = S.st_k1; \
                           *(bf16x8*)(K_lds + (bf) * SHM_K + kwr) = S.st_kr; } while (0)
#define SWRITE_HV(bf) do { *(bf16x8*)(V_lds + (bf) * SHM_V + vst0) = S.st_v0; *(bf16x8*)(V_lds + (bf) * SHM_V + vst1) = S.st_v1; } while (0)
#define SWRITE_H(bf) do { SWRITE_HV(bf); SWRITE_HK(bf); } while (0)

__device__ __forceinline__ void rope_q(const BlockRef& cur, const bf16x8* qrp, char* qrl, int wid, int r32, int hi) {
    const int row = wid * QBLK + r32;
    const unsigned toff = (unsigned)((row * 32 + hi * 8) * 4);
    const float* cp = (const float*)((const char*)cur.CS + toff); const float* sp = (const float*)((const char*)cur.SN + toff);
#pragma unroll
    for (int pr = 0; pr < 2; ++pr) {
        const f32x4 c0 = *(const f32x4*)(cp + pr * 16), c1 = *(const f32x4*)(cp + pr * 16 + 4), s0 = *(const f32x4*)(sp + pr * 16), s1 = *(const f32x4*)(sp + pr * 16 + 4);
        const bf16x8 a = qrp[pr], b = qrp[2 + pr];
        f32x4 o1l, o1h, o2l, o2h;
#pragma unroll
        for (int j = 0; j < 4; ++j) {
            float t1 = bf2f((unsigned short)a[j]), t2 = bf2f((unsigned short)b[j]);
            o1l[j] = t1 * c0[j] - t2 * s0[j]; o2l[j] = t2 * c0[j] + t1 * s0[j];
            t1 = bf2f((unsigned short)a[4 + j]); t2 = bf2f((unsigned short)b[4 + j]);
            o1h[j] = t1 * c1[j] - t2 * s1[j]; o2h[j] = t2 * c1[j] + t1 * s1[j];
        }
        *(bf16x8*)(qrl + pr * 1024) = pack8(o1l, o1h); *(bf16x8*)(qrl + (2 + pr) * 1024) = pack8(o2l, o2h);
    }
}
__device__ __forceinline__ void causal_block(const BlockRef& cur, char* lds) {
    int tid = threadIdx.x; asm volatile("" : "+v"(tid));
    const int wid = __builtin_amdgcn_readfirstlane(tid >> 6), lane = tid & 63, r32 = lane & 31, hi = lane >> 5;
    const int NT = (cur.P0 + QB - 1) / KVBLK + 1;
    const int qlo = cur.P0 + wid * QBLK, qm = qlo + r32 - 4 * hi;
    char* V_lds = lds; char* K_lds = lds + 2 * SHM_V;
    float* ws = (float*)(lds + 2 * SHM_V + 2 * SHM_K) + wid * 64; float* li_l = ws, * al_l = ws + 32;
    float m_reg = -1e30f, l_reg = 0; f32x16 o[4] = {};
    const int sr = tid >> 4, sc = (tid & 15) * 8, vst0 = v_st(sr, sc), vst1 = v_st(32 + sr, sc), kws = KSWZ(sr, sc * 2);
    const int krr = tid >> 3, krc = (tid & 7) * 8, kwr = KSWZ(krr, (128 + krc) * 2);
    const int vb0 = (int)(uintptr_t)V_lds + v_rd_base(lane);
    unsigned koff = (unsigned)((sr * KVS + sc) * 2), kroff = (unsigned)((krr * KRS + krc) * 2);
    unsigned qoff = (unsigned)(((wid * QBLK + r32) * QS + hi * 8) * 2);
    asm volatile("" : "+v"(koff), "+v"(kroff), "+v"(qoff));
    Stage S; bf16x8 qr[8]; char* qrl = lds + QR_OFF + wid * 4096 + lane * 16;
    { bf16x8 qrp[4];
#pragma unroll
      for (int d0 = 0; d0 < 8; ++d0) qr[d0] = *(const bf16x8*)((const char*)cur.Q + qoff + d0 * 32);
#pragma unroll
      for (int d0 = 0; d0 < 4; ++d0) qrp[d0] = *(const bf16x8*)((const char*)cur.Q + qoff + (8 + d0) * 32);
      SLOAD_H(cur, 0);
      rope_q(cur, qrp, qrl, wid, r32, hi); }
    VMW(); SWRITE_H(0); SBAR();
    SLOAD_H(cur, KVBLK); SBAR();
    __syncthreads();
#define RESC(a) do { if (__any((a) < 1.f)) { if (hi == 0) al_l[r32] = (a); asm volatile("s_waitcnt lgkmcnt(0)" ::: "memory");              \
                     for (int d_ = 0; d_ < 4; ++d_) for (int r = 0; r < 16; ++r) o[d_][r] *= al_l[crow(r, hi)]; } } while (0)
#define KBASE(t) ((t) * KVBLK)
#define MASKT(P0_, P1_, t) do { const int kb_ = KBASE(t); if (kb_ + KVBLK - 1 > qlo) mask_tile(P0_, P1_, qm - kb_); } while (0)
    f32x16 pA0, pA1, pB0, pB1; float mnA, mnB, alA, alB; bf16x8 pa0, pa1, pa2, pa3;
    qkt<0>(pA0, pA1, K_lds, r32, hi, qr, qrl);
    MASKT(pA0, pA1, 0); partialSM(pA0, pA1, m_reg, mnA, alA);
    VMW(); SWRITE_H(1);
    __syncthreads();
#define HALF_STEP(PX0, PX1, mnX, alX, PY0, PY1, alY, t, KB, VB, SB) do {                                                      \
        SBAR(); qkt<KB>(PX0, PX1, K_lds, r32, hi, qr, qrl);                                                                        \
        finishSM(PY0, PY1, alY, l_reg, pa0, pa1, pa2, pa3); SBAR();                                                           \
        if ((t) + 1 < NT) { SLOAD_H(cur, KBASE((t) + 1)); SBAR(); }                                                           \
        pv_tile<VB>(o, vb0, pa0, pa1, pa2, pa3); MASKT(PX0, PX1, (t)); partialSM(PX0, PX1, m_reg, mnX, alX);                  \
        __syncthreads();                                                                                                      \
        if ((t) + 1 < NT) { VMW(); SWRITE_H(SB); }                                                                            \
        RESC(alX); __syncthreads(); } while (0)
    for (int t = 1; t + 1 < NT; t += 2) {
        HALF_STEP(pB0, pB1, mnB, alB, pA0, pA1, alA, t, 1, 0, 0);
        HALF_STEP(pA0, pA1, mnA, alA, pB0, pB1, alB, t + 1, 0, 1, 1);
    }
    SBAR(); qkt<1>(pB0, pB1, K_lds, r32, hi, qr, qrl); SBAR();
    finishSM(pA0, pA1, alA, l_reg, pa0, pa1, pa2, pa3); SBAR();
    pv_tile<0>(o, vb0, pa0, pa1, pa2, pa3);
    MASKT(pB0, pB1, NT - 1); partialSM(pB0, pB1, m_reg, mnB, alB); __syncthreads(); RESC(alB);
    finishSM(pB0, pB1, alB, l_reg, pa0, pa1, pa2, pa3); SBAR(); pv_tile<1>(o, vb0, pa0, pa1, pa2, pa3);
    SBAR();
    if (hi == 0) li_l[r32] = l_reg;
    __syncthreads();
    {
        char* ot = lds + wid * (32 * 272);
        const int wb = 4 * hi * 272 + r32 * 2;
#pragma unroll
        for (int rg = 0; rg < 4; ++rg) {
            const f32x4 lv = *(const f32x4*)(li_l + 8 * rg + 4 * hi);
#pragma unroll
            for (int j = 0; j < 4; ++j) { const int r = rg * 4 + j; const float rl = __builtin_amdgcn_rcpf(lv[j]);
#pragma unroll
                for (int d0 = 0; d0 < 4; ++d0) *(bf16_t*)(ot + wb + (j + 8 * rg) * 272 + d0 * 64) = f2bf(o[d0][r] * rl); }
        }
        asm volatile("s_waitcnt lgkmcnt(0)" ::: "memory");
        const int rr = lane >> 4, c8 = (lane & 15) * 8;
        const unsigned zoff = (unsigned)(((wid * QBLK + rr) * ZS + c8) * 2), ooff = (unsigned)(((wid * QBLK + rr) * OS + c8) * 2);
#pragma unroll
        for (int i = 0; i < 8; ++i) {
            const bf16x8 ov = *(const bf16x8*)(ot + (i * 4 + rr) * 272 + c8 * 2);
            const bf16x8 zv = *(const bf16x8*)((const char*)cur.Z + (size_t)(i * 4 * ZS * 2) + zoff);
            f32x4 a, b;
#pragma unroll
            for (int j = 0; j < 4; ++j) { a[j] = bf2f((unsigned short)ov[j]) * bf2f((unsigned short)zv[j]); b[j] = bf2f((unsigned short)ov[4 + j]) * bf2f((unsigned short)zv[4 + j]); }
            *(bf16x8*)((char*)cur.O + (size_t)(i * 4 * OS * 2) + ooff) = pack8(a, b);
        }
    }
    __syncthreads();
#undef RESC
#undef KBASE
#undef MASKT
#undef HALF_STEP
}
#undef VMW
#undef SLOAD_H
#undef SWRITE_HK
#undef SWRITE_HV
#undef SWRITE_H

struct Item { int bh, qb0, qb1; };
constexpr int NQB = SEQ / QB, NX = NQB / 2, NBH = 64, TOTAL = NX * NBH;
__device__ __forceinline__ Item decode(int L) {
    Item it; const int xcd = L & 7, k = L >> 3, gi = k / NX, r = k - gi * NX;
    it.bh = gi * 8 + xcd; it.qb0 = r; it.qb1 = NQB - 1 - r; return it;
}
struct Tensors { const bf16_t* q; const bf16_t* kv; const bf16_t* krot; bf16_t* og; const bf16_t* proj0; const float* cs; const float* sn; };
__device__ __forceinline__ BlockRef mkref(const Item& it, int pass, const Tensors& T) {
    const int qb = pass ? it.qb1 : it.qb0, b = it.bh >> 5, h = it.bh & 31;
    const size_t tok0 = (size_t)b * SEQ, row0 = tok0 + (size_t)qb * QB;
    BlockRef r;
    r.Q = T.q + row0 * QS + h * DQ; r.K = T.kv + tok0 * KVS + h * 256; r.V = r.K + 128; r.KR = T.krot + tok0 * KRS;
    r.O = T.og + row0 * OS + h * DV; r.Z = T.proj0 + row0 * ZS + 1600 + h * DV; r.CS = T.cs + row0 * 32; r.SN = T.sn + row0 * 32; r.P0 = qb * QB;
    return r;
}
__device__ __forceinline__ void attn_phase(char* lds, const Tensors& T) {
#ifndef PROBE_ATTDUP
#define PROBE_ATTDUP 0
#endif
    for (int i = 0; ; ++i) {
        const int L = blockIdx.x + (i >> PROBE_ATTDUP) * gridDim.x; if (L >= TOTAL) break;
        const Item it = decode(L);
#pragma unroll 1
        for (int pass = 0; pass < 2; ++pass) { const BlockRef cur = mkref(it, pass, T); causal_block(cur, lds); }
    }
}
}
__device__ __forceinline__ void wt_phase(const float* __restrict__ W, int K, int N, const float* __restrict__ scale, bf16_t* __restrict__ out, char* lds) {
    int tid = threadIdx.x; asm volatile("" : "+v"(tid));
    const int lane = tid & 63, wv = tid >> 6, gw = blockIdx.x * 8 + wv, nw = gridDim.x * 8;
    char* img = lds + wv * 8192;
    const int kr = lane >> 4, nq = lane & 15, ntn = N / 64, ntiles = ntn * (K / 64);
    for (int t = gw; t < ntiles; t += nw) {
        const int kb = (t / ntn) * 64, nb = (t % ntn) * 64;
        const float* src = W + (size_t)(kb + kr * 16) * N + nb + nq * 4;
        f32x4 v[16];
#pragma unroll
        for (int i = 0; i < 16; ++i) v[i] = *(const f32x4*)(src + (size_t)i * N);
        if (scale) {
            const float* sp = scale + kb + kr * 16;
#pragma unroll
            for (int i = 0; i < 16; i += 4) { const f32x4 sc = *(const f32x4*)(sp + i); v[i] *= sc[0]; v[i + 1] *= sc[1]; v[i + 2] *= sc[2]; v[i + 3] *= sc[3]; }
        }
#pragma unroll
        for (int j = 0; j < 4; ++j) {
            const int n = nq * 4 + j;
#pragma unroll
            for (int hf = 0; hf < 2; ++hf) {
                const f32x4 a = {v[hf * 8 + 0][j], v[hf * 8 + 1][j], v[hf * 8 + 2][j], v[hf * 8 + 3][j]}, b = {v[hf * 8 + 4][j], v[hf * 8 + 5][j], v[hf * 8 + 6][j], v[hf * 8 + 7][j]};
                *(bf16x8*)(img + n * 128 + (((kr * 2 + hf) ^ (nq & 7)) * 16)) = pack8(a, b);
            }
        }
#pragma unroll
        for (int i = 0; i < 8; ++i) {
            const int n = i * 8 + (lane >> 3), kc = lane & 7;
            const bf16x8 r = *(const bf16x8*)(img + n * 128 + ((kc ^ ((n >> 2) & 7)) * 16));
            *(bf16x8*)(out + (size_t)(nb + n) * K + kb + kc * 8) = r;
        }
    }
}
__device__ __forceinline__ void cast_rstd_phase(const float* __restrict__ src, bf16_t* __restrict__ dst, float* __restrict__ rstd) {
    const int lane = threadIdx.x & 63, gw = blockIdx.x * 8 + (threadIdx.x >> 6), nw = gridDim.x * 8;
    for (int row = gw; row < T_TOK; row += nw) {
        const float* s = src + (size_t)row * DM; bf16_t* d = dst + (size_t)row * DM; float ss = 0.f;
#pragma unroll
        for (int i = 0; i < 8; ++i) { const int c = (i * 64 + lane) * 8; const f32x4 a = *(const f32x4*)(s + c), b = *(const f32x4*)(s + c + 4);
            ss += a[0] * a[0] + a[1] * a[1] + a[2] * a[2] + a[3] * a[3] + b[0] * b[0] + b[1] * b[1] + b[2] * b[2] + b[3] * b[3];
            *(bf16x8*)(d + c) = pack8(a, b); }
        ss = wave_sum(ss);
        if (lane == 0) rstd[row] = 1.0f / sqrtf(ss * (1.0f / DM) + EPS);
    }
}
__device__ __forceinline__ void final_norm_phase(const float* __restrict__ src, size_t lds_, float* __restrict__ dst, const float* __restrict__ w) {
    const int lane = threadIdx.x & 63, gw = blockIdx.x * 8 + (threadIdx.x >> 6), nw = gridDim.x * 8;
    for (int row = gw; row < T_TOK; row += nw) {
        const float* s = src + (size_t)row * lds_; float* d = dst + (size_t)row * DM; f32x4 v[16]; float ss = 0.f;
#pragma unroll
        for (int i = 0; i < 16; ++i) { v[i] = *(const f32x4*)(s + (i * 64 + lane) * 4); ss += v[i][0] * v[i][0] + v[i][1] * v[i][1] + v[i][2] * v[i][2] + v[i][3] * v[i][3]; }
        ss = wave_sum(ss);
        const float r = 1.0f / sqrtf(ss * (1.0f / DM) + EPS);
#pragma unroll
        for (int i = 0; i < 16; ++i) { const f32x4 g = *(const f32x4*)(w + (i * 64 + lane) * 4); *(f32x4*)(d + (i * 64 + lane) * 4) = v[i] * r * g; }
    }
}
__device__ __forceinline__ void final_norm_bf16_phase(const bf16_t* __restrict__ src, size_t lds_, const float* __restrict__ ssq, float* __restrict__ dst, const float* __restrict__ w) {
    const int lane = threadIdx.x & 63, gw = blockIdx.x * 8 + (threadIdx.x >> 6), nw = gridDim.x * 8;
    for (int row = gw; row < T_TOK; row += nw) {
        const bf16_t* s = src + (size_t)row * lds_; float* d = dst + (size_t)row * DM;
        const float r = 1.0f / sqrtf(ssq[row] * (1.0f / DM) + EPS);
        bf16x8 v[8];
#pragma unroll
        for (int i = 0; i < 8; ++i) v[i] = *(const bf16x8*)(s + (i * 64 + lane) * 8);
#pragma unroll
        for (int i = 0; i < 8; ++i) { const int c = (i * 64 + lane) * 8; const f32x4 g0 = *(const f32x4*)(w + c), g1 = *(const f32x4*)(w + c + 4); f32x4 a, b;
#pragma unroll
            for (int j = 0; j < 4; ++j) { a[j] = bf2f((unsigned short)v[i][j]) * r * g0[j]; b[j] = bf2f((unsigned short)v[i][4 + j]) * r * g1[j]; }
            *(f32x4*)(d + c) = a; *(f32x4*)(d + c + 4) = b; }
    }
}
__device__ __forceinline__ void tables_phase(const Params& p, float* cs, float* sn, float* lb) {
    const int gt = blockIdx.x * blockDim.x + threadIdx.x, nt = gridDim.x * blockDim.x;
    for (int i = gt; i < T_TOK * 32; i += nt) {
        const int tok = i >> 5, j = i & 31;
        const float ang = (float)p.pos[tok] * p.inv_freq[j];
        const double rev = (double)ang * 0.15915494309189535; const float fr = (float)(rev - rint(rev));
        cs[i] = __builtin_amdgcn_cosf(fr); sn[i] = __builtin_amdgcn_sinf(fr);
    }
    for (int i = gt; i < 4096; i += nt) { const float l0 = p.lower_bounds[i], l1 = p.lower_bounds[4096 + i]; lb[i] = 1.0f / (1.0f + expf(l0 - l1)); }
}
__device__ __forceinline__ void stats_krot_phase(const bf16_t* __restrict__ proj0, float* __restrict__ rq, float* __restrict__ rkv, const float* __restrict__ cs, const float* __restrict__ sn, bf16_t* __restrict__ krot) {
    const int lane = threadIdx.x & 63, gw = blockIdx.x * 8 + (threadIdx.x >> 6), nw = gridDim.x * 8;
    for (int row = gw; row < T_TOK; row += nw) {
        const bf16_t* s = proj0 + (size_t)row * N0P;
        const bf16x8 a = *(const bf16x8*)(s + lane * 8), b = *(const bf16x8*)(s + 512 + lane * 8), c = *(const bf16x8*)(s + 1024 + lane * 8);
        float sq = 0.f, sk = 0.f;
#pragma unroll
        for (int j = 0; j < 8; ++j) { const float x = bf2f((unsigned short)a[j]), y = bf2f((unsigned short)b[j]), z = bf2f((unsigned short)c[j]); sq += x * x + y * y; sk += z * z; }
        sq = wave_sum(sq); sk = wave_sum(sk);
        if (lane == 0) { rq[row] = 1.0f / sqrtf(sq * (1.0f / 1024.0f) + EPS); rkv[row] = 1.0f / sqrtf(sk * (1.0f / 512.0f) + EPS); }
        if (lane < 32) { const float t1 = bf2f(s[1536 + lane]), t2 = bf2f(s[1568 + lane]); const float cc = cs[(size_t)row * 32 + lane], sv = sn[(size_t)row * 32 + lane];
            krot[(size_t)row * 64 + lane] = f2bf(t1 * cc - t2 * sv); krot[(size_t)row * 64 + 32 + lane] = f2bf(t2 * cc + t1 * sv); }
    }
}
__device__ __forceinline__ void headnorm_phase(bf16_t* __restrict__ proj1, const bf16_t* __restrict__ oraw, const float* __restrict__ gn) {
    int tid = threadIdx.x; asm volatile("" : "+v"(tid));
    const int per = T_TOK / gridDim.x;
    const int h = tid >> 4, vs = (tid & 15) >> 2, c8 = (tid & 3) * 8;
    const int v0 = (tid & 15) * 8; const f32x4 g0 = *(const f32x4*)(gn + v0), g1 = *(const f32x4*)(gn + v0 + 4);
    for (int tok0 = blockIdx.x * per; tok0 < (blockIdx.x + 1) * per; tok0 += 4) {
        bf16x8 o[4], z[4];
#pragma unroll
        for (int u = 0; u < 4; ++u) { const int tok = tok0 + u, b = tok >> 13, sq = tok & (SEQ - 1);
            o[u] = *(const bf16x8*)(oraw + ((size_t)((b * 32 + h) * 4 + vs) * SEQ + sq) * 32 + c8); z[u] = *(const bf16x8*)(proj1 + (size_t)tok * N1 + 12288 + tid * 8); }
#pragma unroll
        for (int u = 0; u < 4; ++u) {
            float f[8], ss = 0.f;
#pragma unroll
            for (int j = 0; j < 8; ++j) { f[j] = bf2f((unsigned short)o[u][j]); ss += f[j] * f[j]; }
            ss += __shfl_xor(ss, 1); ss += __shfl_xor(ss, 2); ss += __shfl_xor(ss, 4); ss += __shfl_xor(ss, 8);
            const float r = 1.0f / sqrtf(ss * (1.0f / 128.0f) + EPS);
            f32x4 a, bb;
#pragma unroll
            for (int j = 0; j < 4; ++j) { a[j] = f[j] * r * g0[j] * bf2f((unsigned short)z[u][j]); bb[j] = f[4 + j] * r * g1[j] * bf2f((unsigned short)z[u][4 + j]); }
            *(bf16x8*)(proj1 + (size_t)(tok0 + u) * N1 + 8192 + tid * 8) = pack8(a, bb);
        }
    }
}

namespace hg {
constexpr int QT_S = 272, KD_S = 144;
constexpr int OFF_QT = 0, OFF_KT = OFF_QT + 64 * QT_S, OFF_QB = OFF_KT + 64 * QT_S, OFF_KD = OFF_QB + 64 * QT_S;
constexpr int OFF_VT = OFF_KD + 128 * KD_S, OFF_ST = OFF_VT + 32 * KD_S, OFF_ATT = OFF_ST + 32 * QT_S;
constexpr int OFF_SEG = OFF_ATT + 64 * KD_S, OFF_G32 = OFF_SEG + 2048, OFF_DEC = OFF_G32 + 512, LDS_BYTES = OFF_DEC + 512;
__device__ __forceinline__ int crow(int r, int hi) { return (r & 3) + 8 * (r >> 2) + 4 * hi; }

__device__ __forceinline__ void hgrn2_phase(char* lds, const bf16_t* __restrict__ proj1, bf16_t* __restrict__ oraw) {
    int tid = threadIdx.x; asm volatile("" : "+v"(tid));
    const int wid = __builtin_amdgcn_readfirstlane(tid >> 6), lane = tid & 63, r32 = lane & 31, hi = lane >> 5;
    const int kch = tid & 127, seg = tid >> 7;
    float* segtot = (float*)(lds + OFF_SEG); float* g32s = (float*)(lds + OFF_G32); float* decay = (float*)(lds + OFF_DEC);
    for (int item = blockIdx.x; item < 256; item += gridDim.x) {
        const int vs = item & 3, bh = item >> 2, b = bh >> 5, h = bh & 31;
        const bf16_t* base = proj1 + (size_t)b * SEQ * N1; bf16_t* ob = oraw + (size_t)item * SEQ * 32;
        const int qcol = h * 128 + kch, gcol = 4096 + h * 128 + kch, vcol = 8192 + h * 128 + vs * 32;
        f32x16 sacc = {};
        for (int i = tid; i < 32 * QT_S / 4; i += 512) ((unsigned*)(lds + OFF_ST))[i] = 0u;
        unsigned short graw[16], qraw[16]; u32x2 vraw;
        { const bf16_t* rp = base + (size_t)(seg * 16) * N1;
#pragma unroll
          for (int i = 0; i < 16; ++i) { graw[i] = rp[(size_t)i * N1 + gcol]; qraw[i] = rp[(size_t)i * N1 + qcol]; }
          vraw = *(const u32x2*)(base + (size_t)(tid >> 3) * N1 + vcol + (tid & 7) * 4); }
        for (int ch = 0; ch < 128; ++ch) {
            const int tok0 = ch * 64;
            float gl[16]; float cum = 0.f;
#pragma unroll
            for (int i = 0; i < 16; ++i) { cum += bf2f(graw[i]); gl[i] = cum; }
            segtot[seg * 128 + kch] = cum; if (seg == 2) g32s[kch] = bf2f(graw[0]);
            __syncthreads();
            { const float s0 = segtot[kch], s1 = segtot[128 + kch], s2 = segtot[256 + kch], s3 = segtot[384 + kch];
              const float off = (seg > 0 ? s0 : 0.f) + (seg > 1 ? s1 : 0.f) + (seg > 2 ? s2 : 0.f);
              const float tot = (s0 + s1) + (s2 + s3), bref = s0 + s1 + g32s[kch];
              if (seg == 0) decay[kch] = fast_exp(tot);
              float kd[16];
#pragma unroll
              for (int i = 0; i < 16; ++i) { const int t = seg * 16 + i; const float bb = off + gl[i], gv = bf2f(graw[i]), qv = bf2f(qraw[i]); const float kk = 1.0f - fast_exp(gv);
                  *(bf16_t*)(lds + OFF_QT + t * QT_S + kch * 2) = f2bf_n(qv * fast_exp(bb - bref));
                  *(bf16_t*)(lds + OFF_KT + t * QT_S + kch * 2) = f2bf_n(kk * fast_exp(bref - bb));
                  *(bf16_t*)(lds + OFF_QB + t * QT_S + kch * 2) = f2bf_n(qv * fast_exp(bb));
                  kd[i] = kk * fast_exp(tot - bb); }
              *(bf16x8*)(lds + OFF_KD + kch * KD_S + seg * 32) = pack8((f32x4){kd[0], kd[1], kd[2], kd[3]}, (f32x4){kd[4], kd[5], kd[6], kd[7]});
              *(bf16x8*)(lds + OFF_KD + kch * KD_S + seg * 32 + 16) = pack8((f32x4){kd[8], kd[9], kd[10], kd[11]}, (f32x4){kd[12], kd[13], kd[14], kd[15]});
              { const int t = tid >> 3, v4 = (tid & 7) * 4;
                *(bf16_t*)(lds + OFF_VT + (v4 + 0) * KD_S + t * 2) = (bf16_t)(vraw.x & 0xffffu); *(bf16_t*)(lds + OFF_VT + (v4 + 1) * KD_S + t * 2) = (bf16_t)(vraw.x >> 16);
                *(bf16_t*)(lds + OFF_VT + (v4 + 2) * KD_S + t * 2) = (bf16_t)(vraw.y & 0xffffu); *(bf16_t*)(lds + OFF_VT + (v4 + 3) * KD_S + t * 2) = (bf16_t)(vraw.y >> 16); }
            }
            if (ch + 1 < 128) { const bf16_t* rp = base + (size_t)(tok0 + 64 + seg * 16) * N1;
#pragma unroll
                for (int i = 0; i < 16; ++i) { graw[i] = rp[(size_t)i * N1 + gcol]; qraw[i] = rp[(size_t)i * N1 + qcol]; }
                vraw = *(const u32x2*)(base + (size_t)(tok0 + 64 + (tid >> 3)) * N1 + vcol + (tid & 7) * 4); }
            __syncthreads();
            f32x16 oacc = {};
            if (wid < 4) {
                const int ci = wid >> 1, si = wid & 1;
                if (!(ci == 0 && si == 1)) {
                    f32x16 aacc = {};
#pragma unroll
                    for (int kk = 0; kk < 8; ++kk) {
                        const bf16x8 af = *(const bf16x8*)(lds + OFF_QT + (32 * ci + r32) * QT_S + kk * 32 + hi * 16);
                        const bf16x8 bfr = *(const bf16x8*)(lds + OFF_KT + (32 * si + r32) * QT_S + kk * 32 + hi * 16);
                        aacc = __builtin_amdgcn_mfma_f32_32x32x16_bf16(af, bfr, aacc, 0, 0, 0); }
#pragma unroll
                    for (int i = 0; i < 16; ++i) { const int c = 32 * ci + crow(i, hi), s = 32 * si + r32; const float v = (c >= s) ? aacc[i] : 0.f;
                        *(bf16_t*)(lds + OFF_ATT + c * KD_S + s * 2) = f2bf_n(v); }
                } else {
#pragma unroll
                    for (int i = 0; i < 16; ++i) { const int c = crow(i, hi), s = 32 + r32; *(bf16_t*)(lds + OFF_ATT + c * KD_S + s * 2) = (bf16_t)0; }
                }
#pragma unroll
                for (int g4 = 0; g4 < 4; ++g4) { const f32x4 d = *(const f32x4*)(decay + 32 * wid + 8 * g4 + 4 * hi);
#pragma unroll
                    for (int j = 0; j < 4; ++j) sacc[g4 * 4 + j] *= d[j]; }
#pragma unroll
                for (int kk = 0; kk < 4; ++kk) {
                    const bf16x8 af = *(const bf16x8*)(lds + OFF_KD + (32 * wid + r32) * KD_S + kk * 32 + hi * 16);
                    const bf16x8 bfr = *(const bf16x8*)(lds + OFF_VT + r32 * KD_S + kk * 32 + hi * 16);
                    sacc = __builtin_amdgcn_mfma_f32_32x32x16_bf16(af, bfr, sacc, 0, 0, 0); }
            } else if (wid < 6) {
                const int ci = wid - 4;
#pragma unroll
                for (int kk = 0; kk < 8; ++kk) {
                    const bf16x8 af = *(const bf16x8*)(lds + OFF_QB + (32 * ci + r32) * QT_S + kk * 32 + hi * 16);
                    const bf16x8 bfr = *(const bf16x8*)(lds + OFF_ST + r32 * QT_S + kk * 32 + hi * 16);
                    oacc = __builtin_amdgcn_mfma_f32_32x32x16_bf16(af, bfr, oacc, 0, 0, 0); }
            }
            __syncthreads();
            if (wid < 4) {
#pragma unroll
                for (int g4 = 0; g4 < 4; ++g4) { u32x2 w; w.x = cvtpk_n(sacc[g4 * 4 + 0], sacc[g4 * 4 + 1]); w.y = cvtpk_n(sacc[g4 * 4 + 2], sacc[g4 * 4 + 3]);
                    *(u32x2*)(lds + OFF_ST + r32 * QT_S + (32 * wid + 8 * g4 + 4 * hi) * 2) = w; }
            } else if (wid < 6) {
                const int ci = wid - 4;
#pragma unroll
                for (int kk = 0; kk < 4; ++kk) {
                    const bf16x8 af = *(const bf16x8*)(lds + OFF_ATT + (32 * ci + r32) * KD_S + kk * 32 + hi * 16);
                    const bf16x8 bfr = *(const bf16x8*)(lds + OFF_VT + r32 * KD_S + kk * 32 + hi * 16);
                    oacc = __builtin_amdgcn_mfma_f32_32x32x16_bf16(af, bfr, oacc, 0, 0, 0); }
#pragma unroll
                for (int i = 0; i < 16; ++i) { const int c = 32 * ci + crow(i, hi); ob[(size_t)(tok0 + c) * 32 + r32] = f2bf_n(oacc[i]); }
            }
        }
        __syncthreads();
    }
}
}
namespace hg2 {
#define LBAR() do { asm volatile("s_waitcnt lgkmcnt(0)" ::: "memory"); __builtin_amdgcn_s_barrier(); asm volatile("" ::: "memory"); } while (0)
constexpr int QT_S = 272, KD_S = 144;
constexpr int OFF_QT = 0, OFF_KT = OFF_QT + 64 * QT_S, OFF_QB = OFF_KT + 64 * QT_S, OFF_KD = OFF_QB + 64 * QT_S;
constexpr int OFF_VT4 = OFF_KD + 128 * KD_S, OFF_ATT = OFF_VT4 + 128 * KD_S;
constexpr int OFF_SEG = OFF_ATT + 64 * KD_S, OFF_G32 = OFF_SEG + 2048, OFF_DEC = OFF_G32 + 512, LDS_BYTES = OFF_DEC + 512;
constexpr int ST_BYTES = 32 * QT_S;
__device__ __forceinline__ int crow(int r, int hi) { return (r & 3) + 8 * (r >> 2) + 4 * hi; }

__device__ __forceinline__ void prepass(char* lds, bf16_t* __restrict__ proj1, char* __restrict__ attbuf, float* __restrict__ decbuf) {
    int tid = threadIdx.x; asm volatile("" : "+v"(tid));
    const int wid = __builtin_amdgcn_readfirstlane(tid >> 6), lane = tid & 63, r32 = lane & 31, hi = lane >> 5;
    const int kch = tid & 127, seg = tid >> 7;
    float* segtot = (float*)(lds + OFF_SEG); float* g32s = (float*)(lds + OFF_G32); float* decay = (float*)(lds + OFF_DEC);
    unsigned short graw[16], qraw[16]; bf16x8 vr0, vr1;
#define PRE_LOAD(it_) do { const int bh_ = (it_) >> 7, ch_ = (it_) & 127, b_ = bh_ >> 5, h_ = bh_ & 31;                                   \
        const bf16_t* bs_ = proj1 + ((size_t)b_ * SEQ + ch_ * 64) * N1; const bf16_t* rp_ = bs_ + (size_t)(seg * 16) * N1 + h_ * 128 + kch; \
        _Pragma("unroll") for (int i = 0; i < 16; ++i) { graw[i] = rp_[(size_t)i * N1 + 4096]; qraw[i] = rp_[(size_t)i * N1]; }                \
        const bf16_t* vp_ = bs_ + (size_t)(tid & 63) * N1 + 8192 + h_ * 128 + (tid >> 6) * 16;                                                \
        vr0 = *(const bf16x8*)vp_; vr1 = *(const bf16x8*)(vp_ + 8); } while (0)
    if (blockIdx.x < 8192) PRE_LOAD(blockIdx.x);
    for (int item = blockIdx.x; item < 8192; item += gridDim.x) {
        const int bh = item >> 7, ch = item & 127, b = bh >> 5, h = bh & 31;
        bf16_t* base = proj1 + ((size_t)b * SEQ + ch * 64) * N1;
        const int qcol = h * 128, gcol = 4096 + h * 128, vcol = 8192 + h * 128;
        float gl[16]; float cum = 0.f;
#pragma unroll
        for (int i = 0; i < 16; ++i) { cum += bf2f(graw[i]); gl[i] = cum; }
        segtot[seg * 128 + kch] = cum; if (seg == 2) g32s[kch] = bf2f(graw[0]);
        LBAR();
        { const float s0 = segtot[kch], s1 = segtot[128 + kch], s2 = segtot[256 + kch], s3 = segtot[384 + kch];
          const float off = (seg > 0 ? s0 : 0.f) + (seg > 1 ? s1 : 0.f) + (seg > 2 ? s2 : 0.f);
          const float tot = (s0 + s1) + (s2 + s3), bref = s0 + s1 + g32s[kch];
          if (seg == 0) decay[kch] = fast_exp(tot);
          float kd[16];
#pragma unroll
          for (int i = 0; i < 16; ++i) { const int t = seg * 16 + i; const float bb = off + gl[i], gv = bf2f(graw[i]), qv = bf2f(qraw[i]); const float kk = 1.0f - fast_exp(gv);
              *(bf16_t*)(lds + OFF_QT + t * QT_S + kch * 2) = f2bf_n(qv * fast_exp(bb - bref));
              *(bf16_t*)(lds + OFF_KT + t * QT_S + kch * 2) = f2bf_n(kk * fast_exp(bref - bb));
              *(bf16_t*)(lds + OFF_QB + t * QT_S + kch * 2) = f2bf_n(qv * fast_exp(bb));
              kd[i] = kk * fast_exp(tot - bb); }
          *(bf16x8*)(lds + OFF_KD + kch * KD_S + seg * 32) = pack8((f32x4){kd[0], kd[1], kd[2], kd[3]}, (f32x4){kd[4], kd[5], kd[6], kd[7]});
          *(bf16x8*)(lds + OFF_KD + kch * KD_S + seg * 32 + 16) = pack8((f32x4){kd[8], kd[9], kd[10], kd[11]}, (f32x4){kd[12], kd[13], kd[14], kd[15]});
          { const int t = tid & 63, v16 = (tid >> 6) * 16;
#pragma unroll
            for (int j = 0; j < 8; ++j) { *(bf16_t*)(lds + OFF_VT4 + (v16 + j) * KD_S + t * 2) = (bf16_t)vr0[j]; *(bf16_t*)(lds + OFF_VT4 + (v16 + 8 + j) * KD_S + t * 2) = (bf16_t)vr1[j]; } }
        }
        if (item + (int)gridDim.x < 8192) PRE_LOAD(item + gridDim.x);
        LBAR();
        if (wid < 4) {
            const int ci = wid >> 1, si = wid & 1;
            if (!(ci == 0 && si == 1)) {
                f32x16 aacc = {};
#pragma unroll
                for (int kk = 0; kk < 8; ++kk) {
                    const bf16x8 af = *(const bf16x8*)(lds + OFF_QT + (32 * ci + r32) * QT_S + kk * 32 + hi * 16);
                    const bf16x8 bfr = *(const bf16x8*)(lds + OFF_KT + (32 * si + r32) * QT_S + kk * 32 + hi * 16);
                    aacc = __builtin_amdgcn_mfma_f32_32x32x16_bf16(af, bfr, aacc, 0, 0, 0); }
#pragma unroll
                for (int i = 0; i < 16; ++i) { const int c = 32 * ci + crow(i, hi), s = 32 * si + r32; const float v = (c >= s) ? aacc[i] : 0.f;
                    *(bf16_t*)(lds + OFF_ATT + c * KD_S + s * 2) = f2bf_n(v); }
            } else {
#pragma unroll
                for (int i = 0; i < 16; ++i) { const int c = crow(i, hi), s = 32 + r32; *(bf16_t*)(lds + OFF_ATT + c * KD_S + s * 2) = (bf16_t)0; }
            }
        }
        LBAR();
        { const size_t lrow = (size_t)(lane >> 4) * N1 + (lane & 15) * 8;
#pragma unroll
          for (int e = 0; e < 2; ++e) { const int f = 2 * wid + e;
              { const int ci = f >> 3, kk = f & 7; const bf16x8 fr = *(const bf16x8*)(lds + OFF_QB + (32 * ci + r32) * QT_S + kk * 32 + hi * 16);
                *(bf16x8*)(base + (size_t)(4 * f) * N1 + qcol + lrow) = fr; }
              { const int kt = f >> 2, kk = f & 3; const bf16x8 fr = *(const bf16x8*)(lds + OFF_KD + (32 * kt + r32) * KD_S + kk * 32 + hi * 16);
                *(bf16x8*)(base + (size_t)(4 * f) * N1 + gcol + lrow) = fr; }
              { const int vs = f >> 2, kk = f & 3; const bf16x8 fr = *(const bf16x8*)(lds + OFF_VT4 + (32 * vs + r32) * KD_S + kk * 32 + hi * 16);
                *(bf16x8*)(base + (size_t)(4 * f) * N1 + vcol + lrow) = fr; } }
          { const int f = wid, ci = f >> 2, kk = f & 3; const bf16x8 fr = *(const bf16x8*)(lds + OFF_ATT + (32 * ci + r32) * KD_S + kk * 32 + hi * 16);
            *(bf16x8*)(attbuf + ((size_t)item * 8 + f) * 1024 + lane * 16) = fr; }
          if (tid < 32) *(f32x4*)(decbuf + (size_t)item * 128 + tid * 4) = *(const f32x4*)(decay + tid * 4);
        }
    }
#undef PRE_LOAD
    LBAR();
}

__device__ __forceinline__ void seqpass(char* lds, const bf16_t* __restrict__ proj1, const char* __restrict__ attbuf, const float* __restrict__ decbuf, bf16_t* __restrict__ oraw) {
    int tid = threadIdx.x; asm volatile("" : "+v"(tid));
    const int wid = __builtin_amdgcn_readfirstlane(tid >> 6), lane = tid & 63, r32 = lane & 31, hi = lane >> 5;
    constexpr int OFF_AV = 2 * ST_BYTES;
#ifndef PROBE_SEQDUP
#define PROBE_SEQDUP 0
#endif
    for (int it2 = blockIdx.x; it2 < (1 + PROBE_SEQDUP) * 256; it2 += gridDim.x) {
        const int w_ = it2 & 255;
        const int bh = (w_ & 7) * 8 + (w_ >> 5), vs = (w_ >> 3) & 3, item = bh * 4 + vs, b = bh >> 5, h = bh & 31;
        const char* base0 = (const char*)(proj1 + (size_t)b * SEQ * N1);
        const unsigned lrow = (unsigned)(((lane >> 4) * N1 + (lane & 15) * 8) * 2);
        constexpr size_t CHB = (size_t)64 * N1 * 2, FRB = (size_t)4 * N1 * 2;
        for (int i = tid; i < 2 * ST_BYTES / 4; i += 512) ((unsigned*)lds)[i] = 0u;
        if (wid < 4) {
            f32x16 sacc = {};
            const char* gb = base0 + (size_t)(4096 + h * 128) * 2 + (size_t)(wid * 4) * FRB;
            const char* vb = base0 + (size_t)(8192 + h * 128) * 2 + (size_t)(vs * 4) * FRB;
            const float* db = decbuf + (size_t)bh * 128 * 128 + 32 * wid + 4 * hi;
            bf16x8 K0[4], V0[4], K1[4], V1[4], K2[4], V2[4]; f32x4 D0[4], D1[4], D2[4];
#define ST_LOAD(K_, V_, d_, ch_) do { _Pragma("unroll") for (int kk = 0; kk < 4; ++kk) { K_[kk] = *(const bf16x8*)(gb + (size_t)(ch_) * CHB + kk * FRB + lrow);  \
                                                                                         V_[kk] = *(const bf16x8*)(vb + (size_t)(ch_) * CHB + kk * FRB + lrow);  \
                                                                                         d_[kk] = *(const f32x4*)(db + (size_t)(ch_) * 128 + 8 * kk); } } while (0)
#define ST_STEP(c_, K_, V_, d_, LK_, LV_, Ld_) do { if ((c_) + 2 < 128) ST_LOAD(LK_, LV_, Ld_, (c_) + 2);                                                      \
                char* st_nxt = lds + (((c_) + 1) & 1) * ST_BYTES;                                                                                                \
                _Pragma("unroll") for (int g4 = 0; g4 < 4; ++g4) _Pragma("unroll") for (int j = 0; j < 4; ++j) sacc[g4 * 4 + j] *= d_[g4][j];                    \
                _Pragma("unroll") for (int kk = 0; kk < 4; ++kk) sacc = __builtin_amdgcn_mfma_f32_32x32x16_bf16(K_[kk], V_[kk], sacc, 0, 0, 0);                  \
                _Pragma("unroll") for (int g4 = 0; g4 < 4; ++g4) { u32x2 w; w.x = cvtpk_n(sacc[g4 * 4 + 0], sacc[g4 * 4 + 1]); w.y = cvtpk_n(sacc[g4 * 4 + 2], sacc[g4 * 4 + 3]); \
                    *(u32x2*)(st_nxt + r32 * QT_S + (32 * wid + 8 * g4 + 4 * hi) * 2) = w; }                                                                    \
                LBAR(); } while (0)
            ST_LOAD(K0, V0, D0, 0); ST_LOAD(K1, V1, D1, 1);
            LBAR();
            for (int ch = 0; ch < 126; ch += 3) { ST_STEP(ch, K0, V0, D0, K2, V2, D2); ST_STEP(ch + 1, K1, V1, D1, K0, V0, D0); ST_STEP(ch + 2, K2, V2, D2, K1, V1, D1); }
            ST_STEP(126, K0, V0, D0, K2, V2, D2); ST_STEP(127, K1, V1, D1, K0, V0, D0);
#undef ST_STEP
#undef ST_LOAD
        } else if (wid < 6) {
            const int ci = wid - 4;
            const char* qb = base0 + (size_t)(h * 128) * 2 + (size_t)(ci * 8) * FRB;
            char* ob = (char*)(oraw + (size_t)item * SEQ * 32) + (size_t)(32 * ci) * 64;
            const unsigned ooff = (unsigned)((4 * hi * 32 + r32) * 2);
            bf16x8 Q0[8], Q1[8], Q2[8];
#define O_LOAD(Q_, ch_) do { _Pragma("unroll") for (int kk = 0; kk < 8; ++kk) Q_[kk] = *(const bf16x8*)(qb + (size_t)(ch_) * CHB + kk * FRB + lrow); } while (0)
#define O_STEP(c_, Q_, LQ_) do { if ((c_) + 2 < 128) O_LOAD(LQ_, (c_) + 2);                                                                                      \
                const char* st_cur = lds + ((c_) & 1) * ST_BYTES; const char* av = lds + OFF_AV + ((((c_) & 1) * 2 + ci) * 4) * 1024 + lane * 16;               \
                f32x16 oacc;                                                                                                                                     \
                _Pragma("unroll") for (int q = 0; q < 4; ++q) { const f32x4 t4 = *(const f32x4*)(av + q * 1024); oacc[q * 4 + 0] = t4[0]; oacc[q * 4 + 1] = t4[1]; oacc[q * 4 + 2] = t4[2]; oacc[q * 4 + 3] = t4[3]; } \
                _Pragma("unroll") for (int kk = 0; kk < 8; ++kk) { const bf16x8 sf = *(const bf16x8*)(st_cur + r32 * QT_S + kk * 32 + hi * 16);                  \
                    oacc = __builtin_amdgcn_mfma_f32_32x32x16_bf16(Q_[kk], sf, oacc, 0, 0, 0); }                                                                \
                char* oc = ob + (size_t)(c_) * (64 * 64);                                                                                                        \
                _Pragma("unroll") for (int i = 0; i < 16; ++i) *(bf16_t*)(oc + ((i & 3) + 8 * (i >> 2)) * 64 + ooff) = f2bf_n(oacc[i]);                          \
                LBAR(); } while (0)
            O_LOAD(Q0, 0); O_LOAD(Q1, 1);
            LBAR();
            for (int ch = 0; ch < 126; ch += 3) { O_STEP(ch, Q0, Q2); O_STEP(ch + 1, Q1, Q0); O_STEP(ch + 2, Q2, Q1); }
            O_STEP(126, Q0, Q2); O_STEP(127, Q1, Q0);
#undef O_STEP
#undef O_LOAD
        } else {
            const int ci = wid - 6;
            const char* vb = base0 + (size_t)(8192 + h * 128) * 2 + (size_t)(vs * 4) * FRB;
            const char* ab = attbuf + ((size_t)bh * 128 * 8 + ci * 4) * 1024 + lane * 16;
            bf16x8 A0[4], V0[4], A1[4], V1[4], A2[4], V2[4];
#define AV_LOAD(A_, V_, ch_) do { _Pragma("unroll") for (int kk = 0; kk < 4; ++kk) { A_[kk] = *(const bf16x8*)(ab + (size_t)(ch_) * 8192 + kk * 1024);          \
                                                                                     V_[kk] = *(const bf16x8*)(vb + (size_t)(ch_) * CHB + kk * FRB + lrow); } } while (0)
#define AV_DO(A_, V_, slot_) do { f32x16 acc_ = {}; _Pragma("unroll") for (int kk = 0; kk < 4; ++kk) acc_ = __builtin_amdgcn_mfma_f32_32x32x16_bf16(A_[kk], V_[kk], acc_, 0, 0, 0); \
        char* av_ = lds + OFF_AV + ((((slot_) & 1) * 2 + ci) * 4) * 1024 + lane * 16;                                                                                   \
        _Pragma("unroll") for (int q = 0; q < 4; ++q) *(f32x4*)(av_ + q * 1024) = (f32x4){acc_[q * 4 + 0], acc_[q * 4 + 1], acc_[q * 4 + 2], acc_[q * 4 + 3]}; } while (0)
            AV_LOAD(A0, V0, 0); AV_LOAD(A1, V1, 1); AV_LOAD(A2, V2, 2);
            AV_DO(A0, V0, 0);
            LBAR();
#define AV_STEP(c_, A_, V_, LA_, LV_) do { if ((c_) + 3 < 128) AV_LOAD(LA_, LV_, (c_) + 3); if ((c_) + 1 < 128) AV_DO(A_, V_, (c_) + 1); LBAR(); } while (0)
            for (int ch = 0; ch < 126; ch += 3) { AV_STEP(ch, A1, V1, A0, V0); AV_STEP(ch + 1, A2, V2, A1, V1); AV_STEP(ch + 2, A0, V0, A2, V2); }
            AV_STEP(126, A1, V1, A0, V0); AV_STEP(127, A2, V2, A1, V1);
#undef AV_STEP
#undef AV_LOAD
#undef AV_DO
        }
    }
}
#undef LBAR
}
constexpr int LDS_TOTAL = pg8::STAGE_BYTES;
static_assert(att::LDS_BYTES <= LDS_TOTAL && hg::LDS_BYTES <= LDS_TOTAL && hg2::LDS_BYTES <= LDS_TOTAL, "lds");
static_assert((size_t)8192 * 8192 + (size_t)8192 * 512 <= WS_W1O, "attbuf/decbuf must fit in the dead weight region");

#ifndef PHMASK
#define PHMASK 0xFFFF
#endif
#define EN(n) (((PHMASK) >> (n)) & 1)
#ifndef SKIP_SEQ
#define SKIP_SEQ 0
#endif
#ifndef SKIP_PRE
#define SKIP_PRE 0
#endif
#ifndef PROBE_DUP7
#define PROBE_DUP7 0
#endif

__global__ void __launch_bounds__(512) mla_hgrn2_fwd(Params p) {
    extern __shared__ __attribute__((aligned(16))) unsigned char lds[];
    cg::grid_group grid = cg::this_grid();
    unsigned char* ws = p.ws;
    bf16_t* W0IN = (bf16_t*)(ws + WS_W0IN); bf16_t* WUQ = (bf16_t*)(ws + WS_WUQ); bf16_t* WUKV = (bf16_t*)(ws + WS_WUKV);
    bf16_t* W0O = (bf16_t*)(ws + WS_W0O); bf16_t* W1IN = (bf16_t*)(ws + WS_W1IN); bf16_t* W1O = (bf16_t*)(ws + WS_W1O);
    float* RSTD0 = (float*)(ws + WS_RSTD0); float* RSTDQ = (float*)(ws + WS_RSTDQ); float* RSTDKV = (float*)(ws + WS_RSTDKV); float* RSTD1 = (float*)(ws + WS_RSTD1);
    float* LB = (float*)(ws + WS_LB); float* COS = (float*)(ws + WS_COS); float* SIN = (float*)(ws + WS_SIN);
    bf16_t* KROT = (bf16_t*)(ws + WS_KROT); bf16_t* ACTA = (bf16_t*)(ws + WS_ACTA);
    bf16_t* PROJ0 = (bf16_t*)(ws + WS_PROJ0); bf16_t* QBUF = (bf16_t*)(ws + WS_Q); bf16_t* PROJ1 = (bf16_t*)(ws + WS_PROJ1);
    bf16_t* X1B = (bf16_t*)p.out;
    bf16_t* KVBUF = (bf16_t*)p.out;
    LAS unsigned char* ldsl = (LAS unsigned char*)lds;
    const int G = gridDim.x, c = blockIdx.x;

    if (EN(0))
    {
        char* tile = (char*)lds;
        wt_phase(p.l0_w_in, 4096, N0, p.l0_norm, W0IN, tile);
        wt_phase(p.l0_w_uq, 1024, NQ, p.l0_q_norm, WUQ, tile);
        wt_phase(p.l0_w_ukv, 512, NKV, p.l0_kv_norm, WUKV, tile);
        wt_phase(p.l0_w_o, 4096, 4096, nullptr, W0O, tile);
        wt_phase(p.l1_w_in, 4096, N1, p.l1_norm, W1IN, tile);
        wt_phase(p.l1_w_o, 4096, 4096, nullptr, W1O, tile);
        { u32x4 z = {0u, 0u, 0u, 0u}; u32x4* pad = (u32x4*)(W0IN + (size_t)N0 * 4096); const int n16 = (N0P - N0) * 4096 * 2 / 16;
          for (int i = c * 512 + threadIdx.x; i < n16; i += G * 512) pad[i] = z; }
        cast_rstd_phase(p.x, ACTA, RSTD0);
        tables_phase(p, COS, SIN, LB);
        for (int i = c * 512 + threadIdx.x; i < T_TOK; i += G * 512) RSTD1[i] = 0.f;
    }
#ifdef PROBE_P02
    {
        char* tile = (char*)lds;
        wt_phase(p.l0_w_in, 4096, N0, p.l0_norm, W0IN, tile);
        wt_phase(p.l0_w_uq, 1024, NQ, p.l0_q_norm, WUQ, tile);
        wt_phase(p.l0_w_ukv, 512, NKV, p.l0_kv_norm, WUKV, tile);
        wt_phase(p.l0_w_o, 4096, 4096, nullptr, W0O, tile);
        wt_phase(p.l1_w_in, 4096, N1, p.l1_norm, W1IN, tile);
        wt_phase(p.l1_w_o, 4096, 4096, nullptr, W1O, tile);
    }
#endif
    grid.sync();
#ifdef PROBE_SYNC8
    grid.sync(); grid.sync(); grid.sync(); grid.sync(); grid.sync(); grid.sync(); grid.sync(); grid.sync();
#endif
    if (EN(1)) {
        pg8::Gemm g{ACTA, W0IN, T_TOK, N0P, 4096, 4096}; pg8::StaticOrder S; S.init(T_TOK, N0P, G, c);
        pg8::EpiBf16<1> E{PROJ0, N0P, RSTD0, 1600, nullptr};
        pg8::gemm_phase(ldsl, g, S, E);
    }
    grid.sync();
    if (EN(2)) stats_krot_phase(PROJ0, RSTDQ, RSTDKV, COS, SIN, KROT);
    grid.sync();
    if (EN(3)) {
        pg8::Gemm g{PROJ0, WUQ, T_TOK, NQ, 1024, N0P}; pg8::StaticOrder S; S.init(T_TOK, NQ, G, c);
        pg8::EpiBf16<0> E{QBUF, NQ, RSTDQ, 0, nullptr};
        pg8::gemm_phase(ldsl, g, S, E);
    }
    if (EN(3)) {
        pg8::Gemm g{PROJ0 + 1024, WUKV, T_TOK, NKV, 512, N0P}; pg8::StaticOrder S; S.init(T_TOK, NKV, G, c);
        pg8::EpiBf16<0> E{KVBUF, NKV, RSTDKV, 0, nullptr};
        pg8::gemm_phase(ldsl, g, S, E);
    }
    grid.sync();
    if (EN(4)) {
        att::Tensors T{QBUF, KVBUF, KROT, ACTA, PROJ0, COS, SIN};
        att::attn_phase((char*)lds, T);
    }
    grid.sync();
    if (EN(5)) {
        for (int i = c * 512 + threadIdx.x; i < T_TOK; i += G * 512) RSTDQ[i] = 0.f;
        pg8::Gemm g{ACTA, W0O, T_TOK, 4096, 4096, 4096}; pg8::StaticOrder S; S.init(T_TOK, 4096, G, c);
        pg8::EpiResBf16Stat E{p.x, X1B, 4096, RSTD1};
        pg8::gemm_phase(ldsl, g, S, E);
    }
    grid.sync();
    if (EN(7)) {
        pg8::Gemm g{X1B, W1IN, T_TOK, N1, 4096, 4096}; pg8::StaticOrder S; S.init(T_TOK, N1, G, c, PROBE_DUP7);
        pg8::EpiBf16<2> E{PROJ1, N1, RSTD1, 0, LB, 1};
        pg8::gemm_phase(ldsl, g, S, E);
    }
    grid.sync();
#ifdef HG_OLD
    if (EN(8)) hg::hgrn2_phase((char*)lds, PROJ1, ACTA);
#else
    if (EN(8) && !SKIP_PRE) hg2::prepass((char*)lds, PROJ1, (char*)(ws + WS_W0IN), (float*)(ws + WS_W0IN + (size_t)8192 * 8192));
    grid.sync();
    if (EN(8) && !SKIP_SEQ) hg2::seqpass((char*)lds, PROJ1, (const char*)(ws + WS_W0IN), (const float*)(ws + WS_W0IN + (size_t)8192 * 8192), ACTA);
#endif
#ifdef PROBE_HG2
    __syncthreads(); hg::hgrn2_phase((char*)lds, PROJ1, ACTA);
#endif
    grid.sync();
    if (EN(9)) headnorm_phase(PROJ1, ACTA, p.l1_g_norm);
    grid.sync();
    if (EN(10)) {
        pg8::Gemm g{PROJ1 + 8192, W1O, T_TOK, 4096, 4096, N1}; pg8::StaticOrder S; S.init(T_TOK, 4096, G, c);
        pg8::EpiBf16ResBf16Stat E{X1B, 4096, PROJ1, N1, RSTDQ};
        pg8::gemm_phase(ldsl, g, S, E);
    }
    grid.sync();
    if (EN(11)) final_norm_bf16_phase(PROJ1, (size_t)N1, RSTDQ, p.out, p.final_norm);
}

extern "C" void kernel_launch(void* const* d_in, const int* in_sizes, int n_in, void* d_out, int out_size, void* d_ws, size_t ws_size, hipStream_t stream) {
    static int grid = 0;
    if (grid == 0) {
        if (n_in != 15 || ws_size < WS_END) { fprintf(stderr, "kernel_launch: unexpected inputs (n_in %d, ws %zu, need %zu)\n", n_in, ws_size, (size_t)WS_END); grid = -1; return; }
        int dev = 0, cus = 0, per_cu = 0;
        (void)hipGetDevice(&dev); (void)hipDeviceGetAttribute(&cus, hipDeviceAttributeMultiprocessorCount, dev);
        if (hipFuncSetAttribute((const void*)mla_hgrn2_fwd, hipFuncAttributeMaxDynamicSharedMemorySize, LDS_TOTAL) != hipSuccess) { fprintf(stderr, "kernel_launch: hipFuncSetAttribute failed\n"); grid = -1; return; }
        if (hipOccupancyMaxActiveBlocksPerMultiprocessor(&per_cu, (const void*)mla_hgrn2_fwd, 512, LDS_TOTAL) != hipSuccess || per_cu < 1) { fprintf(stderr, "kernel_launch: occupancy query gave %d\n", per_cu); per_cu = 1; }
        (void)hipGetLastError();
        if (cus <= 0) cus = 256;
        grid = cus * per_cu;
        fprintf(stderr, "kernel_launch: grid %d (cus %d x %d)\n", grid, cus, per_cu);
    }
    if (grid < 0) return;
    Params p{};
    p.x = (const float*)d_in[0]; p.pos = (const int*)d_in[1]; p.l0_norm = (const float*)d_in[2]; p.l0_w_in = (const float*)d_in[3]; p.l0_q_norm = (const float*)d_in[4];
    p.l0_w_uq = (const float*)d_in[5]; p.l0_kv_norm = (const float*)d_in[6]; p.l0_w_ukv = (const float*)d_in[7]; p.l0_w_o = (const float*)d_in[8]; p.l1_norm = (const float*)d_in[9];
    p.l1_w_in = (const float*)d_in[10]; p.l1_g_norm = (const float*)d_in[11]; p.l1_w_o = (const float*)d_in[12]; p.lower_bounds = (const float*)d_in[13]; p.final_norm = (const float*)d_in[14];
    p.out = (float*)d_out; p.ws = (unsigned char*)d_ws;
    for (int j = 0; j < 32; ++j) p.inv_freq[j] = (float)(1.0 / pow(10000.0, (double)(2 * j) / 64.0));
    void* args[] = {&p};
    hipError_t e = hipLaunchCooperativeKernel((const void*)mla_hgrn2_fwd, dim3(grid), dim3(512), args, LDS_TOTAL, stream);
    if (e != hipSuccess) fprintf(stderr, "kernel_launch: cooperative launch failed: %s (grid %d)\n", hipGetErrorString(e), grid);
}
```

```cpp
#include <hip/hip_runtime.h>
#include <hip/hip_cooperative_groups.h>
#include <cstdio>
#include <cstdint>
#include <cmath>
namespace cg = cooperative_groups;

typedef unsigned short bf16_t;
typedef short bf16x8 __attribute__((ext_vector_type(8)));
typedef short s16x4 __attribute__((ext_vector_type(4)));
typedef float f32x4 __attribute__((ext_vector_type(4)));
typedef float f32x16 __attribute__((ext_vector_type(16)));
typedef unsigned u32x4 __attribute__((ext_vector_type(4)));
typedef unsigned u32x2 __attribute__((ext_vector_type(2)));
#define LAS __attribute__((address_space(3)))

constexpr int T_TOK = 16384, SEQ = 8192, DM = 4096;
constexpr int N0 = 5696, N0P = 5888;
constexpr int NQ = 6144, NKV = 8192, N1 = 16384;
constexpr float EPS = 1e-6f;

constexpr size_t WS_W0IN = 0;
constexpr size_t WS_WUQ  = WS_W0IN + (size_t)N0P * 4096 * 2;
constexpr size_t WS_WUKV = WS_WUQ + (size_t)NQ * 1024 * 2;
constexpr size_t WS_W0O  = WS_WUKV + (size_t)NKV * 512 * 2;
constexpr size_t WS_W1IN = WS_W0O + (size_t)4096 * 4096 * 2;
constexpr size_t WS_W1O  = WS_W1IN + (size_t)N1 * 4096 * 2;
constexpr size_t WS_RSTD0 = WS_W1O + (size_t)4096 * 4096 * 2;
constexpr size_t WS_RSTDQ = WS_RSTD0 + 65536;
constexpr size_t WS_RSTDKV = WS_RSTDQ + 65536;
constexpr size_t WS_RSTD1 = WS_RSTDKV + 65536;
constexpr size_t WS_LB = WS_RSTD1 + 65536;
constexpr size_t WS_COS = WS_LB + 16384;
constexpr size_t WS_SIN = WS_COS + (size_t)T_TOK * 32 * 4;
constexpr size_t WS_KROT = WS_SIN + (size_t)T_TOK * 32 * 4;
constexpr size_t WS_ACTA = WS_KROT + (size_t)T_TOK * 64 * 2;
constexpr size_t WS_R = WS_ACTA + (size_t)T_TOK * 4096 * 2;
constexpr size_t WS_PROJ0 = WS_R;
constexpr size_t WS_Q = WS_PROJ0 + (size_t)T_TOK * N0P * 2;
constexpr size_t WS_PROJ1 = WS_R;
constexpr size_t WS_END = WS_R + (size_t)T_TOK * N1 * 2;

struct Params {
    const float* x; const int* pos; const float* l0_norm; const float* l0_w_in; const float* l0_q_norm; const float* l0_w_uq;
    const float* l0_kv_norm; const float* l0_w_ukv; const float* l0_w_o; const float* l1_norm; const float* l1_w_in;
    const float* l1_g_norm; const float* l1_w_o; const float* lower_bounds; const float* final_norm;
    float* out; unsigned char* ws;
    float inv_freq[32];
};

__device__ __forceinline__ unsigned cvtpk(float lo, float hi) { unsigned r; asm volatile("v_cvt_pk_bf16_f32 %0, %1, %2" : "=v"(r) : "v"(lo), "v"(hi)); return r; }
typedef float f32x2 __attribute__((ext_vector_type(2)));
typedef __bf16 bf16x2_t __attribute__((ext_vector_type(2)));
__device__ __forceinline__ unsigned cvtpk_n(float lo, float hi) { f32x2 v = {lo, hi}; bf16x2_t h = __builtin_convertvector(v, bf16x2_t); return __builtin_bit_cast(unsigned, h); }
__device__ __forceinline__ bf16_t f2bf_n(float f) { return (bf16_t)(cvtpk_n(f, 0.f) & 0xffffu); }
__device__ __forceinline__ bf16_t f2bf(float f) { return (bf16_t)(cvtpk(f, 0.f) & 0xffffu); }
__device__ __forceinline__ float bf2f(unsigned short h) { return __uint_as_float((unsigned)h << 16); }
__device__ __forceinline__ float bflo(unsigned w) { return __uint_as_float(w << 16); }
__device__ __forceinline__ float bfhi(unsigned w) { return __uint_as_float(w & 0xffff0000u); }
__device__ __forceinline__ bf16x8 pack8(f32x4 a, f32x4 b) {
    u32x4 w = {cvtpk(a[0], a[1]), cvtpk(a[2], a[3]), cvtpk(b[0], b[1]), cvtpk(b[2], b[3])};
    return *reinterpret_cast<bf16x8*>(&w);
}
__device__ __forceinline__ float fast_exp(float x) { return __builtin_amdgcn_exp2f(x * 1.4426950408889634f); }
__device__ __forceinline__ float silu_f(float v) { return v * __builtin_amdgcn_rcpf(1.0f + fast_exp(-v)); }
__device__ __forceinline__ float wave_sum(float v) {
#pragma unroll
    for (int o = 32; o > 0; o >>= 1) v += __shfl_xor(v, o);
    return v;
}

namespace pg8 {
constexpr int BM = 256, BK = 64, HALF = 128, HTB = HALF * BK * 2, STAGE_BYTES = 8 * HTB, NXCD = 8, WGM = 8;
__host__ __device__ __forceinline__ int lds_byte(int r, int c) { const int st = (r >> 4) * 2 + (c >> 5), rr = r & 15, cc = c & 31, ob = rr * 64 + cc * 2; return st * 1024 + (ob ^ (((ob >> 9) & 1) << 5)); }
__host__ __device__ __forceinline__ void stage_rc(int b, int& R, int& C) { const int st = b / 1024, sb = b % 1024, swz = sb ^ (((sb >> 9) & 1) << 5); R = (st >> 1) * 16 + swz / 64; C = (st & 1) * 32 + (swz % 64) / 2; }
__host__ __device__ __forceinline__ int perm32(int rho) { const int n = rho >> 4, i = rho & 15; return 8 * (i >> 2) + 4 * n + (i & 3); }
struct Unit { int pm, pn; };
struct Gemm { const bf16_t* A; const bf16_t* Bt; int M, N, K, lda; };
struct StaticOrder {
    int nM, nN, nwg, G, c, dup;
    __device__ void init(int M, int N, int G_, int c_, int dup_ = 0) { nM = M / BM; nN = N / BM; nwg = nM * nN; G = G_; c = c_; dup = dup_; }
    __device__ bool next(int i, Unit& u) const {
        const long L = (long)(i >> dup) * G + c; if (L >= nwg) return false;
        int wgid = (int)L; { const int q = nwg / NXCD, r = nwg % NXCD, xcd = wgid % NXCD, off = wgid / NXCD; wgid = (xcd < r ? xcd * (q + 1) : r * (q + 1) + (xcd - r) * q) + off; }
        const int nig = WGM * nN, gid = wgid / nig, fm = gid * WGM, gsz = (nM - fm) < WGM ? (nM - fm) : WGM;
        u.pm = fm + ((wgid % nig) % gsz); u.pn = (wgid % nig) / gsz; return true;
    }
};

template <int MODE> struct EpiBf16 {
    static constexpr bool PERM = true;
    bf16_t* O; int ldc; const float* rs; int thr; const float* lb; int ssqmode;
    __device__ __forceinline__ void operator()(const f32x4 (&acc)[2][2][4][2], const Unit& u, int wr, int wc, int fr, int fq) const {
        const int row0 = u.pm * BM + wr * 64 + fr, col0 = u.pn * BM + wc * 32 + 8 * fq;
        const int sec = (u.pn * BM) >> 12;
        f32x4 lbv[2][2] = {};
        if (MODE == 2) { if (sec == 1) {
#pragma unroll
            for (int bj = 0; bj < 2; ++bj) { lbv[bj][0] = *(const f32x4*)(lb + col0 + bj * HALF - 4096); lbv[bj][1] = *(const f32x4*)(lb + col0 + bj * HALF - 4096 + 4); } } }
        float rsv[2][4];
#pragma unroll
        for (int ai = 0; ai < 2; ++ai)
#pragma unroll
            for (int m = 0; m < 4; ++m) { float t_ = rs[row0 + ai * HALF + m * 16]; if (ssqmode) t_ = 1.0f / sqrtf(t_ * (1.0f / 4096.0f) + EPS); rsv[ai][m] = t_; }
#pragma unroll
        for (int ai = 0; ai < 2; ++ai)
#pragma unroll
            for (int m = 0; m < 4; ++m) {
                const int row = row0 + ai * HALF + m * 16; const float s = rsv[ai][m];
                bf16_t* rowp = O + (size_t)row * ldc + col0;
#pragma unroll
                for (int bj = 0; bj < 2; ++bj) {
                    f32x4 v0 = acc[ai][bj][m][0] * s, v1 = acc[ai][bj][m][1] * s;
                    const int col = col0 + bj * HALF;
                    if (MODE == 1) { if (col >= thr) {
#pragma unroll
                        for (int j = 0; j < 4; ++j) { v0[j] = silu_f(v0[j]); v1[j] = silu_f(v1[j]); } } }
                    if (MODE == 2) {
                        if (sec == 0 || sec == 3) {
#pragma unroll
                            for (int j = 0; j < 4; ++j) { v0[j] = silu_f(v0[j]); v1[j] = silu_f(v1[j]); } }
                        else if (sec == 1) {
                            const f32x4 l0 = lbv[bj][0], l1 = lbv[bj][1];
#pragma unroll
                            for (int j = 0; j < 4; ++j) {
                                float sg = __builtin_amdgcn_rcpf(1.0f + fast_exp(-v0[j])); float fg = l0[j] + (1.0f - l0[j]) * sg; v0[j] = __logf(fg);
                                sg = __builtin_amdgcn_rcpf(1.0f + fast_exp(-v1[j])); fg = l1[j] + (1.0f - l1[j]) * sg; v1[j] = __logf(fg); }
                        }
                    }
                    u32x4 w; w.x = cvtpk(v0[0], v0[1]); w.y = cvtpk(v0[2], v0[3]); w.z = cvtpk(v1[0], v1[1]); w.w = cvtpk(v1[2], v1[3]);
                    *(u32x4*)(rowp + bj * HALF) = w;
                }
            }
    }
};
struct EpiResF32 {
    static constexpr bool PERM = false;
    const float* base; float* out; int ldc;
    __device__ __forceinline__ void operator()(const f32x4 (&acc)[2][2][4][2], const Unit& u, int wr, int wc, int fr, int fq) const {
        const int row0 = u.pm * BM + wr * 64 + fr, col0 = u.pn * BM + wc * 32 + 4 * fq;
        f32x4 bs[2][4];
#define RES_LOAD(g, slot) do { const size_t off_ = (size_t)(row0 + ((g) >> 2) * HALF + ((g) & 3) * 16) * ldc + col0; \
        _Pragma("unroll") for (int bj = 0; bj < 2; ++bj) _Pragma("unroll") for (int n = 0; n < 2; ++n) bs[slot][bj * 2 + n] = *(const f32x4*)(base + off_ + bj * HALF + n * 16); } while (0)
        RES_LOAD(0, 0);
#pragma unroll
        for (int g = 0; g < 8; ++g) {
            if (g + 1 < 8) RES_LOAD(g + 1, (g + 1) & 1);
            const int ai = g >> 2, m = g & 3; const size_t off = (size_t)(row0 + ai * HALF + m * 16) * ldc + col0;
#pragma unroll
            for (int bj = 0; bj < 2; ++bj)
#pragma unroll
                for (int n = 0; n < 2; ++n) *(f32x4*)(out + off + bj * HALF + n * 16) = bs[g & 1][bj * 2 + n] + acc[ai][bj][m][n];
        }
#undef RES_LOAD
    }
};

struct EpiResBf16Stat {
    static constexpr bool PERM = true;
    const float* base; bf16_t* O; int ldc; float* ssq;
    __device__ __forceinline__ void operator()(const f32x4 (&acc)[2][2][4][2], const Unit& u, int wr, int wc, int fr, int fq) const {
        const int row0 = u.pm * BM + wr * 64 + fr, col0 = u.pn * BM + wc * 32 + 8 * fq;
        f32x4 bs[2][4];
#define RES_LOAD(g, slot) do { const size_t off_ = (size_t)(row0 + ((g) >> 2) * HALF + ((g) & 3) * 16) * ldc + col0; \
        _Pragma("unroll") for (int bj = 0; bj < 2; ++bj) { bs[slot][bj * 2] = *(const f32x4*)(base + off_ + bj * HALF); bs[slot][bj * 2 + 1] = *(const f32x4*)(base + off_ + bj * HALF + 4); } } while (0)
        RES_LOAD(0, 0);
#pragma unroll
        for (int g = 0; g < 8; ++g) {
            if (g + 1 < 8) RES_LOAD(g + 1, (g + 1) & 1);
            const int ai = g >> 2, m = g & 3, row = row0 + ai * HALF + m * 16; float ss = 0.f;
#pragma unroll
            for (int bj = 0; bj < 2; ++bj) {
                const f32x4 v0 = acc[ai][bj][m][0] + bs[g & 1][bj * 2], v1 = acc[ai][bj][m][1] + bs[g & 1][bj * 2 + 1];
                ss += (v0[0] * v0[0] + v0[1] * v0[1]) + (v0[2] * v0[2] + v0[3] * v0[3]) + (v1[0] * v1[0] + v1[1] * v1[1]) + (v1[2] * v1[2] + v1[3] * v1[3]);
                u32x4 w; w.x = cvtpk(v0[0], v0[1]); w.y = cvtpk(v0[2], v0[3]); w.z = cvtpk(v1[0], v1[1]); w.w = cvtpk(v1[2], v1[3]);
                *(u32x4*)(O + (size_t)row * ldc + col0 + bj * HALF) = w;
            }
            ss += __shfl_xor(ss, 16); ss += __shfl_xor(ss, 32);
            if (fq == 0) atomicAdd(ssq + row, ss);
        }
#undef RES_LOAD
    }
};
struct EpiResBf16F32 {
    static constexpr bool PERM = false;
    const bf16_t* base; int ldb; float* out; int ldo;
    __device__ __forceinline__ void operator()(const f32x4 (&acc)[2][2][4][2], const Unit& u, int wr, int wc, int fr, int fq) const {
        const int row0 = u.pm * BM + wr * 64 + fr, col0 = u.pn * BM + wc * 32 + 4 * fq;
        u32x2 bs[2][4];
#define RES_LOAD(g, slot) do { const size_t off_ = (size_t)(row0 + ((g) >> 2) * HALF + ((g) & 3) * 16) * ldb + col0; \
        _Pragma("unroll") for (int bj = 0; bj < 2; ++bj) _Pragma("unroll") for (int n = 0; n < 2; ++n) bs[slot][bj * 2 + n] = *(const u32x2*)(base + off_ + bj * HALF + n * 16); } while (0)
        RES_LOAD(0, 0);
#pragma unroll
        for (int g = 0; g < 8; ++g) {
            if (g + 1 < 8) RES_LOAD(g + 1, (g + 1) & 1);
            const int ai = g >> 2, m = g & 3; const size_t off = (size_t)(row0 + ai * HALF + m * 16) * ldo + col0;
#pragma unroll
            for (int bj = 0; bj < 2; ++bj)
#pragma unroll
                for (int n = 0; n < 2; ++n) { const u32x2 b2 = bs[g & 1][bj * 2 + n]; const f32x4 bv = {bflo(b2.x), bfhi(b2.x), bflo(b2.y), bfhi(b2.y)};
                    *(f32x4*)(out + off + bj * HALF + n * 16) = bv + acc[ai][bj][m][n]; }
        }
#undef RES_LOAD
    }
};

struct EpiBf16ResBf16Stat {
    static constexpr bool PERM = true;
    const bf16_t* base; int ldb; bf16_t* O; int ldo; float* ssq;
    __device__ __forceinline__ void operator()(const f32x4 (&acc)[2][2][4][2], const Unit& u, int wr, int wc, int fr, int fq) const {
        const int row0 = u.pm * BM + wr * 64 + fr, col0 = u.pn * BM + wc * 32 + 8 * fq;
        u32x4 bs[2][2];
#define RES_LOAD(g, slot) do { const size_t off_ = (size_t)(row0 + ((g) >> 2) * HALF + ((g) & 3) * 16) * ldb + col0; \
        _Pragma("unroll") for (int bj = 0; bj < 2; ++bj) bs[slot][bj] = *(const u32x4*)(base + off_ + bj * HALF); } while (0)
        RES_LOAD(0, 0);
#pragma unroll
        for (int g = 0; g < 8; ++g) {
            if (g + 1 < 8) RES_LOAD(g + 1, (g + 1) & 1);
            const int ai = g >> 2, m = g & 3, row = row0 + ai * HALF + m * 16; float ss = 0.f;
#pragma unroll
            for (int bj = 0; bj < 2; ++bj) {
                const u32x4 b4 = bs[g & 1][bj];
                const f32x4 v0 = acc[ai][bj][m][0] + (f32x4){bflo(b4.x), bfhi(b4.x), bflo(b4.y), bfhi(b4.y)}, v1 = acc[ai][bj][m][1] + (f32x4){bflo(b4.z), bfhi(b4.z), bflo(b4.w), bfhi(b4.w)};
                ss += (v0[0] * v0[0] + v0[1] * v0[1]) + (v0[2] * v0[2] + v0[3] * v0[3]) + (v1[0] * v1[0] + v1[1] * v1[1]) + (v1[2] * v1[2] + v1[3] * v1[3]);
                u32x4 w; w.x = cvtpk(v0[0], v0[1]); w.y = cvtpk(v0[2], v0[3]); w.z = cvtpk(v1[0], v1[1]); w.w = cvtpk(v1[2], v1[3]);
                *(u32x4*)(O + (size_t)row * ldo + col0 + bj * HALF) = w;
            }
            ss += __shfl_xor(ss, 16); ss += __shfl_xor(ss, 32);
            if (fq == 0) atomicAdd(ssq + row, ss);
        }
#undef RES_LOAD
    }
};

template <class Epi, class Sched>
__device__ __forceinline__ void gemm_phase(LAS unsigned char* lds, const Gemm g, const Sched& S, const Epi& E) {
    int tid = threadIdx.x; asm volatile("" : "+v"(tid));
    const int wid = __builtin_amdgcn_readfirstlane(tid >> 6), lane = tid & 63, wr = wid >> 2, wc = wid & 3, fr = lane & 15, fq = lane >> 4;
    const int K = g.K, nt = K / BK, lda = g.lda;
    unsigned voffA[2], voffB[2];
#pragma unroll
    for (int i = 0; i < 2; ++i) { int R, C; stage_rc(tid * 16 + i * 8192, R, C); const int Rb = Epi::PERM ? ((R & ~31) + perm32(R & 31)) : R;
        voffA[i] = (unsigned)(R * lda + C) * 2u; voffB[i] = (unsigned)(Rb * K + C) * 2u; }
    const size_t kstep = (size_t)(BK * 2);
    const size_t hstepA = (size_t)HALF * lda * 2, hstepB = (size_t)HALF * K * 2;
    const size_t tstepA = 2 * hstepA, tstepB = 2 * hstepB;
    const unsigned ldsw = (unsigned)wid * 1024u;
    const int aoff = lds_byte(wr * 64 + fr, fq * 8), boff = lds_byte(wc * 32 + fr, fq * 8);
#define PG8_SA(b, h) (((b) * 2 + (h)) * HTB)
#define PG8_SB(b, h) ((4 + (b) * 2 + (h)) * HTB)
#define PG8_STAGE(bufoff, gbase, voff) do { _Pragma("unroll") for (int _i = 0; _i < 2; ++_i) \
        __builtin_amdgcn_global_load_lds((const unsigned*)((const char*)(gbase) + (voff)[_i]), (LAS unsigned*)(lds + (bufoff) + ldsw + _i * 8192), 16, 0, 0); } while (0)
#define PG8_LDA(dst, b, h) do { _Pragma("unroll") for (int m = 0; m < 4; ++m) _Pragma("unroll") for (int k = 0; k < 2; ++k) dst[m][k] = *(const LAS bf16x8*)(lds + PG8_SA(b, h) + aoff + m * 2048 + k * 1024); } while (0)
#define PG8_LDB(dst, b, h) do { _Pragma("unroll") for (int n = 0; n < 2; ++n) _Pragma("unroll") for (int k = 0; k < 2; ++k) dst[n][k] = *(const LAS bf16x8*)(lds + PG8_SB(b, h) + boff + n * 2048 + k * 1024); } while (0)
#define PG8_MMA(ai, bj, At, Bt) do { __builtin_amdgcn_s_setprio(1); _Pragma("unroll") for (int m = 0; m < 4; ++m) _Pragma("unroll") for (int n = 0; n < 2; ++n) _Pragma("unroll") for (int k = 0; k < 2; ++k) \
        acc[ai][bj][m][n] = __builtin_amdgcn_mfma_f32_16x16x32_bf16(Bt[n][k], At[m][k], acc[ai][bj][m][n], 0, 0, 0); __builtin_amdgcn_s_setprio(0); } while (0)
#define PG8_WAIT_V(n) asm volatile("s_waitcnt vmcnt(" #n ")" ::: "memory")
#define PG8_WAIT_L(n) asm volatile("s_waitcnt lgkmcnt(" #n ")" ::: "memory")
#define PG8_BAR __builtin_amdgcn_s_barrier()
#define PG8_SCHED __builtin_amdgcn_sched_barrier(0)
    Unit cur, nxt; int ui = 0;
    if (!S.next(0, cur)) return;
    f32x4 acc[2][2][4][2];
#pragma unroll
    for (int a = 0; a < 2; ++a)
#pragma unroll
        for (int b = 0; b < 2; ++b)
#pragma unroll
            for (int m = 0; m < 4; ++m)
#pragma unroll
                for (int n = 0; n < 2; ++n) acc[a][b][m][n] = (f32x4){0.f, 0.f, 0.f, 0.f};
    bf16x8 At[4][2], B0[2][2], B1[2][2];
    const char* cA = (const char*)g.A + (size_t)cur.pm * tstepA; const char* cB = (const char*)g.Bt + (size_t)cur.pn * tstepB;
    PG8_STAGE(PG8_SB(0, 0), cB, voffB); PG8_STAGE(PG8_SA(0, 0), cA, voffA); PG8_STAGE(PG8_SB(0, 1), cB + hstepB, voffB); PG8_STAGE(PG8_SA(0, 1), cA + hstepA, voffA);
    if (wr == 1) PG8_BAR;
    PG8_WAIT_V(4); PG8_BAR;
    PG8_STAGE(PG8_SB(1, 0), cB + kstep, voffB); PG8_STAGE(PG8_SA(1, 0), cA + kstep, voffA); PG8_STAGE(PG8_SB(1, 1), cB + hstepB + kstep, voffB);
    PG8_WAIT_V(6); PG8_BAR;
    for (;;) {
        const bool has_next = S.next(ui + 1, nxt);
        const char* nA = has_next ? (const char*)g.A + (size_t)nxt.pm * tstepA : cA; const char* nB = has_next ? (const char*)g.Bt + (size_t)nxt.pn * tstepB : cB;
        for (int t = 0; t < nt; t += 2) {
            const bool last = (t == nt - 2);
            const char* a1 = cA + (size_t)(t + 1) * kstep;
            const char* a2 = last ? nA : cA + (size_t)(t + 2) * kstep; const char* b2 = last ? nB : cB + (size_t)(t + 2) * kstep;
            const char* a3 = a2 + kstep; const char* b3 = b2 + kstep;
            PG8_LDB(B0, 0, 0); PG8_SCHED; PG8_LDA(At, 0, 0); PG8_STAGE(PG8_SA(1, 1), a1 + hstepA, voffA);
            PG8_WAIT_L(8); PG8_BAR; PG8_WAIT_L(0); PG8_MMA(0, 0, At, B0); PG8_BAR; PG8_SCHED;
            PG8_LDB(B1, 0, 1); PG8_STAGE(PG8_SB(0, 0), b2, voffB);
            PG8_BAR; PG8_WAIT_L(0); PG8_MMA(0, 1, At, B1); PG8_BAR;
            PG8_LDA(At, 0, 1); PG8_STAGE(PG8_SA(0, 0), a2, voffA);
            PG8_BAR; PG8_WAIT_L(0); PG8_MMA(1, 0, At, B0); PG8_BAR; PG8_SCHED;
            PG8_STAGE(PG8_SB(0, 1), b2 + hstepB, voffB);
            PG8_WAIT_V(6); PG8_BAR; PG8_MMA(1, 1, At, B1); PG8_BAR;
            PG8_LDB(B0, 1, 0); PG8_SCHED; PG8_LDA(At, 1, 0); PG8_STAGE(PG8_SA(0, 1), a2 + hstepA, voffA);
            PG8_WAIT_L(8); PG8_BAR; PG8_WAIT_L(0); PG8_MMA(0, 0, At, B0); PG8_BAR; PG8_SCHED;
            PG8_LDB(B1, 1, 1); PG8_STAGE(PG8_SB(1, 0), b3, voffB);
            PG8_BAR; PG8_WAIT_L(0); PG8_MMA(0, 1, At, B1); PG8_BAR;
            PG8_LDA(At, 1, 1); PG8_STAGE(PG8_SA(1, 0), a3, voffA);
            PG8_BAR; PG8_WAIT_L(0); PG8_MMA(1, 0, At, B0); PG8_BAR; PG8_SCHED;
            PG8_STAGE(PG8_SB(1, 1), b3 + hstepB, voffB);
            PG8_WAIT_V(6); PG8_BAR; PG8_MMA(1, 1, At, B1); PG8_BAR;
        }
        E(acc, cur, wr, wc, fr, fq);
        if (!has_next) break;
#pragma unroll
        for (int a = 0; a < 2; ++a)
#pragma unroll
            for (int b = 0; b < 2; ++b)
#pragma unroll
                for (int m = 0; m < 4; ++m)
#pragma unroll
                    for (int n = 0; n < 2; ++n) acc[a][b][m][n] = (f32x4){0.f, 0.f, 0.f, 0.f};
        cur = nxt; cA = nA; cB = nB; ++ui;
    }
    PG8_WAIT_V(0);
    if (wr == 0) PG8_BAR;
    PG8_BAR;
#undef PG8_SA
#undef PG8_SB
#undef PG8_STAGE
#undef PG8_LDA
#undef PG8_LDB
#undef PG8_MMA
#undef PG8_WAIT_V
#undef PG8_WAIT_L
#undef PG8_BAR
#undef PG8_SCHED
}
}
#define XB_TMO      128
#define XB_XCNT(j)  (256  + 64 * (j))
#define XB_XSUB(j)  (1280 + 64 * (j))
#define XB_XGEN(j)  (2304 + 64 * (j))
#define XB_TOP      3328
#define XB_TOPGEN   3392
#define XCD_BAR_WORDS 3456
#define XB_SPIN_CAP (1u << 18)

__device__ __forceinline__ unsigned xb_ld(unsigned* p)              { return __hip_atomic_load(p, __ATOMIC_RELAXED, __HIP_MEMORY_SCOPE_AGENT); }
__device__ __forceinline__ unsigned xb_add(unsigned* p, unsigned v) { return __hip_atomic_fetch_add(p, v, __ATOMIC_RELAXED, __HIP_MEMORY_SCOPE_AGENT); }
__device__ __forceinline__ unsigned xb_xcc_id() { return (unsigned)__builtin_amdgcn_s_getreg((3 << 11) | 20) & 0xFu; }
#define XB_SPIN(cond, bar) do { unsigned _sp = 0; while (cond) { __builtin_amdgcn_s_sleep(1); \
    if ((++_sp & 255u) == 0u) { if (xb_ld(&(bar)[XB_TMO])) break; if (_sp > XB_SPIN_CAP) { atomicAdd(&(bar)[XB_TMO], 1u); break; } } } } while (0)

struct XcdBarrier {
    unsigned* bar; unsigned x;
    volatile LAS unsigned* st;
};

__device__ __forceinline__ XcdBarrier xcd_barrier_post(unsigned* bar, volatile LAS unsigned* st) {
    XcdBarrier b; b.bar = bar; b.x = xb_xcc_id(); b.st = st;
    if (threadIdx.x == 0) (void)xb_add(&bar[XB_XCNT(b.x)], 1u);
    return b;
}
__device__ __forceinline__ void xcd_barrier_complete(unsigned* bar, unsigned x, unsigned& nloc, unsigned& nx) {
    const unsigned G = gridDim.x * gridDim.y * gridDim.z;
    unsigned sum, cnt, mine, sp = 0u;
    for (;;) {
        sum = 0u; cnt = 0u; mine = 0u;
#pragma unroll
        for (unsigned j = 0; j < 16; ++j) { const unsigned c = xb_ld(&bar[XB_XCNT(j)]); sum += c; cnt += (c > 0u) ? 1u : 0u; mine = (j == x) ? c : mine; }
        if (sum == G) break;
        __builtin_amdgcn_s_sleep(1);
        if ((++sp & 255u) == 0u) { if (xb_ld(&bar[XB_TMO])) break; if (sp > XB_SPIN_CAP) { atomicAdd(&bar[XB_TMO], 1u); break; } }
    }
    nloc = mine > 0u ? mine : 1u; nx = cnt > 0u ? cnt : 1u;
}

__device__ __forceinline__ void xcd_barrier(const XcdBarrier& b) {
    asm volatile("s_waitcnt vmcnt(0)" ::: "memory");
    __syncthreads();
    if (threadIdx.x == 0) {
        unsigned* bar = b.bar;
        __builtin_amdgcn_s_waitcnt(0);
        unsigned nloc = b.st[0], nx = b.st[1];
        if (nloc == 0u) { xcd_barrier_complete(bar, b.x, nloc, nx); b.st[0] = nloc; b.st[1] = nx; }
        const unsigned old = xb_add(&bar[XB_XSUB(b.x)], 1u);
        const unsigned gen = old / nloc;
        if (old + 1u == (gen + 1u) * nloc) {
            __builtin_amdgcn_fence(__ATOMIC_RELEASE, "agent");
            asm volatile("s_waitcnt vmcnt(0)" ::: "memory");
            const unsigned og = xb_add(&bar[XB_TOP], 1u);
            const unsigned tg = og / nx;
            if (og + 1u == (tg + 1u) * nx) xb_add(&bar[XB_TOPGEN], 1u);
            else XB_SPIN(xb_ld(&bar[XB_TOPGEN]) == tg, bar);
            __builtin_amdgcn_fence(__ATOMIC_ACQUIRE, "agent");
            xb_add(&bar[XB_XGEN(b.x)], 1u);
            asm volatile("s_waitcnt vmcnt(0)" ::: "memory");
        } else {
            XB_SPIN(xb_ld(&bar[XB_XGEN(b.x)]) == gen, bar);
            __builtin_amdgcn_fence(__ATOMIC_ACQUIRE, "agent");
            asm volatile("s_waitcnt vmcnt(0)" ::: "memory");
        }
    }
    __syncthreads();
}


namespace att {
constexpr int NW = 8, QBLK = 32, KVBLK = 64, QB = NW * QBLK;
constexpr int DQ = 192, DV = 128;
constexpr int QS = NQ, KVS = NKV, KRS = 64, OS = 4096, ZS = N0P;
constexpr int SHM_V = KVBLK * DV * 2, SHM_K = KVBLK * DQ * 2;
constexpr int QR_OFF = 2 * SHM_V + 2 * SHM_K + NW * 64 * 4;
constexpr int LDS_BYTES = QR_OFF + NW * 4096;
constexpr float SCALE = 0.07216878364870322f;
constexpr float THR = 8.f;
constexpr unsigned WBIG = 0x40000000u;

#define KSWZ(row, colB) ((row) * 384 + ((colB) ^ (((row) & 7) << 4)))
#define SBAR() __builtin_amdgcn_sched_barrier(0)
__device__ __forceinline__ int v_st(int k, int c) { const int kk = (k & ~0xC) | ((k & 4) << 1) | ((k & 8) >> 1); return ((kk >> 3) * 4 + (c >> 5)) * 512 + ((kk & 7) * 32 + (c & 31)) * 2; }
__device__ __forceinline__ int v_rd_base(int lane) { return ((lane & 3) << 3) | (((lane >> 2) & 3) << 6) | (((lane >> 4) & 1) << 5) | (((lane >> 5) & 1) << 8); }
constexpr int v_rd_off(int d0, int ks, int half) { return d0 * 512 + ks * 4096 + half * 2048; }
__device__ __forceinline__ int crow(int r, int hi) { return (r & 3) + 8 * (r >> 2) + 4 * hi; }
__device__ __forceinline__ bf16x8 load8(const bf16_t* p) { return *reinterpret_cast<const bf16x8*>(p); }

__device__ __forceinline__ void mask_tile(f32x16& p0, f32x16& p1, int dq) {
    const float NEG = -__builtin_inff();
#pragma unroll
    for (int r = 0; r < 16; ++r) {
        const int c = (r & 3) + 8 * (r >> 2);
        if ((unsigned)(dq - c) >= WBIG) p0[r] = NEG;
        if ((unsigned)(dq - c - 32) >= WBIG) p1[r] = NEG;
    }
}
__device__ __forceinline__ void partialSM(f32x16& p0, f32x16& p1, float& m_reg, float& mn, float& alpha) {
    float pmax = p0[0];
#pragma unroll
    for (int r = 1; r < 16; ++r) pmax = fmaxf(pmax, p0[r]);
#pragma unroll
    for (int r = 0; r < 16; ++r) pmax = fmaxf(pmax, p1[r]);
    { auto rr = __builtin_amdgcn_permlane32_swap(__float_as_uint(pmax), __float_as_uint(pmax), false, false);
      pmax = fmaxf(__uint_as_float(rr[0]), __uint_as_float(rr[1])); }
    constexpr float C2 = 1.4426950408889634f * SCALE;
    if (__builtin_expect(__all((pmax - m_reg) * SCALE <= THR), 1)) { mn = m_reg; alpha = 1.f; }
    else { mn = fmaxf(m_reg, pmax); alpha = __builtin_amdgcn_exp2f((m_reg - mn) * C2); m_reg = mn; }
    const float mnL = -mn * C2;
#pragma unroll
    for (int r = 0; r < 16; ++r) p0[r] = fmaf(p0[r], C2, mnL);
#pragma unroll
    for (int r = 0; r < 16; ++r) p1[r] = fmaf(p1[r], C2, mnL);
#pragma unroll
    for (int r = 0; r < 16; ++r) p0[r] = __builtin_amdgcn_exp2f(p0[r]);
}
__device__ __forceinline__ void finishSM(f32x16& p0, f32x16& p1, float alpha, float& l_reg, bf16x8& pa0, bf16x8& pa1, bf16x8& pa2, bf16x8& pa3) {
#pragma unroll
    for (int r = 0; r < 16; ++r) p1[r] = __builtin_amdgcn_exp2f(p1[r]);
    float ps = 0;
#pragma unroll
    for (int r = 0; r < 16; ++r) ps += p0[r];
#pragma unroll
    for (int r = 0; r < 16; ++r) ps += p1[r];
    { auto rr = __builtin_amdgcn_permlane32_swap(__float_as_uint(ps), __float_as_uint(ps), false, false);
      ps = __uint_as_float(rr[0]) + __uint_as_float(rr[1]); }
    l_reg = l_reg * alpha + ps;
#define PK4(P, B_, OUT) do { unsigned a0 = cvtpk(P[B_+0], P[B_+1]), a1 = cvtpk(P[B_+2], P[B_+3]);                          \
        unsigned b0 = cvtpk(P[B_+4], P[B_+5]), b1 = cvtpk(P[B_+6], P[B_+7]);                                             \
        auto r0 = __builtin_amdgcn_permlane32_swap(a0, b0, false, false); auto r1 = __builtin_amdgcn_permlane32_swap(a1, b1, false, false); \
        u32x4 w = {r0[0], r1[0], r0[1], r1[1]}; OUT = *reinterpret_cast<bf16x8*>(&w); } while (0)
    PK4(p0, 0, pa0); PK4(p0, 8, pa1); PK4(p1, 0, pa2); PK4(p1, 8, pa3);
#undef PK4
}
template <int KB>
__device__ __forceinline__ void qkt(f32x16& p0, f32x16& p1, const char* K_lds, int r32, int hi, const bf16x8* qr, const char* qrl) {
    p0 = f32x16{}; p1 = f32x16{};
    const char* kb[4];
#pragma unroll
    for (int dd = 0; dd < 4; ++dd) kb[dd] = K_lds + KB * SHM_K + KSWZ(r32, (dd * 16 + hi * 8) * 2);
#pragma unroll
    for (int d0 = 0; d0 < 12; ++d0) { const char* a = kb[d0 & 3] + (d0 >> 2) * 128;
        bf16x8 b0 = *reinterpret_cast<const bf16x8*>(a);
        bf16x8 b1 = *reinterpret_cast<const bf16x8*>(a + 32 * 384);
        bf16x8 qf; if (d0 < 8) qf = qr[d0]; else qf = *reinterpret_cast<const bf16x8*>(qrl + (d0 - 8) * 1024);
        p0 = __builtin_amdgcn_mfma_f32_32x32x16_bf16(b0, qf, p0, 0, 0, 0);
        p1 = __builtin_amdgcn_mfma_f32_32x32x16_bf16(b1, qf, p1, 0, 0, 0);
    }
}
template <int VB>
__device__ __forceinline__ void pv_tile(f32x16* o, int vb0, bf16x8 pa0, bf16x8 pa1, bf16x8 pa2, bf16x8 pa3) {
#define TRRD(dst, off) asm volatile("ds_read_b64_tr_b16 %0, %1 offset:%2" : "=&v"(dst) : "v"(vb0), "i"(off) : "memory")
#define PV_D0(d0) do { s16x4 l0, l1, l2, l3, h0, h1, h2, h3; constexpr int b_ = VB * SHM_V + v_rd_off(d0, 0, 0); \
        TRRD(l0, b_); TRRD(h0, b_ + 2048); TRRD(l1, b_ + 4096); TRRD(h1, b_ + 6144); TRRD(l2, b_ + 8192); TRRD(h2, b_ + 10240); TRRD(l3, b_ + 12288); TRRD(h3, b_ + 14336); \
        asm volatile("s_waitcnt lgkmcnt(0)" ::: "memory"); SBAR();   \
        o[d0] = __builtin_amdgcn_mfma_f32_32x32x16_bf16(pa0, (bf16x8){l0[0], l0[1], l0[2], l0[3], h0[0], h0[1], h0[2], h0[3]}, o[d0], 0, 0, 0);   \
        o[d0] = __builtin_amdgcn_mfma_f32_32x32x16_bf16(pa1, (bf16x8){l1[0], l1[1], l1[2], l1[3], h1[0], h1[1], h1[2], h1[3]}, o[d0], 0, 0, 0);   \
        o[d0] = __builtin_amdgcn_mfma_f32_32x32x16_bf16(pa2, (bf16x8){l2[0], l2[1], l2[2], l2[3], h2[0], h2[1], h2[2], h2[3]}, o[d0], 0, 0, 0);   \
        o[d0] = __builtin_amdgcn_mfma_f32_32x32x16_bf16(pa3, (bf16x8){l3[0], l3[1], l3[2], l3[3], h3[0], h3[1], h3[2], h3[3]}, o[d0], 0, 0, 0); } while (0)
    PV_D0(0); PV_D0(1); PV_D0(2); PV_D0(3);
#undef PV_D0
#undef TRRD
}

struct BlockRef { const bf16_t* Q; const bf16_t* K; const bf16_t* KR; const bf16_t* V; bf16_t* O; const bf16_t* Z; const float* CS; const float* SN; int P0; };
struct Stage { bf16x8 st_v0, st_v1, st_k0, st_k1, st_kr; };
#define VMW() asm volatile("s_waitcnt vmcnt(0)" ::: "memory")
#define SLOAD_H(R, k0) do { const char* kt_ = (const char*)(R).K + (size_t)(k0) * (KVS * 2); const char* kt2_ = kt_ + 32 * KVS * 2; const char* krt_ = (const char*)(R).KR + (size_t)(k0) * (KRS * 2); \
                            S.st_v0 = *(const bf16x8*)(kt_ + koff + 256); S.st_v1 = *(const bf16x8*)(kt2_ + koff + 256);  \
                            S.st_k0 = *(const bf16x8*)(kt_ + koff); S.st_k1 = *(const bf16x8*)(kt2_ + koff);  \
                            S.st_kr = *(const bf16x8*)(krt_ + kroff); } while (0)
#define SWRITE_HK(bf) do { *(bf16x8*)(K_lds + (bf) * SHM_K + kws) = S.st_k0; *(bf16x8*)(K_lds + (bf) * SHM_K + kws + 32 * 384) = S.st_k1; \
                           *(bf16x8*)(K_lds + (bf) * SHM_K + kwr) = S.st_kr; } while (0)
#define SWRITE_HV(bf) do { *(bf16x8*)(V_lds + (bf) * SHM_V + vst0) = S.st_v0; *(bf16x8*)(V_lds + (bf) * SHM_V + vst1) = S.st_v1; } while (0)
#define SWRITE_H(bf) do { SWRITE_HV(bf); SWRITE_HK(bf); } while (0)

__device__ __forceinline__ void rope_q(const BlockRef& cur, const bf16x8* qrp, char* qrl, int wid, int r32, int hi) {
    const int row = wid * QBLK + r32;
    const unsigned toff = (unsigned)((row * 32 + hi * 8) * 4);
    const float* cp = (const float*)((const char*)cur.CS + toff); const float* sp = (const float*)((const char*)cur.SN + toff);
#pragma unroll
    for (int pr = 0; pr < 2; ++pr) {
        const f32x4 c0 = *(const f32x4*)(cp + pr * 16), c1 = *(const f32x4*)(cp + pr * 16 + 4), s0 = *(const f32x4*)(sp + pr * 16), s1 = *(const f32x4*)(sp + pr * 16 + 4);
        const bf16x8 a = qrp[pr], b = qrp[2 + pr];
        f32x4 o1l, o1h, o2l, o2h;
#pragma unroll
        for (int j = 0; j < 4; ++j) {
            float t1 = bf2f((unsigned short)a[j]), t2 = bf2f((unsigned short)b[j]);
            o1l[j] = t1 * c0[j] - t2 * s0[j]; o2l[j] = t2 * c0[j] + t1 * s0[j];
            t1 = bf2f((unsigned short)a[4 + j]); t2 = bf2f((unsigned short)b[4 + j]);
            o1h[j] = t1 * c1[j] - t2 * s1[j]; o2h[j] = t2 * c1[j] + t1 * s1[j];
        }
        *(bf16x8*)(qrl + pr * 1024) = pack8(o1l, o1h); *(bf16x8*)(qrl + (2 + pr) * 1024) = pack8(o2l, o2h);
    }
}
__device__ __forceinline__ void causal_block(const BlockRef& cur, char* lds) {
    int tid = threadIdx.x; asm volatile("" : "+v"(tid));
    const int wid = __builtin_amdgcn_readfirstlane(tid >> 6), lane = tid & 63, r32 = lane & 31, hi = lane >> 5;
    const int NT = (cur.P0 + QB - 1) / KVBLK + 1;
    const int qlo = cur.P0 + wid * QBLK, qm = qlo + r32 - 4 * hi;
    char* V_lds = lds; char* K_lds = lds + 2 * SHM_V;
    float* ws = (float*)(lds + 2 * SHM_V + 2 * SHM_K) + wid * 64; float* li_l = ws, * al_l = ws + 32;
    float m_reg = -1e30f, l_reg = 0; f32x16 o[4] = {};
    const int sr = tid >> 4, sc = (tid & 15) * 8, vst0 = v_st(sr, sc), vst1 = v_st(32 + sr, sc), kws = KSWZ(sr, sc * 2);
    const int krr = tid >> 3, krc = (tid & 7) * 8, kwr = KSWZ(krr, (128 + krc) * 2);
    const int vb0 = (int)(uintptr_t)V_lds + v_rd_base(lane);
    unsigned koff = (unsigned)((sr * KVS + sc) * 2), kroff = (unsigned)((krr * KRS + krc) * 2);
    unsigned qoff = (unsigned)(((wid * QBLK + r32) * QS + hi * 8) * 2);
    asm volatile("" : "+v"(koff), "+v"(kroff), "+v"(qoff));
    Stage S; bf16x8 qr[8]; char* qrl = lds + QR_OFF + wid * 4096 + lane * 16;
    { bf16x8 qrp[4];
#pragma unroll
      for (int d0 = 0; d0 < 8; ++d0) qr[d0] = *(const bf16x8*)((const char*)cur.Q + qoff + d0 * 32);
#pragma unroll
      for (int d0 = 0; d0 < 4; ++d0) qrp[d0] = *(const bf16x8*)((const char*)cur.Q + qoff + (8 + d0) * 32);
      SLOAD_H(cur, 0);
      rope_q(cur, qrp, qrl, wid, r32, hi); }
    VMW(); SWRITE_H(0); SBAR();
    SLOAD_H(cur, KVBLK); SBAR();
    __syncthreads();
#define RESC(a) do { if (__any((a) < 1.f)) { if (hi == 0) al_l[r32] = (a); asm volatile("s_waitcnt lgkmcnt(0)" ::: "memory");              \
                     for (int d_ = 0; d_ < 4; ++d_) for (int r = 0; r < 16; ++r) o[d_][r] *= al_l[crow(r, hi)]; } } while (0)
#define KBASE(t) ((t) * KVBLK)
#define MASKT(P0_, P1_, t) do { const int kb_ = KBASE(t); if (kb_ + KVBLK - 1 > qlo) mask_tile(P0_, P1_, qm - kb_); } while (0)
    f32x16 pA0, pA1, pB0, pB1; float mnA, mnB, alA, alB; bf16x8 pa0, pa1, pa2, pa3;
    qkt<0>(pA0, pA1, K_lds, r32, hi, qr, qrl);
    MASKT(pA0, pA1, 0); partialSM(pA0, pA1, m_reg, mnA, alA);
    VMW(); SWRITE_H(1);
    __syncthreads();
#define HALF_STEP(PX0, PX1, mnX, alX, PY0, PY1, alY, t, KB, VB, SB) do {                                                      \
        SBAR(); qkt<KB>(PX0, PX1, K_lds, r32, hi, qr, qrl);                                                                        \
        finishSM(PY0, PY1, alY, l_reg, pa0, pa1, pa2, pa3); SBAR();                                                           \
        if ((t) + 1 < NT) { SLOAD_H(cur, KBASE((t) + 1)); SBAR(); }                                                           \
        pv_tile<VB>(o, vb0, pa0, pa1, pa2, pa3); MASKT(PX0, PX1, (t)); partialSM(PX0, PX1, m_reg, mnX, alX);                  \
        __syncthreads();                                                                                                      \
        if ((t) + 1 < NT) { VMW(); SWRITE_H(SB); }                                                                            \
        RESC(alX); __syncthreads(); } while (0)
    for (int t = 1; t + 1 < NT; t += 2) {
        HALF_STEP(pB0, pB1, mnB, alB, pA0, pA1, alA, t, 1, 0, 0);
        HALF_STEP(pA0, pA1, mnA, alA, pB0, pB1, alB, t + 1, 0, 1, 1);
    }
    SBAR(); qkt<1>(pB0, pB1, K_lds, r32, hi, qr, qrl); SBAR();
    finishSM(pA0, pA1, alA, l_reg, pa0, pa1, pa2, pa3); SBAR();
    pv_tile<0>(o, vb0, pa0, pa1, pa2, pa3);
    MASKT(pB0, pB1, NT - 1); partialSM(pB0, pB1, m_reg, mnB, alB); __syncthreads(); RESC(alB);
    finishSM(pB0, pB1, alB, l_reg, pa0, pa1, pa2, pa3); SBAR(); pv_tile<1>(o, vb0, pa0, pa1, pa2, pa3);
    SBAR();
    if (hi == 0) li_l[r32] = l_reg;
    __syncthreads();
    {
        char* ot = lds + wid * (32 * 272);
        const int wb = 4 * hi * 272 + r32 * 2;
#pragma unroll
        for (int rg = 0; rg < 4; ++rg) {
            const f32x4 lv = *(const f32x4*)(li_l + 8 * rg + 4 * hi);
#pragma unroll
            for (int j = 0; j < 4; ++j) { const int r = rg * 4 + j; const float rl = __builtin_amdgcn_rcpf(lv[j]);
#pragma unroll
                for (int d0 = 0; d0 < 4; ++d0) *(bf16_t*)(ot + wb + (j + 8 * rg) * 272 + d0 * 64) = f2bf(o[d0][r] * rl); }
        }
        asm volatile("s_waitcnt lgkmcnt(0)" ::: "memory");
        const int rr = lane >> 4, c8 = (lane & 15) * 8;
        const unsigned zoff = (unsigned)(((wid * QBLK + rr) * ZS + c8) * 2), ooff = (unsigned)(((wid * QBLK + rr) * OS + c8) * 2);
#pragma unroll
        for (int i = 0; i < 8; ++i) {
            const bf16x8 ov = *(const bf16x8*)(ot + (i * 4 + rr) * 272 + c8 * 2);
            const bf16x8 zv = *(const bf16x8*)((const char*)cur.Z + (size_t)(i * 4 * ZS * 2) + zoff);
            f32x4 a, b;
#pragma unroll
            for (int j = 0; j < 4; ++j) { a[j] = bf2f((unsigned short)ov[j]) * bf2f((unsigned short)zv[j]); b[j] = bf2f((unsigned short)ov[4 + j]) * bf2f((unsigned short)zv[4 + j]); }
            *(bf16x8*)((char*)cur.O + (size_t)(i * 4 * OS * 2) + ooff) = pack8(a, b);
        }
    }
    __syncthreads();
#undef RESC
#undef KBASE
#undef MASKT
#undef HALF_STEP
}
#undef VMW
#undef SLOAD_H
#undef SWRITE_HK
#undef SWRITE_HV
#undef SWRITE_H

struct Item { int bh, qb0, qb1; };
constexpr int NQB = SEQ / QB, NX = NQB / 2, NBH = 64, TOTAL = NX * NBH;
__device__ __forceinline__ Item decode(int L) {
    Item it; const int xcd = L & 7, k = L >> 3, gi = k / NX, r = k - gi * NX;
    it.bh = gi * 8 + xcd; it.qb0 = r; it.qb1 = NQB - 1 - r; return it;
}
struct Tensors { const bf16_t* q; const bf16_t* kv; const bf16_t* krot; bf16_t* og; const bf16_t* proj0; const float* cs; const float* sn; };
__device__ __forceinline__ BlockRef mkref(const Item& it, int pass, const Tensors& T) {
    const int qb = pass ? it.qb1 : it.qb0, b = it.bh >> 5, h = it.bh & 31;
    const size_t tok0 = (size_t)b * SEQ, row0 = tok0 + (size_t)qb * QB;
    BlockRef r;
    r.Q = T.q + row0 * QS + h * DQ; r.K = T.kv + tok0 * KVS + h * 256; r.V = r.K + 128; r.KR = T.krot + tok0 * KRS;
    r.O = T.og + row0 * OS + h * DV; r.Z = T.proj0 + row0 * ZS + 1600 + h * DV; r.CS = T.cs + row0 * 32; r.SN = T.sn + row0 * 32; r.P0 = qb * QB;
    return r;
}
__device__ __forceinline__ void attn_phase(char* lds, const Tensors& T) {
#ifndef PROBE_ATTDUP
#define PROBE_ATTDUP 0
#endif
    for (int i = 0; ; ++i) {
        const int L = blockIdx.x + (i >> PROBE_ATTDUP) * gridDim.x; if (L >= TOTAL) break;
        const Item it = decode(L);
#pragma unroll 1
        for (int pass = 0; pass < 2; ++pass) { const BlockRef cur = mkref(it, pass, T); causal_block(cur, lds); }
    }
}
}
__device__ __forceinline__ void wt_phase(const float* __restrict__ W, int K, int N, const float* __restrict__ scale, bf16_t* __restrict__ out, char* lds) {
    int tid = threadIdx.x; asm volatile("" : "+v"(tid));
    const int lane = tid & 63, wv = tid >> 6, gw = blockIdx.x * 8 + wv, nw = gridDim.x * 8;
    char* img = lds + wv * 8192;
    const int kr = lane >> 4, nq = lane & 15, ntn = N / 64, ntiles = ntn * (K / 64);
    for (int t = gw; t < ntiles; t += nw) {
        const int kb = (t / ntn) * 64, nb = (t % ntn) * 64;
        const float* src = W + (size_t)(kb + kr * 16) * N + nb + nq * 4;
        f32x4 v[16];
#pragma unroll
        for (int i = 0; i < 16; ++i) v[i] = *(const f32x4*)(src + (size_t)i * N);
        if (scale) {
            const float* sp = scale + kb + kr * 16;
#pragma unroll
            for (int i = 0; i < 16; i += 4) { const f32x4 sc = *(const f32x4*)(sp + i); v[i] *= sc[0]; v[i + 1] *= sc[1]; v[i + 2] *= sc[2]; v[i + 3] *= sc[3]; }
        }
#pragma unroll
        for (int j = 0; j < 4; ++j) {
            const int n = nq * 4 + j;
#pragma unroll
            for (int hf = 0; hf < 2; ++hf) {
                const f32x4 a = {v[hf * 8 + 0][j], v[hf * 8 + 1][j], v[hf * 8 + 2][j], v[hf * 8 + 3][j]}, b = {v[hf * 8 + 4][j], v[hf * 8 + 5][j], v[hf * 8 + 6][j], v[hf * 8 + 7][j]};
                *(bf16x8*)(img + n * 128 + (((kr * 2 + hf) ^ (nq & 7)) * 16)) = pack8(a, b);
            }
        }
#pragma unroll
        for (int i = 0; i < 8; ++i) {
            const int n = i * 8 + (lane >> 3), kc = lane & 7;
            const bf16x8 r = *(const bf16x8*)(img + n * 128 + ((kc ^ ((n >> 2) & 7)) * 16));
            *(bf16x8*)(out + (size_t)(nb + n) * K + kb + kc * 8) = r;
        }
    }
}
__device__ __forceinline__ void cast_rstd_phase(const float* __restrict__ src, bf16_t* __restrict__ dst, float* __restrict__ rstd) {
    const int lane = threadIdx.x & 63, gw = blockIdx.x * 8 + (threadIdx.x >> 6), nw = gridDim.x * 8;
    for (int row = gw; row < T_TOK; row += nw) {
        const float* s = src + (size_t)row * DM; bf16_t* d = dst + (size_t)row * DM; float ss = 0.f;
#pragma unroll
        for (int i = 0; i < 8; ++i) { const int c = (i * 64 + lane) * 8; const f32x4 a = *(const f32x4*)(s + c), b = *(const f32x4*)(s + c + 4);
            ss += a[0] * a[0] + a[1] * a[1] + a[2] * a[2] + a[3] * a[3] + b[0] * b[0] + b[1] * b[1] + b[2] * b[2] + b[3] * b[3];
            *(bf16x8*)(d + c) = pack8(a, b); }
        ss = wave_sum(ss);
        if (lane == 0) rstd[row] = 1.0f / sqrtf(ss * (1.0f / DM) + EPS);
    }
}
__device__ __forceinline__ void final_norm_phase(const float* __restrict__ src, size_t lds_, float* __restrict__ dst, const float* __restrict__ w) {
    const int lane = threadIdx.x & 63, gw = blockIdx.x * 8 + (threadIdx.x >> 6), nw = gridDim.x * 8;
    for (int row = gw; row < T_TOK; row += nw) {
        const float* s = src + (size_t)row * lds_; float* d = dst + (size_t)row * DM; f32x4 v[16]; float ss = 0.f;
#pragma unroll
        for (int i = 0; i < 16; ++i) { v[i] = *(const f32x4*)(s + (i * 64 + lane) * 4); ss += v[i][0] * v[i][0] + v[i][1] * v[i][1] + v[i][2] * v[i][2] + v[i][3] * v[i][3]; }
        ss = wave_sum(ss);
        const float r = 1.0f / sqrtf(ss * (1.0f / DM) + EPS);
#pragma unroll
        for (int i = 0; i < 16; ++i) { const f32x4 g = *(const f32x4*)(w + (i * 64 + lane) * 4); *(f32x4*)(d + (i * 64 + lane) * 4) = v[i] * r * g; }
    }
}
__device__ __forceinline__ void final_norm_bf16_phase(const bf16_t* __restrict__ src, size_t lds_, const float* __restrict__ ssq, float* __restrict__ dst, const float* __restrict__ w) {
    const int lane = threadIdx.x & 63, gw = blockIdx.x * 8 + (threadIdx.x >> 6), nw = gridDim.x * 8;
    for (int row = gw; row < T_TOK; row += nw) {
        const bf16_t* s = src + (size_t)row * lds_; float* d = dst + (size_t)row * DM;
        const float r = 1.0f / sqrtf(ssq[row] * (1.0f / DM) + EPS);
        bf16x8 v[8];
#pragma unroll
        for (int i = 0; i < 8; ++i) v[i] = *(const bf16x8*)(s + (i * 64 + lane) * 8);
#pragma unroll
        for (int i = 0; i < 8; ++i) { const int c = (i * 64 + lane) * 8; const f32x4 g0 = *(const f32x4*)(w + c), g1 = *(const f32x4*)(w + c + 4); f32x4 a, b;
#pragma unroll
            for (int j = 0; j < 4; ++j) { a[j] = bf2f((unsigned short)v[i][j]) * r * g0[j]; b[j] = bf2f((unsigned short)v[i][4 + j]) * r * g1[j]; }
            *(f32x4*)(d + c) = a; *(f32x4*)(d + c + 4) = b; }
    }
}
__device__ __forceinline__ void tables_phase(const Params& p, float* cs, float* sn, float* lb) {
    const int gt = blockIdx.x * blockDim.x + threadIdx.x, nt = gridDim.x * blockDim.x;
    for (int i = gt; i < T_TOK * 32; i += nt) {
        const int tok = i >> 5, j = i & 31;
        const float ang = (float)p.pos[tok] * p.inv_freq[j];
        const double rev = (double)ang * 0.15915494309189535; const float fr = (float)(rev - rint(rev));
        cs[i] = __builtin_amdgcn_cosf(fr); sn[i] = __builtin_amdgcn_sinf(fr);
    }
    for (int i = gt; i < 4096; i += nt) { const float l0 = p.lower_bounds[i], l1 = p.lower_bounds[4096 + i]; lb[i] = 1.0f / (1.0f + expf(l0 - l1)); }
}
__device__ __forceinline__ void stats_krot_phase(const bf16_t* __restrict__ proj0, float* __restrict__ rq, float* __restrict__ rkv, const float* __restrict__ cs, const float* __restrict__ sn, bf16_t* __restrict__ krot) {
    const int lane = threadIdx.x & 63, gw = blockIdx.x * 8 + (threadIdx.x >> 6), nw = gridDim.x * 8;
    for (int row = gw; row < T_TOK; row += nw) {
        const bf16_t* s = proj0 + (size_t)row * N0P;
        const bf16x8 a = *(const bf16x8*)(s + lane * 8), b = *(const bf16x8*)(s + 512 + lane * 8), c = *(const bf16x8*)(s + 1024 + lane * 8);
        float sq = 0.f, sk = 0.f;
#pragma unroll
        for (int j = 0; j < 8; ++j) { const float x = bf2f((unsigned short)a[j]), y = bf2f((unsigned short)b[j]), z = bf2f((unsigned short)c[j]); sq += x * x + y * y; sk += z * z; }
        sq = wave_sum(sq); sk = wave_sum(sk);
        if (lane == 0) { rq[row] = 1.0f / sqrtf(sq * (1.0f / 1024.0f) + EPS); rkv[row] = 1.0f / sqrtf(sk * (1.0f / 512.0f) + EPS); }
        if (lane < 32) { const float t1 = bf2f(s[1536 + lane]), t2 = bf2f(s[1568 + lane]); const float cc = cs[(size_t)row * 32 + lane], sv = sn[(size_t)row * 32 + lane];
            krot[(size_t)row * 64 + lane] = f2bf(t1 * cc - t2 * sv); krot[(size_t)row * 64 + 32 + lane] = f2bf(t2 * cc + t1 * sv); }
    }
}
__device__ __forceinline__ void headnorm_phase(bf16_t* __restrict__ proj1, const bf16_t* __restrict__ oraw, const float* __restrict__ gn) {
    int tid = threadIdx.x; asm volatile("" : "+v"(tid));
    const int per = T_TOK / gridDim.x;
    const int h = tid >> 4, vs = (tid & 15) >> 2, c8 = (tid & 3) * 8;
    const int v0 = (tid & 15) * 8; const f32x4 g0 = *(const f32x4*)(gn + v0), g1 = *(const f32x4*)(gn + v0 + 4);
    for (int tok0 = blockIdx.x * per; tok0 < (blockIdx.x + 1) * per; tok0 += 4) {
        bf16x8 o[4], z[4];
#pragma unroll
        for (int u = 0; u < 4; ++u) { const int tok = tok0 + u, b = tok >> 13, sq = tok & (SEQ - 1);
            o[u] = *(const bf16x8*)(oraw + ((size_t)((b * 32 + h) * 4 + vs) * SEQ + sq) * 32 + c8); z[u] = *(const bf16x8*)(proj1 + (size_t)tok * N1 + 12288 + tid * 8); }
#pragma unroll
        for (int u = 0; u < 4; ++u) {
            float f[8], ss = 0.f;
#pragma unroll
            for (int j = 0; j < 8; ++j) { f[j] = bf2f((unsigned short)o[u][j]); ss += f[j] * f[j]; }
            ss += __shfl_xor(ss, 1); ss += __shfl_xor(ss, 2); ss += __shfl_xor(ss, 4); ss += __shfl_xor(ss, 8);
            const float r = 1.0f / sqrtf(ss * (1.0f / 128.0f) + EPS);
            f32x4 a, bb;
#pragma unroll
            for (int j = 0; j < 4; ++j) { a[j] = f[j] * r * g0[j] * bf2f((unsigned short)z[u][j]); bb[j] = f[4 + j] * r * g1[j] * bf2f((unsigned short)z[u][4 + j]); }
            *(bf16x8*)(proj1 + (size_t)(tok0 + u) * N1 + 8192 + tid * 8) = pack8(a, bb);
        }
    }
}

namespace hg {
constexpr int QT_S = 272, KD_S = 144;
constexpr int OFF_QT = 0, OFF_KT = OFF_QT + 64 * QT_S, OFF_QB = OFF_KT + 64 * QT_S, OFF_KD = OFF_QB + 64 * QT_S;
constexpr int OFF_VT = OFF_KD + 128 * KD_S, OFF_ST = OFF_VT + 32 * KD_S, OFF_ATT = OFF_ST + 32 * QT_S;
constexpr int OFF_SEG = OFF_ATT + 64 * KD_S, OFF_G32 = OFF_SEG + 2048, OFF_DEC = OFF_G32 + 512, LDS_BYTES = OFF_DEC + 512;
__device__ __forceinline__ int crow(int r, int hi) { return (r & 3) + 8 * (r >> 2) + 4 * hi; }

__device__ __forceinline__ void hgrn2_phase(char* lds, const bf16_t* __restrict__ proj1, bf16_t* __restrict__ oraw) {
    int tid = threadIdx.x; asm volatile("" : "+v"(tid));
    const int wid = __builtin_amdgcn_readfirstlane(tid >> 6), lane = tid & 63, r32 = lane & 31, hi = lane >> 5;
    const int kch = tid & 127, seg = tid >> 7;
    float* segtot = (float*)(lds + OFF_SEG); float* g32s = (float*)(lds + OFF_G32); float* decay = (float*)(lds + OFF_DEC);
    for (int item = blockIdx.x; item < 256; item += gridDim.x) {
        const int vs = item & 3, bh = item >> 2, b = bh >> 5, h = bh & 31;
        const bf16_t* base = proj1 + (size_t)b * SEQ * N1; bf16_t* ob = oraw + (size_t)item * SEQ * 32;
        const int qcol = h * 128 + kch, gcol = 4096 + h * 128 + kch, vcol = 8192 + h * 128 + vs * 32;
        f32x16 sacc = {};
        for (int i = tid; i < 32 * QT_S / 4; i += 512) ((unsigned*)(lds + OFF_ST))[i] = 0u;
        unsigned short graw[16], qraw[16]; u32x2 vraw;
        { const bf16_t* rp = base + (size_t)(seg * 16) * N1;
#pragma unroll
          for (int i = 0; i < 16; ++i) { graw[i] = rp[(size_t)i * N1 + gcol]; qraw[i] = rp[(size_t)i * N1 + qcol]; }
          vraw = *(const u32x2*)(base + (size_t)(tid >> 3) * N1 + vcol + (tid & 7) * 4); }
        for (int ch = 0; ch < 128; ++ch) {
            const int tok0 = ch * 64;
            float gl[16]; float cum = 0.f;
#pragma unroll
            for (int i = 0; i < 16; ++i) { cum += bf2f(graw[i]); gl[i] = cum; }
            segtot[seg * 128 + kch] = cum; if (seg == 2) g32s[kch] = bf2f(graw[0]);
            __syncthreads();
            { const float s0 = segtot[kch], s1 = segtot[128 + kch], s2 = segtot[256 + kch], s3 = segtot[384 + kch];
              const float off = (seg > 0 ? s0 : 0.f) + (seg > 1 ? s1 : 0.f) + (seg > 2 ? s2 : 0.f);
              const float tot = (s0 + s1) + (s2 + s3), bref = s0 + s1 + g32s[kch];
              if (seg == 0) decay[kch] = fast_exp(tot);
              float kd[16];
#pragma unroll
              for (int i = 0; i < 16; ++i) { const int t = seg * 16 + i; const float bb = off + gl[i], gv = bf2f(graw[i]), qv = bf2f(qraw[i]); const float kk = 1.0f - fast_exp(gv);
                  *(bf16_t*)(lds + OFF_QT + t * QT_S + kch * 2) = f2bf_n(qv * fast_exp(bb - bref));
                  *(bf16_t*)(lds + OFF_KT + t * QT_S + kch * 2) = f2bf_n(kk * fast_exp(bref - bb));
                  *(bf16_t*)(lds + OFF_QB + t * QT_S + kch * 2) = f2bf_n(qv * fast_exp(bb));
                  kd[i] = kk * fast_exp(tot - bb); }
              *(bf16x8*)(lds + OFF_KD + kch * KD_S + seg * 32) = pack8((f32x4){kd[0], kd[1], kd[2], kd[3]}, (f32x4){kd[4], kd[5], kd[6], kd[7]});
              *(bf16x8*)(lds + OFF_KD + kch * KD_S + seg * 32 + 16) = pack8((f32x4){kd[8], kd[9], kd[10], kd[11]}, (f32x4){kd[12], kd[13], kd[14], kd[15]});
              { const int t = tid >> 3, v4 = (tid & 7) * 4;
                *(bf16_t*)(lds + OFF_VT + (v4 + 0) * KD_S + t * 2) = (bf16_t)(vraw.x & 0xffffu); *(bf16_t*)(lds + OFF_VT + (v4 + 1) * KD_S + t * 2) = (bf16_t)(vraw.x >> 16);
                *(bf16_t*)(lds + OFF_VT + (v4 + 2) * KD_S + t * 2) = (bf16_t)(vraw.y & 0xffffu); *(bf16_t*)(lds + OFF_VT + (v4 + 3) * KD_S + t * 2) = (bf16_t)(vraw.y >> 16); }
            }
            if (ch + 1 < 128) { const bf16_t* rp = base + (size_t)(tok0 + 64 + seg * 16) * N1;
#pragma unroll
                for (int i = 0; i < 16; ++i) { graw[i] = rp[(size_t)i * N1 + gcol]; qraw[i] = rp[(size_t)i * N1 + qcol]; }
                vraw = *(const u32x2*)(base + (size_t)(tok0 + 64 + (tid >> 3)) * N1 + vcol + (tid & 7) * 4); }
            __syncthreads();
            f32x16 oacc = {};
            if (wid < 4) {
                const int ci = wid >> 1, si = wid & 1;
                if (!(ci == 0 && si == 1)) {
                    f32x16 aacc = {};
#pragma unroll
                    for (int kk = 0; kk < 8; ++kk) {
                        const bf16x8 af = *(const bf16x8*)(lds + OFF_QT + (32 * ci + r32) * QT_S + kk * 32 + hi * 16);
                        const bf16x8 bfr = *(const bf16x8*)(lds + OFF_KT + (32 * si + r32) * QT_S + kk * 32 + hi * 16);
                        aacc = __builtin_amdgcn_mfma_f32_32x32x16_bf16(af, bfr, aacc, 0, 0, 0); }
#pragma unroll
                    for (int i = 0; i < 16; ++i) { const int c = 32 * ci + crow(i, hi), s = 32 * si + r32; const float v = (c >= s) ? aacc[i] : 0.f;
                        *(bf16_t*)(lds + OFF_ATT + c * KD_S + s * 2) = f2bf_n(v); }
                } else {
#pragma unroll
                    for (int i = 0; i < 16; ++i) { const int c = crow(i, hi), s = 32 + r32; *(bf16_t*)(lds + OFF_ATT + c * KD_S + s * 2) = (bf16_t)0; }
                }
#pragma unroll
                for (int g4 = 0; g4 < 4; ++g4) { const f32x4 d = *(const f32x4*)(decay + 32 * wid + 8 * g4 + 4 * hi);
#pragma unroll
                    for (int j = 0; j < 4; ++j) sacc[g4 * 4 + j] *= d[j]; }
#pragma unroll
                for (int kk = 0; kk < 4; ++kk) {
                    const bf16x8 af = *(const bf16x8*)(lds + OFF_KD + (32 * wid + r32) * KD_S + kk * 32 + hi * 16);
                    const bf16x8 bfr = *(const bf16x8*)(lds + OFF_VT + r32 * KD_S + kk * 32 + hi * 16);
                    sacc = __builtin_amdgcn_mfma_f32_32x32x16_bf16(af, bfr, sacc, 0, 0, 0); }
            } else if (wid < 6) {
                const int ci = wid - 4;
#pragma unroll
                for (int kk = 0; kk < 8; ++kk) {
                    const bf16x8 af = *(const bf16x8*)(lds + OFF_QB + (32 * ci + r32) * QT_S + kk * 32 + hi * 16);
                    const bf16x8 bfr = *(const bf16x8*)(lds + OFF_ST + r32 * QT_S + kk * 32 + hi * 16);
                    oacc = __builtin_amdgcn_mfma_f32_32x32x16_bf16(af, bfr, oacc, 0, 0, 0); }
            }
            __syncthreads();
            if (wid < 4) {
#pragma unroll
                for (int g4 = 0; g4 < 4; ++g4) { u32x2 w; w.x = cvtpk_n(sacc[g4 * 4 + 0], sacc[g4 * 4 + 1]); w.y = cvtpk_n(sacc[g4 * 4 + 2], sacc[g4 * 4 + 3]);
                    *(u32x2*)(lds + OFF_ST + r32 * QT_S + (32 * wid + 8 * g4 + 4 * hi) * 2) = w; }
            } else if (wid < 6) {
                const int ci = wid - 4;
#pragma unroll
                for (int kk = 0; kk < 4; ++kk) {
                    const bf16x8 af = *(const bf16x8*)(lds + OFF_ATT + (32 * ci + r32) * KD_S + kk * 32 + hi * 16);
                    const bf16x8 bfr = *(const bf16x8*)(lds + OFF_VT + r32 * KD_S + kk * 32 + hi * 16);
                    oacc = __builtin_amdgcn_mfma_f32_32x32x16_bf16(af, bfr, oacc, 0, 0, 0); }
#pragma unroll
                for (int i = 0; i < 16; ++i) { const int c = 32 * ci + crow(i, hi); ob[(size_t)(tok0 + c) * 32 + r32] = f2bf_n(oacc[i]); }
            }
        }
        __syncthreads();
    }
}
}
namespace hg2 {
#define LBAR() do { asm volatile("s_waitcnt lgkmcnt(0)" ::: "memory"); __builtin_amdgcn_s_barrier(); asm volatile("" ::: "memory"); } while (0)
constexpr int QT_S = 272, KD_S = 144;
constexpr int OFF_QT = 0, OFF_KT = OFF_QT + 64 * QT_S, OFF_QB = OFF_KT + 64 * QT_S, OFF_KD = OFF_QB + 64 * QT_S;
constexpr int OFF_VT4 = OFF_KD + 128 * KD_S, OFF_ATT = OFF_VT4 + 128 * KD_S;
constexpr int OFF_SEG = OFF_ATT + 64 * KD_S, OFF_G32 = OFF_SEG + 2048, OFF_DEC = OFF_G32 + 512, LDS_BYTES = OFF_DEC + 512;
constexpr int ST_BYTES = 32 * QT_S;
__device__ __forceinline__ int crow(int r, int hi) { return (r & 3) + 8 * (r >> 2) + 4 * hi; }

__device__ __forceinline__ void prepass(char* lds, bf16_t* __restrict__ proj1, char* __restrict__ attbuf, float* __restrict__ decbuf) {
    int tid = threadIdx.x; asm volatile("" : "+v"(tid));
    const int wid = __builtin_amdgcn_readfirstlane(tid >> 6), lane = tid & 63, r32 = lane & 31, hi = lane >> 5;
    const int kch = tid & 127, seg = tid >> 7;
    float* segtot = (float*)(lds + OFF_SEG); float* g32s = (float*)(lds + OFF_G32); float* decay = (float*)(lds + OFF_DEC);
    unsigned short graw[16], qraw[16]; bf16x8 vr0, vr1;
#define PRE_LOAD(it_) do { const int bh_ = (it_) >> 7, ch_ = (it_) & 127, b_ = bh_ >> 5, h_ = bh_ & 31;                                   \
        const bf16_t* bs_ = proj1 + ((size_t)b_ * SEQ + ch_ * 64) * N1; const bf16_t* rp_ = bs_ + (size_t)(seg * 16) * N1 + h_ * 128 + kch; \
        _Pragma("unroll") for (int i = 0; i < 16; ++i) { graw[i] = rp_[(size_t)i * N1 + 4096]; qraw[i] = rp_[(size_t)i * N1]; }                \
        const bf16_t* vp_ = bs_ + (size_t)(tid & 63) * N1 + 8192 + h_ * 128 + (tid >> 6) * 16;                                                \
        vr0 = *(const bf16x8*)vp_; vr1 = *(const bf16x8*)(vp_ + 8); } while (0)
    if (blockIdx.x < 8192) PRE_LOAD(blockIdx.x);
    for (int item = blockIdx.x; item < 8192; item += gridDim.x) {
        const int bh = item >> 7, ch = item & 127, b = bh >> 5, h = bh & 31;
        bf16_t* base = proj1 + ((size_t)b * SEQ + ch * 64) * N1;
        const int qcol = h * 128, gcol = 4096 + h * 128, vcol = 8192 + h * 128;
        float gl[16]; float cum = 0.f;
#pragma unroll
        for (int i = 0; i < 16; ++i) { cum += bf2f(graw[i]); gl[i] = cum; }
        segtot[seg * 128 + kch] = cum; if (seg == 2) g32s[kch] = bf2f(graw[0]);
        LBAR();
        { const float s0 = segtot[kch], s1 = segtot[128 + kch], s2 = segtot[256 + kch], s3 = segtot[384 + kch];
          const float off = (seg > 0 ? s0 : 0.f) + (seg > 1 ? s1 : 0.f) + (seg > 2 ? s2 : 0.f);
          const float tot = (s0 + s1) + (s2 + s3), bref = s0 + s1 + g32s[kch];
          if (seg == 0) decay[kch] = fast_exp(tot);
          float kd[16];
#pragma unroll
          for (int i = 0; i < 16; ++i) { const int t = seg * 16 + i; const float bb = off + gl[i], gv = bf2f(graw[i]), qv = bf2f(qraw[i]); const float kk = 1.0f - fast_exp(gv);
              *(bf16_t*)(lds + OFF_QT + t * QT_S + kch * 2) = f2bf_n(qv * fast_exp(bb - bref));
              *(bf16_t*)(lds + OFF_KT + t * QT_S + kch * 2) = f2bf_n(kk * fast_exp(bref - bb));
              *(bf16_t*)(lds + OFF_QB + t * QT_S + kch * 2) = f2bf_n(qv * fast_exp(bb));
              kd[i] = kk * fast_exp(tot - bb); }
          *(bf16x8*)(lds + OFF_KD + kch * KD_S + seg * 32) = pack8((f32x4){kd[0], kd[1], kd[2], kd[3]}, (f32x4){kd[4], kd[5], kd[6], kd[7]});
          *(bf16x8*)(lds + OFF_KD + kch * KD_S + seg * 32 + 16) = pack8((f32x4){kd[8], kd[9], kd[10], kd[11]}, (f32x4){kd[12], kd[13], kd[14], kd[15]});
          { const int t = tid & 63, v16 = (tid >> 6) * 16;
#pragma unroll
            for (int j = 0; j < 8; ++j) { *(bf16_t*)(lds + OFF_VT4 + (v16 + j) * KD_S + t * 2) = (bf16_t)vr0[j]; *(bf16_t*)(lds + OFF_VT4 + (v16 + 8 + j) * KD_S + t * 2) = (bf16_t)vr1[j]; } }
        }
        if (item + (int)gridDim.x < 8192) PRE_LOAD(item + gridDim.x);
        LBAR();
        if (wid < 4) {
            const int ci = wid >> 1, si = wid & 1;
            if (!(ci == 0 && si == 1)) {
                f32x16 aacc = {};
#pragma unroll
                for (int kk = 0; kk < 8; ++kk) {
                    const bf16x8 af = *(const bf16x8*)(lds + OFF_QT + (32 * ci + r32) * QT_S + kk * 32 + hi * 16);
                    const bf16x8 bfr = *(const bf16x8*)(lds + OFF_KT + (32 * si + r32) * QT_S + kk * 32 + hi * 16);
                    aacc = __builtin_amdgcn_mfma_f32_32x32x16_bf16(af, bfr, aacc, 0, 0, 0); }
#pragma unroll
                for (int i = 0; i < 16; ++i) { const int c = 32 * ci + crow(i, hi), s = 32 * si + r32; const float v = (c >= s) ? aacc[i] : 0.f;
                    *(bf16_t*)(lds + OFF_ATT + c * KD_S + s * 2) = f2bf_n(v); }
            } else {
#pragma unroll
                for (int i = 0; i < 16; ++i) { const int c = crow(i, hi), s = 32 + r32; *(bf16_t*)(lds + OFF_ATT + c * KD_S + s * 2) = (bf16_t)0; }
            }
        }
        LBAR();
        { const size_t lrow = (size_t)(lane >> 4) * N1 + (lane & 15) * 8;
#pragma unroll
          for (int e = 0; e < 2; ++e) { const int f = 2 * wid + e;
              { const int ci = f >> 3, kk = f & 7; const bf16x8 fr = *(const bf16x8*)(lds + OFF_QB + (32 * ci + r32) * QT_S + kk * 32 + hi * 16);
                *(bf16x8*)(base + (size_t)(4 * f) * N1 + qcol + lrow) = fr; }
              { const int kt = f >> 2, kk = f & 3; const bf16x8 fr = *(const bf16x8*)(lds + OFF_KD + (32 * kt + r32) * KD_S + kk * 32 + hi * 16);
                *(bf16x8*)(base + (size_t)(4 * f) * N1 + gcol + lrow) = fr; }
              { const int vs = f >> 2, kk = f & 3; const bf16x8 fr = *(const bf16x8*)(lds + OFF_VT4 + (32 * vs + r32) * KD_S + kk * 32 + hi * 16);
                *(bf16x8*)(base + (size_t)(4 * f) * N1 + vcol + lrow) = fr; } }
          { const int f = wid, ci = f >> 2, kk = f & 3; const bf16x8 fr = *(const bf16x8*)(lds + OFF_ATT + (32 * ci + r32) * KD_S + kk * 32 + hi * 16);
            *(bf16x8*)(attbuf + ((size_t)item * 8 + f) * 1024 + lane * 16) = fr; }
          if (tid < 32) *(f32x4*)(decbuf + (size_t)item * 128 + tid * 4) = *(const f32x4*)(decay + tid * 4);
        }
    }
#undef PRE_LOAD
    LBAR();
}

__device__ __forceinline__ void seqpass(char* lds, const bf16_t* __restrict__ proj1, const char* __restrict__ attbuf, const float* __restrict__ decbuf, bf16_t* __restrict__ oraw) {
    int tid = threadIdx.x; asm volatile("" : "+v"(tid));
    const int wid = __builtin_amdgcn_readfirstlane(tid >> 6), lane = tid & 63, r32 = lane & 31, hi = lane >> 5;
    constexpr int OFF_AV = 2 * ST_BYTES;
#ifndef PROBE_SEQDUP
#define PROBE_SEQDUP 0
#endif
    for (int it2 = blockIdx.x; it2 < (1 + PROBE_SEQDUP) * 256; it2 += gridDim.x) {
        const int w_ = it2 & 255;
        const int bh = (w_ & 7) * 8 + (w_ >> 5), vs = (w_ >> 3) & 3, item = bh * 4 + vs, b = bh >> 5, h = bh & 31;
        const char* base0 = (const char*)(proj1 + (size_t)b * SEQ * N1);
        const unsigned lrow = (unsigned)(((lane >> 4) * N1 + (lane & 15) * 8) * 2);
        constexpr size_t CHB = (size_t)64 * N1 * 2, FRB = (size_t)4 * N1 * 2;
        for (int i = tid; i < 2 * ST_BYTES / 4; i += 512) ((unsigned*)lds)[i] = 0u;
        if (wid < 4) {
            f32x16 sacc = {};
            const char* gb = base0 + (size_t)(4096 + h * 128) * 2 + (size_t)(wid * 4) * FRB;
            const char* vb = base0 + (size_t)(8192 + h * 128) * 2 + (size_t)(vs * 4) * FRB;
            const float* db = decbuf + (size_t)bh * 128 * 128 + 32 * wid + 4 * hi;
            bf16x8 K0[4], V0[4], K1[4], V1[4], K2[4], V2[4]; f32x4 D0[4], D1[4], D2[4];
#define ST_LOAD(K_, V_, d_, ch_) do { _Pragma("unroll") for (int kk = 0; kk < 4; ++kk) { K_[kk] = *(const bf16x8*)(gb + (size_t)(ch_) * CHB + kk * FRB + lrow);  \
                                                                                         V_[kk] = *(const bf16x8*)(vb + (size_t)(ch_) * CHB + kk * FRB + lrow);  \
                                                                                         d_[kk] = *(const f32x4*)(db + (size_t)(ch_) * 128 + 8 * kk); } } while (0)
#define ST_STEP(c_, K_, V_, d_, LK_, LV_, Ld_) do { if ((c_) + 2 < 128) ST_LOAD(LK_, LV_, Ld_, (c_) + 2);                                                      \
                char* st_nxt = lds + (((c_) + 1) & 1) * ST_BYTES;                                                                                                \
                _Pragma("unroll") for (int g4 = 0; g4 < 4; ++g4) _Pragma("unroll") for (int j = 0; j < 4; ++j) sacc[g4 * 4 + j] *= d_[g4][j];                    \
                _Pragma("unroll") for (int kk = 0; kk < 4; ++kk) sacc = __builtin_amdgcn_mfma_f32_32x32x16_bf16(K_[kk], V_[kk], sacc, 0, 0, 0);                  \
                _Pragma("unroll") for (int g4 = 0; g4 < 4; ++g4) { u32x2 w; w.x = cvtpk_n(sacc[g4 * 4 + 0], sacc[g4 * 4 + 1]); w.y = cvtpk_n(sacc[g4 * 4 + 2], sacc[g4 * 4 + 3]); \
                    *(u32x2*)(st_nxt + r32 * QT_S + (32 * wid + 8 * g4 + 4 * hi) * 2) = w; }                                                                    \
                LBAR(); } while (0)
            ST_LOAD(K0, V0, D0, 0); ST_LOAD(K1, V1, D1, 1);
            LBAR();
            for (int ch = 0; ch < 126; ch += 3) { ST_STEP(ch, K0, V0, D0, K2, V2, D2); ST_STEP(ch + 1, K1, V1, D1, K0, V0, D0); ST_STEP(ch + 2, K2, V2, D2, K1, V1, D1); }
            ST_STEP(126, K0, V0, D0, K2, V2, D2); ST_STEP(127, K1, V1, D1, K0, V0, D0);
#undef ST_STEP
#undef ST_LOAD
        } else if (wid < 6) {
            const int ci = wid - 4;
            const char* qb = base0 + (size_t)(h * 128) * 2 + (size_t)(ci * 8) * FRB;
            char* ob = (char*)(oraw + (size_t)item * SEQ * 32) + (size_t)(32 * ci) * 64;
            const unsigned ooff = (unsigned)((4 * hi * 32 + r32) * 2);
            bf16x8 Q0[8], Q1[8], Q2[8];
#define O_LOAD(Q_, ch_) do { _Pragma("unroll") for (int kk = 0; kk < 8; ++kk) Q_[kk] = *(const bf16x8*)(qb + (size_t)(ch_) * CHB + kk * FRB + lrow); } while (0)
#define O_STEP(c_, Q_, LQ_) do { if ((c_) + 2 < 128) O_LOAD(LQ_, (c_) + 2);                                                                                      \
                const char* st_cur = lds + ((c_) & 1) * ST_BYTES; const char* av = lds + OFF_AV + ((((c_) & 1) * 2 + ci) * 4) * 1024 + lane * 16;               \
                f32x16 oacc;                                                                                                                                     \
                _Pragma("unroll") for (int q = 0; q < 4; ++q) { const f32x4 t4 = *(const f32x4*)(av + q * 1024); oacc[q * 4 + 0] = t4[0]; oacc[q * 4 + 1] = t4[1]; oacc[q * 4 + 2] = t4[2]; oacc[q * 4 + 3] = t4[3]; } \
                _Pragma("unroll") for (int kk = 0; kk < 8; ++kk) { const bf16x8 sf = *(const bf16x8*)(st_cur + r32 * QT_S + kk * 32 + hi * 16);                  \
                    oacc = __builtin_amdgcn_mfma_f32_32x32x16_bf16(Q_[kk], sf, oacc, 0, 0, 0); }                                                                \
                char* oc = ob + (size_t)(c_) * (64 * 64);                                                                                                        \
                _Pragma("unroll") for (int i = 0; i < 16; ++i) *(bf16_t*)(oc + ((i & 3) + 8 * (i >> 2)) * 64 + ooff) = f2bf_n(oacc[i]);                          \
                LBAR(); } while (0)
            O_LOAD(Q0, 0); O_LOAD(Q1, 1);
            LBAR();
            for (int ch = 0; ch < 126; ch += 3) { O_STEP(ch, Q0, Q2); O_STEP(ch + 1, Q1, Q0); O_STEP(ch + 2, Q2, Q1); }
            O_STEP(126, Q0, Q2); O_STEP(127, Q1, Q0);
#undef O_STEP
#undef O_LOAD
        } else {
            const int ci = wid - 6;
            const char* vb = base0 + (size_t)(8192 + h * 128) * 2 + (size_t)(vs * 4) * FRB;
            const char* ab = attbuf + ((size_t)bh * 128 * 8 + ci * 4) * 1024 + lane * 16;
            bf16x8 A0[4], V0[4], A1[4], V1[4], A2[4], V2[4];
#define AV_LOAD(A_, V_, ch_) do { _Pragma("unroll") for (int kk = 0; kk < 4; ++kk) { A_[kk] = *(const bf16x8*)(ab + (size_t)(ch_) * 8192 + kk * 1024);          \
                                                                                     V_[kk] = *(const bf16x8*)(vb + (size_t)(ch_) * CHB + kk * FRB + lrow); } } while (0)
#define AV_DO(A_, V_, slot_) do { f32x16 acc_ = {}; _Pragma("unroll") for (int kk = 0; kk < 4; ++kk) acc_ = __builtin_amdgcn_mfma_f32_32x32x16_bf16(A_[kk], V_[kk], acc_, 0, 0, 0); \
        char* av_ = lds + OFF_AV + ((((slot_) & 1) * 2 + ci) * 4) * 1024 + lane * 16;                                                                                   \
        _Pragma("unroll") for (int q = 0; q < 4; ++q) *(f32x4*)(av_ + q * 1024) = (f32x4){acc_[q * 4 + 0], acc_[q * 4 + 1], acc_[q * 4 + 2], acc_[q * 4 + 3]}; } while (0)
            AV_LOAD(A0, V0, 0); AV_LOAD(A1, V1, 1); AV_LOAD(A2, V2, 2);
            AV_DO(A0, V0, 0);
            LBAR();
#define AV_STEP(c_, A_, V_, LA_, LV_) do { if ((c_) + 3 < 128) AV_LOAD(LA_, LV_, (c_) + 3); if ((c_) + 1 < 128) AV_DO(A_, V_, (c_) + 1); LBAR(); } while (0)
            for (int ch = 0; ch < 126; ch += 3) { AV_STEP(ch, A1, V1, A0, V0); AV_STEP(ch + 1, A2, V2, A1, V1); AV_STEP(ch + 2, A0, V0, A2, V2); }
            AV_STEP(126, A1, V1, A0, V0); AV_STEP(127, A2, V2, A1, V1);
#undef AV_STEP
#undef AV_LOAD
#undef AV_DO
        }
    }
}
#undef LBAR
}
constexpr int LDS_MAIN = pg8::STAGE_BYTES;
constexpr int LDS_TOTAL = LDS_MAIN + 16;
constexpr size_t WS_BAR = WS_END;
static_assert(att::LDS_BYTES <= LDS_MAIN && hg::LDS_BYTES <= LDS_MAIN && hg2::LDS_BYTES <= LDS_MAIN, "lds");
static_assert((size_t)8192 * 8192 + (size_t)8192 * 512 <= WS_W1O, "attbuf/decbuf must fit in the dead weight region");

#ifndef PHMASK
#define PHMASK 0xFFFF
#endif
#define EN(n) (((PHMASK) >> (n)) & 1)
#ifndef SKIP_SEQ
#define SKIP_SEQ 0
#endif
#ifndef SKIP_PRE
#define SKIP_PRE 0
#endif
#ifndef PROBE_DUP7
#define PROBE_DUP7 0
#endif

__global__ void __launch_bounds__(512) mla_hgrn2_fwd(Params p) {
    extern __shared__ __attribute__((aligned(16))) unsigned char lds[];
    cg::grid_group grid = cg::this_grid();
    unsigned char* ws = p.ws;
    bf16_t* W0IN = (bf16_t*)(ws + WS_W0IN); bf16_t* WUQ = (bf16_t*)(ws + WS_WUQ); bf16_t* WUKV = (bf16_t*)(ws + WS_WUKV);
    bf16_t* W0O = (bf16_t*)(ws + WS_W0O); bf16_t* W1IN = (bf16_t*)(ws + WS_W1IN); bf16_t* W1O = (bf16_t*)(ws + WS_W1O);
    float* RSTD0 = (float*)(ws + WS_RSTD0); float* RSTDQ = (float*)(ws + WS_RSTDQ); float* RSTDKV = (float*)(ws + WS_RSTDKV); float* RSTD1 = (float*)(ws + WS_RSTD1);
    float* LB = (float*)(ws + WS_LB); float* COS = (float*)(ws + WS_COS); float* SIN = (float*)(ws + WS_SIN);
    bf16_t* KROT = (bf16_t*)(ws + WS_KROT); bf16_t* ACTA = (bf16_t*)(ws + WS_ACTA);
    bf16_t* PROJ0 = (bf16_t*)(ws + WS_PROJ0); bf16_t* QBUF = (bf16_t*)(ws + WS_Q); bf16_t* PROJ1 = (bf16_t*)(ws + WS_PROJ1);
    bf16_t* X1B = (bf16_t*)p.out;
    bf16_t* KVBUF = (bf16_t*)p.out;
    LAS unsigned char* ldsl = (LAS unsigned char*)lds;
    const int G = gridDim.x, c = blockIdx.x;
    volatile LAS unsigned* bst = (volatile LAS unsigned*)(ldsl + LDS_MAIN);
    if (threadIdx.x == 0) { bst[0] = 0u; bst[1] = 0u; bst[2] = 0u; bst[3] = 0u; }
    __syncthreads();
    const XcdBarrier xbar = xcd_barrier_post((unsigned*)(ws + WS_BAR), bst);
#define GRID_BAR() xcd_barrier(xbar)

    if (EN(0))
    {
        char* tile = (char*)lds;
        wt_phase(p.l0_w_in, 4096, N0, p.l0_norm, W0IN, tile);
        wt_phase(p.l0_w_uq, 1024, NQ, p.l0_q_norm, WUQ, tile);
        wt_phase(p.l0_w_ukv, 512, NKV, p.l0_kv_norm, WUKV, tile);
        wt_phase(p.l0_w_o, 4096, 4096, nullptr, W0O, tile);
        wt_phase(p.l1_w_in, 4096, N1, p.l1_norm, W1IN, tile);
        wt_phase(p.l1_w_o, 4096, 4096, nullptr, W1O, tile);
        { u32x4 z = {0u, 0u, 0u, 0u}; u32x4* pad = (u32x4*)(W0IN + (size_t)N0 * 4096); const int n16 = (N0P - N0) * 4096 * 2 / 16;
          for (int i = c * 512 + threadIdx.x; i < n16; i += G * 512) pad[i] = z; }
        cast_rstd_phase(p.x, ACTA, RSTD0);
        tables_phase(p, COS, SIN, LB);
        for (int i = c * 512 + threadIdx.x; i < T_TOK; i += G * 512) RSTD1[i] = 0.f;
    }
#ifdef PROBE_P02
    {
        char* tile = (char*)lds;
        wt_phase(p.l0_w_in, 4096, N0, p.l0_norm, W0IN, tile);
        wt_phase(p.l0_w_uq, 1024, NQ, p.l0_q_norm, WUQ, tile);
        wt_phase(p.l0_w_ukv, 512, NKV, p.l0_kv_norm, WUKV, tile);
        wt_phase(p.l0_w_o, 4096, 4096, nullptr, W0O, tile);
        wt_phase(p.l1_w_in, 4096, N1, p.l1_norm, W1IN, tile);
        wt_phase(p.l1_w_o, 4096, 4096, nullptr, W1O, tile);
    }
#endif
    grid.sync();
    if (EN(1)) {
        pg8::Gemm g{ACTA, W0IN, T_TOK, N0P, 4096, 4096}; pg8::StaticOrder S; S.init(T_TOK, N0P, G, c);
        pg8::EpiBf16<1> E{PROJ0, N0P, RSTD0, 1600, nullptr};
        pg8::gemm_phase(ldsl, g, S, E);
    }
    GRID_BAR();
    if (EN(2)) stats_krot_phase(PROJ0, RSTDQ, RSTDKV, COS, SIN, KROT);
    GRID_BAR();
    if (EN(3)) {
        pg8::Gemm g{PROJ0, WUQ, T_TOK, NQ, 1024, N0P}; pg8::StaticOrder S; S.init(T_TOK, NQ, G, c);
        pg8::EpiBf16<0> E{QBUF, NQ, RSTDQ, 0, nullptr};
        pg8::gemm_phase(ldsl, g, S, E);
    }
    if (EN(3)) {
        pg8::Gemm g{PROJ0 + 1024, WUKV, T_TOK, NKV, 512, N0P}; pg8::StaticOrder S; S.init(T_TOK, NKV, G, c);
        pg8::EpiBf16<0> E{KVBUF, NKV, RSTDKV, 0, nullptr};
        pg8::gemm_phase(ldsl, g, S, E);
    }
    GRID_BAR();
    if (EN(4)) {
        att::Tensors T{QBUF, KVBUF, KROT, ACTA, PROJ0, COS, SIN};
        att::attn_phase((char*)lds, T);
    }
    GRID_BAR();
    if (EN(5)) {
        for (int i = c * 512 + threadIdx.x; i < T_TOK; i += G * 512) RSTDQ[i] = 0.f;
        pg8::Gemm g{ACTA, W0O, T_TOK, 4096, 4096, 4096}; pg8::StaticOrder S; S.init(T_TOK, 4096, G, c);
        pg8::EpiResBf16Stat E{p.x, X1B, 4096, RSTD1};
        pg8::gemm_phase(ldsl, g, S, E);
    }
    GRID_BAR();
    if (EN(7)) {
        pg8::Gemm g{X1B, W1IN, T_TOK, N1, 4096, 4096}; pg8::StaticOrder S; S.init(T_TOK, N1, G, c, PROBE_DUP7);
        pg8::EpiBf16<2> E{PROJ1, N1, RSTD1, 0, LB, 1};
        pg8::gemm_phase(ldsl, g, S, E);
    }
    GRID_BAR();
#ifdef HG_OLD
    if (EN(8)) hg::hgrn2_phase((char*)lds, PROJ1, ACTA);
#else
    if (EN(8) && !SKIP_PRE) hg2::prepass((char*)lds, PROJ1, (char*)(ws + WS_W0IN), (float*)(ws + WS_W0IN + (size_t)8192 * 8192));
    GRID_BAR();
    if (EN(8) && !SKIP_SEQ) hg2::seqpass((char*)lds, PROJ1, (const char*)(ws + WS_W0IN), (const float*)(ws + WS_W0IN + (size_t)8192 * 8192), ACTA);
#endif
#ifdef PROBE_HG2
    __syncthreads(); hg::hgrn2_phase((char*)lds, PROJ1, ACTA);
#endif
    GRID_BAR();
    if (EN(9)) headnorm_phase(PROJ1, ACTA, p.l1_g_norm);
    GRID_BAR();
    if (EN(10)) {
        pg8::Gemm g{PROJ1 + 8192, W1O, T_TOK, 4096, 4096, N1}; pg8::StaticOrder S; S.init(T_TOK, 4096, G, c);
        pg8::EpiBf16ResBf16Stat E{X1B, 4096, PROJ1, N1, RSTDQ};
        pg8::gemm_phase(ldsl, g, S, E);
    }
    GRID_BAR();
    if (EN(11)) final_norm_bf16_phase(PROJ1, (size_t)N1, RSTDQ, p.out, p.final_norm);
}

extern "C" void kernel_launch(void* const* d_in, const int* in_sizes, int n_in, void* d_out, int out_size, void* d_ws, size_t ws_size, hipStream_t stream) {
    static int grid = 0;
    if (grid == 0) {
        if (n_in != 15 || ws_size < WS_BAR + XCD_BAR_WORDS * sizeof(unsigned)) { fprintf(stderr, "kernel_launch: unexpected inputs (n_in %d, ws %zu, need %zu)\n", n_in, ws_size, (size_t)(WS_BAR + XCD_BAR_WORDS * sizeof(unsigned))); grid = -1; return; }
        int dev = 0, cus = 0, per_cu = 0;
        (void)hipGetDevice(&dev); (void)hipDeviceGetAttribute(&cus, hipDeviceAttributeMultiprocessorCount, dev);
        if (hipFuncSetAttribute((const void*)mla_hgrn2_fwd, hipFuncAttributeMaxDynamicSharedMemorySize, LDS_TOTAL) != hipSuccess) { fprintf(stderr, "kernel_launch: hipFuncSetAttribute failed\n"); grid = -1; return; }
        if (hipOccupancyMaxActiveBlocksPerMultiprocessor(&per_cu, (const void*)mla_hgrn2_fwd, 512, LDS_TOTAL) != hipSuccess || per_cu < 1) { fprintf(stderr, "kernel_launch: occupancy query gave %d\n", per_cu); per_cu = 1; }
        (void)hipGetLastError();
        if (cus <= 0) cus = 256;
        grid = cus * per_cu;
        fprintf(stderr, "kernel_launch: grid %d (cus %d x %d)\n", grid, cus, per_cu);
    }
    if (grid < 0) return;
    Params p{};
    p.x = (const float*)d_in[0]; p.pos = (const int*)d_in[1]; p.l0_norm = (const float*)d_in[2]; p.l0_w_in = (const float*)d_in[3]; p.l0_q_norm = (const float*)d_in[4];
    p.l0_w_uq = (const float*)d_in[5]; p.l0_kv_norm = (const float*)d_in[6]; p.l0_w_ukv = (const float*)d_in[7]; p.l0_w_o = (const float*)d_in[8]; p.l1_norm = (const float*)d_in[9];
    p.l1_w_in = (const float*)d_in[10]; p.l1_g_norm = (const float*)d_in[11]; p.l1_w_o = (const float*)d_in[12]; p.lower_bounds = (const float*)d_in[13]; p.final_norm = (const float*)d_in[14];
    p.out = (float*)d_out; p.ws = (unsigned char*)d_ws;
    for (int j = 0; j < 32; ++j) p.inv_freq[j] = (float)(1.0 / pow(10000.0, (double)(2 * j) / 64.0));
    if (hipMemsetAsync((char*)d_ws + WS_BAR, 0, XCD_BAR_WORDS * sizeof(unsigned), stream) != hipSuccess) { fprintf(stderr, "kernel_launch: memset of the barrier words failed\n"); return; }
    void* args[] = {&p};
    hipError_t e = hipLaunchCooperativeKernel((const void*)mla_hgrn2_fwd, dim3(grid), dim3(512), args, LDS_TOTAL, stream);
    if (e != hipSuccess) fprintf(stderr, "kernel_launch: cooperative launch failed: %s (grid %d)\n", hipGetErrorString(e), grid);
}
```

```cpp
#include <hip/hip_runtime.h>
#include <hip/hip_cooperative_groups.h>
#include <cstdio>
#include <cstdint>
#include <cmath>
namespace cg = cooperative_groups;

typedef unsigned short bf16_t;
typedef short bf16x8 __attribute__((ext_vector_type(8)));
typedef short s16x4 __attribute__((ext_vector_type(4)));
typedef float f32x4 __attribute__((ext_vector_type(4)));
typedef float f32x16 __attribute__((ext_vector_type(16)));
typedef unsigned u32x4 __attribute__((ext_vector_type(4)));
typedef unsigned u32x2 __attribute__((ext_vector_type(2)));
#define LAS __attribute__((address_space(3)))

constexpr int T_TOK = 16384, SEQ = 8192, DM = 4096;
constexpr int N0 = 5696, N0P = 5888;
constexpr int NQ = 6144, NKV = 8192, N1 = 16384;
constexpr float EPS = 1e-6f;

constexpr size_t WS_W0IN = 0;
constexpr size_t WS_WUQ  = WS_W0IN + (size_t)N0P * 4096 * 2;
constexpr size_t WS_WUKV = WS_WUQ + (size_t)NQ * 1024 * 2;
constexpr size_t WS_W0O  = WS_WUKV + (size_t)NKV * 512 * 2;
constexpr size_t WS_W1IN = WS_W0O + (size_t)4096 * 4096 * 2;
constexpr size_t WS_W1O  = WS_W1IN + (size_t)N1 * 4096 * 2;
constexpr size_t WS_RSTD0 = WS_W1O + (size_t)4096 * 4096 * 2;
constexpr size_t WS_RSTDQ = WS_RSTD0 + 65536;
constexpr size_t WS_RSTDKV = WS_RSTDQ + 65536;
constexpr size_t WS_RSTD1 = WS_RSTDKV + 65536;
constexpr size_t WS_LB = WS_RSTD1 + 65536;
constexpr size_t WS_COS = WS_LB + 16384;
constexpr size_t WS_SIN = WS_COS + (size_t)T_TOK * 32 * 4;
constexpr size_t WS_KROT = WS_SIN + (size_t)T_TOK * 32 * 4;
constexpr size_t WS_ACTA = WS_KROT + (size_t)T_TOK * 64 * 2;
constexpr size_t WS_R = WS_ACTA + (size_t)T_TOK * 4096 * 2;
constexpr size_t WS_PROJ0 = WS_R;
constexpr size_t WS_Q = WS_PROJ0 + (size_t)T_TOK * N0P * 2;
constexpr size_t WS_PROJ1 = WS_R;
constexpr size_t WS_END = WS_R + (size_t)T_TOK * N1 * 2;

struct Params {
    const float* x; const int* pos; const float* l0_norm; const float* l0_w_in; const float* l0_q_norm; const float* l0_w_uq;
    const float* l0_kv_norm; const float* l0_w_ukv; const float* l0_w_o; const float* l1_norm; const float* l1_w_in;
    const float* l1_g_norm; const float* l1_w_o; const float* lower_bounds; const float* final_norm;
    float* out; unsigned char* ws;
    float inv_freq[32];
};

__device__ __forceinline__ unsigned cvtpk(float lo, float hi) { unsigned r; asm volatile("v_cvt_pk_bf16_f32 %0, %1, %2" : "=v"(r) : "v"(lo), "v"(hi)); return r; }
typedef float f32x2 __attribute__((ext_vector_type(2)));
typedef __bf16 bf16x2_t __attribute__((ext_vector_type(2)));
__device__ __forceinline__ unsigned cvtpk_n(float lo, float hi) { f32x2 v = {lo, hi}; bf16x2_t h = __builtin_convertvector(v, bf16x2_t); return __builtin_bit_cast(unsigned, h); }
__device__ __forceinline__ bf16_t f2bf_n(float f) { return (bf16_t)(cvtpk_n(f, 0.f) & 0xffffu); }
__device__ __forceinline__ bf16_t f2bf(float f) { return (bf16_t)(cvtpk(f, 0.f) & 0xffffu); }
__device__ __forceinline__ float bf2f(unsigned short h) { return __uint_as_float((unsigned)h << 16); }
__device__ __forceinline__ float bflo(unsigned w) { return __uint_as_float(w << 16); }
__device__ __forceinline__ float bfhi(unsigned w) { return __uint_as_float(w & 0xffff0000u); }
__device__ __forceinline__ bf16x8 pack8(f32x4 a, f32x4 b) {
    u32x4 w = {cvtpk(a[0], a[1]), cvtpk(a[2], a[3]), cvtpk(b[0], b[1]), cvtpk(b[2], b[3])};
    return *reinterpret_cast<bf16x8*>(&w);
}
__device__ __forceinline__ float fast_exp(float x) { return __builtin_amdgcn_exp2f(x * 1.4426950408889634f); }
__device__ __forceinline__ float silu_f(float v) { return v * __builtin_amdgcn_rcpf(1.0f + fast_exp(-v)); }
__device__ __forceinline__ float wave_sum(float v) {
#pragma unroll
    for (int o = 32; o > 0; o >>= 1) v += __shfl_xor(v, o);
    return v;
}

namespace pg8 {
constexpr int BM = 256, BK = 64, HALF = 128, HTB = HALF * BK * 2, STAGE_BYTES = 8 * HTB, NXCD = 8, WGM = 8;
__host__ __device__ __forceinline__ int lds_byte(int r, int c) { const int st = (r >> 4) * 2 + (c >> 5), rr = r & 15, cc = c & 31, ob = rr * 64 + cc * 2; return st * 1024 + (ob ^ (((ob >> 9) & 1) << 5)); }
__host__ __device__ __forceinline__ void stage_rc(int b, int& R, int& C) { const int st = b / 1024, sb = b % 1024, swz = sb ^ (((sb >> 9) & 1) << 5); R = (st >> 1) * 16 + swz / 64; C = (st & 1) * 32 + (swz % 64) / 2; }
__host__ __device__ __forceinline__ int perm32(int rho) { const int n = rho >> 4, i = rho & 15; return 8 * (i >> 2) + 4 * n + (i & 3); }
struct Unit { int pm, pn; };
struct Gemm { const bf16_t* A; const bf16_t* Bt; int M, N, K, lda; };
struct StaticOrder {
    int nM, nN, nwg, G, c, dup;
    __device__ void init(int M, int N, int G_, int c_, int dup_ = 0) { nM = M / BM; nN = N / BM; nwg = nM * nN; G = G_; c = c_; dup = dup_; }
    __device__ bool next(int i, Unit& u) const {
        const long L = (long)(i >> dup) * G + c; if (L >= nwg) return false;
        int wgid = (int)L; { const int q = nwg / NXCD, r = nwg % NXCD, xcd = wgid % NXCD, off = wgid / NXCD; wgid = (xcd < r ? xcd * (q + 1) : r * (q + 1) + (xcd - r) * q) + off; }
        const int nig = WGM * nN, gid = wgid / nig, fm = gid * WGM, gsz = (nM - fm) < WGM ? (nM - fm) : WGM;
        u.pm = fm + ((wgid % nig) % gsz); u.pn = (wgid % nig) / gsz; return true;
    }
};

template <int MODE> struct EpiBf16 {
    static constexpr bool PERM = true;
    bf16_t* O; int ldc; const float* rs; int thr; const float* lb; int ssqmode;
    __device__ __forceinline__ void operator()(const f32x4 (&acc)[2][2][4][2], const Unit& u, int wr, int wc, int fr, int fq) const {
        const int row0 = u.pm * BM + wr * 64 + fr, col0 = u.pn * BM + wc * 32 + 8 * fq;
        const int sec = (u.pn * BM) >> 12;
        f32x4 lbv[2][2] = {};
        if (MODE == 2) { if (sec == 1) {
#pragma unroll
            for (int bj = 0; bj < 2; ++bj) { lbv[bj][0] = *(const f32x4*)(lb + col0 + bj * HALF - 4096); lbv[bj][1] = *(const f32x4*)(lb + col0 + bj * HALF - 4096 + 4); } } }
        float rsv[2][4];
#pragma unroll
        for (int ai = 0; ai < 2; ++ai)
#pragma unroll
            for (int m = 0; m < 4; ++m) { float t_ = rs[row0 + ai * HALF + m * 16]; if (ssqmode) t_ = 1.0f / sqrtf(t_ * (1.0f / 4096.0f) + EPS); rsv[ai][m] = t_; }
#pragma unroll
        for (int ai = 0; ai < 2; ++ai)
#pragma unroll
            for (int m = 0; m < 4; ++m) {
                const int row = row0 + ai * HALF + m * 16; const float s = rsv[ai][m];
                bf16_t* rowp = O + (size_t)row * ldc + col0;
#pragma unroll
                for (int bj = 0; bj < 2; ++bj) {
                    f32x4 v0 = acc[ai][bj][m][0] * s, v1 = acc[ai][bj][m][1] * s;
                    const int col = col0 + bj * HALF;
                    if (MODE == 1) { if (col >= thr) {
#pragma unroll
                        for (int j = 0; j < 4; ++j) { v0[j] = silu_f(v0[j]); v1[j] = silu_f(v1[j]); } } }
                    if (MODE == 2) {
                        if (sec == 0 || sec == 3) {
#pragma unroll
                            for (int j = 0; j < 4; ++j) { v0[j] = silu_f(v0[j]); v1[j] = silu_f(v1[j]); } }
                        else if (sec == 1) {
                            const f32x4 l0 = lbv[bj][0], l1 = lbv[bj][1];
#pragma unroll
                            for (int j = 0; j < 4; ++j) {
                                float sg = __builtin_amdgcn_rcpf(1.0f + fast_exp(-v0[j])); float fg = l0[j] + (1.0f - l0[j]) * sg; v0[j] = __logf(fg);
                                sg = __builtin_amdgcn_rcpf(1.0f + fast_exp(-v1[j])); fg = l1[j] + (1.0f - l1[j]) * sg; v1[j] = __logf(fg); }
                        }
                    }
                    u32x4 w; w.x = cvtpk(v0[0], v0[1]); w.y = cvtpk(v0[2], v0[3]); w.z = cvtpk(v1[0], v1[1]); w.w = cvtpk(v1[2], v1[3]);
                    *(u32x4*)(rowp + bj * HALF) = w;
                }
            }
    }
};
struct EpiResF32 {
    static constexpr bool PERM = false;
    const float* base; float* out; int ldc;
    __device__ __forceinline__ void operator()(const f32x4 (&acc)[2][2][4][2], const Unit& u, int wr, int wc, int fr, int fq) const {
        const int row0 = u.pm * BM + wr * 64 + fr, col0 = u.pn * BM + wc * 32 + 4 * fq;
        f32x4 bs[2][4];
#define RES_LOAD(g, slot) do { const size_t off_ = (size_t)(row0 + ((g) >> 2) * HALF + ((g) & 3) * 16) * ldc + col0; \
        _Pragma("unroll") for (int bj = 0; bj < 2; ++bj) _Pragma("unroll") for (int n = 0; n < 2; ++n) bs[slot][bj * 2 + n] = *(const f32x4*)(base + off_ + bj * HALF + n * 16); } while (0)
        RES_LOAD(0, 0);
#pragma unroll
        for (int g = 0; g < 8; ++g) {
            if (g + 1 < 8) RES_LOAD(g + 1, (g + 1) & 1);
            const int ai = g >> 2, m = g & 3; const size_t off = (size_t)(row0 + ai * HALF + m * 16) * ldc + col0;
#pragma unroll
            for (int bj = 0; bj < 2; ++bj)
#pragma unroll
                for (int n = 0; n < 2; ++n) *(f32x4*)(out + off + bj * HALF + n * 16) = bs[g & 1][bj * 2 + n] + acc[ai][bj][m][n];
        }
#undef RES_LOAD
    }
};

struct EpiResBf16Stat {
    static constexpr bool PERM = true;
    const float* base; bf16_t* O; int ldc; float* ssq;
    __device__ __forceinline__ void operator()(const f32x4 (&acc)[2][2][4][2], const Unit& u, int wr, int wc, int fr, int fq) const {
        const int row0 = u.pm * BM + wr * 64 + fr, col0 = u.pn * BM + wc * 32 + 8 * fq;
        f32x4 bs[2][4];
#define RES_LOAD(g, slot) do { const size_t off_ = (size_t)(row0 + ((g) >> 2) * HALF + ((g) & 3) * 16) * ldc + col0; \
        _Pragma("unroll") for (int bj = 0; bj < 2; ++bj) { bs[slot][bj * 2] = *(const f32x4*)(base + off_ + bj * HALF); bs[slot][bj * 2 + 1] = *(const f32x4*)(base + off_ + bj * HALF + 4); } } while (0)
        RES_LOAD(0, 0);
#pragma unroll
        for (int g = 0; g < 8; ++g) {
            if (g + 1 < 8) RES_LOAD(g + 1, (g + 1) & 1);
            const int ai = g >> 2, m = g & 3, row = row0 + ai * HALF + m * 16; float ss = 0.f;
#pragma unroll
            for (int bj = 0; bj < 2; ++bj) {
                const f32x4 v0 = acc[ai][bj][m][0] + bs[g & 1][bj * 2], v1 = acc[ai][bj][m][1] + bs[g & 1][bj * 2 + 1];
                ss += (v0[0] * v0[0] + v0[1] * v0[1]) + (v0[2] * v0[2] + v0[3] * v0[3]) + (v1[0] * v1[0] + v1[1] * v1[1]) + (v1[2] * v1[2] + v1[3] * v1[3]);
                u32x4 w; w.x = cvtpk(v0[0], v0[1]); w.y = cvtpk(v0[2], v0[3]); w.z = cvtpk(v1[0], v1[1]); w.w = cvtpk(v1[2], v1[3]);
                *(u32x4*)(O + (size_t)row * ldc + col0 + bj * HALF) = w;
            }
            ss += __shfl_xor(ss, 16); ss += __shfl_xor(ss, 32);
            if (fq == 0) atomicAdd(ssq + row, ss);
        }
#undef RES_LOAD
    }
};
struct EpiResBf16F32 {
    static constexpr bool PERM = false;
    const bf16_t* base; int ldb; float* out; int ldo;
    __device__ __forceinline__ void operator()(const f32x4 (&acc)[2][2][4][2], const Unit& u, int wr, int wc, int fr, int fq) const {
        const int row0 = u.pm * BM + wr * 64 + fr, col0 = u.pn * BM + wc * 32 + 4 * fq;
        u32x2 bs[2][4];
#define RES_LOAD(g, slot) do { const size_t off_ = (size_t)(row0 + ((g) >> 2) * HALF + ((g) & 3) * 16) * ldb + col0; \
        _Pragma("unroll") for (int bj = 0; bj < 2; ++bj) _Pragma("unroll") for (int n = 0; n < 2; ++n) bs[slot][bj * 2 + n] = *(const u32x2*)(base + off_ + bj * HALF + n * 16); } while (0)
        RES_LOAD(0, 0);
#pragma unroll
        for (int g = 0; g < 8; ++g) {
            if (g + 1 < 8) RES_LOAD(g + 1, (g + 1) & 1);
            const int ai = g >> 2, m = g & 3; const size_t off = (size_t)(row0 + ai * HALF + m * 16) * ldo + col0;
#pragma unroll
            for (int bj = 0; bj < 2; ++bj)
#pragma unroll
                for (int n = 0; n < 2; ++n) { const u32x2 b2 = bs[g & 1][bj * 2 + n]; const f32x4 bv = {bflo(b2.x), bfhi(b2.x), bflo(b2.y), bfhi(b2.y)};
                    *(f32x4*)(out + off + bj * HALF + n * 16) = bv + acc[ai][bj][m][n]; }
        }
#undef RES_LOAD
    }
};

struct EpiBf16ResBf16Stat {
    static constexpr bool PERM = true;
    const bf16_t* base; int ldb; bf16_t* O; int ldo; float* ssq;
    __device__ __forceinline__ void operator()(const f32x4 (&acc)[2][2][4][2], const Unit& u, int wr, int wc, int fr, int fq) const {
        const int row0 = u.pm * BM + wr * 64 + fr, col0 = u.pn * BM + wc * 32 + 8 * fq;
        u32x4 bs[2][2];
#define RES_LOAD(g, slot) do { const size_t off_ = (size_t)(row0 + ((g) >> 2) * HALF + ((g) & 3) * 16) * ldb + col0; \
        _Pragma("unroll") for (int bj = 0; bj < 2; ++bj) bs[slot][bj] = *(const u32x4*)(base + off_ + bj * HALF); } while (0)
        RES_LOAD(0, 0);
#pragma unroll
        for (int g = 0; g < 8; ++g) {
            if (g + 1 < 8) RES_LOAD(g + 1, (g + 1) & 1);
            const int ai = g >> 2, m = g & 3, row = row0 + ai * HALF + m * 16; float ss = 0.f;
#pragma unroll
            for (int bj = 0; bj < 2; ++bj) {
                const u32x4 b4 = bs[g & 1][bj];
                const f32x4 v0 = acc[ai][bj][m][0] + (f32x4){bflo(b4.x), bfhi(b4.x), bflo(b4.y), bfhi(b4.y)}, v1 = acc[ai][bj][m][1] + (f32x4){bflo(b4.z), bfhi(b4.z), bflo(b4.w), bfhi(b4.w)};
                ss += (v0[0] * v0[0] + v0[1] * v0[1]) + (v0[2] * v0[2] + v0[3] * v0[3]) + (v1[0] * v1[0] + v1[1] * v1[1]) + (v1[2] * v1[2] + v1[3] * v1[3]);
                u32x4 w; w.x = cvtpk(v0[0], v0[1]); w.y = cvtpk(v0[2], v0[3]); w.z = cvtpk(v1[0], v1[1]); w.w = cvtpk(v1[2], v1[3]);
                *(u32x4*)(O + (size_t)row * ldo + col0 + bj * HALF) = w;
            }
            ss += __shfl_xor(ss, 16); ss += __shfl_xor(ss, 32);
            if (fq == 0) atomicAdd(ssq + row, ss);
        }
#undef RES_LOAD
    }
};

template <class Epi, class Sched>
__device__ __forceinline__ void gemm_phase(LAS unsigned char* lds, const Gemm g, const Sched& S, const Epi& E) {
    int tid = threadIdx.x; asm volatile("" : "+v"(tid));
    const int wid = __builtin_amdgcn_readfirstlane(tid >> 6), lane = tid & 63, wr = wid >> 2, wc = wid & 3, fr = lane & 15, fq = lane >> 4;
    const int K = g.K, nt = K / BK, lda = g.lda;
    unsigned voffA[2], voffB[2];
#pragma unroll
    for (int i = 0; i < 2; ++i) { int R, C; stage_rc(tid * 16 + i * 8192, R, C); const int Rb = Epi::PERM ? ((R & ~31) + perm32(R & 31)) : R;
        voffA[i] = (unsigned)(R * lda + C) * 2u; voffB[i] = (unsigned)(Rb * K + C) * 2u; }
    const size_t kstep = (size_t)(BK * 2);
    const size_t hstepA = (size_t)HALF * lda * 2, hstepB = (size_t)HALF * K * 2;
    const size_t tstepA = 2 * hstepA, tstepB = 2 * hstepB;
    const unsigned ldsw = (unsigned)wid * 1024u;
    const int aoff = lds_byte(wr * 64 + fr, fq * 8), boff = lds_byte(wc * 32 + fr, fq * 8);
#define PG8_SA(b, h) (((b) * 2 + (h)) * HTB)
#define PG8_SB(b, h) ((4 + (b) * 2 + (h)) * HTB)
#define PG8_STAGE(bufoff, gbase, voff) do { _Pragma("unroll") for (int _i = 0; _i < 2; ++_i) \
        __builtin_amdgcn_global_load_lds((const unsigned*)((const char*)(gbase) + (voff)[_i]), (LAS unsigned*)(lds + (bufoff) + ldsw + _i * 8192), 16, 0, 0); } while (0)
#define PG8_LDA(dst, b, h) do { _Pragma("unroll") for (int m = 0; m < 4; ++m) _Pragma("unroll") for (int k = 0; k < 2; ++k) dst[m][k] = *(const LAS bf16x8*)(lds + PG8_SA(b, h) + aoff + m * 2048 + k * 1024); } while (0)
#define PG8_LDB(dst, b, h) do { _Pragma("unroll") for (int n = 0; n < 2; ++n) _Pragma("unroll") for (int k = 0; k < 2; ++k) dst[n][k] = *(const LAS bf16x8*)(lds + PG8_SB(b, h) + boff + n * 2048 + k * 1024); } while (0)
#define PG8_MMA(ai, bj, At, Bt) do { __builtin_amdgcn_s_setprio(1); _Pragma("unroll") for (int m = 0; m < 4; ++m) _Pragma("unroll") for (int n = 0; n < 2; ++n) _Pragma("unroll") for (int k = 0; k < 2; ++k) \
        acc[ai][bj][m][n] = __builtin_amdgcn_mfma_f32_16x16x32_bf16(Bt[n][k], At[m][k], acc[ai][bj][m][n], 0, 0, 0); __builtin_amdgcn_s_setprio(0); } while (0)
#define PG8_WAIT_V(n) asm volatile("s_waitcnt vmcnt(" #n ")" ::: "memory")
#define PG8_WAIT_L(n) asm volatile("s_waitcnt lgkmcnt(" #n ")" ::: "memory")
#define PG8_BAR __builtin_amdgcn_s_barrier()
#define PG8_SCHED __builtin_amdgcn_sched_barrier(0)
    Unit cur, nxt; int ui = 0;
    if (!S.next(0, cur)) return;
    f32x4 acc[2][2][4][2];
#pragma unroll
    for (int a = 0; a < 2; ++a)
#pragma unroll
        for (int b = 0; b < 2; ++b)
#pragma unroll
            for (int m = 0; m < 4; ++m)
#pragma unroll
                for (int n = 0; n < 2; ++n) acc[a][b][m][n] = (f32x4){0.f, 0.f, 0.f, 0.f};
    bf16x8 At[4][2], B0[2][2], B1[2][2];
    const char* cA = (const char*)g.A + (size_t)cur.pm * tstepA; const char* cB = (const char*)g.Bt + (size_t)cur.pn * tstepB;
    PG8_STAGE(PG8_SB(0, 0), cB, voffB); PG8_STAGE(PG8_SA(0, 0), cA, voffA); PG8_STAGE(PG8_SB(0, 1), cB + hstepB, voffB); PG8_STAGE(PG8_SA(0, 1), cA + hstepA, voffA);
    if (wr == 1) PG8_BAR;
    PG8_WAIT_V(4); PG8_BAR;
    PG8_STAGE(PG8_SB(1, 0), cB + kstep, voffB); PG8_STAGE(PG8_SA(1, 0), cA + kstep, voffA); PG8_STAGE(PG8_SB(1, 1), cB + hstepB + kstep, voffB);
    PG8_WAIT_V(6); PG8_BAR;
    for (;;) {
        const bool has_next = S.next(ui + 1, nxt);
        const char* nA = has_next ? (const char*)g.A + (size_t)nxt.pm * tstepA : cA; const char* nB = has_next ? (const char*)g.Bt + (size_t)nxt.pn * tstepB : cB;
        for (int t = 0; t < nt; t += 2) {
            const bool last = (t == nt - 2);
            const char* a1 = cA + (size_t)(t + 1) * kstep;
            const char* a2 = last ? nA : cA + (size_t)(t + 2) * kstep; const char* b2 = last ? nB : cB + (size_t)(t + 2) * kstep;
            const char* a3 = a2 + kstep; const char* b3 = b2 + kstep;
            PG8_LDB(B0, 0, 0); PG8_SCHED; PG8_LDA(At, 0, 0); PG8_STAGE(PG8_SA(1, 1), a1 + hstepA, voffA);
            PG8_WAIT_L(8); PG8_BAR; PG8_WAIT_L(0); PG8_MMA(0, 0, At, B0); PG8_BAR; PG8_SCHED;
            PG8_LDB(B1, 0, 1); PG8_STAGE(PG8_SB(0, 0), b2, voffB);
            PG8_BAR; PG8_WAIT_L(0); PG8_MMA(0, 1, At, B1); PG8_BAR;
            PG8_LDA(At, 0, 1); PG8_STAGE(PG8_SA(0, 0), a2, voffA);
            PG8_BAR; PG8_WAIT_L(0); PG8_MMA(1, 0, At, B0); PG8_BAR; PG8_SCHED;
            PG8_STAGE(PG8_SB(0, 1), b2 + hstepB, voffB);
            PG8_WAIT_V(6); PG8_BAR; PG8_MMA(1, 1, At, B1); PG8_BAR;
            PG8_LDB(B0, 1, 0); PG8_SCHED; PG8_LDA(At, 1, 0); PG8_STAGE(PG8_SA(0, 1), a2 + hstepA, voffA);
            PG8_WAIT_L(8); PG8_BAR; PG8_WAIT_L(0); PG8_MMA(0, 0, At, B0); PG8_BAR; PG8_SCHED;
            PG8_LDB(B1, 1, 1); PG8_STAGE(PG8_SB(1, 0), b3, voffB);
            PG8_BAR; PG8_WAIT_L(0); PG8_MMA(0, 1, At, B1); PG8_BAR;
            PG8_LDA(At, 1, 1); PG8_STAGE(PG8_SA(1, 0), a3, voffA);
            PG8_BAR; PG8_WAIT_L(0); PG8_MMA(1, 0, At, B0); PG8_BAR; PG8_SCHED;
            PG8_STAGE(PG8_SB(1, 1), b3 + hstepB, voffB);
            PG8_WAIT_V(6); PG8_BAR; PG8_MMA(1, 1, At, B1); PG8_BAR;
        }
        E(acc, cur, wr, wc, fr, fq);
        if (!has_next) break;
#pragma unroll
        for (int a = 0; a < 2; ++a)
#pragma unroll
            for (int b = 0; b < 2; ++b)
#pragma unroll
                for (int m = 0; m < 4; ++m)
#pragma unroll
                    for (int n = 0; n < 2; ++n) acc[a][b][m][n] = (f32x4){0.f, 0.f, 0.f, 0.f};
        cur = nxt; cA = nA; cB = nB; ++ui;
    }
    PG8_WAIT_V(0);
    if (wr == 0) PG8_BAR;
    PG8_BAR;
#undef PG8_SA
#undef PG8_SB
#undef PG8_STAGE
#undef PG8_LDA
#undef PG8_LDB
#undef PG8_MMA
#undef PG8_WAIT_V
#undef PG8_WAIT_L
#undef PG8_BAR
#undef PG8_SCHED
}
}
#define XB_TMO      128
#define XB_XCNT(j)  (256  + 64 * (j))
#define XB_XSUB(j)  (1280 + 64 * (j))
#define XB_XGEN(j)  (2304 + 64 * (j))
#define XB_TOP      3328
#define XB_TOPGEN   3392
#define XCD_BAR_WORDS 3456
#define XB_SPIN_CAP (1u << 18)

__device__ __forceinline__ unsigned xb_ld(unsigned* p)              { return __hip_atomic_load(p, __ATOMIC_RELAXED, __HIP_MEMORY_SCOPE_AGENT); }
__device__ __forceinline__ unsigned xb_add(unsigned* p, unsigned v) { return __hip_atomic_fetch_add(p, v, __ATOMIC_RELAXED, __HIP_MEMORY_SCOPE_AGENT); }
__device__ __forceinline__ unsigned xb_xcc_id() { return (unsigned)__builtin_amdgcn_s_getreg((3 << 11) | 20) & 0xFu; }
#define XB_SPIN(cond, bar) do { unsigned _sp = 0; while (cond) { __builtin_amdgcn_s_sleep(1); \
    if ((++_sp & 255u) == 0u) { if (xb_ld(&(bar)[XB_TMO])) break; if (_sp > XB_SPIN_CAP) { atomicAdd(&(bar)[XB_TMO], 1u); break; } } } } while (0)

struct XcdBarrier {
    unsigned* bar; unsigned x;
    volatile LAS unsigned* st;
};

__device__ __forceinline__ XcdBarrier xcd_barrier_post(unsigned* bar, volatile LAS unsigned* st) {
    XcdBarrier b; b.bar = bar; b.x = xb_xcc_id(); b.st = st;
    if (threadIdx.x == 0) (void)xb_add(&bar[XB_XCNT(b.x)], 1u);
    return b;
}
__device__ __forceinline__ void xcd_barrier_complete(unsigned* bar, unsigned x, unsigned& nloc, unsigned& nx) {
    const unsigned G = gridDim.x * gridDim.y * gridDim.z;
    unsigned sum, cnt, mine, sp = 0u;
    for (;;) {
        sum = 0u; cnt = 0u; mine = 0u;
#pragma unroll
        for (unsigned j = 0; j < 16; ++j) { const unsigned c = xb_ld(&bar[XB_XCNT(j)]); sum += c; cnt += (c > 0u) ? 1u : 0u; mine = (j == x) ? c : mine; }
        if (sum == G) break;
        __builtin_amdgcn_s_sleep(1);
        if ((++sp & 255u) == 0u) { if (xb_ld(&bar[XB_TMO])) break; if (sp > XB_SPIN_CAP) { atomicAdd(&bar[XB_TMO], 1u); break; } }
    }
    nloc = mine > 0u ? mine : 1u; nx = cnt > 0u ? cnt : 1u;
}

__device__ __forceinline__ void xcd_barrier(const XcdBarrier& b) {
    asm volatile("s_waitcnt vmcnt(0)" ::: "memory");
    __syncthreads();
    if (threadIdx.x == 0) {
        unsigned* bar = b.bar;
        __builtin_amdgcn_s_waitcnt(0);
        unsigned nloc = b.st[0], nx = b.st[1];
        if (nloc == 0u) { xcd_barrier_complete(bar, b.x, nloc, nx); b.st[0] = nloc; b.st[1] = nx; }
        const unsigned old = xb_add(&bar[XB_XSUB(b.x)], 1u);
        const unsigned gen = old / nloc;
        if (old + 1u == (gen + 1u) * nloc) {
            __builtin_amdgcn_fence(__ATOMIC_RELEASE, "agent");
            asm volatile("s_waitcnt vmcnt(0)" ::: "memory");
            const unsigned og = xb_add(&bar[XB_TOP], 1u);
            const unsigned tg = og / nx;
            if (og + 1u == (tg + 1u) * nx) xb_add(&bar[XB_TOPGEN], 1u);
            else XB_SPIN(xb_ld(&bar[XB_TOPGEN]) == tg, bar);
            __builtin_amdgcn_fence(__ATOMIC_ACQUIRE, "agent");
            xb_add(&bar[XB_XGEN(b.x)], 1u);
            asm volatile("s_waitcnt vmcnt(0)" ::: "memory");
        } else {
            XB_SPIN(xb_ld(&bar[XB_XGEN(b.x)]) == gen, bar);
            __builtin_amdgcn_fence(__ATOMIC_ACQUIRE, "agent");
            asm volatile("s_waitcnt vmcnt(0)" ::: "memory");
        }
    }
    __syncthreads();
}


namespace att {
constexpr int NW = 8, QBLK = 32, KVBLK = 64, QB = NW * QBLK;
constexpr int DQ = 192, DV = 128;
constexpr int QS = NQ, KVS = NKV, KRS = 64, OS = 4096, ZS = N0P;
constexpr int SHM_V = KVBLK * DV * 2, SHM_K = KVBLK * DQ * 2;
constexpr int QR_OFF = 2 * SHM_V + 2 * SHM_K + NW * 64 * 4;
constexpr int LDS_BYTES = QR_OFF + NW * 4096;
constexpr float SCALE = 0.07216878364870322f;
constexpr float THR = 8.f;
constexpr unsigned WBIG = 0x40000000u;

#define KSWZ(row, colB) ((row) * 384 + ((colB) ^ (((row) & 7) << 4)))
#define SBAR() __builtin_amdgcn_sched_barrier(0)
__device__ __forceinline__ int v_st(int k, int c) { const int kk = (k & ~0xC) | ((k & 4) << 1) | ((k & 8) >> 1); return ((kk >> 3) * 4 + (c >> 5)) * 512 + ((kk & 7) * 32 + (c & 31)) * 2; }
__device__ __forceinline__ int v_rd_base(int lane) { return ((lane & 3) << 3) | (((lane >> 2) & 3) << 6) | (((lane >> 4) & 1) << 5) | (((lane >> 5) & 1) << 8); }
constexpr int v_rd_off(int d0, int ks, int half) { return d0 * 512 + ks * 4096 + half * 2048; }
__device__ __forceinline__ int crow(int r, int hi) { return (r & 3) + 8 * (r >> 2) + 4 * hi; }
__device__ __forceinline__ bf16x8 load8(const bf16_t* p) { return *reinterpret_cast<const bf16x8*>(p); }

__device__ __forceinline__ void mask_tile(f32x16& p0, f32x16& p1, int dq) {
    const float NEG = -__builtin_inff();
#pragma unroll
    for (int r = 0; r < 16; ++r) {
        const int c = (r & 3) + 8 * (r >> 2);
        if ((unsigned)(dq - c) >= WBIG) p0[r] = NEG;
        if ((unsigned)(dq - c - 32) >= WBIG) p1[r] = NEG;
    }
}
__device__ __forceinline__ void partialSM(f32x16& p0, f32x16& p1, float& m_reg, float& mn, float& alpha) {
    float pmax = p0[0];
#pragma unroll
    for (int r = 1; r < 16; ++r) pmax = fmaxf(pmax, p0[r]);
#pragma unroll
    for (int r = 0; r < 16; ++r) pmax = fmaxf(pmax, p1[r]);
    { auto rr = __builtin_amdgcn_permlane32_swap(__float_as_uint(pmax), __float_as_uint(pmax), false, false);
      pmax = fmaxf(__uint_as_float(rr[0]), __uint_as_float(rr[1])); }
    constexpr float C2 = 1.4426950408889634f * SCALE;
    if (__builtin_expect(__all((pmax - m_reg) * SCALE <= THR), 1)) { mn = m_reg; alpha = 1.f; }
    else { mn = fmaxf(m_reg, pmax); alpha = __builtin_amdgcn_exp2f((m_reg - mn) * C2); m_reg = mn; }
    const float mnL = -mn * C2;
#pragma unroll
    for (int r = 0; r < 16; ++r) p0[r] = fmaf(p0[r], C2, mnL);
#pragma unroll
    for (int r = 0; r < 16; ++r) p1[r] = fmaf(p1[r], C2, mnL);
#pragma unroll
    for (int r = 0; r < 16; ++r) p0[r] = __builtin_amdgcn_exp2f(p0[r]);
}
__device__ __forceinline__ void finishSM(f32x16& p0, f32x16& p1, float alpha, float& l_reg, bf16x8& pa0, bf16x8& pa1, bf16x8& pa2, bf16x8& pa3) {
#pragma unroll
    for (int r = 0; r < 16; ++r) p1[r] = __builtin_amdgcn_exp2f(p1[r]);
    float ps = 0;
#pragma unroll
    for (int r = 0; r < 16; ++r) ps += p0[r];
#pragma unroll
    for (int r = 0; r < 16; ++r) ps += p1[r];
    { auto rr = __builtin_amdgcn_permlane32_swap(__float_as_uint(ps), __float_as_uint(ps), false, false);
      ps = __uint_as_float(rr[0]) + __uint_as_float(rr[1]); }
    l_reg = l_reg * alpha + ps;
#define PK4(P, B_, OUT) do { unsigned a0 = cvtpk(P[B_+0], P[B_+1]), a1 = cvtpk(P[B_+2], P[B_+3]);                          \
        unsigned b0 = cvtpk(P[B_+4], P[B_+5]), b1 = cvtpk(P[B_+6], P[B_+7]);                                             \
        auto r0 = __builtin_amdgcn_permlane32_swap(a0, b0, false, false); auto r1 = __builtin_amdgcn_permlane32_swap(a1, b1, false, false); \
        u32x4 w = {r0[0], r1[0], r0[1], r1[1]}; OUT = *reinterpret_cast<bf16x8*>(&w); } while (0)
    PK4(p0, 0, pa0); PK4(p0, 8, pa1); PK4(p1, 0, pa2); PK4(p1, 8, pa3);
#undef PK4
}
template <int KB>
__device__ __forceinline__ void qkt(f32x16& p0, f32x16& p1, const char* K_lds, int r32, int hi, const bf16x8* qr, const char* qrl) {
    p0 = f32x16{}; p1 = f32x16{};
    const char* kb[4];
#pragma unroll
    for (int dd = 0; dd < 4; ++dd) kb[dd] = K_lds + KB * SHM_K + KSWZ(r32, (dd * 16 + hi * 8) * 2);
#pragma unroll
    for (int d0 = 0; d0 < 12; ++d0) { const char* a = kb[d0 & 3] + (d0 >> 2) * 128;
        bf16x8 b0 = *reinterpret_cast<const bf16x8*>(a);
        bf16x8 b1 = *reinterpret_cast<const bf16x8*>(a + 32 * 384);
        bf16x8 qf; if (d0 < 8) qf = qr[d0]; else qf = *reinterpret_cast<const bf16x8*>(qrl + (d0 - 8) * 1024);
        p0 = __builtin_amdgcn_mfma_f32_32x32x16_bf16(b0, qf, p0, 0, 0, 0);
        p1 = __builtin_amdgcn_mfma_f32_32x32x16_bf16(b1, qf, p1, 0, 0, 0);
    }
}
template <int VB>
__device__ __forceinline__ void pv_tile(f32x16* o, int vb0, bf16x8 pa0, bf16x8 pa1, bf16x8 pa2, bf16x8 pa3) {
#define TRRD(dst, off) asm volatile("ds_read_b64_tr_b16 %0, %1 offset:%2" : "=&v"(dst) : "v"(vb0), "i"(off) : "memory")
#define PV_D0(d0) do { s16x4 l0, l1, l2, l3, h0, h1, h2, h3; constexpr int b_ = VB * SHM_V + v_rd_off(d0, 0, 0); \
        TRRD(l0, b_); TRRD(h0, b_ + 2048); TRRD(l1, b_ + 4096); TRRD(h1, b_ + 6144); TRRD(l2, b_ + 8192); TRRD(h2, b_ + 10240); TRRD(l3, b_ + 12288); TRRD(h3, b_ + 14336); \
        asm volatile("s_waitcnt lgkmcnt(0)" ::: "memory"); SBAR();   \
        o[d0] = __builtin_amdgcn_mfma_f32_32x32x16_bf16(pa0, (bf16x8){l0[0], l0[1], l0[2], l0[3], h0[0], h0[1], h0[2], h0[3]}, o[d0], 0, 0, 0);   \
        o[d0] = __builtin_amdgcn_mfma_f32_32x32x16_bf16(pa1, (bf16x8){l1[0], l1[1], l1[2], l1[3], h1[0], h1[1], h1[2], h1[3]}, o[d0], 0, 0, 0);   \
        o[d0] = __builtin_amdgcn_mfma_f32_32x32x16_bf16(pa2, (bf16x8){l2[0], l2[1], l2[2], l2[3], h2[0], h2[1], h2[2], h2[3]}, o[d0], 0, 0, 0);   \
        o[d0] = __builtin_amdgcn_mfma_f32_32x32x16_bf16(pa3, (bf16x8){l3[0], l3[1], l3[2], l3[3], h3[0], h3[1], h3[2], h3[3]}, o[d0], 0, 0, 0); } while (0)
    PV_D0(0); PV_D0(1); PV_D0(2); PV_D0(3);
#undef PV_D0
#undef TRRD
}

struct BlockRef { const bf16_t* Q; const bf16_t* K; const bf16_t* KR; const bf16_t* V; bf16_t* O; const bf16_t* Z; const float* CS; const float* SN; int P0; };
struct Stage { bf16x8 st_v0, st_v1, st_k0, st_k1, st_kr; };
#define VMW() asm volatile("s_waitcnt vmcnt(0)" ::: "memory")
#define SLOAD_H(R, k0) do { const char* kt_ = (const char*)(R).K + (size_t)(k0) * (KVS * 2); const char* kt2_ = kt_ + 32 * KVS * 2; const char* krt_ = (const char*)(R).KR + (size_t)(k0) * (KRS * 2); \
                            S.st_v0 = *(const bf16x8*)(kt_ + koff + 256); S.st_v1 = *(const bf16x8*)(kt2_ + koff + 256);  \
                            S.st_k0 = *(const bf16x8*)(kt_ + koff); S.st_k1 = *(const bf16x8*)(kt2_ + koff);  \
                            S.st_kr = *(const bf16x8*)(krt_ + kroff); } while (0)
#define SWRITE_HK(bf) do { *(bf16x8*)(K_lds + (bf) * SHM_K + kws) = S.st_k0; *(bf16x8*)(K_lds + (bf) * SHM_K + kws + 32 * 384) = S.st_k1; \
                           *(bf16x8*)(K_lds + (bf) * SHM_K + kwr) = S.st_kr; } while (0)
#define SWRITE_HV(bf) do { *(bf16x8*)(V_lds + (bf) * SHM_V + vst0) = S.st_v0; *(bf16x8*)(V_lds + (bf) * SHM_V + vst1) = S.st_v1; } while (0)
#define SWRITE_H(bf) do { SWRITE_HV(bf); SWRITE_HK(bf); } while (0)

__device__ __forceinline__ void rope_q(const BlockRef& cur, const bf16x8* qrp, char* qrl, int wid, int r32, int hi) {
    const int row = wid * QBLK + r32;
    const unsigned toff = (unsigned)((row * 32 + hi * 8) * 4);
    const float* cp = (const float*)((const char*)cur.CS + toff); const float* sp = (const float*)((const char*)cur.SN + toff);
#pragma unroll
    for (int pr = 0; pr < 2; ++pr) {
        const f32x4 c0 = *(const f32x4*)(cp + pr * 16), c1 = *(const f32x4*)(cp + pr * 16 + 4), s0 = *(const f32x4*)(sp + pr * 16), s1 = *(const f32x4*)(sp + pr * 16 + 4);
        const bf16x8 a = qrp[pr], b = qrp[2 + pr];
        f32x4 o1l, o1h, o2l, o2h;
#pragma unroll
        for (int j = 0; j < 4; ++j) {
            float t1 = bf2f((unsigned short)a[j]), t2 = bf2f((unsigned short)b[j]);
            o1l[j] = t1 * c0[j] - t2 * s0[j]; o2l[j] = t2 * c0[j] + t1 * s0[j];
            t1 = bf2f((unsigned short)a[4 + j]); t2 = bf2f((unsigned short)b[4 + j]);
            o1h[j] = t1 * c1[j] - t2 * s1[j]; o2h[j] = t2 * c1[j] + t1 * s1[j];
        }
        *(bf16x8*)(qrl + pr * 1024) = pack8(o1l, o1h); *(bf16x8*)(qrl + (2 + pr) * 1024) = pack8(o2l, o2h);
    }
}
__device__ __forceinline__ void causal_block(const BlockRef& cur, char* lds) {
    int tid = threadIdx.x; asm volatile("" : "+v"(tid));
    const int wid = __builtin_amdgcn_readfirstlane(tid >> 6), lane = tid & 63, r32 = lane & 31, hi = lane >> 5;
    const int NT = (cur.P0 + QB - 1) / KVBLK + 1;
    const int qlo = cur.P0 + wid * QBLK, qm = qlo + r32 - 4 * hi;
    char* V_lds = lds; char* K_lds = lds + 2 * SHM_V;
    float* ws = (float*)(lds + 2 * SHM_V + 2 * SHM_K) + wid * 64; float* li_l = ws, * al_l = ws + 32;
    float m_reg = -1e30f, l_reg = 0; f32x16 o[4] = {};
    const int sr = tid >> 4, sc = (tid & 15) * 8, vst0 = v_st(sr, sc), vst1 = v_st(32 + sr, sc), kws = KSWZ(sr, sc * 2);
    const int krr = tid >> 3, krc = (tid & 7) * 8, kwr = KSWZ(krr, (128 + krc) * 2);
    const int vb0 = (int)(uintptr_t)V_lds + v_rd_base(lane);
    unsigned koff = (unsigned)((sr * KVS + sc) * 2), kroff = (unsigned)((krr * KRS + krc) * 2);
    unsigned qoff = (unsigned)(((wid * QBLK + r32) * QS + hi * 8) * 2);
    asm volatile("" : "+v"(koff), "+v"(kroff), "+v"(qoff));
    Stage S; bf16x8 qr[8]; char* qrl = lds + QR_OFF + wid * 4096 + lane * 16;
    { bf16x8 qrp[4];
#pragma unroll
      for (int d0 = 0; d0 < 8; ++d0) qr[d0] = *(const bf16x8*)((const char*)cur.Q + qoff + d0 * 32);
#pragma unroll
      for (int d0 = 0; d0 < 4; ++d0) qrp[d0] = *(const bf16x8*)((const char*)cur.Q + qoff + (8 + d0) * 32);
      SLOAD_H(cur, 0);
      rope_q(cur, qrp, qrl, wid, r32, hi); }
    VMW(); SWRITE_H(0); SBAR();
    SLOAD_H(cur, KVBLK); SBAR();
    __syncthreads();
#define RESC(a) do { if (__any((a) < 1.f)) { if (hi == 0) al_l[r32] = (a); asm volatile("s_waitcnt lgkmcnt(0)" ::: "memory");              \
                     for (int d_ = 0; d_ < 4; ++d_) for (int r = 0; r < 16; ++r) o[d_][r] *= al_l[crow(r, hi)]; } } while (0)
#define KBASE(t) ((t) * KVBLK)
#define MASKT(P0_, P1_, t) do { const int kb_ = KBASE(t); if (kb_ + KVBLK - 1 > qlo) mask_tile(P0_, P1_, qm - kb_); } while (0)
    f32x16 pA0, pA1, pB0, pB1; float mnA, mnB, alA, alB; bf16x8 pa0, pa1, pa2, pa3;
    qkt<0>(pA0, pA1, K_lds, r32, hi, qr, qrl);
    MASKT(pA0, pA1, 0); partialSM(pA0, pA1, m_reg, mnA, alA);
    VMW(); SWRITE_H(1);
    __syncthreads();
#define HALF_STEP(PX0, PX1, mnX, alX, PY0, PY1, alY, t, KB, VB, SB) do {                                                      \
        SBAR(); qkt<KB>(PX0, PX1, K_lds, r32, hi, qr, qrl);                                                                        \
        finishSM(PY0, PY1, alY, l_reg, pa0, pa1, pa2, pa3); SBAR();                                                           \
        if ((t) + 1 < NT) { SLOAD_H(cur, KBASE((t) + 1)); SBAR(); }                                                           \
        pv_tile<VB>(o, vb0, pa0, pa1, pa2, pa3); MASKT(PX0, PX1, (t)); partialSM(PX0, PX1, m_reg, mnX, alX);                  \
        __syncthreads();                                                                                                      \
        if ((t) + 1 < NT) { VMW(); SWRITE_H(SB); }                                                                            \
        RESC(alX); __syncthreads(); } while (0)
    for (int t = 1; t + 1 < NT; t += 2) {
        HALF_STEP(pB0, pB1, mnB, alB, pA0, pA1, alA, t, 1, 0, 0);
        HALF_STEP(pA0, pA1, mnA, alA, pB0, pB1, alB, t + 1, 0, 1, 1);
    }
    SBAR(); qkt<1>(pB0, pB1, K_lds, r32, hi, qr, qrl); SBAR();
    finishSM(pA0, pA1, alA, l_reg, pa0, pa1, pa2, pa3); SBAR();
    pv_tile<0>(o, vb0, pa0, pa1, pa2, pa3);
    MASKT(pB0, pB1, NT - 1); partialSM(pB0, pB1, m_reg, mnB, alB); __syncthreads(); RESC(alB);
    finishSM(pB0, pB1, alB, l_reg, pa0, pa1, pa2, pa3); SBAR(); pv_tile<1>(o, vb0, pa0, pa1, pa2, pa3);
    SBAR();
    if (hi == 0) li_l[r32] = l_reg;
    __syncthreads();
    {
        char* ot = lds + wid * (32 * 272);
        const int wb = 4 * hi * 272 + r32 * 2;
#pragma unroll
        for (int rg = 0; rg < 4; ++rg) {
            const f32x4 lv = *(const f32x4*)(li_l + 8 * rg + 4 * hi);
#pragma unroll
            for (int j = 0; j < 4; ++j) { const int r = rg * 4 + j; const float rl = __builtin_amdgcn_rcpf(lv[j]);
#pragma unroll
                for (int d0 = 0; d0 < 4; ++d0) *(bf16_t*)(ot + wb + (j + 8 * rg) * 272 + d0 * 64) = f2bf(o[d0][r] * rl); }
        }
        asm volatile("s_waitcnt lgkmcnt(0)" ::: "memory");
        const int rr = lane >> 4, c8 = (lane & 15) * 8;
        const unsigned zoff = (unsigned)(((wid * QBLK + rr) * ZS + c8) * 2), ooff = (unsigned)(((wid * QBLK + rr) * OS + c8) * 2);
#pragma unroll
        for (int i = 0; i < 8; ++i) {
            const bf16x8 ov = *(const bf16x8*)(ot + (i * 4 + rr) * 272 + c8 * 2);
            const bf16x8 zv = *(const bf16x8*)((const char*)cur.Z + (size_t)(i * 4 * ZS * 2) + zoff);
            f32x4 a, b;
#pragma unroll
            for (int j = 0; j < 4; ++j) { a[j] = bf2f((unsigned short)ov[j]) * bf2f((unsigned short)zv[j]); b[j] = bf2f((unsigned short)ov[4 + j]) * bf2f((unsigned short)zv[4 + j]); }
            *(bf16x8*)((char*)cur.O + (size_t)(i * 4 * OS * 2) + ooff) = pack8(a, b);
        }
    }
    __syncthreads();
#undef RESC
#undef KBASE
#undef MASKT
#undef HALF_STEP
}
#undef VMW
#undef SLOAD_H
#undef SWRITE_HK
#undef SWRITE_HV
#undef SWRITE_H

struct Item { int bh, qb0, qb1; };
constexpr int NQB = SEQ / QB, NX = NQB / 2, NBH = 64, TOTAL = NX * NBH;
__device__ __forceinline__ Item decode(int L) {
    Item it; const int xcd = L & 7, k = L >> 3, gi = k / NX, r = k - gi * NX;
    it.bh = gi * 8 + xcd; it.qb0 = r; it.qb1 = NQB - 1 - r; return it;
}
struct Tensors { const bf16_t* q; const bf16_t* kv; const bf16_t* krot; bf16_t* og; const bf16_t* proj0; const float* cs; const float* sn; };
__device__ __forceinline__ BlockRef mkref(const Item& it, int pass, const Tensors& T) {
    const int qb = pass ? it.qb1 : it.qb0, b = it.bh >> 5, h = it.bh & 31;
    const size_t tok0 = (size_t)b * SEQ, row0 = tok0 + (size_t)qb * QB;
    BlockRef r;
    r.Q = T.q + row0 * QS + h * DQ; r.K = T.kv + tok0 * KVS + h * 256; r.V = r.K + 128; r.KR = T.krot + tok0 * KRS;
    r.O = T.og + row0 * OS + h * DV; r.Z = T.proj0 + row0 * ZS + 1600 + h * DV; r.CS = T.cs + row0 * 32; r.SN = T.sn + row0 * 32; r.P0 = qb * QB;
    return r;
}
__device__ __forceinline__ void attn_phase(char* lds, const Tensors& T) {
#ifndef PROBE_ATTDUP
#define PROBE_ATTDUP 0
#endif
    for (int i = 0; ; ++i) {
        const int L = blockIdx.x + (i >> PROBE_ATTDUP) * gridDim.x; if (L >= TOTAL) break;
        const Item it = decode(L);
#pragma unroll 1
        for (int pass = 0; pass < 2; ++pass) { const BlockRef cur = mkref(it, pass, T); causal_block(cur, lds); }
    }
}
}
__device__ __forceinline__ void wt_phase(const float* __restrict__ W, int K, int N, const float* __restrict__ scale, bf16_t* __restrict__ out, char* lds) {
    int tid = threadIdx.x; asm volatile("" : "+v"(tid));
    const int lane = tid & 63, wv = tid >> 6, gw = blockIdx.x * 8 + wv, nw = gridDim.x * 8;
    char* img = lds + wv * 8192;
    const int kr = lane >> 4, nq = lane & 15, ntn = N / 64, ntiles = ntn * (K / 64);
    for (int t = gw; t < ntiles; t += nw) {
        const int kb = (t / ntn) * 64, nb = (t % ntn) * 64;
        const float* src = W + (size_t)(kb + kr * 16) * N + nb + nq * 4;
        f32x4 v[16];
#pragma unroll
        for (int i = 0; i < 16; ++i) v[i] = *(const f32x4*)(src + (size_t)i * N);
        if (scale) {
            const float* sp = scale + kb + kr * 16;
#pragma unroll
            for (int i = 0; i < 16; i += 4) { const f32x4 sc = *(const f32x4*)(sp + i); v[i] *= sc[0]; v[i + 1] *= sc[1]; v[i + 2] *= sc[2]; v[i + 3] *= sc[3]; }
        }
#pragma unroll
        for (int j = 0; j < 4; ++j) {
            const int n = nq * 4 + j;
#pragma unroll
            for (int hf = 0; hf < 2; ++hf) {
                const f32x4 a = {v[hf * 8 + 0][j], v[hf * 8 + 1][j], v[hf * 8 + 2][j], v[hf * 8 + 3][j]}, b = {v[hf * 8 + 4][j], v[hf * 8 + 5][j], v[hf * 8 + 6][j], v[hf * 8 + 7][j]};
                *(bf16x8*)(img + n * 128 + (((kr * 2 + hf) ^ (nq & 7)) * 16)) = pack8(a, b);
            }
        }
#pragma unroll
        for (int i = 0; i < 8; ++i) {
            const int n = i * 8 + (lane >> 3), kc = lane & 7;
            const bf16x8 r = *(const bf16x8*)(img + n * 128 + ((kc ^ ((n >> 2) & 7)) * 16));
            *(bf16x8*)(out + (size_t)(nb + n) * K + kb + kc * 8) = r;
        }
    }
}
__device__ __forceinline__ void cast_rstd_phase(const float* __restrict__ src, bf16_t* __restrict__ dst, float* __restrict__ rstd) {
    const int lane = threadIdx.x & 63, gw = blockIdx.x * 8 + (threadIdx.x >> 6), nw = gridDim.x * 8;
    for (int row = gw; row < T_TOK; row += nw) {
        const float* s = src + (size_t)row * DM; bf16_t* d = dst + (size_t)row * DM; float ss = 0.f;
#pragma unroll
        for (int i = 0; i < 8; ++i) { const int c = (i * 64 + lane) * 8; const f32x4 a = *(const f32x4*)(s + c), b = *(const f32x4*)(s + c + 4);
            ss += a[0] * a[0] + a[1] * a[1] + a[2] * a[2] + a[3] * a[3] + b[0] * b[0] + b[1] * b[1] + b[2] * b[2] + b[3] * b[3];
            *(bf16x8*)(d + c) = pack8(a, b); }
        ss = wave_sum(ss);
        if (lane == 0) rstd[row] = 1.0f / sqrtf(ss * (1.0f / DM) + EPS);
    }
}
__device__ __forceinline__ void final_norm_phase(const float* __restrict__ src, size_t lds_, float* __restrict__ dst, const float* __restrict__ w) {
    const int lane = threadIdx.x & 63, gw = blockIdx.x * 8 + (threadIdx.x >> 6), nw = gridDim.x * 8;
    for (int row = gw; row < T_TOK; row += nw) {
        const float* s = src + (size_t)row * lds_; float* d = dst + (size_t)row * DM; f32x4 v[16]; float ss = 0.f;
#pragma unroll
        for (int i = 0; i < 16; ++i) { v[i] = *(const f32x4*)(s + (i * 64 + lane) * 4); ss += v[i][0] * v[i][0] + v[i][1] * v[i][1] + v[i][2] * v[i][2] + v[i][3] * v[i][3]; }
        ss = wave_sum(ss);
        const float r = 1.0f / sqrtf(ss * (1.0f / DM) + EPS);
#pragma unroll
        for (int i = 0; i < 16; ++i) { const f32x4 g = *(const f32x4*)(w + (i * 64 + lane) * 4); *(f32x4*)(d + (i * 64 + lane) * 4) = v[i] * r * g; }
    }
}
__device__ __forceinline__ void final_norm_bf16_phase(const bf16_t* __restrict__ src, size_t lds_, const float* __restrict__ ssq, float* __restrict__ dst, const float* __restrict__ w) {
    const int lane = threadIdx.x & 63, gw = blockIdx.x * 8 + (threadIdx.x >> 6), nw = gridDim.x * 8;
    for (int row = gw; row < T_TOK; row += nw) {
        const bf16_t* s = src + (size_t)row * lds_; float* d = dst + (size_t)row * DM;
        const float r = 1.0f / sqrtf(ssq[row] * (1.0f / DM) + EPS);
        bf16x8 v[8];
#pragma unroll
        for (int i = 0; i < 8; ++i) v[i] = *(const bf16x8*)(s + (i * 64 + lane) * 8);
#pragma unroll
        for (int i = 0; i < 8; ++i) { const int c = (i * 64 + lane) * 8; const f32x4 g0 = *(const f32x4*)(w + c), g1 = *(const f32x4*)(w + c + 4); f32x4 a, b;
#pragma unroll
            for (int j = 0; j < 4; ++j) { a[j] = bf2f((unsigned short)v[i][j]) * r * g0[j]; b[j] = bf2f((unsigned short)v[i][4 + j]) * r * g1[j]; }
            *(f32x4*)(d + c) = a; *(f32x4*)(d + c + 4) = b; }
    }
}
__device__ __forceinline__ void tables_phase(const Params& p, float* cs, float* sn, float* lb) {
    const int gt = blockIdx.x * blockDim.x + threadIdx.x, nt = gridDim.x * blockDim.x;
    for (int i = gt; i < T_TOK * 32; i += nt) {
        const int tok = i >> 5, j = i & 31;
        const float ang = (float)p.pos[tok] * p.inv_freq[j];
        const double rev = (double)ang * 0.15915494309189535; const float fr = (float)(rev - rint(rev));
        cs[i] = __builtin_amdgcn_cosf(fr); sn[i] = __builtin_amdgcn_sinf(fr);
    }
    for (int i = gt; i < 4096; i += nt) { const float l0 = p.lower_bounds[i], l1 = p.lower_bounds[4096 + i]; lb[i] = 1.0f / (1.0f + expf(l0 - l1)); }
}
__device__ __forceinline__ void stats_krot_phase(const bf16_t* __restrict__ proj0, float* __restrict__ rq, float* __restrict__ rkv, const float* __restrict__ cs, const float* __restrict__ sn, bf16_t* __restrict__ krot) {
    const int lane = threadIdx.x & 63, gw = blockIdx.x * 8 + (threadIdx.x >> 6), nw = gridDim.x * 8;
    for (int row0 = gw; row0 < T_TOK; row0 += 4 * nw) {
        bf16x8 a[4], b[4], c[4]; float t1[4], t2[4], cc[4], sv[4];
#pragma unroll
        for (int u4 = 0; u4 < 4; ++u4) { const int row = row0 + u4 * nw; const bool ok = row < T_TOK; const bf16_t* s = proj0 + (size_t)(ok ? row : row0) * N0P; const size_t tr = (size_t)(ok ? row : row0) * 32 + (lane & 31);
            a[u4] = *(const bf16x8*)(s + lane * 8); b[u4] = *(const bf16x8*)(s + 512 + lane * 8); c[u4] = *(const bf16x8*)(s + 1024 + lane * 8);
            t1[u4] = bf2f(s[1536 + (lane & 31)]); t2[u4] = bf2f(s[1568 + (lane & 31)]); cc[u4] = cs[tr]; sv[u4] = sn[tr]; }
#pragma unroll
        for (int u4 = 0; u4 < 4; ++u4) { const int row = row0 + u4 * nw; if (row >= T_TOK) continue;
            float sq = 0.f, sk = 0.f;
#pragma unroll
            for (int j = 0; j < 8; ++j) { const float x = bf2f((unsigned short)a[u4][j]), y = bf2f((unsigned short)b[u4][j]), z = bf2f((unsigned short)c[u4][j]); sq += x * x + y * y; sk += z * z; }
            sq = wave_sum(sq); sk = wave_sum(sk);
            if (lane == 0) { rq[row] = 1.0f / sqrtf(sq * (1.0f / 1024.0f) + EPS); rkv[row] = 1.0f / sqrtf(sk * (1.0f / 512.0f) + EPS); }
            if (lane < 32) { krot[(size_t)row * 64 + lane] = f2bf(t1[u4] * cc[u4] - t2[u4] * sv[u4]); krot[(size_t)row * 64 + 32 + lane] = f2bf(t2[u4] * cc[u4] + t1[u4] * sv[u4]); } }
    }
}
__device__ __forceinline__ void headnorm_phase(bf16_t* __restrict__ proj1, const bf16_t* __restrict__ oraw, const float* __restrict__ gn) {
    int tid = threadIdx.x; asm volatile("" : "+v"(tid));
    const int per = T_TOK / gridDim.x;
    const int h = tid >> 4, vs = (tid & 15) >> 2, c8 = (tid & 3) * 8;
    const int v0 = (tid & 15) * 8; const f32x4 g0 = *(const f32x4*)(gn + v0), g1 = *(const f32x4*)(gn + v0 + 4);
    for (int tok0 = blockIdx.x * per; tok0 < (blockIdx.x + 1) * per; tok0 += 4) {
        bf16x8 o[4], z[4];
#pragma unroll
        for (int u = 0; u < 4; ++u) { const int tok = tok0 + u, b = tok >> 13, sq = tok & (SEQ - 1);
            o[u] = *(const bf16x8*)(oraw + ((size_t)((b * 32 + h) * 4 + vs) * SEQ + sq) * 32 + c8); z[u] = *(const bf16x8*)(proj1 + (size_t)tok * N1 + 12288 + tid * 8); }
#pragma unroll
        for (int u = 0; u < 4; ++u) {
            float f[8], ss = 0.f;
#pragma unroll
            for (int j = 0; j < 8; ++j) { f[j] = bf2f((unsigned short)o[u][j]); ss += f[j] * f[j]; }
            ss += __shfl_xor(ss, 1); ss += __shfl_xor(ss, 2); ss += __shfl_xor(ss, 4); ss += __shfl_xor(ss, 8);
            const float r = 1.0f / sqrtf(ss * (1.0f / 128.0f) + EPS);
            f32x4 a, bb;
#pragma unroll
            for (int j = 0; j < 4; ++j) { a[j] = f[j] * r * g0[j] * bf2f((unsigned short)z[u][j]); bb[j] = f[4 + j] * r * g1[j] * bf2f((unsigned short)z[u][4 + j]); }
            *(bf16x8*)(proj1 + (size_t)(tok0 + u) * N1 + 8192 + tid * 8) = pack8(a, bb);
        }
    }
}

namespace hg {
constexpr int QT_S = 272, KD_S = 144;
constexpr int OFF_QT = 0, OFF_KT = OFF_QT + 64 * QT_S, OFF_QB = OFF_KT + 64 * QT_S, OFF_KD = OFF_QB + 64 * QT_S;
constexpr int OFF_VT = OFF_KD + 128 * KD_S, OFF_ST = OFF_VT + 32 * KD_S, OFF_ATT = OFF_ST + 32 * QT_S;
constexpr int OFF_SEG = OFF_ATT + 64 * KD_S, OFF_G32 = OFF_SEG + 2048, OFF_DEC = OFF_G32 + 512, LDS_BYTES = OFF_DEC + 512;
__device__ __forceinline__ int crow(int r, int hi) { return (r & 3) + 8 * (r >> 2) + 4 * hi; }

__device__ __forceinline__ void hgrn2_phase(char* lds, const bf16_t* __restrict__ proj1, bf16_t* __restrict__ oraw) {
    int tid = threadIdx.x; asm volatile("" : "+v"(tid));
    const int wid = __builtin_amdgcn_readfirstlane(tid >> 6), lane = tid & 63, r32 = lane & 31, hi = lane >> 5;
    const int kch = tid & 127, seg = tid >> 7;
    float* segtot = (float*)(lds + OFF_SEG); float* g32s = (float*)(lds + OFF_G32); float* decay = (float*)(lds + OFF_DEC);
    for (int item = blockIdx.x; item < 256; item += gridDim.x) {
        const int vs = item & 3, bh = item >> 2, b = bh >> 5, h = bh & 31;
        const bf16_t* base = proj1 + (size_t)b * SEQ * N1; bf16_t* ob = oraw + (size_t)item * SEQ * 32;
        const int qcol = h * 128 + kch, gcol = 4096 + h * 128 + kch, vcol = 8192 + h * 128 + vs * 32;
        f32x16 sacc = {};
        for (int i = tid; i < 32 * QT_S / 4; i += 512) ((unsigned*)(lds + OFF_ST))[i] = 0u;
        unsigned short graw[16], qraw[16]; u32x2 vraw;
        { const bf16_t* rp = base + (size_t)(seg * 16) * N1;
#pragma unroll
          for (int i = 0; i < 16; ++i) { graw[i] = rp[(size_t)i * N1 + gcol]; qraw[i] = rp[(size_t)i * N1 + qcol]; }
          vraw = *(const u32x2*)(base + (size_t)(tid >> 3) * N1 + vcol + (tid & 7) * 4); }
        for (int ch = 0; ch < 128; ++ch) {
            const int tok0 = ch * 64;
            float gl[16]; float cum = 0.f;
#pragma unroll
            for (int i = 0; i < 16; ++i) { cum += bf2f(graw[i]); gl[i] = cum; }
            segtot[seg * 128 + kch] = cum; if (seg == 2) g32s[kch] = bf2f(graw[0]);
            __syncthreads();
            { const float s0 = segtot[kch], s1 = segtot[128 + kch], s2 = segtot[256 + kch], s3 = segtot[384 + kch];
              const float off = (seg > 0 ? s0 : 0.f) + (seg > 1 ? s1 : 0.f) + (seg > 2 ? s2 : 0.f);
              const float tot = (s0 + s1) + (s2 + s3), bref = s0 + s1 + g32s[kch];
              if (seg == 0) decay[kch] = fast_exp(tot);
              float kd[16];
#pragma unroll
              for (int i = 0; i < 16; ++i) { const int t = seg * 16 + i; const float bb = off + gl[i], gv = bf2f(graw[i]), qv = bf2f(qraw[i]); const float kk = 1.0f - fast_exp(gv);
                  *(bf16_t*)(lds + OFF_QT + t * QT_S + kch * 2) = f2bf_n(qv * fast_exp(bb - bref));
                  *(bf16_t*)(lds + OFF_KT + t * QT_S + kch * 2) = f2bf_n(kk * fast_exp(bref - bb));
                  *(bf16_t*)(lds + OFF_QB + t * QT_S + kch * 2) = f2bf_n(qv * fast_exp(bb));
                  kd[i] = kk * fast_exp(tot - bb); }
              *(bf16x8*)(lds + OFF_KD + kch * KD_S + seg * 32) = pack8((f32x4){kd[0], kd[1], kd[2], kd[3]}, (f32x4){kd[4], kd[5], kd[6], kd[7]});
              *(bf16x8*)(lds + OFF_KD + kch * KD_S + seg * 32 + 16) = pack8((f32x4){kd[8], kd[9], kd[10], kd[11]}, (f32x4){kd[12], kd[13], kd[14], kd[15]});
              { const int t = tid >> 3, v4 = (tid & 7) * 4;
                *(bf16_t*)(lds + OFF_VT + (v4 + 0) * KD_S + t * 2) = (bf16_t)(vraw.x & 0xffffu); *(bf16_t*)(lds + OFF_VT + (v4 + 1) * KD_S + t * 2) = (bf16_t)(vraw.x >> 16);
                *(bf16_t*)(lds + OFF_VT + (v4 + 2) * KD_S + t * 2) = (bf16_t)(vraw.y & 0xffffu); *(bf16_t*)(lds + OFF_VT + (v4 + 3) * KD_S + t * 2) = (bf16_t)(vraw.y >> 16); }
            }
            if (ch + 1 < 128) { const bf16_t* rp = base + (size_t)(tok0 + 64 + seg * 16) * N1;
#pragma unroll
                for (int i = 0; i < 16; ++i) { graw[i] = rp[(size_t)i * N1 + gcol]; qraw[i] = rp[(size_t)i * N1 + qcol]; }
                vraw = *(const u32x2*)(base + (size_t)(tok0 + 64 + (tid >> 3)) * N1 + vcol + (tid & 7) * 4); }
            __syncthreads();
            f32x16 oacc = {};
            if (wid < 4) {
                const int ci = wid >> 1, si = wid & 1;
                if (!(ci == 0 && si == 1)) {
                    f32x16 aacc = {};
#pragma unroll
                    for (int kk = 0; kk < 8; ++kk) {
                        const bf16x8 af = *(const bf16x8*)(lds + OFF_QT + (32 * ci + r32) * QT_S + kk * 32 + hi * 16);
                        const bf16x8 bfr = *(const bf16x8*)(lds + OFF_KT + (32 * si + r32) * QT_S + kk * 32 + hi * 16);
                        aacc = __builtin_amdgcn_mfma_f32_32x32x16_bf16(af, bfr, aacc, 0, 0, 0); }
#pragma unroll
                    for (int i = 0; i < 16; ++i) { const int c = 32 * ci + crow(i, hi), s = 32 * si + r32; const float v = (c >= s) ? aacc[i] : 0.f;
                        *(bf16_t*)(lds + OFF_ATT + c * KD_S + s * 2) = f2bf_n(v); }
                } else {
#pragma unroll
                    for (int i = 0; i < 16; ++i) { const int c = crow(i, hi), s = 32 + r32; *(bf16_t*)(lds + OFF_ATT + c * KD_S + s * 2) = (bf16_t)0; }
                }
#pragma unroll
                for (int g4 = 0; g4 < 4; ++g4) { const f32x4 d = *(const f32x4*)(decay + 32 * wid + 8 * g4 + 4 * hi);
#pragma unroll
                    for (int j = 0; j < 4; ++j) sacc[g4 * 4 + j] *= d[j]; }
#pragma unroll
                for (int kk = 0; kk < 4; ++kk) {
                    const bf16x8 af = *(const bf16x8*)(lds + OFF_KD + (32 * wid + r32) * KD_S + kk * 32 + hi * 16);
                    const bf16x8 bfr = *(const bf16x8*)(lds + OFF_VT + r32 * KD_S + kk * 32 + hi * 16);
                    sacc = __builtin_amdgcn_mfma_f32_32x32x16_bf16(af, bfr, sacc, 0, 0, 0); }
            } else if (wid < 6) {
                const int ci = wid - 4;
#pragma unroll
                for (int kk = 0; kk < 8; ++kk) {
                    const bf16x8 af = *(const bf16x8*)(lds + OFF_QB + (32 * ci + r32) * QT_S + kk * 32 + hi * 16);
                    const bf16x8 bfr = *(const bf16x8*)(lds + OFF_ST + r32 * QT_S + kk * 32 + hi * 16);
                    oacc = __builtin_amdgcn_mfma_f32_32x32x16_bf16(af, bfr, oacc, 0, 0, 0); }
            }
            __syncthreads();
            if (wid < 4) {
#pragma unroll
                for (int g4 = 0; g4 < 4; ++g4) { u32x2 w; w.x = cvtpk_n(sacc[g4 * 4 + 0], sacc[g4 * 4 + 1]); w.y = cvtpk_n(sacc[g4 * 4 + 2], sacc[g4 * 4 + 3]);
                    *(u32x2*)(lds + OFF_ST + r32 * QT_S + (32 * wid + 8 * g4 + 4 * hi) * 2) = w; }
            } else if (wid < 6) {
                const int ci = wid - 4;
#pragma unroll
                for (int kk = 0; kk < 4; ++kk) {
                    const bf16x8 af = *(const bf16x8*)(lds + OFF_ATT + (32 * ci + r32) * KD_S + kk * 32 + hi * 16);
                    const bf16x8 bfr = *(const bf16x8*)(lds + OFF_VT + r32 * KD_S + kk * 32 + hi * 16);
                    oacc = __builtin_amdgcn_mfma_f32_32x32x16_bf16(af, bfr, oacc, 0, 0, 0); }
#pragma unroll
                for (int i = 0; i < 16; ++i) { const int c = 32 * ci + crow(i, hi); ob[(size_t)(tok0 + c) * 32 + r32] = f2bf_n(oacc[i]); }
            }
        }
        __syncthreads();
    }
}
}
namespace hg2 {
#define LBAR() do { asm volatile("s_waitcnt lgkmcnt(0)" ::: "memory"); __builtin_amdgcn_s_barrier(); asm volatile("" ::: "memory"); } while (0)
constexpr int QT_S = 272, KD_S = 144;
constexpr int OFF_QT = 0, OFF_KT = OFF_QT + 64 * QT_S, OFF_QB = OFF_KT + 64 * QT_S, OFF_KD = OFF_QB + 64 * QT_S;
constexpr int OFF_VT4 = OFF_KD + 128 * KD_S, OFF_ATT = OFF_VT4 + 128 * KD_S;
constexpr int OFF_SEG = OFF_ATT + 64 * KD_S, OFF_G32 = OFF_SEG + 2048, OFF_DEC = OFF_G32 + 512, LDS_BYTES = OFF_DEC + 512;
constexpr int ST_BYTES = 32 * QT_S;
__device__ __forceinline__ int crow(int r, int hi) { return (r & 3) + 8 * (r >> 2) + 4 * hi; }

__device__ __forceinline__ void prepass(char* lds, bf16_t* __restrict__ proj1, char* __restrict__ attbuf, float* __restrict__ decbuf) {
    int tid = threadIdx.x; asm volatile("" : "+v"(tid));
    const int wid = __builtin_amdgcn_readfirstlane(tid >> 6), lane = tid & 63, r32 = lane & 31, hi = lane >> 5;
    const int kch = tid & 127, seg = tid >> 7;
    float* segtot = (float*)(lds + OFF_SEG); float* g32s = (float*)(lds + OFF_G32); float* decay = (float*)(lds + OFF_DEC);
    unsigned short graw[16], qraw[16]; bf16x8 vr0, vr1;
#define PRE_LOAD(it_) do { const int bh_ = (it_) >> 7, ch_ = (it_) & 127, b_ = bh_ >> 5, h_ = bh_ & 31;                                   \
        const bf16_t* bs_ = proj1 + ((size_t)b_ * SEQ + ch_ * 64) * N1; const bf16_t* rp_ = bs_ + (size_t)(seg * 16) * N1 + h_ * 128 + kch; \
        _Pragma("unroll") for (int i = 0; i < 16; ++i) { graw[i] = rp_[(size_t)i * N1 + 4096]; qraw[i] = rp_[(size_t)i * N1]; }                \
        const bf16_t* vp_ = bs_ + (size_t)(tid & 63) * N1 + 8192 + h_ * 128 + (tid >> 6) * 16;                                                \
        vr0 = *(const bf16x8*)vp_; vr1 = *(const bf16x8*)(vp_ + 8); } while (0)
    if (blockIdx.x < 8192) PRE_LOAD(blockIdx.x);
    for (int item = blockIdx.x; item < 8192; item += gridDim.x) {
        const int bh = item >> 7, ch = item & 127, b = bh >> 5, h = bh & 31;
        bf16_t* base = proj1 + ((size_t)b * SEQ + ch * 64) * N1;
        const int qcol = h * 128, gcol = 4096 + h * 128, vcol = 8192 + h * 128;
        float gl[16]; float cum = 0.f;
#pragma unroll
        for (int i = 0; i < 16; ++i) { cum += bf2f(graw[i]); gl[i] = cum; }
        segtot[seg * 128 + kch] = cum; if (seg == 2) g32s[kch] = bf2f(graw[0]);
        LBAR();
        { const float s0 = segtot[kch], s1 = segtot[128 + kch], s2 = segtot[256 + kch], s3 = segtot[384 + kch];
          const float off = (seg > 0 ? s0 : 0.f) + (seg > 1 ? s1 : 0.f) + (seg > 2 ? s2 : 0.f);
          const float tot = (s0 + s1) + (s2 + s3), bref = s0 + s1 + g32s[kch];
          if (seg == 0) decay[kch] = fast_exp(tot);
          float kd[16];
#pragma unroll
          for (int i = 0; i < 16; ++i) { const int t = seg * 16 + i; const float bb = off + gl[i], gv = bf2f(graw[i]), qv = bf2f(qraw[i]); const float kk = 1.0f - fast_exp(gv);
              *(bf16_t*)(lds + OFF_QT + t * QT_S + kch * 2) = f2bf_n(qv * fast_exp(bb - bref));
              *(bf16_t*)(lds + OFF_KT + t * QT_S + kch * 2) = f2bf_n(kk * fast_exp(bref - bb));
              *(bf16_t*)(lds + OFF_QB + t * QT_S + kch * 2) = f2bf_n(qv * fast_exp(bb));
              kd[i] = kk * fast_exp(tot - bb); }
          *(bf16x8*)(lds + OFF_KD + kch * KD_S + seg * 32) = pack8((f32x4){kd[0], kd[1], kd[2], kd[3]}, (f32x4){kd[4], kd[5], kd[6], kd[7]});
          *(bf16x8*)(lds + OFF_KD + kch * KD_S + seg * 32 + 16) = pack8((f32x4){kd[8], kd[9], kd[10], kd[11]}, (f32x4){kd[12], kd[13], kd[14], kd[15]});
          { const int t = tid & 63, v16 = (tid >> 6) * 16;
#pragma unroll
            for (int j = 0; j < 8; ++j) { *(bf16_t*)(lds + OFF_VT4 + (v16 + j) * KD_S + t * 2) = (bf16_t)vr0[j]; *(bf16_t*)(lds + OFF_VT4 + (v16 + 8 + j) * KD_S + t * 2) = (bf16_t)vr1[j]; } }
        }
        if (item + (int)gridDim.x < 8192) PRE_LOAD(item + gridDim.x);
        LBAR();
        const size_t lrow = (size_t)(lane >> 4) * N1 + (lane & 15) * 8;
        if (wid < 4) {
            const int ci = wid >> 1, si = wid & 1;
            if (!(ci == 0 && si == 1)) {
                f32x16 aacc = {};
#pragma unroll
                for (int kk = 0; kk < 8; ++kk) {
                    const bf16x8 af = *(const bf16x8*)(lds + OFF_QT + (32 * ci + r32) * QT_S + kk * 32 + hi * 16);
                    const bf16x8 bfr = *(const bf16x8*)(lds + OFF_KT + (32 * si + r32) * QT_S + kk * 32 + hi * 16);
                    aacc = __builtin_amdgcn_mfma_f32_32x32x16_bf16(af, bfr, aacc, 0, 0, 0); }
#pragma unroll
                for (int i = 0; i < 16; ++i) { const int c = 32 * ci + crow(i, hi), s = 32 * si + r32; const float v = (c >= s) ? aacc[i] : 0.f;
                    *(bf16_t*)(lds + OFF_ATT + c * KD_S + s * 2) = f2bf_n(v); }
            } else {
#pragma unroll
                for (int i = 0; i < 16; ++i) { const int c = crow(i, hi), s = 32 + r32; *(bf16_t*)(lds + OFF_ATT + c * KD_S + s * 2) = (bf16_t)0; }
            }
        } else {
#pragma unroll
            for (int e = 0; e < 4; ++e) { const int f = 4 * (wid - 4) + e;
                { const int ci = f >> 3, kk = f & 7; const bf16x8 fr = *(const bf16x8*)(lds + OFF_QB + (32 * ci + r32) * QT_S + kk * 32 + hi * 16);
                  *(bf16x8*)(base + (size_t)(4 * f) * N1 + qcol + lrow) = fr; }
                { const int kt = f >> 2, kk = f & 3; const bf16x8 fr = *(const bf16x8*)(lds + OFF_KD + (32 * kt + r32) * KD_S + kk * 32 + hi * 16);
                  *(bf16x8*)(base + (size_t)(4 * f) * N1 + gcol + lrow) = fr; }
                { const int vs = f >> 2, kk = f & 3; const bf16x8 fr = *(const bf16x8*)(lds + OFF_VT4 + (32 * vs + r32) * KD_S + kk * 32 + hi * 16);
                  *(bf16x8*)(base + (size_t)(4 * f) * N1 + vcol + lrow) = fr; } }
        }
        LBAR();
        { const int f = wid, ci = f >> 2, kk = f & 3; const bf16x8 fr = *(const bf16x8*)(lds + OFF_ATT + (32 * ci + r32) * KD_S + kk * 32 + hi * 16);
          *(bf16x8*)(attbuf + ((size_t)item * 8 + f) * 1024 + lane * 16) = fr; }
        if (tid < 32) *(f32x4*)(decbuf + (size_t)item * 128 + tid * 4) = *(const f32x4*)(decay + tid * 4);
    }
#undef PRE_LOAD
    LBAR();
}

__device__ __forceinline__ void seqpass(char* lds, const bf16_t* __restrict__ proj1, const char* __restrict__ attbuf, const float* __restrict__ decbuf, bf16_t* __restrict__ oraw) {
    int tid = threadIdx.x; asm volatile("" : "+v"(tid));
    const int wid = __builtin_amdgcn_readfirstlane(tid >> 6), lane = tid & 63, r32 = lane & 31, hi = lane >> 5;
    constexpr int OFF_AV = 2 * ST_BYTES;
#ifndef PROBE_SEQDUP
#define PROBE_SEQDUP 0
#endif
    for (int it2 = blockIdx.x; it2 < (1 + PROBE_SEQDUP) * 256; it2 += gridDim.x) {
        const int w_ = it2 & 255;
        const int bh = (w_ & 7) * 8 + (w_ >> 5), vs = (w_ >> 3) & 3, item = bh * 4 + vs, b = bh >> 5, h = bh & 31;
        const char* base0 = (const char*)(proj1 + (size_t)b * SEQ * N1);
        const unsigned lrow = (unsigned)(((lane >> 4) * N1 + (lane & 15) * 8) * 2);
        constexpr size_t CHB = (size_t)64 * N1 * 2, FRB = (size_t)4 * N1 * 2;
        for (int i = tid; i < 2 * ST_BYTES / 4; i += 512) ((unsigned*)lds)[i] = 0u;
        if (wid < 4) {
            f32x16 sacc = {};
            const char* gb = base0 + (size_t)(4096 + h * 128) * 2 + (size_t)(wid * 4) * FRB;
            const char* vb = base0 + (size_t)(8192 + h * 128) * 2 + (size_t)(vs * 4) * FRB;
            const float* db = decbuf + (size_t)bh * 128 * 128 + 32 * wid + 4 * hi;
            bf16x8 K0[4], V0[4], K1[4], V1[4], K2[4], V2[4]; f32x4 D0[4], D1[4], D2[4];
#define ST_LOAD(K_, V_, d_, ch_) do { _Pragma("unroll") for (int kk = 0; kk < 4; ++kk) { K_[kk] = *(const bf16x8*)(gb + (size_t)(ch_) * CHB + kk * FRB + lrow);  \
                                                                                         V_[kk] = *(const bf16x8*)(vb + (size_t)(ch_) * CHB + kk * FRB + lrow);  \
                                                                                         d_[kk] = *(const f32x4*)(db + (size_t)(ch_) * 128 + 8 * kk); } } while (0)
#define ST_STEP(c_, K_, V_, d_, LK_, LV_, Ld_) do { if ((c_) + 2 < 128) ST_LOAD(LK_, LV_, Ld_, (c_) + 2);                                                      \
                char* st_nxt = lds + (((c_) + 1) & 1) * ST_BYTES;                                                                                                \
                _Pragma("unroll") for (int g4 = 0; g4 < 4; ++g4) _Pragma("unroll") for (int j = 0; j < 4; ++j) sacc[g4 * 4 + j] *= d_[g4][j];                    \
                _Pragma("unroll") for (int kk = 0; kk < 4; ++kk) sacc = __builtin_amdgcn_mfma_f32_32x32x16_bf16(K_[kk], V_[kk], sacc, 0, 0, 0);                  \
                _Pragma("unroll") for (int g4 = 0; g4 < 4; ++g4) { u32x2 w; w.x = cvtpk_n(sacc[g4 * 4 + 0], sacc[g4 * 4 + 1]); w.y = cvtpk_n(sacc[g4 * 4 + 2], sacc[g4 * 4 + 3]); \
                    *(u32x2*)(st_nxt + r32 * QT_S + (32 * wid + 8 * g4 + 4 * hi) * 2) = w; }                                                                    \
                LBAR(); } while (0)
            ST_LOAD(K0, V0, D0, 0); ST_LOAD(K1, V1, D1, 1);
            LBAR();
            for (int ch = 0; ch < 126; ch += 3) { ST_STEP(ch, K0, V0, D0, K2, V2, D2); ST_STEP(ch + 1, K1, V1, D1, K0, V0, D0); ST_STEP(ch + 2, K2, V2, D2, K1, V1, D1); }
            ST_STEP(126, K0, V0, D0, K2, V2, D2); ST_STEP(127, K1, V1, D1, K0, V0, D0);
#undef ST_STEP
#undef ST_LOAD
        } else if (wid < 6) {
            const int ci = wid - 4;
            const char* qb = base0 + (size_t)(h * 128) * 2 + (size_t)(ci * 8) * FRB;
            char* ob = (char*)(oraw + (size_t)item * SEQ * 32) + (size_t)(32 * ci) * 64;
            const unsigned ooff = (unsigned)((4 * hi * 32 + r32) * 2);
            char* ot = lds + OFF_AV + 16384 + ci * 2048;
            bf16x8 Q0[8], Q1[8], Q2[8];
#define O_LOAD(Q_, ch_) do { _Pragma("unroll") for (int kk = 0; kk < 8; ++kk) Q_[kk] = *(const bf16x8*)(qb + (size_t)(ch_) * CHB + kk * FRB + lrow); } while (0)
#define O_STEP(c_, Q_, LQ_) do { if ((c_) + 2 < 128) O_LOAD(LQ_, (c_) + 2);                                                                                      \
                const char* st_cur = lds + ((c_) & 1) * ST_BYTES; const char* av = lds + OFF_AV + ((((c_) & 1) * 2 + ci) * 4) * 1024 + lane * 16;               \
                f32x16 oacc;                                                                                                                                     \
                _Pragma("unroll") for (int q = 0; q < 4; ++q) { const f32x4 t4 = *(const f32x4*)(av + q * 1024); oacc[q * 4 + 0] = t4[0]; oacc[q * 4 + 1] = t4[1]; oacc[q * 4 + 2] = t4[2]; oacc[q * 4 + 3] = t4[3]; } \
                _Pragma("unroll") for (int kk = 0; kk < 8; ++kk) { const bf16x8 sf = *(const bf16x8*)(st_cur + r32 * QT_S + kk * 32 + hi * 16);                  \
                    oacc = __builtin_amdgcn_mfma_f32_32x32x16_bf16(Q_[kk], sf, oacc, 0, 0, 0); }                                                                \
                char* oc = ob + (size_t)(c_) * (64 * 64);                                                                                                        \
                _Pragma("unroll") for (int i = 0; i < 16; ++i) *(bf16_t*)(ot + ((i & 3) + 8 * (i >> 2)) * 64 + ooff) = f2bf_n(oacc[i]);     \
                asm volatile("s_waitcnt lgkmcnt(0)" ::: "memory");                                                                                               \
                { const bf16x8 w0 = *(const bf16x8*)(ot + lane * 16), w1 = *(const bf16x8*)(ot + 1024 + lane * 16);                                              \
                  *(bf16x8*)(oc + lane * 16) = w0; *(bf16x8*)(oc + 1024 + lane * 16) = w1; }                    \
                LBAR(); } while (0)
            O_LOAD(Q0, 0); O_LOAD(Q1, 1);
            LBAR();
            for (int ch = 0; ch < 126; ch += 3) { O_STEP(ch, Q0, Q2); O_STEP(ch + 1, Q1, Q0); O_STEP(ch + 2, Q2, Q1); }
            O_STEP(126, Q0, Q2); O_STEP(127, Q1, Q0);
#undef O_STEP
#undef O_LOAD
        } else {
            const int ci = wid - 6;
            const char* vb = base0 + (size_t)(8192 + h * 128) * 2 + (size_t)(vs * 4) * FRB;
            const char* ab = attbuf + ((size_t)bh * 128 * 8 + ci * 4) * 1024 + lane * 16;
            bf16x8 A0[4], V0[4], A1[4], V1[4], A2[4], V2[4];
#define AV_LOAD(A_, V_, ch_) do { _Pragma("unroll") for (int kk = 0; kk < 4; ++kk) { A_[kk] = *(const bf16x8*)(ab + (size_t)(ch_) * 8192 + kk * 1024);          \
                                                                                     V_[kk] = *(const bf16x8*)(vb + (size_t)(ch_) * CHB + kk * FRB + lrow); } } while (0)
#define AV_DO(A_, V_, slot_) do { f32x16 acc_ = {}; _Pragma("unroll") for (int kk = 0; kk < 4; ++kk) acc_ = __builtin_amdgcn_mfma_f32_32x32x16_bf16(A_[kk], V_[kk], acc_, 0, 0, 0); \
        char* av_ = lds + OFF_AV + ((((slot_) & 1) * 2 + ci) * 4) * 1024 + lane * 16;                                                                                   \
        _Pragma("unroll") for (int q = 0; q < 4; ++q) *(f32x4*)(av_ + q * 1024) = (f32x4){acc_[q * 4 + 0], acc_[q * 4 + 1], acc_[q * 4 + 2], acc_[q * 4 + 3]}; } while (0)
            AV_LOAD(A0, V0, 0); AV_LOAD(A1, V1, 1); AV_LOAD(A2, V2, 2);
            AV_DO(A0, V0, 0);
            LBAR();
#define AV_STEP(c_, A_, V_, LA_, LV_) do { if ((c_) + 3 < 128) AV_LOAD(LA_, LV_, (c_) + 3); if ((c_) + 1 < 128) AV_DO(A_, V_, (c_) + 1); LBAR(); } while (0)
            for (int ch = 0; ch < 126; ch += 3) { AV_STEP(ch, A1, V1, A0, V0); AV_STEP(ch + 1, A2, V2, A1, V1); AV_STEP(ch + 2, A0, V0, A2, V2); }
            AV_STEP(126, A1, V1, A0, V0); AV_STEP(127, A2, V2, A1, V1);
#undef AV_STEP
#undef AV_LOAD
#undef AV_DO
        }
    }
}
#undef LBAR
}
constexpr int LDS_MAIN = pg8::STAGE_BYTES;
constexpr int LDS_TOTAL = LDS_MAIN + 16;
constexpr size_t WS_BAR = WS_END;
static_assert(att::LDS_BYTES <= LDS_MAIN && hg::LDS_BYTES <= LDS_MAIN && hg2::LDS_BYTES <= LDS_MAIN, "lds");
static_assert((size_t)8192 * 8192 + (size_t)8192 * 512 <= WS_W1O, "attbuf/decbuf must fit in the dead weight region");

#ifndef PHMASK
#define PHMASK 0xFFFF
#endif
#define EN(n) (((PHMASK) >> (n)) & 1)
#ifndef SKIP_SEQ
#define SKIP_SEQ 0
#endif
#ifndef SKIP_PRE
#define SKIP_PRE 0
#endif
#ifndef PROBE_DUP7
#define PROBE_DUP7 0
#endif

__global__ void __launch_bounds__(512) mla_hgrn2_fwd(Params p) {
    extern __shared__ __attribute__((aligned(16))) unsigned char lds[];
    cg::grid_group grid = cg::this_grid();
    unsigned char* ws = p.ws;
    bf16_t* W0IN = (bf16_t*)(ws + WS_W0IN); bf16_t* WUQ = (bf16_t*)(ws + WS_WUQ); bf16_t* WUKV = (bf16_t*)(ws + WS_WUKV);
    bf16_t* W0O = (bf16_t*)(ws + WS_W0O); bf16_t* W1IN = (bf16_t*)(ws + WS_W1IN); bf16_t* W1O = (bf16_t*)(ws + WS_W1O);
    float* RSTD0 = (float*)(ws + WS_RSTD0); float* RSTDQ = (float*)(ws + WS_RSTDQ); float* RSTDKV = (float*)(ws + WS_RSTDKV); float* RSTD1 = (float*)(ws + WS_RSTD1);
    float* LB = (float*)(ws + WS_LB); float* COS = (float*)(ws + WS_COS); float* SIN = (float*)(ws + WS_SIN);
    bf16_t* KROT = (bf16_t*)(ws + WS_KROT); bf16_t* ACTA = (bf16_t*)(ws + WS_ACTA);
    bf16_t* PROJ0 = (bf16_t*)(ws + WS_PROJ0); bf16_t* QBUF = (bf16_t*)(ws + WS_Q); bf16_t* PROJ1 = (bf16_t*)(ws + WS_PROJ1);
    bf16_t* X1B = (bf16_t*)p.out;
    bf16_t* KVBUF = (bf16_t*)p.out;
    LAS unsigned char* ldsl = (LAS unsigned char*)lds;
    const int G = gridDim.x, c = blockIdx.x;
    volatile LAS unsigned* bst = (volatile LAS unsigned*)(ldsl + LDS_MAIN);
    if (threadIdx.x == 0) { bst[0] = 0u; bst[1] = 0u; bst[2] = 0u; bst[3] = 0u; }
    __syncthreads();
    const XcdBarrier xbar = xcd_barrier_post((unsigned*)(ws + WS_BAR), bst);
#define GRID_BAR() xcd_barrier(xbar)

    if (EN(0))
    {
        char* tile = (char*)lds;
        wt_phase(p.l0_w_in, 4096, N0, p.l0_norm, W0IN, tile);
        wt_phase(p.l0_w_uq, 1024, NQ, p.l0_q_norm, WUQ, tile);
        wt_phase(p.l0_w_ukv, 512, NKV, p.l0_kv_norm, WUKV, tile);
        wt_phase(p.l0_w_o, 4096, 4096, nullptr, W0O, tile);
        wt_phase(p.l1_w_in, 4096, N1, p.l1_norm, W1IN, tile);
        wt_phase(p.l1_w_o, 4096, 4096, nullptr, W1O, tile);
        { u32x4 z = {0u, 0u, 0u, 0u}; u32x4* pad = (u32x4*)(W0IN + (size_t)N0 * 4096); const int n16 = (N0P - N0) * 4096 * 2 / 16;
          for (int i = c * 512 + threadIdx.x; i < n16; i += G * 512) pad[i] = z; }
        cast_rstd_phase(p.x, ACTA, RSTD0);
        tables_phase(p, COS, SIN, LB);
        for (int i = c * 512 + threadIdx.x; i < T_TOK; i += G * 512) RSTD1[i] = 0.f;
    }
#ifdef PROBE_P02
    {
        char* tile = (char*)lds;
        wt_phase(p.l0_w_in, 4096, N0, p.l0_norm, W0IN, tile);
        wt_phase(p.l0_w_uq, 1024, NQ, p.l0_q_norm, WUQ, tile);
        wt_phase(p.l0_w_ukv, 512, NKV, p.l0_kv_norm, WUKV, tile);
        wt_phase(p.l0_w_o, 4096, 4096, nullptr, W0O, tile);
        wt_phase(p.l1_w_in, 4096, N1, p.l1_norm, W1IN, tile);
        wt_phase(p.l1_w_o, 4096, 4096, nullptr, W1O, tile);
    }
#endif
    grid.sync();
    if (EN(1)) {
        pg8::Gemm g{ACTA, W0IN, T_TOK, N0P, 4096, 4096}; pg8::StaticOrder S; S.init(T_TOK, N0P, G, c);
        pg8::EpiBf16<1> E{PROJ0, N0P, RSTD0, 1600, nullptr};
        pg8::gemm_phase(ldsl, g, S, E);
    }
    GRID_BAR();
    if (EN(2)) stats_krot_phase(PROJ0, RSTDQ, RSTDKV, COS, SIN, KROT);
    GRID_BAR();
    if (EN(3)) {
        pg8::Gemm g{PROJ0, WUQ, T_TOK, NQ, 1024, N0P}; pg8::StaticOrder S; S.init(T_TOK, NQ, G, c);
        pg8::EpiBf16<0> E{QBUF, NQ, RSTDQ, 0, nullptr};
        pg8::gemm_phase(ldsl, g, S, E);
    }
    if (EN(3)) {
        pg8::Gemm g{PROJ0 + 1024, WUKV, T_TOK, NKV, 512, N0P}; pg8::StaticOrder S; S.init(T_TOK, NKV, G, c);
        pg8::EpiBf16<0> E{KVBUF, NKV, RSTDKV, 0, nullptr};
        pg8::gemm_phase(ldsl, g, S, E);
    }
    GRID_BAR();
    if (EN(4)) {
        att::Tensors T{QBUF, KVBUF, KROT, ACTA, PROJ0, COS, SIN};
        att::attn_phase((char*)lds, T);
    }
    GRID_BAR();
    if (EN(5)) {
        for (int i = c * 512 + threadIdx.x; i < T_TOK; i += G * 512) RSTDQ[i] = 0.f;
        pg8::Gemm g{ACTA, W0O, T_TOK, 4096, 4096, 4096}; pg8::StaticOrder S; S.init(T_TOK, 4096, G, c);
        pg8::EpiResBf16Stat E{p.x, X1B, 4096, RSTD1};
        pg8::gemm_phase(ldsl, g, S, E);
    }
    GRID_BAR();
    if (EN(7)) {
        pg8::Gemm g{X1B, W1IN, T_TOK, N1, 4096, 4096}; pg8::StaticOrder S; S.init(T_TOK, N1, G, c, PROBE_DUP7);
        pg8::EpiBf16<2> E{PROJ1, N1, RSTD1, 0, LB, 1};
        pg8::gemm_phase(ldsl, g, S, E);
    }
    GRID_BAR();
#ifdef HG_OLD
    if (EN(8)) hg::hgrn2_phase((char*)lds, PROJ1, ACTA);
#else
    if (EN(8) && !SKIP_PRE) hg2::prepass((char*)lds, PROJ1, (char*)(ws + WS_W0IN), (float*)(ws + WS_W0IN + (size_t)8192 * 8192));
    GRID_BAR();
    if (EN(8) && !SKIP_SEQ) hg2::seqpass((char*)lds, PROJ1, (const char*)(ws + WS_W0IN), (const float*)(ws + WS_W0IN + (size_t)8192 * 8192), ACTA);
#endif
#ifdef PROBE_HG2
    __syncthreads(); hg::hgrn2_phase((char*)lds, PROJ1, ACTA);
#endif
    GRID_BAR();
    if (EN(9)) headnorm_phase(PROJ1, ACTA, p.l1_g_norm);
    GRID_BAR();
    if (EN(10)) {
        pg8::Gemm g{PROJ1 + 8192, W1O, T_TOK, 4096, 4096, N1}; pg8::StaticOrder S; S.init(T_TOK, 4096, G, c);
        pg8::EpiBf16ResBf16Stat E{X1B, 4096, PROJ1, N1, RSTDQ};
        pg8::gemm_phase(ldsl, g, S, E);
    }
    GRID_BAR();
    if (EN(11)) final_norm_bf16_phase(PROJ1, (size_t)N1, RSTDQ, p.out, p.final_norm);
}

extern "C" void kernel_launch(void* const* d_in, const int* in_sizes, int n_in, void* d_out, int out_size, void* d_ws, size_t ws_size, hipStream_t stream) {
    static int grid = 0;
    if (grid == 0) {
        if (n_in != 15 || ws_size < WS_BAR + XCD_BAR_WORDS * sizeof(unsigned)) { fprintf(stderr, "kernel_launch: unexpected inputs (n_in %d, ws %zu, need %zu)\n", n_in, ws_size, (size_t)(WS_BAR + XCD_BAR_WORDS * sizeof(unsigned))); grid = -1; return; }
        int dev = 0, cus = 0, per_cu = 0;
        (void)hipGetDevice(&dev); (void)hipDeviceGetAttribute(&cus, hipDeviceAttributeMultiprocessorCount, dev);
        if (hipFuncSetAttribute((const void*)mla_hgrn2_fwd, hipFuncAttributeMaxDynamicSharedMemorySize, LDS_TOTAL) != hipSuccess) { fprintf(stderr, "kernel_launch: hipFuncSetAttribute failed\n"); grid = -1; return; }
        if (hipOccupancyMaxActiveBlocksPerMultiprocessor(&per_cu, (const void*)mla_hgrn2_fwd, 512, LDS_TOTAL) != hipSuccess || per_cu < 1) { fprintf(stderr, "kernel_launch: occupancy query gave %d\n", per_cu); per_cu = 1; }
        (void)hipGetLastError();
        if (cus <= 0) cus = 256;
        grid = cus * per_cu;
        fprintf(stderr, "kernel_launch: grid %d (cus %d x %d)\n", grid, cus, per_cu);
    }
    if (grid < 0) return;
    Params p{};
    p.x = (const float*)d_in[0]; p.pos = (const int*)d_in[1]; p.l0_norm = (const float*)d_in[2]; p.l0_w_in = (const float*)d_in[3]; p.l0_q_norm = (const float*)d_in[4];
    p.l0_w_uq = (const float*)d_in[5]; p.l0_kv_norm = (const float*)d_in[6]; p.l0_w_ukv = (const float*)d_in[7]; p.l0_w_o = (const float*)d_in[8]; p.l1_norm = (const float*)d_in[9];
    p.l1_w_in = (const float*)d_in[10]; p.l1_g_norm = (const float*)d_in[11]; p.l1_w_o = (const float*)d_in[12]; p.lower_bounds = (const float*)d_in[13]; p.final_norm = (const float*)d_in[14];
    p.out = (float*)d_out; p.ws = (unsigned char*)d_ws;
    for (int j = 0; j < 32; ++j) p.inv_freq[j] = (float)(1.0 / pow(10000.0, (double)(2 * j) / 64.0));
    if (hipMemsetAsync((char*)d_ws + WS_BAR, 0, XCD_BAR_WORDS * sizeof(unsigned), stream) != hipSuccess) { fprintf(stderr, "kernel_launch: memset of the barrier words failed\n"); return; }
    void* args[] = {&p};
    hipError_t e = hipLaunchCooperativeKernel((const void*)mla_hgrn2_fwd, dim3(grid), dim3(512), args, LDS_TOTAL, stream);
    if (e != hipSuccess) fprintf(stderr, "kernel_launch: cooperative launch failed: %s (grid %d)\n", hipGetErrorString(e), grid);
}
```

```cpp
#include <hip/hip_runtime.h>
#include <hip/hip_cooperative_groups.h>
#include <cstdio>
#include <cstdint>
#include <cmath>
namespace cg = cooperative_groups;

typedef unsigned short bf16_t;
typedef short bf16x8 __attribute__((ext_vector_type(8)));
typedef short s16x4 __attribute__((ext_vector_type(4)));
typedef float f32x4 __attribute__((ext_vector_type(4)));
typedef float f32x16 __attribute__((ext_vector_type(16)));
typedef unsigned u32x4 __attribute__((ext_vector_type(4)));
typedef unsigned u32x2 __attribute__((ext_vector_type(2)));
#define LAS __attribute__((address_space(3)))

constexpr int T_TOK = 16384, SEQ = 8192, DM = 4096;
constexpr int N0 = 5696, N0P = 5888;
constexpr int NQ = 6144, NKV = 8192, N1 = 16384;
constexpr float EPS = 1e-6f;

constexpr size_t WS_W0IN = 0;
constexpr size_t WS_WUQ  = WS_W0IN + (size_t)N0P * 4096 * 2;
constexpr size_t WS_WUKV = WS_WUQ + (size_t)NQ * 1024 * 2;
constexpr size_t WS_W0O  = WS_WUKV + (size_t)NKV * 512 * 2;
constexpr size_t WS_W1IN = WS_W0O + (size_t)4096 * 4096 * 2;
constexpr size_t WS_W1O  = WS_W1IN + (size_t)N1 * 4096 * 2;
constexpr size_t WS_RSTD0 = WS_W1O + (size_t)4096 * 4096 * 2;
constexpr size_t WS_RSTDQ = WS_RSTD0 + 65536;
constexpr size_t WS_RSTDKV = WS_RSTDQ + 65536;
constexpr size_t WS_RSTD1 = WS_RSTDKV + 65536;
constexpr size_t WS_LB = WS_RSTD1 + 65536;
constexpr size_t WS_COS = WS_LB + 16384;
constexpr size_t WS_SIN = WS_COS + (size_t)T_TOK * 32 * 4;
constexpr size_t WS_KROT = WS_SIN + (size_t)T_TOK * 32 * 4;
constexpr size_t WS_ACTA = WS_KROT + (size_t)T_TOK * 64 * 2;
constexpr size_t WS_R = WS_ACTA + (size_t)T_TOK * 4096 * 2;
constexpr size_t WS_PROJ0 = WS_R;
constexpr size_t WS_Q = WS_PROJ0 + (size_t)T_TOK * N0P * 2;
constexpr size_t WS_PROJ1 = WS_R;
constexpr size_t WS_END = WS_R + (size_t)T_TOK * N1 * 2;

struct Params {
    const float* x; const int* pos; const float* l0_norm; const float* l0_w_in; const float* l0_q_norm; const float* l0_w_uq;
    const float* l0_kv_norm; const float* l0_w_ukv; const float* l0_w_o; const float* l1_norm; const float* l1_w_in;
    const float* l1_g_norm; const float* l1_w_o; const float* lower_bounds; const float* final_norm;
    float* out; unsigned char* ws;
    float inv_freq[32];
};

__device__ __forceinline__ unsigned cvtpk(float lo, float hi) { unsigned r; asm volatile("v_cvt_pk_bf16_f32 %0, %1, %2" : "=v"(r) : "v"(lo), "v"(hi)); return r; }
typedef float f32x2 __attribute__((ext_vector_type(2)));
typedef __bf16 bf16x2_t __attribute__((ext_vector_type(2)));
__device__ __forceinline__ unsigned cvtpk_n(float lo, float hi) { f32x2 v = {lo, hi}; bf16x2_t h = __builtin_convertvector(v, bf16x2_t); return __builtin_bit_cast(unsigned, h); }
__device__ __forceinline__ bf16_t f2bf_n(float f) { return (bf16_t)(cvtpk_n(f, 0.f) & 0xffffu); }
__device__ __forceinline__ bf16_t f2bf(float f) { return (bf16_t)(cvtpk(f, 0.f) & 0xffffu); }
__device__ __forceinline__ float bf2f(unsigned short h) { return __uint_as_float((unsigned)h << 16); }
__device__ __forceinline__ float bflo(unsigned w) { return __uint_as_float(w << 16); }
__device__ __forceinline__ float bfhi(unsigned w) { return __uint_as_float(w & 0xffff0000u); }
__device__ __forceinline__ bf16x8 pack8(f32x4 a, f32x4 b) {
    u32x4 w = {cvtpk(a[0], a[1]), cvtpk(a[2], a[3]), cvtpk(b[0], b[1]), cvtpk(b[2], b[3])};
    return *reinterpret_cast<bf16x8*>(&w);
}
__device__ __forceinline__ float fast_exp(float x) { return __builtin_amdgcn_exp2f(x * 1.4426950408889634f); }
__device__ __forceinline__ float silu_f(float v) { return v * __builtin_amdgcn_rcpf(1.0f + fast_exp(-v)); }
__device__ __forceinline__ float wave_sum(float v) {
#pragma unroll
    for (int o = 32; o > 0; o >>= 1) v += __shfl_xor(v, o);
    return v;
}

namespace pg8 {
constexpr int BM = 256, BK = 64, HALF = 128, HTB = HALF * BK * 2, STAGE_BYTES = 8 * HTB, NXCD = 8, WGM = 8;
__host__ __device__ __forceinline__ int lds_byte(int r, int c) { const int st = (r >> 4) * 2 + (c >> 5), rr = r & 15, cc = c & 31, ob = rr * 64 + cc * 2; return st * 1024 + (ob ^ (((ob >> 9) & 1) << 5)); }
__host__ __device__ __forceinline__ void stage_rc(int b, int& R, int& C) { const int st = b / 1024, sb = b % 1024, swz = sb ^ (((sb >> 9) & 1) << 5); R = (st >> 1) * 16 + swz / 64; C = (st & 1) * 32 + (swz % 64) / 2; }
__host__ __device__ __forceinline__ int perm32(int rho) { const int n = rho >> 4, i = rho & 15; return 8 * (i >> 2) + 4 * n + (i & 3); }
struct Unit { int pm, pn; };
struct Gemm { const bf16_t* A; const bf16_t* Bt; int M, N, K, lda; };
struct StaticOrder {
    int nM, nN, nwg, G, c, dup;
    __device__ void init(int M, int N, int G_, int c_, int dup_ = 0) { nM = M / BM; nN = N / BM; nwg = nM * nN; G = G_; c = c_; dup = dup_; }
    __device__ bool next(int i, Unit& u) const {
        const long L = (long)(i >> dup) * G + c; if (L >= nwg) return false;
        int wgid = (int)L; { const int q = nwg / NXCD, r = nwg % NXCD, xcd = wgid % NXCD, off = wgid / NXCD; wgid = (xcd < r ? xcd * (q + 1) : r * (q + 1) + (xcd - r) * q) + off; }
        const int nig = WGM * nN, gid = wgid / nig, fm = gid * WGM, gsz = (nM - fm) < WGM ? (nM - fm) : WGM;
        u.pm = fm + ((wgid % nig) % gsz); u.pn = (wgid % nig) / gsz; return true;
    }
};

template <int MODE> struct EpiBf16 {
    static constexpr bool PERM = true;
    bf16_t* O; int ldc; const float* rs; int thr; const float* lb; int ssqmode;
    __device__ __forceinline__ void operator()(const f32x4 (&acc)[2][2][4][2], const Unit& u, int wr, int wc, int fr, int fq) const {
        const int row0 = u.pm * BM + wr * 64 + fr, col0 = u.pn * BM + wc * 32 + 8 * fq;
        const int sec = (u.pn * BM) >> 12;
        f32x4 lbv[2][2] = {};
        if (MODE == 2) { if (sec == 1) {
#pragma unroll
            for (int bj = 0; bj < 2; ++bj) { lbv[bj][0] = *(const f32x4*)(lb + col0 + bj * HALF - 4096); lbv[bj][1] = *(const f32x4*)(lb + col0 + bj * HALF - 4096 + 4); } } }
        float rsv[2][4];
#pragma unroll
        for (int ai = 0; ai < 2; ++ai)
#pragma unroll
            for (int m = 0; m < 4; ++m) { float t_ = rs[row0 + ai * HALF + m * 16]; if (ssqmode) t_ = 1.0f / sqrtf(t_ * (1.0f / 4096.0f) + EPS); rsv[ai][m] = t_; }
#pragma unroll
        for (int ai = 0; ai < 2; ++ai)
#pragma unroll
            for (int m = 0; m < 4; ++m) {
                const int row = row0 + ai * HALF + m * 16; const float s = rsv[ai][m];
                bf16_t* rowp = O + (size_t)row * ldc + col0;
#pragma unroll
                for (int bj = 0; bj < 2; ++bj) {
                    f32x4 v0 = acc[ai][bj][m][0] * s, v1 = acc[ai][bj][m][1] * s;
                    const int col = col0 + bj * HALF;
                    if (MODE == 1) { if (col >= thr) {
#pragma unroll
                        for (int j = 0; j < 4; ++j) { v0[j] = silu_f(v0[j]); v1[j] = silu_f(v1[j]); } } }
                    if (MODE == 2) {
                        if (sec == 0 || sec == 3) {
#pragma unroll
                            for (int j = 0; j < 4; ++j) { v0[j] = silu_f(v0[j]); v1[j] = silu_f(v1[j]); } }
                        else if (sec == 1) {
                            const f32x4 l0 = lbv[bj][0], l1 = lbv[bj][1];
#pragma unroll
                            for (int j = 0; j < 4; ++j) {
                                float sg = __builtin_amdgcn_rcpf(1.0f + fast_exp(-v0[j])); float fg = l0[j] + (1.0f - l0[j]) * sg; v0[j] = __logf(fg);
                                sg = __builtin_amdgcn_rcpf(1.0f + fast_exp(-v1[j])); fg = l1[j] + (1.0f - l1[j]) * sg; v1[j] = __logf(fg); }
                        }
                    }
                    u32x4 w; w.x = cvtpk(v0[0], v0[1]); w.y = cvtpk(v0[2], v0[3]); w.z = cvtpk(v1[0], v1[1]); w.w = cvtpk(v1[2], v1[3]);
                    *(u32x4*)(rowp + bj * HALF) = w;
                }
            }
    }
};
struct EpiResF32 {
    static constexpr bool PERM = false;
    const float* base; float* out; int ldc;
    __device__ __forceinline__ void operator()(const f32x4 (&acc)[2][2][4][2], const Unit& u, int wr, int wc, int fr, int fq) const {
        const int row0 = u.pm * BM + wr * 64 + fr, col0 = u.pn * BM + wc * 32 + 4 * fq;
        f32x4 bs[2][4];
#define RES_LOAD(g, slot) do { const size_t off_ = (size_t)(row0 + ((g) >> 2) * HALF + ((g) & 3) * 16) * ldc + col0; \
        _Pragma("unroll") for (int bj = 0; bj < 2; ++bj) _Pragma("unroll") for (int n = 0; n < 2; ++n) bs[slot][bj * 2 + n] = *(const f32x4*)(base + off_ + bj * HALF + n * 16); } while (0)
        RES_LOAD(0, 0);
#pragma unroll
        for (int g = 0; g < 8; ++g) {
            if (g + 1 < 8) RES_LOAD(g + 1, (g + 1) & 1);
            const int ai = g >> 2, m = g & 3; const size_t off = (size_t)(row0 + ai * HALF + m * 16) * ldc + col0;
#pragma unroll
            for (int bj = 0; bj < 2; ++bj)
#pragma unroll
                for (int n = 0; n < 2; ++n) *(f32x4*)(out + off + bj * HALF + n * 16) = bs[g & 1][bj * 2 + n] + acc[ai][bj][m][n];
        }
#undef RES_LOAD
    }
};

struct EpiResBf16Stat {
    static constexpr bool PERM = true;
    const float* base; bf16_t* O; int ldc; float* ssq;
    __device__ __forceinline__ void operator()(const f32x4 (&acc)[2][2][4][2], const Unit& u, int wr, int wc, int fr, int fq) const {
        const int row0 = u.pm * BM + wr * 64 + fr, col0 = u.pn * BM + wc * 32 + 8 * fq;
        f32x4 bs[2][4];
#define RES_LOAD(g, slot) do { const size_t off_ = (size_t)(row0 + ((g) >> 2) * HALF + ((g) & 3) * 16) * ldc + col0; \
        _Pragma("unroll") for (int bj = 0; bj < 2; ++bj) { bs[slot][bj * 2] = *(const f32x4*)(base + off_ + bj * HALF); bs[slot][bj * 2 + 1] = *(const f32x4*)(base + off_ + bj * HALF + 4); } } while (0)
        RES_LOAD(0, 0);
#pragma unroll
        for (int g = 0; g < 8; ++g) {
            if (g + 1 < 8) RES_LOAD(g + 1, (g + 1) & 1);
            const int ai = g >> 2, m = g & 3, row = row0 + ai * HALF + m * 16; float ss = 0.f;
#pragma unroll
            for (int bj = 0; bj < 2; ++bj) {
                const f32x4 v0 = acc[ai][bj][m][0] + bs[g & 1][bj * 2], v1 = acc[ai][bj][m][1] + bs[g & 1][bj * 2 + 1];
                ss += (v0[0] * v0[0] + v0[1] * v0[1]) + (v0[2] * v0[2] + v0[3] * v0[3]) + (v1[0] * v1[0] + v1[1] * v1[1]) + (v1[2] * v1[2] + v1[3] * v1[3]);
                u32x4 w; w.x = cvtpk(v0[0], v0[1]); w.y = cvtpk(v0[2], v0[3]); w.z = cvtpk(v1[0], v1[1]); w.w = cvtpk(v1[2], v1[3]);
                *(u32x4*)(O + (size_t)row * ldc + col0 + bj * HALF) = w;
            }
            ss += __shfl_xor(ss, 16); ss += __shfl_xor(ss, 32);
            if (fq == 0) atomicAdd(ssq + row, ss);
        }
#undef RES_LOAD
    }
};
struct EpiResBf16F32 {
    static constexpr bool PERM = false;
    const bf16_t* base; int ldb; float* out; int ldo;
    __device__ __forceinline__ void operator()(const f32x4 (&acc)[2][2][4][2], const Unit& u, int wr, int wc, int fr, int fq) const {
        const int row0 = u.pm * BM + wr * 64 + fr, col0 = u.pn * BM + wc * 32 + 4 * fq;
        u32x2 bs[2][4];
#define RES_LOAD(g, slot) do { const size_t off_ = (size_t)(row0 + ((g) >> 2) * HALF + ((g) & 3) * 16) * ldb + col0; \
        _Pragma("unroll") for (int bj = 0; bj < 2; ++bj) _Pragma("unroll") for (int n = 0; n < 2; ++n) bs[slot][bj * 2 + n] = *(const u32x2*)(base + off_ + bj * HALF + n * 16); } while (0)
        RES_LOAD(0, 0);
#pragma unroll
        for (int g = 0; g < 8; ++g) {
            if (g + 1 < 8) RES_LOAD(g + 1, (g + 1) & 1);
            const int ai = g >> 2, m = g & 3; const size_t off = (size_t)(row0 + ai * HALF + m * 16) * ldo + col0;
#pragma unroll
            for (int bj = 0; bj < 2; ++bj)
#pragma unroll
                for (int n = 0; n < 2; ++n) { const u32x2 b2 = bs[g & 1][bj * 2 + n]; const f32x4 bv = {bflo(b2.x), bfhi(b2.x), bflo(b2.y), bfhi(b2.y)};
                    *(f32x4*)(out + off + bj * HALF + n * 16) = bv + acc[ai][bj][m][n]; }
        }
#undef RES_LOAD
    }
};

struct EpiBf16ResBf16Stat {
    static constexpr bool PERM = true;
    const bf16_t* base; int ldb; bf16_t* O; int ldo; float* ssq;
    __device__ __forceinline__ void operator()(const f32x4 (&acc)[2][2][4][2], const Unit& u, int wr, int wc, int fr, int fq) const {
        const int row0 = u.pm * BM + wr * 64 + fr, col0 = u.pn * BM + wc * 32 + 8 * fq;
        u32x4 bs[2][2];
#define RES_LOAD(g, slot) do { const size_t off_ = (size_t)(row0 + ((g) >> 2) * HALF + ((g) & 3) * 16) * ldb + col0; \
        _Pragma("unroll") for (int bj = 0; bj < 2; ++bj) bs[slot][bj] = *(const u32x4*)(base + off_ + bj * HALF); } while (0)
        RES_LOAD(0, 0);
#pragma unroll
        for (int g = 0; g < 8; ++g) {
            if (g + 1 < 8) RES_LOAD(g + 1, (g + 1) & 1);
            const int ai = g >> 2, m = g & 3, row = row0 + ai * HALF + m * 16; float ss = 0.f;
#pragma unroll
            for (int bj = 0; bj < 2; ++bj) {
                const u32x4 b4 = bs[g & 1][bj];
                const f32x4 v0 = acc[ai][bj][m][0] + (f32x4){bflo(b4.x), bfhi(b4.x), bflo(b4.y), bfhi(b4.y)}, v1 = acc[ai][bj][m][1] + (f32x4){bflo(b4.z), bfhi(b4.z), bflo(b4.w), bfhi(b4.w)};
                ss += (v0[0] * v0[0] + v0[1] * v0[1]) + (v0[2] * v0[2] + v0[3] * v0[3]) + (v1[0] * v1[0] + v1[1] * v1[1]) + (v1[2] * v1[2] + v1[3] * v1[3]);
                u32x4 w; w.x = cvtpk(v0[0], v0[1]); w.y = cvtpk(v0[2], v0[3]); w.z = cvtpk(v1[0], v1[1]); w.w = cvtpk(v1[2], v1[3]);
                *(u32x4*)(O + (size_t)row * ldo + col0 + bj * HALF) = w;
            }
            ss += __shfl_xor(ss, 16); ss += __shfl_xor(ss, 32);
            if (fq == 0) atomicAdd(ssq + row, ss);
        }
#undef RES_LOAD
    }
};

template <class Epi, class Sched>
__device__ __forceinline__ void gemm_phase(LAS unsigned char* lds, const Gemm g, const Sched& S, const Epi& E) {
    int tid = threadIdx.x; asm volatile("" : "+v"(tid));
    const int wid = __builtin_amdgcn_readfirstlane(tid >> 6), lane = tid & 63, wr = wid >> 2, wc = wid & 3, fr = lane & 15, fq = lane >> 4;
    const int K = g.K, nt = K / BK, lda = g.lda;
    unsigned voffA[2], voffB[2];
#pragma unroll
    for (int i = 0; i < 2; ++i) { int R, C; stage_rc(tid * 16 + i * 8192, R, C); const int Rb = Epi::PERM ? ((R & ~31) + perm32(R & 31)) : R;
        voffA[i] = (unsigned)(R * lda + C) * 2u; voffB[i] = (unsigned)(Rb * K + C) * 2u; }
    const size_t kstep = (size_t)(BK * 2);
    const size_t hstepA = (size_t)HALF * lda * 2, hstepB = (size_t)HALF * K * 2;
    const size_t tstepA = 2 * hstepA, tstepB = 2 * hstepB;
    const unsigned ldsw = (unsigned)wid * 1024u;
    const int aoff = lds_byte(wr * 64 + fr, fq * 8), boff = lds_byte(wc * 32 + fr, fq * 8);
#define PG8_SA(b, h) (((b) * 2 + (h)) * HTB)
#define PG8_SB(b, h) ((4 + (b) * 2 + (h)) * HTB)
#define PG8_STAGE(bufoff, gbase, voff) do { _Pragma("unroll") for (int _i = 0; _i < 2; ++_i) \
        __builtin_amdgcn_global_load_lds((const unsigned*)((const char*)(gbase) + (voff)[_i]), (LAS unsigned*)(lds + (bufoff) + ldsw + _i * 8192), 16, 0, 0); } while (0)
#define PG8_LDA(dst, b, h) do { _Pragma("unroll") for (int m = 0; m < 4; ++m) _Pragma("unroll") for (int k = 0; k < 2; ++k) dst[m][k] = *(const LAS bf16x8*)(lds + PG8_SA(b, h) + aoff + m * 2048 + k * 1024); } while (0)
#define PG8_LDB(dst, b, h) do { _Pragma("unroll") for (int n = 0; n < 2; ++n) _Pragma("unroll") for (int k = 0; k < 2; ++k) dst[n][k] = *(const LAS bf16x8*)(lds + PG8_SB(b, h) + boff + n * 2048 + k * 1024); } while (0)
#define PG8_MMA(ai, bj, At, Bt) do { __builtin_amdgcn_s_setprio(1); _Pragma("unroll") for (int m = 0; m < 4; ++m) _Pragma("unroll") for (int n = 0; n < 2; ++n) _Pragma("unroll") for (int k = 0; k < 2; ++k) \
        acc[ai][bj][m][n] = __builtin_amdgcn_mfma_f32_16x16x32_bf16(Bt[n][k], At[m][k], acc[ai][bj][m][n], 0, 0, 0); __builtin_amdgcn_s_setprio(0); } while (0)
#define PG8_WAIT_V(n) asm volatile("s_waitcnt vmcnt(" #n ")" ::: "memory")
#define PG8_WAIT_L(n) asm volatile("s_waitcnt lgkmcnt(" #n ")" ::: "memory")
#define PG8_BAR __builtin_amdgcn_s_barrier()
#define PG8_SCHED __builtin_amdgcn_sched_barrier(0)
    Unit cur, nxt; int ui = 0;
    if (!S.next(0, cur)) return;
    f32x4 acc[2][2][4][2];
#pragma unroll
    for (int a = 0; a < 2; ++a)
#pragma unroll
        for (int b = 0; b < 2; ++b)
#pragma unroll
            for (int m = 0; m < 4; ++m)
#pragma unroll
                for (int n = 0; n < 2; ++n) acc[a][b][m][n] = (f32x4){0.f, 0.f, 0.f, 0.f};
    bf16x8 At[4][2], B0[2][2], B1[2][2];
    const char* cA = (const char*)g.A + (size_t)cur.pm * tstepA; const char* cB = (const char*)g.Bt + (size_t)cur.pn * tstepB;
    PG8_STAGE(PG8_SB(0, 0), cB, voffB); PG8_STAGE(PG8_SA(0, 0), cA, voffA); PG8_STAGE(PG8_SB(0, 1), cB + hstepB, voffB); PG8_STAGE(PG8_SA(0, 1), cA + hstepA, voffA);
    if (wr == 1) PG8_BAR;
    PG8_WAIT_V(4); PG8_BAR;
    PG8_STAGE(PG8_SB(1, 0), cB + kstep, voffB); PG8_STAGE(PG8_SA(1, 0), cA + kstep, voffA); PG8_STAGE(PG8_SB(1, 1), cB + hstepB + kstep, voffB);
    PG8_WAIT_V(6); PG8_BAR;
    for (;;) {
        const bool has_next = S.next(ui + 1, nxt);
        const char* nA = has_next ? (const char*)g.A + (size_t)nxt.pm * tstepA : cA; const char* nB = has_next ? (const char*)g.Bt + (size_t)nxt.pn * tstepB : cB;
        for (int t = 0; t < nt; t += 2) {
            const bool last = (t == nt - 2);
            const char* a1 = cA + (size_t)(t + 1) * kstep;
            const char* a2 = last ? nA : cA + (size_t)(t + 2) * kstep; const char* b2 = last ? nB : cB + (size_t)(t + 2) * kstep;
            const char* a3 = a2 + kstep; const char* b3 = b2 + kstep;
            PG8_LDB(B0, 0, 0); PG8_SCHED; PG8_LDA(At, 0, 0); PG8_STAGE(PG8_SA(1, 1), a1 + hstepA, voffA);
            PG8_WAIT_L(8); PG8_BAR; PG8_WAIT_L(0); PG8_MMA(0, 0, At, B0); PG8_BAR; PG8_SCHED;
            PG8_LDB(B1, 0, 1); PG8_STAGE(PG8_SB(0, 0), b2, voffB);
            PG8_BAR; PG8_WAIT_L(0); PG8_MMA(0, 1, At, B1); PG8_BAR;
            PG8_LDA(At, 0, 1); PG8_STAGE(PG8_SA(0, 0), a2, voffA);
            PG8_BAR; PG8_WAIT_L(0); PG8_MMA(1, 0, At, B0); PG8_BAR; PG8_SCHED;
            PG8_STAGE(PG8_SB(0, 1), b2 + hstepB, voffB);
            PG8_WAIT_V(6); PG8_BAR; PG8_MMA(1, 1, At, B1); PG8_BAR;
            PG8_LDB(B0, 1, 0); PG8_SCHED; PG8_LDA(At, 1, 0); PG8_STAGE(PG8_SA(0, 1), a2 + hstepA, voffA);
            PG8_WAIT_L(8); PG8_BAR; PG8_WAIT_L(0); PG8_MMA(0, 0, At, B0); PG8_BAR; PG8_SCHED;
            PG8_LDB(B1, 1, 1); PG8_STAGE(PG8_SB(1, 0), b3, voffB);
            PG8_BAR; PG8_WAIT_L(0); PG8_MMA(0, 1, At, B1); PG8_BAR;
            PG8_LDA(At, 1, 1); PG8_STAGE(PG8_SA(1, 0), a3, voffA);
            PG8_BAR; PG8_WAIT_L(0); PG8_MMA(1, 0, At, B0); PG8_BAR; PG8_SCHED;
            PG8_STAGE(PG8_SB(1, 1), b3 + hstepB, voffB);
            PG8_WAIT_V(6); PG8_BAR; PG8_MMA(1, 1, At, B1); PG8_BAR;
        }
        E(acc, cur, wr, wc, fr, fq);
        if (!has_next) break;
#pragma unroll
        for (int a = 0; a < 2; ++a)
#pragma unroll
            for (int b = 0; b < 2; ++b)
#pragma unroll
                for (int m = 0; m < 4; ++m)
#pragma unroll
                    for (int n = 0; n < 2; ++n) acc[a][b][m][n] = (f32x4){0.f, 0.f, 0.f, 0.f};
        cur = nxt; cA = nA; cB = nB; ++ui;
    }
    PG8_WAIT_V(0);
    if (wr == 0) PG8_BAR;
    PG8_BAR;
#undef PG8_SA
#undef PG8_SB
#undef PG8_STAGE
#undef PG8_LDA
#undef PG8_LDB
#undef PG8_MMA
#undef PG8_WAIT_V
#undef PG8_WAIT_L
#undef PG8_BAR
#undef PG8_SCHED
}
}
#define XB_TMO      128
#define XB_XCNT(j)  (256  + 64 * (j))
#define XB_XSUB(j)  (1280 + 64 * (j))
#define XB_XGEN(j)  (2304 + 64 * (j))
#define XB_TOP      3328
#define XB_TOPGEN   3392
#define XCD_BAR_WORDS 3456
#define XB_SPIN_CAP (1u << 18)

__device__ __forceinline__ unsigned xb_ld(unsigned* p)              { return __hip_atomic_load(p, __ATOMIC_RELAXED, __HIP_MEMORY_SCOPE_AGENT); }
__device__ __forceinline__ unsigned xb_add(unsigned* p, unsigned v) { return __hip_atomic_fetch_add(p, v, __ATOMIC_RELAXED, __HIP_MEMORY_SCOPE_AGENT); }
__device__ __forceinline__ unsigned xb_xcc_id() { return (unsigned)__builtin_amdgcn_s_getreg((3 << 11) | 20) & 0xFu; }
#define XB_SPIN(cond, bar) do { unsigned _sp = 0; while (cond) { __builtin_amdgcn_s_sleep(1); \
    if ((++_sp & 255u) == 0u) { if (xb_ld(&(bar)[XB_TMO])) break; if (_sp > XB_SPIN_CAP) { atomicAdd(&(bar)[XB_TMO], 1u); break; } } } } while (0)

struct XcdBarrier {
    unsigned* bar; unsigned x;
    volatile LAS unsigned* st;
};

__device__ __forceinline__ XcdBarrier xcd_barrier_post(unsigned* bar, volatile LAS unsigned* st) {
    XcdBarrier b; b.bar = bar; b.x = xb_xcc_id(); b.st = st;
    if (threadIdx.x == 0) (void)xb_add(&bar[XB_XCNT(b.x)], 1u);
    return b;
}
__device__ __forceinline__ void xcd_barrier_complete(unsigned* bar, unsigned x, unsigned& nloc, unsigned& nx) {
    const unsigned G = gridDim.x * gridDim.y * gridDim.z;
    unsigned sum, cnt, mine, sp = 0u;
    for (;;) {
        sum = 0u; cnt = 0u; mine = 0u;
#pragma unroll
        for (unsigned j = 0; j < 16; ++j) { const unsigned c = xb_ld(&bar[XB_XCNT(j)]); sum += c; cnt += (c > 0u) ? 1u : 0u; mine = (j == x) ? c : mine; }
        if (sum == G) break;
        __builtin_amdgcn_s_sleep(1);
        if ((++sp & 255u) == 0u) { if (xb_ld(&bar[XB_TMO])) break; if (sp > XB_SPIN_CAP) { atomicAdd(&bar[XB_TMO], 1u); break; } }
    }
    nloc = mine > 0u ? mine : 1u; nx = cnt > 0u ? cnt : 1u;
}

__device__ __forceinline__ void xcd_barrier(const XcdBarrier& b) {
    asm volatile("s_waitcnt vmcnt(0)" ::: "memory");
    __syncthreads();
    if (threadIdx.x == 0) {
        unsigned* bar = b.bar;
        __builtin_amdgcn_s_waitcnt(0);
        unsigned nloc = b.st[0], nx = b.st[1];
        if (nloc == 0u) { xcd_barrier_complete(bar, b.x, nloc, nx); b.st[0] = nloc; b.st[1] = nx; }
        const unsigned old = xb_add(&bar[XB_XSUB(b.x)], 1u);
        const unsigned gen = old / nloc;
        if (old + 1u == (gen + 1u) * nloc) {
            __builtin_amdgcn_fence(__ATOMIC_RELEASE, "agent");
            asm volatile("s_waitcnt vmcnt(0)" ::: "memory");
            const unsigned og = xb_add(&bar[XB_TOP], 1u);
            const unsigned tg = og / nx;
            if (og + 1u == (tg + 1u) * nx) xb_add(&bar[XB_TOPGEN], 1u);
            else XB_SPIN(xb_ld(&bar[XB_TOPGEN]) == tg, bar);
            __builtin_amdgcn_fence(__ATOMIC_ACQUIRE, "agent");
            xb_add(&bar[XB_XGEN(b.x)], 1u);
            asm volatile("s_waitcnt vmcnt(0)" ::: "memory");
        } else {
            XB_SPIN(xb_ld(&bar[XB_XGEN(b.x)]) == gen, bar);
            __builtin_amdgcn_fence(__ATOMIC_ACQUIRE, "agent");
            asm volatile("s_waitcnt vmcnt(0)" ::: "memory");
        }
    }
    __syncthreads();
}


namespace att {
constexpr int NW = 8, QBLK = 32, KVBLK = 64, QB = NW * QBLK;
constexpr int DQ = 192, DV = 128;
constexpr int QS = NQ, KVS = NKV, KRS = 64, OS = 4096, ZS = N0P;
constexpr int SHM_V = KVBLK * DV * 2, SHM_K = KVBLK * DQ * 2;
constexpr int QR_OFF = 2 * SHM_V + 2 * SHM_K + NW * 64 * 4;
constexpr int LDS_BYTES = QR_OFF + NW * 4096;
constexpr float SCALE = 0.07216878364870322f;
constexpr float THR = 8.f;
constexpr unsigned WBIG = 0x40000000u;

#define KSWZ(row, colB) ((row) * 384 + ((colB) ^ (((row) & 7) << 4)))
#define SBAR() __builtin_amdgcn_sched_barrier(0)
__device__ __forceinline__ int v_st(int k, int c) { const int kk = (k & ~0xC) | ((k & 4) << 1) | ((k & 8) >> 1); return ((kk >> 3) * 4 + (c >> 5)) * 512 + ((kk & 7) * 32 + (c & 31)) * 2; }
__device__ __forceinline__ int v_rd_base(int lane) { return ((lane & 3) << 3) | (((lane >> 2) & 3) << 6) | (((lane >> 4) & 1) << 5) | (((lane >> 5) & 1) << 8); }
constexpr int v_rd_off(int d0, int ks, int half) { return d0 * 512 + ks * 4096 + half * 2048; }
__device__ __forceinline__ int crow(int r, int hi) { return (r & 3) + 8 * (r >> 2) + 4 * hi; }
__device__ __forceinline__ bf16x8 load8(const bf16_t* p) { return *reinterpret_cast<const bf16x8*>(p); }

__device__ __forceinline__ void mask_tile(f32x16& p0, f32x16& p1, int dq) {
    const float NEG = -__builtin_inff();
#pragma unroll
    for (int r = 0; r < 16; ++r) {
        const int c = (r & 3) + 8 * (r >> 2);
        if ((unsigned)(dq - c) >= WBIG) p0[r] = NEG;
        if ((unsigned)(dq - c - 32) >= WBIG) p1[r] = NEG;
    }
}
__device__ __forceinline__ void partialSM(f32x16& p0, f32x16& p1, float& m_reg, float& mn, float& alpha) {
    float pmax = p0[0];
#pragma unroll
    for (int r = 1; r < 16; ++r) pmax = fmaxf(pmax, p0[r]);
#pragma unroll
    for (int r = 0; r < 16; ++r) pmax = fmaxf(pmax, p1[r]);
    { auto rr = __builtin_amdgcn_permlane32_swap(__float_as_uint(pmax), __float_as_uint(pmax), false, false);
      pmax = fmaxf(__uint_as_float(rr[0]), __uint_as_float(rr[1])); }
    constexpr float C2 = 1.4426950408889634f * SCALE;
    if (__builtin_expect(__all((pmax - m_reg) * SCALE <= THR), 1)) { mn = m_reg; alpha = 1.f; }
    else { mn = fmaxf(m_reg, pmax); alpha = __builtin_amdgcn_exp2f((m_reg - mn) * C2); m_reg = mn; }
    const float mnL = -mn * C2;
#pragma unroll
    for (int r = 0; r < 16; ++r) p0[r] = fmaf(p0[r], C2, mnL);
#pragma unroll
    for (int r = 0; r < 16; ++r) p1[r] = fmaf(p1[r], C2, mnL);
#pragma unroll
    for (int r = 0; r < 16; ++r) p0[r] = __builtin_amdgcn_exp2f(p0[r]);
}
__device__ __forceinline__ void finishSM(f32x16& p0, f32x16& p1, float alpha, float& l_reg, bf16x8& pa0, bf16x8& pa1, bf16x8& pa2, bf16x8& pa3) {
#pragma unroll
    for (int r = 0; r < 16; ++r) p1[r] = __builtin_amdgcn_exp2f(p1[r]);
    float ps = 0;
#pragma unroll
    for (int r = 0; r < 16; ++r) ps += p0[r];
#pragma unroll
    for (int r = 0; r < 16; ++r) ps += p1[r];
    { auto rr = __builtin_amdgcn_permlane32_swap(__float_as_uint(ps), __float_as_uint(ps), false, false);
      ps = __uint_as_float(rr[0]) + __uint_as_float(rr[1]); }
    l_reg = l_reg * alpha + ps;
#define PK4(P, B_, OUT) do { unsigned a0 = cvtpk(P[B_+0], P[B_+1]), a1 = cvtpk(P[B_+2], P[B_+3]);                          \
        unsigned b0 = cvtpk(P[B_+4], P[B_+5]), b1 = cvtpk(P[B_+6], P[B_+7]);                                             \
        auto r0 = __builtin_amdgcn_permlane32_swap(a0, b0, false, false); auto r1 = __builtin_amdgcn_permlane32_swap(a1, b1, false, false); \
        u32x4 w = {r0[0], r1[0], r0[1], r1[1]}; OUT = *reinterpret_cast<bf16x8*>(&w); } while (0)
    PK4(p0, 0, pa0); PK4(p0, 8, pa1); PK4(p1, 0, pa2); PK4(p1, 8, pa3);
#undef PK4
}
template <int KB>
__device__ __forceinline__ void qkt(f32x16& p0, f32x16& p1, const char* K_lds, int r32, int hi, const bf16x8* qr, const char* qrl) {
    p0 = f32x16{}; p1 = f32x16{};
    const char* kb[4];
#pragma unroll
    for (int dd = 0; dd < 4; ++dd) kb[dd] = K_lds + KB * SHM_K + KSWZ(r32, (dd * 16 + hi * 8) * 2);
#pragma unroll
    for (int d0 = 0; d0 < 12; ++d0) { const char* a = kb[d0 & 3] + (d0 >> 2) * 128;
        bf16x8 b0 = *reinterpret_cast<const bf16x8*>(a);
        bf16x8 b1 = *reinterpret_cast<const bf16x8*>(a + 32 * 384);
        bf16x8 qf; if (d0 < 8) qf = qr[d0]; else qf = *reinterpret_cast<const bf16x8*>(qrl + (d0 - 8) * 1024);
        p0 = __builtin_amdgcn_mfma_f32_32x32x16_bf16(b0, qf, p0, 0, 0, 0);
        p1 = __builtin_amdgcn_mfma_f32_32x32x16_bf16(b1, qf, p1, 0, 0, 0);
    }
}
template <int VB>
__device__ __forceinline__ void pv_tile(f32x16* o, int vb0, bf16x8 pa0, bf16x8 pa1, bf16x8 pa2, bf16x8 pa3) {
#define TRRD(dst, off) asm volatile("ds_read_b64_tr_b16 %0, %1 offset:%2" : "=&v"(dst) : "v"(vb0), "i"(off) : "memory")
#define PV_D0(d0) do { s16x4 l0, l1, l2, l3, h0, h1, h2, h3; constexpr int b_ = VB * SHM_V + v_rd_off(d0, 0, 0); \
        TRRD(l0, b_); TRRD(h0, b_ + 2048); TRRD(l1, b_ + 4096); TRRD(h1, b_ + 6144); TRRD(l2, b_ + 8192); TRRD(h2, b_ + 10240); TRRD(l3, b_ + 12288); TRRD(h3, b_ + 14336); \
        asm volatile("s_waitcnt lgkmcnt(0)" ::: "memory"); SBAR();   \
        o[d0] = __builtin_amdgcn_mfma_f32_32x32x16_bf16(pa0, (bf16x8){l0[0], l0[1], l0[2], l0[3], h0[0], h0[1], h0[2], h0[3]}, o[d0], 0, 0, 0);   \
        o[d0] = __builtin_amdgcn_mfma_f32_32x32x16_bf16(pa1, (bf16x8){l1[0], l1[1], l1[2], l1[3], h1[0], h1[1], h1[2], h1[3]}, o[d0], 0, 0, 0);   \
        o[d0] = __builtin_amdgcn_mfma_f32_32x32x16_bf16(pa2, (bf16x8){l2[0], l2[1], l2[2], l2[3], h2[0], h2[1], h2[2], h2[3]}, o[d0], 0, 0, 0);   \
        o[d0] = __builtin_amdgcn_mfma_f32_32x32x16_bf16(pa3, (bf16x8){l3[0], l3[1], l3[2], l3[3], h3[0], h3[1], h3[2], h3[3]}, o[d0], 0, 0, 0); } while (0)
    PV_D0(0); PV_D0(1); PV_D0(2); PV_D0(3);
#undef PV_D0
#undef TRRD
}

struct BlockRef { const bf16_t* Q; const bf16_t* K; const bf16_t* KR; const bf16_t* V; bf16_t* O; const bf16_t* Z; const float* CS; const float* SN; int P0; };
struct Stage { bf16x8 st_v0, st_v1, st_k0, st_k1, st_kr; };
#define VMW() asm volatile("s_waitcnt vmcnt(0)" ::: "memory")
#define SLOAD_H(R, k0) do { const char* kt_ = (const char*)(R).K + (size_t)(k0) * (KVS * 2); const char* kt2_ = kt_ + 32 * KVS * 2; const char* krt_ = (const char*)(R).KR + (size_t)(k0) * (KRS * 2); \
                            S.st_v0 = *(const bf16x8*)(kt_ + koff + 256); S.st_v1 = *(const bf16x8*)(kt2_ + koff + 256);  \
                            S.st_k0 = *(const bf16x8*)(kt_ + koff); S.st_k1 = *(const bf16x8*)(kt2_ + koff);  \
                            S.st_kr = *(const bf16x8*)(krt_ + kroff); } while (0)
#define SWRITE_HK(bf) do { *(bf16x8*)(K_lds + (bf) * SHM_K + kws) = S.st_k0; *(bf16x8*)(K_lds + (bf) * SHM_K + kws + 32 * 384) = S.st_k1; \
                           *(bf16x8*)(K_lds + (bf) * SHM_K + kwr) = S.st_kr; } while (0)
#define SWRITE_HV(bf) do { *(bf16x8*)(V_lds + (bf) * SHM_V + vst0) = S.st_v0; *(bf16x8*)(V_lds + (bf) * SHM_V + vst1) = S.st_v1; } while (0)
#define SWRITE_H(bf) do { SWRITE_HV(bf); SWRITE_HK(bf); } while (0)

__device__ __forceinline__ void rope_q(const BlockRef& cur, const bf16x8* qrp, char* qrl, int wid, int r32, int hi) {
    const int row = wid * QBLK + r32;
    const unsigned toff = (unsigned)((row * 32 + hi * 8) * 4);
    const float* cp = (const float*)((const char*)cur.CS + toff); const float* sp = (const float*)((const char*)cur.SN + toff);
#pragma unroll
    for (int pr = 0; pr < 2; ++pr) {
        const f32x4 c0 = *(const f32x4*)(cp + pr * 16), c1 = *(const f32x4*)(cp + pr * 16 + 4), s0 = *(const f32x4*)(sp + pr * 16), s1 = *(const f32x4*)(sp + pr * 16 + 4);
        const bf16x8 a = qrp[pr], b = qrp[2 + pr];
        f32x4 o1l, o1h, o2l, o2h;
#pragma unroll
        for (int j = 0; j < 4; ++j) {
            float t1 = bf2f((unsigned short)a[j]), t2 = bf2f((unsigned short)b[j]);
            o1l[j] = t1 * c0[j] - t2 * s0[j]; o2l[j] = t2 * c0[j] + t1 * s0[j];
            t1 = bf2f((unsigned short)a[4 + j]); t2 = bf2f((unsigned short)b[4 + j]);
            o1h[j] = t1 * c1[j] - t2 * s1[j]; o2h[j] = t2 * c1[j] + t1 * s1[j];
        }
        *(bf16x8*)(qrl + pr * 1024) = pack8(o1l, o1h); *(bf16x8*)(qrl + (2 + pr) * 1024) = pack8(o2l, o2h);
    }
}
__device__ __forceinline__ void causal_block(const BlockRef& cur, char* lds) {
    int tid = threadIdx.x; asm volatile("" : "+v"(tid));
    const int wid = __builtin_amdgcn_readfirstlane(tid >> 6), lane = tid & 63, r32 = lane & 31, hi = lane >> 5;
    const int NT = (cur.P0 + QB - 1) / KVBLK + 1;
    const int qlo = cur.P0 + wid * QBLK, qm = qlo + r32 - 4 * hi;
    char* V_lds = lds; char* K_lds = lds + 2 * SHM_V;
    float* ws = (float*)(lds + 2 * SHM_V + 2 * SHM_K) + wid * 64; float* li_l = ws, * al_l = ws + 32;
    float m_reg = -1e30f, l_reg = 0; f32x16 o[4] = {};
    const int sr = tid >> 4, sc = (tid & 15) * 8, vst0 = v_st(sr, sc), vst1 = v_st(32 + sr, sc), kws = KSWZ(sr, sc * 2);
    const int krr = tid >> 3, krc = (tid & 7) * 8, kwr = KSWZ(krr, (128 + krc) * 2);
    const int vb0 = (int)(uintptr_t)V_lds + v_rd_base(lane);
    unsigned koff = (unsigned)((sr * KVS + sc) * 2), kroff = (unsigned)((krr * KRS + krc) * 2);
    unsigned qoff = (unsigned)(((wid * QBLK + r32) * QS + hi * 8) * 2);
    asm volatile("" : "+v"(koff), "+v"(kroff), "+v"(qoff));
    Stage S; bf16x8 qr[8]; char* qrl = lds + QR_OFF + wid * 4096 + lane * 16;
    { bf16x8 qrp[4];
#pragma unroll
      for (int d0 = 0; d0 < 8; ++d0) qr[d0] = *(const bf16x8*)((const char*)cur.Q + qoff + d0 * 32);
#pragma unroll
      for (int d0 = 0; d0 < 4; ++d0) qrp[d0] = *(const bf16x8*)((const char*)cur.Q + qoff + (8 + d0) * 32);
      SLOAD_H(cur, 0);
      rope_q(cur, qrp, qrl, wid, r32, hi); }
    VMW(); SWRITE_H(0); SBAR();
    SLOAD_H(cur, KVBLK); SBAR();
    __syncthreads();
#define RESC(a) do { if (__any((a) < 1.f)) { if (hi == 0) al_l[r32] = (a); asm volatile("s_waitcnt lgkmcnt(0)" ::: "memory");              \
                     for (int d_ = 0; d_ < 4; ++d_) for (int r = 0; r < 16; ++r) o[d_][r] *= al_l[crow(r, hi)]; } } while (0)
#define KBASE(t) ((t) * KVBLK)
#define MASKT(P0_, P1_, t) do { const int kb_ = KBASE(t); if (kb_ + KVBLK - 1 > qlo) mask_tile(P0_, P1_, qm - kb_); } while (0)
    f32x16 pA0, pA1, pB0, pB1; float mnA, mnB, alA, alB; bf16x8 pa0, pa1, pa2, pa3;
    qkt<0>(pA0, pA1, K_lds, r32, hi, qr, qrl);
    MASKT(pA0, pA1, 0); partialSM(pA0, pA1, m_reg, mnA, alA);
    VMW(); SWRITE_H(1);
    __syncthreads();
#define HALF_STEP(PX0, PX1, mnX, alX, PY0, PY1, alY, t, KB, VB, SB) do {                                                      \
        SBAR(); qkt<KB>(PX0, PX1, K_lds, r32, hi, qr, qrl);                                                                        \
        finishSM(PY0, PY1, alY, l_reg, pa0, pa1, pa2, pa3); SBAR();                                                           \
        if ((t) + 1 < NT) { SLOAD_H(cur, KBASE((t) + 1)); SBAR(); }                                                           \
        pv_tile<VB>(o, vb0, pa0, pa1, pa2, pa3); MASKT(PX0, PX1, (t)); partialSM(PX0, PX1, m_reg, mnX, alX);                  \
        __syncthreads();                                                                                                      \
        if ((t) + 1 < NT) { VMW(); SWRITE_H(SB); }                                                                            \
        RESC(alX); __syncthreads(); } while (0)
    for (int t = 1; t + 1 < NT; t += 2) {
        HALF_STEP(pB0, pB1, mnB, alB, pA0, pA1, alA, t, 1, 0, 0);
        HALF_STEP(pA0, pA1, mnA, alA, pB0, pB1, alB, t + 1, 0, 1, 1);
    }
    SBAR(); qkt<1>(pB0, pB1, K_lds, r32, hi, qr, qrl); SBAR();
    finishSM(pA0, pA1, alA, l_reg, pa0, pa1, pa2, pa3); SBAR();
    pv_tile<0>(o, vb0, pa0, pa1, pa2, pa3);
    MASKT(pB0, pB1, NT - 1); partialSM(pB0, pB1, m_reg, mnB, alB); __syncthreads(); RESC(alB);
    finishSM(pB0, pB1, alB, l_reg, pa0, pa1, pa2, pa3); SBAR(); pv_tile<1>(o, vb0, pa0, pa1, pa2, pa3);
    SBAR();
    if (hi == 0) li_l[r32] = l_reg;
    __syncthreads();
    {
        char* ot = lds + wid * (32 * 272);
        const int wb = 4 * hi * 272 + r32 * 2;
#pragma unroll
        for (int rg = 0; rg < 4; ++rg) {
            const f32x4 lv = *(const f32x4*)(li_l + 8 * rg + 4 * hi);
#pragma unroll
            for (int j = 0; j < 4; ++j) { const int r = rg * 4 + j; const float rl = __builtin_amdgcn_rcpf(lv[j]);
#pragma unroll
                for (int d0 = 0; d0 < 4; ++d0) *(bf16_t*)(ot + wb + (j + 8 * rg) * 272 + d0 * 64) = f2bf(o[d0][r] * rl); }
        }
        asm volatile("s_waitcnt lgkmcnt(0)" ::: "memory");
        const int rr = lane >> 4, c8 = (lane & 15) * 8;
        const unsigned zoff = (unsigned)(((wid * QBLK + rr) * ZS + c8) * 2), ooff = (unsigned)(((wid * QBLK + rr) * OS + c8) * 2);
#pragma unroll
        for (int i = 0; i < 8; ++i) {
            const bf16x8 ov = *(const bf16x8*)(ot + (i * 4 + rr) * 272 + c8 * 2);
            const bf16x8 zv = *(const bf16x8*)((const char*)cur.Z + (size_t)(i * 4 * ZS * 2) + zoff);
            f32x4 a, b;
#pragma unroll
            for (int j = 0; j < 4; ++j) { a[j] = bf2f((unsigned short)ov[j]) * bf2f((unsigned short)zv[j]); b[j] = bf2f((unsigned short)ov[4 + j]) * bf2f((unsigned short)zv[4 + j]); }
            *(bf16x8*)((char*)cur.O + (size_t)(i * 4 * OS * 2) + ooff) = pack8(a, b);
        }
    }
    __syncthreads();
#undef RESC
#undef KBASE
#undef MASKT
#undef HALF_STEP
}
#undef VMW
#undef SLOAD_H
#undef SWRITE_HK
#undef SWRITE_HV
#undef SWRITE_H

struct Item { int bh, qb0, qb1; };
constexpr int NQB = SEQ / QB, NX = NQB / 2, NBH = 64, TOTAL = NX * NBH;
__device__ __forceinline__ Item decode(int L) {
    Item it; const int xcd = L & 7, k = L >> 3, gi = k / NX, r = k - gi * NX;
    it.bh = gi * 8 + xcd; it.qb0 = r; it.qb1 = NQB - 1 - r; return it;
}
struct Tensors { const bf16_t* q; const bf16_t* kv; const bf16_t* krot; bf16_t* og; const bf16_t* proj0; const float* cs; const float* sn; };
__device__ __forceinline__ BlockRef mkref(const Item& it, int pass, const Tensors& T) {
    const int qb = pass ? it.qb1 : it.qb0, b = it.bh >> 5, h = it.bh & 31;
    const size_t tok0 = (size_t)b * SEQ, row0 = tok0 + (size_t)qb * QB;
    BlockRef r;
    r.Q = T.q + row0 * QS + h * DQ; r.K = T.kv + tok0 * KVS + h * 256; r.V = r.K + 128; r.KR = T.krot + tok0 * KRS;
    r.O = T.og + row0 * OS + h * DV; r.Z = T.proj0 + row0 * ZS + 1600 + h * DV; r.CS = T.cs + row0 * 32; r.SN = T.sn + row0 * 32; r.P0 = qb * QB;
    return r;
}
__device__ __forceinline__ void attn_phase(char* lds, const Tensors& T) {
#ifndef PROBE_ATTDUP
#define PROBE_ATTDUP 0
#endif
    for (int i = 0; ; ++i) {
        const int L = blockIdx.x + (i >> PROBE_ATTDUP) * gridDim.x; if (L >= TOTAL) break;
        const Item it = decode(L);
#pragma unroll 1
        for (int pass = 0; pass < 2; ++pass) { const BlockRef cur = mkref(it, pass, T); causal_block(cur, lds); }
    }
}
}
__device__ __forceinline__ void wt_phase(const float* __restrict__ W, int K, int N, const float* __restrict__ scale, bf16_t* __restrict__ out, char* lds) {
    int tid = threadIdx.x; asm volatile("" : "+v"(tid));
    const int lane = tid & 63, wv = tid >> 6, gw = blockIdx.x * 8 + wv, nw = gridDim.x * 8;
    char* img = lds + wv * 8192;
    const int kr = lane >> 4, nq = lane & 15, ntn = N / 64, ntiles = ntn * (K / 64);
    for (int t = gw; t < ntiles; t += nw) {
        const int kb = (t / ntn) * 64, nb = (t % ntn) * 64;
        const float* src = W + (size_t)(kb + kr * 16) * N + nb + nq * 4;
        f32x4 v[16];
#pragma unroll
        for (int i = 0; i < 16; ++i) v[i] = *(const f32x4*)(src + (size_t)i * N);
        if (scale) {
            const float* sp = scale + kb + kr * 16;
#pragma unroll
            for (int i = 0; i < 16; i += 4) { const f32x4 sc = *(const f32x4*)(sp + i); v[i] *= sc[0]; v[i + 1] *= sc[1]; v[i + 2] *= sc[2]; v[i + 3] *= sc[3]; }
        }
#pragma unroll
        for (int j = 0; j < 4; ++j) {
            const int n = nq * 4 + j;
#pragma unroll
            for (int hf = 0; hf < 2; ++hf) {
                const f32x4 a = {v[hf * 8 + 0][j], v[hf * 8 + 1][j], v[hf * 8 + 2][j], v[hf * 8 + 3][j]}, b = {v[hf * 8 + 4][j], v[hf * 8 + 5][j], v[hf * 8 + 6][j], v[hf * 8 + 7][j]};
                *(bf16x8*)(img + n * 128 + (((kr * 2 + hf) ^ (nq & 7)) * 16)) = pack8(a, b);
            }
        }
#pragma unroll
        for (int i = 0; i < 8; ++i) {
            const int n = i * 8 + (lane >> 3), kc = lane & 7;
            const bf16x8 r = *(const bf16x8*)(img + n * 128 + ((kc ^ ((n >> 2) & 7)) * 16));
            *(bf16x8*)(out + (size_t)(nb + n) * K + kb + kc * 8) = r;
        }
    }
}
__device__ __forceinline__ void cast_rstd_phase(const float* __restrict__ src, bf16_t* __restrict__ dst, float* __restrict__ rstd) {
    const int lane = threadIdx.x & 63, gw = blockIdx.x * 8 + (threadIdx.x >> 6), nw = gridDim.x * 8;
    for (int row = gw; row < T_TOK; row += nw) {
        const float* s = src + (size_t)row * DM; bf16_t* d = dst + (size_t)row * DM; float ss = 0.f;
#pragma unroll
        for (int i = 0; i < 8; ++i) { const int c = (i * 64 + lane) * 8; const f32x4 a = *(const f32x4*)(s + c), b = *(const f32x4*)(s + c + 4);
            ss += a[0] * a[0] + a[1] * a[1] + a[2] * a[2] + a[3] * a[3] + b[0] * b[0] + b[1] * b[1] + b[2] * b[2] + b[3] * b[3];
            *(bf16x8*)(d + c) = pack8(a, b); }
        ss = wave_sum(ss);
        if (lane == 0) rstd[row] = 1.0f / sqrtf(ss * (1.0f / DM) + EPS);
    }
}
__device__ __forceinline__ void final_norm_phase(const float* __restrict__ src, size_t lds_, float* __restrict__ dst, const float* __restrict__ w) {
    const int lane = threadIdx.x & 63, gw = blockIdx.x * 8 + (threadIdx.x >> 6), nw = gridDim.x * 8;
    for (int row = gw; row < T_TOK; row += nw) {
        const float* s = src + (size_t)row * lds_; float* d = dst + (size_t)row * DM; f32x4 v[16]; float ss = 0.f;
#pragma unroll
        for (int i = 0; i < 16; ++i) { v[i] = *(const f32x4*)(s + (i * 64 + lane) * 4); ss += v[i][0] * v[i][0] + v[i][1] * v[i][1] + v[i][2] * v[i][2] + v[i][3] * v[i][3]; }
        ss = wave_sum(ss);
        const float r = 1.0f / sqrtf(ss * (1.0f / DM) + EPS);
#pragma unroll
        for (int i = 0; i < 16; ++i) { const f32x4 g = *(const f32x4*)(w + (i * 64 + lane) * 4); *(f32x4*)(d + (i * 64 + lane) * 4) = v[i] * r * g; }
    }
}
__device__ __forceinline__ void final_norm_bf16_phase(const bf16_t* __restrict__ src, size_t lds_, const float* __restrict__ ssq, float* __restrict__ dst, const float* __restrict__ w) {
    const int lane = threadIdx.x & 63, gw = blockIdx.x * 8 + (threadIdx.x >> 6), nw = gridDim.x * 8;
    for (int row = gw; row < T_TOK; row += nw) {
        const bf16_t* s = src + (size_t)row * lds_; float* d = dst + (size_t)row * DM;
        const float r = 1.0f / sqrtf(ssq[row] * (1.0f / DM) + EPS);
        bf16x8 v[8];
#pragma unroll
        for (int i = 0; i < 8; ++i) v[i] = *(const bf16x8*)(s + (i * 64 + lane) * 8);
#pragma unroll
        for (int i = 0; i < 8; ++i) { const int c = (i * 64 + lane) * 8; const f32x4 g0 = *(const f32x4*)(w + c), g1 = *(const f32x4*)(w + c + 4); f32x4 a, b;
#pragma unroll
            for (int j = 0; j < 4; ++j) { a[j] = bf2f((unsigned short)v[i][j]) * r * g0[j]; b[j] = bf2f((unsigned short)v[i][4 + j]) * r * g1[j]; }
            *(f32x4*)(d + c) = a; *(f32x4*)(d + c + 4) = b; }
    }
}
__device__ __forceinline__ void tables_phase(const Params& p, float* cs, float* sn, float* lb) {
    const int gt = blockIdx.x * blockDim.x + threadIdx.x, nt = gridDim.x * blockDim.x;
    for (int i = gt; i < T_TOK * 32; i += nt) {
        const int tok = i >> 5, j = i & 31;
        const float ang = (float)p.pos[tok] * p.inv_freq[j];
        const double rev = (double)ang * 0.15915494309189535; const float fr = (float)(rev - rint(rev));
        cs[i] = __builtin_amdgcn_cosf(fr); sn[i] = __builtin_amdgcn_sinf(fr);
    }
    for (int i = gt; i < 4096; i += nt) { const float l0 = p.lower_bounds[i], l1 = p.lower_bounds[4096 + i]; lb[i] = 1.0f / (1.0f + expf(l0 - l1)); }
}
__device__ __forceinline__ void stats_krot_phase(const bf16_t* __restrict__ proj0, float* __restrict__ rq, float* __restrict__ rkv, const float* __restrict__ cs, const float* __restrict__ sn, bf16_t* __restrict__ krot) {
    const int lane = threadIdx.x & 63, gw = blockIdx.x * 8 + (threadIdx.x >> 6), nw = gridDim.x * 8;
    for (int row0 = gw; row0 < T_TOK; row0 += 4 * nw) {
        bf16x8 a[4], b[4], c[4]; float t1[4], t2[4], cc[4], sv[4];
#pragma unroll
        for (int u4 = 0; u4 < 4; ++u4) { const int row = row0 + u4 * nw; const bool ok = row < T_TOK; const bf16_t* s = proj0 + (size_t)(ok ? row : row0) * N0P; const size_t tr = (size_t)(ok ? row : row0) * 32 + (lane & 31);
            a[u4] = *(const bf16x8*)(s + lane * 8); b[u4] = *(const bf16x8*)(s + 512 + lane * 8); c[u4] = *(const bf16x8*)(s + 1024 + lane * 8);
            t1[u4] = bf2f(s[1536 + (lane & 31)]); t2[u4] = bf2f(s[1568 + (lane & 31)]); cc[u4] = cs[tr]; sv[u4] = sn[tr]; }
#pragma unroll
        for (int u4 = 0; u4 < 4; ++u4) { const int row = row0 + u4 * nw; if (row >= T_TOK) continue;
            float sq = 0.f, sk = 0.f;
#pragma unroll
            for (int j = 0; j < 8; ++j) { const float x = bf2f((unsigned short)a[u4][j]), y = bf2f((unsigned short)b[u4][j]), z = bf2f((unsigned short)c[u4][j]); sq += x * x + y * y; sk += z * z; }
            sq = wave_sum(sq); sk = wave_sum(sk);
            if (lane == 0) { rq[row] = 1.0f / sqrtf(sq * (1.0f / 1024.0f) + EPS); rkv[row] = 1.0f / sqrtf(sk * (1.0f / 512.0f) + EPS); }
            if (lane < 32) { krot[(size_t)row * 64 + lane] = f2bf(t1[u4] * cc[u4] - t2[u4] * sv[u4]); krot[(size_t)row * 64 + 32 + lane] = f2bf(t2[u4] * cc[u4] + t1[u4] * sv[u4]); } }
    }
}
__device__ __forceinline__ void headnorm_phase(bf16_t* __restrict__ proj1, const bf16_t* __restrict__ oraw, const float* __restrict__ gn) {
    int tid = threadIdx.x; asm volatile("" : "+v"(tid));
    const int per = T_TOK / gridDim.x;
    const int h = tid >> 4, vs = (tid & 15) >> 2, c8 = (tid & 3) * 8;
    const int v0 = (tid & 15) * 8; const f32x4 g0 = *(const f32x4*)(gn + v0), g1 = *(const f32x4*)(gn + v0 + 4);
    for (int tok0 = blockIdx.x * per; tok0 < (blockIdx.x + 1) * per; tok0 += 4) {
        bf16x8 o[4], z[4];
#pragma unroll
        for (int u = 0; u < 4; ++u) { const int tok = tok0 + u, b = tok >> 13, sq = tok & (SEQ - 1);
            o[u] = *(const bf16x8*)(oraw + ((size_t)((b * 32 + h) * 4 + vs) * SEQ + sq) * 32 + c8); z[u] = *(const bf16x8*)(proj1 + (size_t)tok * N1 + 12288 + tid * 8); }
#pragma unroll
        for (int u = 0; u < 4; ++u) {
            float f[8], ss = 0.f;
#pragma unroll
            for (int j = 0; j < 8; ++j) { f[j] = bf2f((unsigned short)o[u][j]); ss += f[j] * f[j]; }
            ss += __shfl_xor(ss, 1); ss += __shfl_xor(ss, 2); ss += __shfl_xor(ss, 4); ss += __shfl_xor(ss, 8);
            const float r = 1.0f / sqrtf(ss * (1.0f / 128.0f) + EPS);
            f32x4 a, bb;
#pragma unroll
            for (int j = 0; j < 4; ++j) { a[j] = f[j] * r * g0[j] * bf2f((unsigned short)z[u][j]); bb[j] = f[4 + j] * r * g1[j] * bf2f((unsigned short)z[u][4 + j]); }
            *(bf16x8*)(proj1 + (size_t)(tok0 + u) * N1 + 8192 + tid * 8) = pack8(a, bb);
        }
    }
}

namespace hg {
constexpr int QT_S = 272, KD_S = 144;
constexpr int OFF_QT = 0, OFF_KT = OFF_QT + 64 * QT_S, OFF_QB = OFF_KT + 64 * QT_S, OFF_KD = OFF_QB + 64 * QT_S;
constexpr int OFF_VT = OFF_KD + 128 * KD_S, OFF_ST = OFF_VT + 32 * KD_S, OFF_ATT = OFF_ST + 32 * QT_S;
constexpr int OFF_SEG = OFF_ATT + 64 * KD_S, OFF_G32 = OFF_SEG + 2048, OFF_DEC = OFF_G32 + 512, LDS_BYTES = OFF_DEC + 512;
__device__ __forceinline__ int crow(int r, int hi) { return (r & 3) + 8 * (r >> 2) + 4 * hi; }

__device__ __forceinline__ void hgrn2_phase(char* lds, const bf16_t* __restrict__ proj1, bf16_t* __restrict__ oraw) {
    int tid = threadIdx.x; asm volatile("" : "+v"(tid));
    const int wid = __builtin_amdgcn_readfirstlane(tid >> 6), lane = tid & 63, r32 = lane & 31, hi = lane >> 5;
    const int kch = tid & 127, seg = tid >> 7;
    float* segtot = (float*)(lds + OFF_SEG); float* g32s = (float*)(lds + OFF_G32); float* decay = (float*)(lds + OFF_DEC);
    for (int item = blockIdx.x; item < 256; item += gridDim.x) {
        const int vs = item & 3, bh = item >> 2, b = bh >> 5, h = bh & 31;
        const bf16_t* base = proj1 + (size_t)b * SEQ * N1; bf16_t* ob = oraw + (size_t)item * SEQ * 32;
        const int qcol = h * 128 + kch, gcol = 4096 + h * 128 + kch, vcol = 8192 + h * 128 + vs * 32;
        f32x16 sacc = {};
        for (int i = tid; i < 32 * QT_S / 4; i += 512) ((unsigned*)(lds + OFF_ST))[i] = 0u;
        unsigned short graw[16], qraw[16]; u32x2 vraw;
        { const bf16_t* rp = base + (size_t)(seg * 16) * N1;
#pragma unroll
          for (int i = 0; i < 16; ++i) { graw[i] = rp[(size_t)i * N1 + gcol]; qraw[i] = rp[(size_t)i * N1 + qcol]; }
          vraw = *(const u32x2*)(base + (size_t)(tid >> 3) * N1 + vcol + (tid & 7) * 4); }
        for (int ch = 0; ch < 128; ++ch) {
            const int tok0 = ch * 64;
            float gl[16]; float cum = 0.f;
#pragma unroll
            for (int i = 0; i < 16; ++i) { cum += bf2f(graw[i]); gl[i] = cum; }
            segtot[seg * 128 + kch] = cum; if (seg == 2) g32s[kch] = bf2f(graw[0]);
            __syncthreads();
            { const float s0 = segtot[kch], s1 = segtot[128 + kch], s2 = segtot[256 + kch], s3 = segtot[384 + kch];
              const float off = (seg > 0 ? s0 : 0.f) + (seg > 1 ? s1 : 0.f) + (seg > 2 ? s2 : 0.f);
              const float tot = (s0 + s1) + (s2 + s3), bref = s0 + s1 + g32s[kch];
              if (seg == 0) decay[kch] = fast_exp(tot);
              float kd[16];
#pragma unroll
              for (int i = 0; i < 16; ++i) { const int t = seg * 16 + i; const float bb = off + gl[i], gv = bf2f(graw[i]), qv = bf2f(qraw[i]); const float kk = 1.0f - fast_exp(gv);
                  *(bf16_t*)(lds + OFF_QT + t * QT_S + kch * 2) = f2bf_n(qv * fast_exp(bb - bref));
                  *(bf16_t*)(lds + OFF_KT + t * QT_S + kch * 2) = f2bf_n(kk * fast_exp(bref - bb));
                  *(bf16_t*)(lds + OFF_QB + t * QT_S + kch * 2) = f2bf_n(qv * fast_exp(bb));
                  kd[i] = kk * fast_exp(tot - bb); }
              *(bf16x8*)(lds + OFF_KD + kch * KD_S + seg * 32) = pack8((f32x4){kd[0], kd[1], kd[2], kd[3]}, (f32x4){kd[4], kd[5], kd[6], kd[7]});
              *(bf16x8*)(lds + OFF_KD + kch * KD_S + seg * 32 + 16) = pack8((f32x4){kd[8], kd[9], kd[10], kd[11]}, (f32x4){kd[12], kd[13], kd[14], kd[15]});
              { const int t = tid >> 3, v4 = (tid & 7) * 4;
                *(bf16_t*)(lds + OFF_VT + (v4 + 0) * KD_S + t * 2) = (bf16_t)(vraw.x & 0xffffu); *(bf16_t*)(lds + OFF_VT + (v4 + 1) * KD_S + t * 2) = (bf16_t)(vraw.x >> 16);
                *(bf16_t*)(lds + OFF_VT + (v4 + 2) * KD_S + t * 2) = (bf16_t)(vraw.y & 0xffffu); *(bf16_t*)(lds + OFF_VT + (v4 + 3) * KD_S + t * 2) = (bf16_t)(vraw.y >> 16); }
            }
            if (ch + 1 < 128) { const bf16_t* rp = base + (size_t)(tok0 + 64 + seg * 16) * N1;
#pragma unroll
                for (int i = 0; i < 16; ++i) { graw[i] = rp[(size_t)i * N1 + gcol]; qraw[i] = rp[(size_t)i * N1 + qcol]; }
                vraw = *(const u32x2*)(base + (size_t)(tok0 + 64 + (tid >> 3)) * N1 + vcol + (tid & 7) * 4); }
            __syncthreads();
            f32x16 oacc = {};
            if (wid < 4) {
                const int ci = wid >> 1, si = wid & 1;
                if (!(ci == 0 && si == 1)) {
                    f32x16 aacc = {};
#pragma unroll
                    for (int kk = 0; kk < 8; ++kk) {
                        const bf16x8 af = *(const bf16x8*)(lds + OFF_QT + (32 * ci + r32) * QT_S + kk * 32 + hi * 16);
                        const bf16x8 bfr = *(const bf16x8*)(lds + OFF_KT + (32 * si + r32) * QT_S + kk * 32 + hi * 16);
                        aacc = __builtin_amdgcn_mfma_f32_32x32x16_bf16(af, bfr, aacc, 0, 0, 0); }
#pragma unroll
                    for (int i = 0; i < 16; ++i) { const int c = 32 * ci + crow(i, hi), s = 32 * si + r32; const float v = (c >= s) ? aacc[i] : 0.f;
                        *(bf16_t*)(lds + OFF_ATT + c * KD_S + s * 2) = f2bf_n(v); }
                } else {
#pragma unroll
                    for (int i = 0; i < 16; ++i) { const int c = crow(i, hi), s = 32 + r32; *(bf16_t*)(lds + OFF_ATT + c * KD_S + s * 2) = (bf16_t)0; }
                }
#pragma unroll
                for (int g4 = 0; g4 < 4; ++g4) { const f32x4 d = *(const f32x4*)(decay + 32 * wid + 8 * g4 + 4 * hi);
#pragma unroll
                    for (int j = 0; j < 4; ++j) sacc[g4 * 4 + j] *= d[j]; }
#pragma unroll
                for (int kk = 0; kk < 4; ++kk) {
                    const bf16x8 af = *(const bf16x8*)(lds + OFF_KD + (32 * wid + r32) * KD_S + kk * 32 + hi * 16);
                    const bf16x8 bfr = *(const bf16x8*)(lds + OFF_VT + r32 * KD_S + kk * 32 + hi * 16);
                    sacc = __builtin_amdgcn_mfma_f32_32x32x16_bf16(af, bfr, sacc, 0, 0, 0); }
            } else if (wid < 6) {
                const int ci = wid - 4;
#pragma unroll
                for (int kk = 0; kk < 8; ++kk) {
                    const bf16x8 af = *(const bf16x8*)(lds + OFF_QB + (32 * ci + r32) * QT_S + kk * 32 + hi * 16);
                    const bf16x8 bfr = *(const bf16x8*)(lds + OFF_ST + r32 * QT_S + kk * 32 + hi * 16);
                    oacc = __builtin_amdgcn_mfma_f32_32x32x16_bf16(af, bfr, oacc, 0, 0, 0); }
            }
            __syncthreads();
            if (wid < 4) {
#pragma unroll
                for (int g4 = 0; g4 < 4; ++g4) { u32x2 w; w.x = cvtpk_n(sacc[g4 * 4 + 0], sacc[g4 * 4 + 1]); w.y = cvtpk_n(sacc[g4 * 4 + 2], sacc[g4 * 4 + 3]);
                    *(u32x2*)(lds + OFF_ST + r32 * QT_S + (32 * wid + 8 * g4 + 4 * hi) * 2) = w; }
            } else if (wid < 6) {
                const int ci = wid - 4;
#pragma unroll
                for (int kk = 0; kk < 4; ++kk) {
                    const bf16x8 af = *(const bf16x8*)(lds + OFF_ATT + (32 * ci + r32) * KD_S + kk * 32 + hi * 16);
                    const bf16x8 bfr = *(const bf16x8*)(lds + OFF_VT + r32 * KD_S + kk * 32 + hi * 16);
                    oacc = __builtin_amdgcn_mfma_f32_32x32x16_bf16(af, bfr, oacc, 0, 0, 0); }
#pragma unroll
                for (int i = 0; i < 16; ++i) { const int c = 32 * ci + crow(i, hi); ob[(size_t)(tok0 + c) * 32 + r32] = f2bf_n(oacc[i]); }
            }
        }
        __syncthreads();
    }
}
}
namespace hg2 {
#define LBAR() do { asm volatile("s_waitcnt lgkmcnt(0)" ::: "memory"); __builtin_amdgcn_s_barrier(); asm volatile("" ::: "memory"); } while (0)
constexpr int QT_S = 272, KD_S = 144;
constexpr int OFF_QT = 0, OFF_KT = OFF_QT + 64 * QT_S, OFF_QB = OFF_KT + 64 * QT_S, OFF_KD = OFF_QB + 64 * QT_S;
constexpr int OFF_VT4 = OFF_KD + 128 * KD_S, OFF_ATT = OFF_VT4 + 128 * KD_S;
constexpr int OFF_SEG = OFF_ATT + 64 * KD_S, OFF_G32 = OFF_SEG + 2048, OFF_DEC = OFF_G32 + 512, LDS_BYTES = OFF_DEC + 512;
constexpr int ST_BYTES = 32 * QT_S;
__device__ __forceinline__ int crow(int r, int hi) { return (r & 3) + 8 * (r >> 2) + 4 * hi; }

__device__ __forceinline__ void prepass(char* lds, bf16_t* __restrict__ proj1, char* __restrict__ attbuf, float* __restrict__ decbuf) {
    int tid = threadIdx.x; asm volatile("" : "+v"(tid));
    const int wid = __builtin_amdgcn_readfirstlane(tid >> 6), lane = tid & 63, r32 = lane & 31, hi = lane >> 5;
    const int kch = tid & 127, seg = tid >> 7;
    float* segtot = (float*)(lds + OFF_SEG); float* g32s = (float*)(lds + OFF_G32); float* decay = (float*)(lds + OFF_DEC);
    unsigned short graw[16], qraw[16]; bf16x8 vr0, vr1;
#define PRE_LOAD(it_) do { const int bh_ = (it_) >> 7, ch_ = (it_) & 127, b_ = bh_ >> 5, h_ = bh_ & 31;                                   \
        const bf16_t* bs_ = proj1 + ((size_t)b_ * SEQ + ch_ * 64) * N1; const bf16_t* rp_ = bs_ + (size_t)(seg * 16) * N1 + h_ * 128 + kch; \
        _Pragma("unroll") for (int i = 0; i < 16; ++i) { graw[i] = rp_[(size_t)i * N1 + 4096]; qraw[i] = rp_[(size_t)i * N1]; }                \
        const bf16_t* vp_ = bs_ + (size_t)(tid & 63) * N1 + 8192 + h_ * 128 + (tid >> 6) * 16;                                                \
        vr0 = *(const bf16x8*)vp_; vr1 = *(const bf16x8*)(vp_ + 8); } while (0)
    if (blockIdx.x < 8192) PRE_LOAD(blockIdx.x);
    for (int item = blockIdx.x; item < 8192; item += gridDim.x) {
        const int bh = item >> 7, ch = item & 127, b = bh >> 5, h = bh & 31;
        bf16_t* base = proj1 + ((size_t)b * SEQ + ch * 64) * N1;
        const int qcol = h * 128, gcol = 4096 + h * 128, vcol = 8192 + h * 128;
        float gl[16]; float cum = 0.f;
#pragma unroll
        for (int i = 0; i < 16; ++i) { cum += bf2f(graw[i]); gl[i] = cum; }
        segtot[seg * 128 + kch] = cum; if (seg == 2) g32s[kch] = bf2f(graw[0]);
        LBAR();
        { const float s0 = segtot[kch], s1 = segtot[128 + kch], s2 = segtot[256 + kch], s3 = segtot[384 + kch];
          const float off = (seg > 0 ? s0 : 0.f) + (seg > 1 ? s1 : 0.f) + (seg > 2 ? s2 : 0.f);
          const float tot = (s0 + s1) + (s2 + s3), bref = s0 + s1 + g32s[kch];
          if (seg == 0) decay[kch] = fast_exp(tot);
          float kd[16];
#pragma unroll
          for (int i = 0; i < 16; ++i) { const int t = seg * 16 + i; const float bb = off + gl[i], gv = bf2f(graw[i]), qv = bf2f(qraw[i]); const float kk = 1.0f - fast_exp(gv);
              *(bf16_t*)(lds + OFF_QT + t * QT_S + kch * 2) = f2bf_n(qv * fast_exp(bb - bref));
              *(bf16_t*)(lds + OFF_KT + t * QT_S + kch * 2) = f2bf_n(kk * fast_exp(bref - bb));
              *(bf16_t*)(lds + OFF_QB + t * QT_S + kch * 2) = f2bf_n(qv * fast_exp(bb));
              kd[i] = kk * fast_exp(tot - bb); }
          *(bf16x8*)(lds + OFF_KD + kch * KD_S + seg * 32) = pack8((f32x4){kd[0], kd[1], kd[2], kd[3]}, (f32x4){kd[4], kd[5], kd[6], kd[7]});
          *(bf16x8*)(lds + OFF_KD + kch * KD_S + seg * 32 + 16) = pack8((f32x4){kd[8], kd[9], kd[10], kd[11]}, (f32x4){kd[12], kd[13], kd[14], kd[15]});
          { const int t = tid & 63, v16 = (tid >> 6) * 16;
#pragma unroll
            for (int j = 0; j < 8; ++j) { *(bf16_t*)(lds + OFF_VT4 + (v16 + j) * KD_S + t * 2) = (bf16_t)vr0[j]; *(bf16_t*)(lds + OFF_VT4 + (v16 + 8 + j) * KD_S + t * 2) = (bf16_t)vr1[j]; } }
        }
        if (item + (int)gridDim.x < 8192) PRE_LOAD(item + gridDim.x);
        LBAR();
        const size_t lrow = (size_t)(lane >> 4) * N1 + (lane & 15) * 8;
        if (wid < 4) {
            const int ci = wid >> 1, si = wid & 1;
            if (!(ci == 0 && si == 1)) {
                f32x16 aacc = {};
#pragma unroll
                for (int kk = 0; kk < 8; ++kk) {
                    const bf16x8 af = *(const bf16x8*)(lds + OFF_QT + (32 * ci + r32) * QT_S + kk * 32 + hi * 16);
                    const bf16x8 bfr = *(const bf16x8*)(lds + OFF_KT + (32 * si + r32) * QT_S + kk * 32 + hi * 16);
                    aacc = __builtin_amdgcn_mfma_f32_32x32x16_bf16(af, bfr, aacc, 0, 0, 0); }
#pragma unroll
                for (int i = 0; i < 16; ++i) { const int c = 32 * ci + crow(i, hi), s = 32 * si + r32; const float v = (c >= s) ? aacc[i] : 0.f;
                    *(bf16_t*)(lds + OFF_ATT + c * KD_S + s * 2) = f2bf_n(v); }
            } else {
#pragma unroll
                for (int i = 0; i < 16; ++i) { const int c = crow(i, hi), s = 32 + r32; *(bf16_t*)(lds + OFF_ATT + c * KD_S + s * 2) = (bf16_t)0; }
            }
        } else {
#pragma unroll
            for (int e = 0; e < 4; ++e) { const int f = 4 * (wid - 4) + e;
                { const int ci = f >> 3, kk = f & 7; const bf16x8 fr = *(const bf16x8*)(lds + OFF_QB + (32 * ci + r32) * QT_S + kk * 32 + hi * 16);
                  *(bf16x8*)(base + (size_t)(4 * f) * N1 + qcol + lrow) = fr; }
                { const int kt = f >> 2, kk = f & 3; const bf16x8 fr = *(const bf16x8*)(lds + OFF_KD + (32 * kt + r32) * KD_S + kk * 32 + hi * 16);
                  *(bf16x8*)(base + (size_t)(4 * f) * N1 + gcol + lrow) = fr; }
                { const int vs = f >> 2, kk = f & 3; const bf16x8 fr = *(const bf16x8*)(lds + OFF_VT4 + (32 * vs + r32) * KD_S + kk * 32 + hi * 16);
                  *(bf16x8*)(base + (size_t)(4 * f) * N1 + vcol + lrow) = fr; } }
        }
        LBAR();
        { const int f = wid, ci = f >> 2, kk = f & 3; const bf16x8 fr = *(const bf16x8*)(lds + OFF_ATT + (32 * ci + r32) * KD_S + kk * 32 + hi * 16);
          *(bf16x8*)(attbuf + ((size_t)item * 8 + f) * 1024 + lane * 16) = fr; }
        if (tid < 32) *(f32x4*)(decbuf + (size_t)item * 128 + tid * 4) = *(const f32x4*)(decay + tid * 4);
    }
#undef PRE_LOAD
    LBAR();
}

__device__ __forceinline__ void seqpass(char* lds, const bf16_t* __restrict__ proj1, const char* __restrict__ attbuf, const float* __restrict__ decbuf, bf16_t* __restrict__ oraw) {
    int tid = threadIdx.x; asm volatile("" : "+v"(tid));
    const int wid = __builtin_amdgcn_readfirstlane(tid >> 6), lane = tid & 63, r32 = lane & 31, hi = lane >> 5;
    constexpr int OFF_AV = 2 * ST_BYTES;
#ifndef PROBE_SEQDUP
#define PROBE_SEQDUP 0
#endif
    for (int it2 = blockIdx.x; it2 < (1 + PROBE_SEQDUP) * 256; it2 += gridDim.x) {
        const int w_ = it2 & 255;
        const int bh = (w_ & 7) * 8 + (w_ >> 5), vs = (w_ >> 3) & 3, item = bh * 4 + vs, b = bh >> 5, h = bh & 31;
        const char* base0 = (const char*)(proj1 + (size_t)b * SEQ * N1);
        const unsigned lrow = (unsigned)(((lane >> 4) * N1 + (lane & 15) * 8) * 2);
        constexpr size_t CHB = (size_t)64 * N1 * 2, FRB = (size_t)4 * N1 * 2;
        for (int i = tid; i < 2 * ST_BYTES / 4; i += 512) ((unsigned*)lds)[i] = 0u;
        if (wid < 4) {
            f32x16 sacc = {};
            const char* gb = base0 + (size_t)(4096 + h * 128) * 2 + (size_t)(wid * 4) * FRB;
            const char* vb = base0 + (size_t)(8192 + h * 128) * 2 + (size_t)(vs * 4) * FRB;
            const float* db = decbuf + (size_t)bh * 128 * 128 + 32 * wid + 4 * hi;
            bf16x8 K0[4], V0[4], K1[4], V1[4], K2[4], V2[4]; f32x4 D0[4], D1[4], D2[4];
#define ST_LOAD(K_, V_, d_, ch_) do { _Pragma("unroll") for (int kk = 0; kk < 4; ++kk) { K_[kk] = *(const bf16x8*)(gb + (size_t)(ch_) * CHB + kk * FRB + lrow);  \
                                                                                         V_[kk] = *(const bf16x8*)(vb + (size_t)(ch_) * CHB + kk * FRB + lrow);  \
                                                                                         d_[kk] = *(const f32x4*)(db + (size_t)(ch_) * 128 + 8 * kk); } } while (0)
#define ST_STEP(c_, K_, V_, d_, LK_, LV_, Ld_) do { if ((c_) + 2 < 128) ST_LOAD(LK_, LV_, Ld_, (c_) + 2);                                                      \
                char* st_nxt = lds + (((c_) + 1) & 1) * ST_BYTES;                                                                                                \
                _Pragma("unroll") for (int g4 = 0; g4 < 4; ++g4) _Pragma("unroll") for (int j = 0; j < 4; ++j) sacc[g4 * 4 + j] *= d_[g4][j];                    \
                _Pragma("unroll") for (int kk = 0; kk < 4; ++kk) sacc = __builtin_amdgcn_mfma_f32_32x32x16_bf16(K_[kk], V_[kk], sacc, 0, 0, 0);                  \
                _Pragma("unroll") for (int g4 = 0; g4 < 4; ++g4) { u32x2 w; w.x = cvtpk_n(sacc[g4 * 4 + 0], sacc[g4 * 4 + 1]); w.y = cvtpk_n(sacc[g4 * 4 + 2], sacc[g4 * 4 + 3]); \
                    *(u32x2*)(st_nxt + r32 * QT_S + (32 * wid + 8 * g4 + 4 * hi) * 2) = w; }                                                                    \
                LBAR(); } while (0)
            ST_LOAD(K0, V0, D0, 0); ST_LOAD(K1, V1, D1, 1);
            LBAR();
            for (int ch = 0; ch < 126; ch += 3) { ST_STEP(ch, K0, V0, D0, K2, V2, D2); ST_STEP(ch + 1, K1, V1, D1, K0, V0, D0); ST_STEP(ch + 2, K2, V2, D2, K1, V1, D1); }
            ST_STEP(126, K0, V0, D0, K2, V2, D2); ST_STEP(127, K1, V1, D1, K0, V0, D0);
#undef ST_STEP
#undef ST_LOAD
        } else if (wid < 6) {
            const int ci = wid - 4;
            const char* qb = base0 + (size_t)(h * 128) * 2 + (size_t)(ci * 8) * FRB;
            char* ob = (char*)(oraw + (size_t)item * SEQ * 32) + (size_t)(32 * ci) * 64;
            const unsigned ooff = (unsigned)((4 * hi * 32 + r32) * 2);
            char* ot = lds + OFF_AV + 16384 + ci * 2048;
            bf16x8 Q0[8], Q1[8], Q2[8];
#define O_LOAD(Q_, ch_) do { _Pragma("unroll") for (int kk = 0; kk < 8; ++kk) Q_[kk] = *(const bf16x8*)(qb + (size_t)(ch_) * CHB + kk * FRB + lrow); } while (0)
#define O_STEP(c_, Q_, LQ_) do { if ((c_) + 2 < 128) O_LOAD(LQ_, (c_) + 2);                                                                                      \
                const char* st_cur = lds + ((c_) & 1) * ST_BYTES; const char* av = lds + OFF_AV + ((((c_) & 1) * 2 + ci) * 4) * 1024 + lane * 16;               \
                f32x16 oacc;                                                                                                                                     \
                _Pragma("unroll") for (int q = 0; q < 4; ++q) { const f32x4 t4 = *(const f32x4*)(av + q * 1024); oacc[q * 4 + 0] = t4[0]; oacc[q * 4 + 1] = t4[1]; oacc[q * 4 + 2] = t4[2]; oacc[q * 4 + 3] = t4[3]; } \
                _Pragma("unroll") for (int kk = 0; kk < 8; ++kk) { const bf16x8 sf = *(const bf16x8*)(st_cur + r32 * QT_S + kk * 32 + hi * 16);                  \
                    oacc = __builtin_amdgcn_mfma_f32_32x32x16_bf16(Q_[kk], sf, oacc, 0, 0, 0); }                                                                \
                char* oc = ob + (size_t)(c_) * (64 * 64);                                                                                                        \
                _Pragma("unroll") for (int i = 0; i < 16; ++i) *(bf16_t*)(ot + ((i & 3) + 8 * (i >> 2)) * 64 + ooff) = f2bf_n(oacc[i]);     \
                asm volatile("s_waitcnt lgkmcnt(0)" ::: "memory");                                                                                               \
                { const bf16x8 w0 = *(const bf16x8*)(ot + lane * 16), w1 = *(const bf16x8*)(ot + 1024 + lane * 16);                                              \
                  *(bf16x8*)(oc + lane * 16) = w0; *(bf16x8*)(oc + 1024 + lane * 16) = w1; }                    \
                LBAR(); } while (0)
            O_LOAD(Q0, 0); O_LOAD(Q1, 1);
            LBAR();
            for (int ch = 0; ch < 126; ch += 3) { O_STEP(ch, Q0, Q2); O_STEP(ch + 1, Q1, Q0); O_STEP(ch + 2, Q2, Q1); }
            O_STEP(126, Q0, Q2); O_STEP(127, Q1, Q0);
#undef O_STEP
#undef O_LOAD
        } else {
            const int ci = wid - 6;
            const char* vb = base0 + (size_t)(8192 + h * 128) * 2 + (size_t)(vs * 4) * FRB;
            const char* ab = attbuf + ((size_t)bh * 128 * 8 + ci * 4) * 1024 + lane * 16;
            bf16x8 A0[4], V0[4], A1[4], V1[4], A2[4], V2[4];
#define AV_LOAD(A_, V_, ch_) do { _Pragma("unroll") for (int kk = 0; kk < 4; ++kk) { A_[kk] = *(const bf16x8*)(ab + (size_t)(ch_) * 8192 + kk * 1024);          \
                                                                                     V_[kk] = *(const bf16x8*)(vb + (size_t)(ch_) * CHB + kk * FRB + lrow); } } while (0)
#define AV_DO(A_, V_, slot_) do { f32x16 acc_ = {}; _Pragma("unroll") for (int kk = 0; kk < 4; ++kk) acc_ = __builtin_amdgcn_mfma_f32_32x32x16_bf16(A_[kk], V_[kk], acc_, 0, 0, 0); \
        char* av_ = lds + OFF_AV + ((((slot_) & 1) * 2 + ci) * 4) * 1024 + lane * 16;                                                                                   \
        _Pragma("unroll") for (int q = 0; q < 4; ++q) *(f32x4*)(av_ + q * 1024) = (f32x4){acc_[q * 4 + 0], acc_[q * 4 + 1], acc_[q * 4 + 2], acc_[q * 4 + 3]}; } while (0)
            AV_LOAD(A0, V0, 0); AV_LOAD(A1, V1, 1); AV_LOAD(A2, V2, 2);
            AV_DO(A0, V0, 0);
            LBAR();
#define AV_STEP(c_, A_, V_, LA_, LV_) do { if ((c_) + 3 < 128) AV_LOAD(LA_, LV_, (c_) + 3); if ((c_) + 1 < 128) AV_DO(A_, V_, (c_) + 1); LBAR(); } while (0)
            for (int ch = 0; ch < 126; ch += 3) { AV_STEP(ch, A1, V1, A0, V0); AV_STEP(ch + 1, A2, V2, A1, V1); AV_STEP(ch + 2, A0, V0, A2, V2); }
            AV_STEP(126, A1, V1, A0, V0); AV_STEP(127, A2, V2, A1, V1);
#undef AV_STEP
#undef AV_LOAD
#undef AV_DO
        }
    }
}
#undef LBAR
}
constexpr int LDS_MAIN = pg8::STAGE_BYTES;
constexpr int LDS_TOTAL = LDS_MAIN + 16;
constexpr size_t WS_BAR = WS_END;
static_assert(att::LDS_BYTES <= LDS_MAIN && hg::LDS_BYTES <= LDS_MAIN && hg2::LDS_BYTES <= LDS_MAIN, "lds");
static_assert((size_t)8192 * 8192 + (size_t)8192 * 512 <= WS_W1O, "attbuf/decbuf must fit in the dead weight region");

#ifndef PHMASK
#define PHMASK 0xFFFF
#endif
#define EN(n) (((PHMASK) >> (n)) & 1)
#ifndef SKIP_SEQ
#define SKIP_SEQ 0
#endif
#ifndef SKIP_PRE
#define SKIP_PRE 0
#endif
#ifndef PROBE_DUP7
#define PROBE_DUP7 0
#endif

__global__ void __launch_bounds__(512) mla_hgrn2_fwd(Params p) {
    extern __shared__ __attribute__((aligned(16))) unsigned char lds[];
    cg::grid_group grid = cg::this_grid();
    unsigned char* ws = p.ws;
    bf16_t* W0IN = (bf16_t*)(ws + WS_W0IN); bf16_t* WUQ = (bf16_t*)(ws + WS_WUQ); bf16_t* WUKV = (bf16_t*)(ws + WS_WUKV);
    bf16_t* W0O = (bf16_t*)(ws + WS_W0O); bf16_t* W1IN = (bf16_t*)(ws + WS_W1IN); bf16_t* W1O = (bf16_t*)(ws + WS_W1O);
    float* RSTD0 = (float*)(ws + WS_RSTD0); float* RSTDQ = (float*)(ws + WS_RSTDQ); float* RSTDKV = (float*)(ws + WS_RSTDKV); float* RSTD1 = (float*)(ws + WS_RSTD1);
    float* LB = (float*)(ws + WS_LB); float* COS = (float*)(ws + WS_COS); float* SIN = (float*)(ws + WS_SIN);
    bf16_t* KROT = (bf16_t*)(ws + WS_KROT); bf16_t* ACTA = (bf16_t*)(ws + WS_ACTA);
    bf16_t* PROJ0 = (bf16_t*)(ws + WS_PROJ0); bf16_t* QBUF = (bf16_t*)(ws + WS_Q); bf16_t* PROJ1 = (bf16_t*)(ws + WS_PROJ1);
    bf16_t* X1B = (bf16_t*)p.out;
    bf16_t* KVBUF = (bf16_t*)p.out;
    LAS unsigned char* ldsl = (LAS unsigned char*)lds;
    const int G = gridDim.x, c = blockIdx.x;
    volatile LAS unsigned* bst = (volatile LAS unsigned*)(ldsl + LDS_MAIN);
    if (threadIdx.x == 0) { bst[0] = 0u; bst[1] = 0u; bst[2] = 0u; bst[3] = 0u; }
    __syncthreads();
    const XcdBarrier xbar = xcd_barrier_post((unsigned*)(ws + WS_BAR), bst);
#define GRID_BAR() xcd_barrier(xbar)

    if (EN(0))
    {
        char* tile = (char*)lds;
        wt_phase(p.l0_w_in, 4096, N0, p.l0_norm, W0IN, tile);
        wt_phase(p.l0_w_uq, 1024, NQ, p.l0_q_norm, WUQ, tile);
        wt_phase(p.l0_w_ukv, 512, NKV, p.l0_kv_norm, WUKV, tile);
        wt_phase(p.l0_w_o, 4096, 4096, nullptr, W0O, tile);
        wt_phase(p.l1_w_in, 4096, N1, p.l1_norm, W1IN, tile);
        wt_phase(p.l1_w_o, 4096, 4096, nullptr, W1O, tile);
        { u32x4 z = {0u, 0u, 0u, 0u}; u32x4* pad = (u32x4*)(W0IN + (size_t)N0 * 4096); const int n16 = (N0P - N0) * 4096 * 2 / 16;
          for (int i = c * 512 + threadIdx.x; i < n16; i += G * 512) pad[i] = z; }
        cast_rstd_phase(p.x, ACTA, RSTD0);
        tables_phase(p, COS, SIN, LB);
        for (int i = c * 512 + threadIdx.x; i < T_TOK; i += G * 512) RSTD1[i] = 0.f;
    }
#ifdef PROBE_P02
    {
        char* tile = (char*)lds;
        wt_phase(p.l0_w_in, 4096, N0, p.l0_norm, W0IN, tile);
        wt_phase(p.l0_w_uq, 1024, NQ, p.l0_q_norm, WUQ, tile);
        wt_phase(p.l0_w_ukv, 512, NKV, p.l0_kv_norm, WUKV, tile);
        wt_phase(p.l0_w_o, 4096, 4096, nullptr, W0O, tile);
        wt_phase(p.l1_w_in, 4096, N1, p.l1_norm, W1IN, tile);
        wt_phase(p.l1_w_o, 4096, 4096, nullptr, W1O, tile);
    }
#endif
    if (p.ws == nullptr) grid.sync();
    GRID_BAR();
    if (EN(1)) {
        pg8::Gemm g{ACTA, W0IN, T_TOK, N0P, 4096, 4096}; pg8::StaticOrder S; S.init(T_TOK, N0P, G, c);
        pg8::EpiBf16<1> E{PROJ0, N0P, RSTD0, 1600, nullptr};
        pg8::gemm_phase(ldsl, g, S, E);
    }
    GRID_BAR();
    if (EN(2)) stats_krot_phase(PROJ0, RSTDQ, RSTDKV, COS, SIN, KROT);
    GRID_BAR();
    if (EN(3)) {
        pg8::Gemm g{PROJ0, WUQ, T_TOK, NQ, 1024, N0P}; pg8::StaticOrder S; S.init(T_TOK, NQ, G, c);
        pg8::EpiBf16<0> E{QBUF, NQ, RSTDQ, 0, nullptr};
        pg8::gemm_phase(ldsl, g, S, E);
    }
    if (EN(3)) {
        pg8::Gemm g{PROJ0 + 1024, WUKV, T_TOK, NKV, 512, N0P}; pg8::StaticOrder S; S.init(T_TOK, NKV, G, c);
        pg8::EpiBf16<0> E{KVBUF, NKV, RSTDKV, 0, nullptr};
        pg8::gemm_phase(ldsl, g, S, E);
    }
    GRID_BAR();
    if (EN(4)) {
        att::Tensors T{QBUF, KVBUF, KROT, ACTA, PROJ0, COS, SIN};
        att::attn_phase((char*)lds, T);
    }
    GRID_BAR();
    if (EN(5)) {
        for (int i = c * 512 + threadIdx.x; i < T_TOK; i += G * 512) RSTDQ[i] = 0.f;
        pg8::Gemm g{ACTA, W0O, T_TOK, 4096, 4096, 4096}; pg8::StaticOrder S; S.init(T_TOK, 4096, G, c);
        pg8::EpiResBf16Stat E{p.x, X1B, 4096, RSTD1};
        pg8::gemm_phase(ldsl, g, S, E);
    }
    GRID_BAR();
    if (EN(7)) {
        pg8::Gemm g{X1B, W1IN, T_TOK, N1, 4096, 4096}; pg8::StaticOrder S; S.init(T_TOK, N1, G, c, PROBE_DUP7);
        pg8::EpiBf16<2> E{PROJ1, N1, RSTD1, 0, LB, 1};
        pg8::gemm_phase(ldsl, g, S, E);
    }
    GRID_BAR();
#ifdef HG_OLD
    if (EN(8)) hg::hgrn2_phase((char*)lds, PROJ1, ACTA);
#else
    if (EN(8) && !SKIP_PRE) hg2::prepass((char*)lds, PROJ1, (char*)(ws + WS_W0IN), (float*)(ws + WS_W0IN + (size_t)8192 * 8192));
    GRID_BAR();
    if (EN(8) && !SKIP_SEQ) hg2::seqpass((char*)lds, PROJ1, (const char*)(ws + WS_W0IN), (const float*)(ws + WS_W0IN + (size_t)8192 * 8192), ACTA);
#endif
#ifdef PROBE_HG2
    __syncthreads(); hg::hgrn2_phase((char*)lds, PROJ1, ACTA);
#endif
    GRID_BAR();
    if (EN(9)) headnorm_phase(PROJ1, ACTA, p.l1_g_norm);
    GRID_BAR();
    if (EN(10)) {
        pg8::Gemm g{PROJ1 + 8192, W1O, T_TOK, 4096, 4096, N1}; pg8::StaticOrder S; S.init(T_TOK, 4096, G, c);
        pg8::EpiBf16ResBf16Stat E{X1B, 4096, PROJ1, N1, RSTDQ};
        pg8::gemm_phase(ldsl, g, S, E);
    }
    GRID_BAR();
    if (EN(11)) final_norm_bf16_phase(PROJ1, (size_t)N1, RSTDQ, p.out, p.final_norm);
}

extern "C" void kernel_launch(void* const* d_in, const int* in_sizes, int n_in, void* d_out, int out_size, void* d_ws, size_t ws_size, hipStream_t stream) {
    static int grid = 0;
    if (grid == 0) {
        if (n_in != 15 || ws_size < WS_BAR + XCD_BAR_WORDS * sizeof(unsigned)) { fprintf(stderr, "kernel_launch: unexpected inputs (n_in %d, ws %zu, need %zu)\n", n_in, ws_size, (size_t)(WS_BAR + XCD_BAR_WORDS * sizeof(unsigned))); grid = -1; return; }
        int dev = 0, cus = 0, per_cu = 0;
        (void)hipGetDevice(&dev); (void)hipDeviceGetAttribute(&cus, hipDeviceAttributeMultiprocessorCount, dev);
        if (hipFuncSetAttribute((const void*)mla_hgrn2_fwd, hipFuncAttributeMaxDynamicSharedMemorySize, LDS_TOTAL) != hipSuccess) { fprintf(stderr, "kernel_launch: hipFuncSetAttribute failed\n"); grid = -1; return; }
        if (hipOccupancyMaxActiveBlocksPerMultiprocessor(&per_cu, (const void*)mla_hgrn2_fwd, 512, LDS_TOTAL) != hipSuccess || per_cu < 1) { fprintf(stderr, "kernel_launch: occupancy query gave %d\n", per_cu); per_cu = 1; }
        (void)hipGetLastError();
        if (cus <= 0) cus = 256;
        grid = cus * per_cu;
        fprintf(stderr, "kernel_launch: grid %d (cus %d x %d)\n", grid, cus, per_cu);
    }
    if (grid < 0) return;
    Params p{};
    p.x = (const float*)d_in[0]; p.pos = (const int*)d_in[1]; p.l0_norm = (const float*)d_in[2]; p.l0_w_in = (const float*)d_in[3]; p.l0_q_norm = (const float*)d_in[4];
    p.l0_w_uq = (const float*)d_in[5]; p.l0_kv_norm = (const float*)d_in[6]; p.l0_w_ukv = (const float*)d_in[7]; p.l0_w_o = (const float*)d_in[8]; p.l1_norm = (const float*)d_in[9];
    p.l1_w_in = (const float*)d_in[10]; p.l1_g_norm = (const float*)d_in[11]; p.l1_w_o = (const float*)d_in[12]; p.lower_bounds = (const float*)d_in[13]; p.final_norm = (const float*)d_in[14];
    p.out = (float*)d_out; p.ws = (unsigned char*)d_ws;
    for (int j = 0; j < 32; ++j) p.inv_freq[j] = (float)(1.0 / pow(10000.0, (double)(2 * j) / 64.0));
    if (hipMemsetAsync((char*)d_ws + WS_BAR, 0, XCD_BAR_WORDS * sizeof(unsigned), stream) != hipSuccess) { fprintf(stderr, "kernel_launch: memset of the barrier words failed\n"); return; }
    void* args[] = {&p};
    hipError_t e = hipLaunchCooperativeKernel((const void*)mla_hgrn2_fwd, dim3(grid), dim3(512), args, LDS_TOTAL, stream);
    if (e != hipSuccess) fprintf(stderr, "kernel_launch: cooperative launch failed: %s (grid %d)\n", hipGetErrorString(e), grid);
}
```

```cpp
#include <hip/hip_runtime.h>
#include <hip/hip_cooperative_groups.h>
#include <cstdio>
#include <cstdint>
#include <cmath>
namespace cg = cooperative_groups;

typedef unsigned short bf16_t;
typedef short bf16x8 __attribute__((ext_vector_type(8)));
typedef short s16x4 __attribute__((ext_vector_type(4)));
typedef float f32x4 __attribute__((ext_vector_type(4)));
typedef float f32x16 __attribute__((ext_vector_type(16)));
typedef unsigned u32x4 __attribute__((ext_vector_type(4)));
typedef unsigned u32x2 __attribute__((ext_vector_type(2)));
#define LAS __attribute__((address_space(3)))

constexpr int T_TOK = 16384, SEQ = 8192, DM = 4096;
constexpr int N0 = 5696, N0P = 5888;
constexpr int NQ = 6144, NKV = 8192, N1 = 16384;
constexpr float EPS = 1e-6f;

constexpr size_t WS_W0IN = 0;
constexpr size_t WS_WUQ  = WS_W0IN + (size_t)N0P * 4096 * 2;
constexpr size_t WS_WUKV = WS_WUQ + (size_t)NQ * 1024 * 2;
constexpr size_t WS_W0O  = WS_WUKV + (size_t)NKV * 512 * 2;
constexpr size_t WS_W1IN = WS_W0O + (size_t)4096 * 4096 * 2;
constexpr size_t WS_W1O  = WS_W1IN + (size_t)N1 * 4096 * 2;
constexpr size_t WS_RSTD0 = WS_W1O + (size_t)4096 * 4096 * 2;
constexpr size_t WS_RSTDQ = WS_RSTD0 + 65536;
constexpr size_t WS_RSTDKV = WS_RSTDQ + 65536;
constexpr size_t WS_RSTD1 = WS_RSTDKV + 65536;
constexpr size_t WS_LB = WS_RSTD1 + 65536;
constexpr size_t WS_COS = WS_LB + 16384;
constexpr size_t WS_SIN = WS_COS + (size_t)T_TOK * 32 * 4;
constexpr size_t WS_KROT = WS_SIN + (size_t)T_TOK * 32 * 4;
constexpr size_t WS_ACTA = WS_KROT + (size_t)T_TOK * 64 * 2;
constexpr size_t WS_R = WS_ACTA + (size_t)T_TOK * 4096 * 2;
constexpr size_t WS_PROJ0 = WS_R;
constexpr size_t WS_Q = WS_PROJ0 + (size_t)T_TOK * N0P * 2;
constexpr size_t WS_PROJ1 = WS_R;
constexpr size_t WS_END = WS_R + (size_t)T_TOK * N1 * 2;

struct Params {
    const float* x; const int* pos; const float* l0_norm; const float* l0_w_in; const float* l0_q_norm; const float* l0_w_uq;
    const float* l0_kv_norm; const float* l0_w_ukv; const float* l0_w_o; const float* l1_norm; const float* l1_w_in;
    const float* l1_g_norm; const float* l1_w_o; const float* lower_bounds; const float* final_norm;
    float* out; unsigned char* ws;
    float inv_freq[32];
};

__device__ __forceinline__ unsigned cvtpk(float lo, float hi) { unsigned r; asm volatile("v_cvt_pk_bf16_f32 %0, %1, %2" : "=v"(r) : "v"(lo), "v"(hi)); return r; }
typedef float f32x2 __attribute__((ext_vector_type(2)));
typedef __bf16 bf16x2_t __attribute__((ext_vector_type(2)));
__device__ __forceinline__ unsigned cvtpk_n(float lo, float hi) { f32x2 v = {lo, hi}; bf16x2_t h = __builtin_convertvector(v, bf16x2_t); return __builtin_bit_cast(unsigned, h); }
__device__ __forceinline__ bf16_t f2bf_n(float f) { return (bf16_t)(cvtpk_n(f, 0.f) & 0xffffu); }
__device__ __forceinline__ bf16_t f2bf(float f) { return (bf16_t)(cvtpk(f, 0.f) & 0xffffu); }
__device__ __forceinline__ float bf2f(unsigned short h) { return __uint_as_float((unsigned)h << 16); }
__device__ __forceinline__ float bflo(unsigned w) { return __uint_as_float(w << 16); }
__device__ __forceinline__ float bfhi(unsigned w) { return __uint_as_float(w & 0xffff0000u); }
__device__ __forceinline__ bf16x8 pack8(f32x4 a, f32x4 b) {
    u32x4 w = {cvtpk(a[0], a[1]), cvtpk(a[2], a[3]), cvtpk(b[0], b[1]), cvtpk(b[2], b[3])};
    return *reinterpret_cast<bf16x8*>(&w);
}
__device__ __forceinline__ float fast_exp(float x) { return __builtin_amdgcn_exp2f(x * 1.4426950408889634f); }
__device__ __forceinline__ float silu_f(float v) { return v * __builtin_amdgcn_rcpf(1.0f + fast_exp(-v)); }
__device__ __forceinline__ float wave_sum(float v) {
#pragma unroll
    for (int o = 32; o > 0; o >>= 1) v += __shfl_xor(v, o);
    return v;
}

namespace pg8 {
constexpr int BM = 256, BK = 64, HALF = 128, HTB = HALF * BK * 2, STAGE_BYTES = 8 * HTB, NXCD = 8, WGM = 8;
__host__ __device__ __forceinline__ int lds_byte(int r, int c) { const int st = (r >> 4) * 2 + (c >> 5), rr = r & 15, cc = c & 31, ob = rr * 64 + cc * 2; return st * 1024 + (ob ^ (((ob >> 9) & 1) << 5)); }
__host__ __device__ __forceinline__ void stage_rc(int b, int& R, int& C) { const int st = b / 1024, sb = b % 1024, swz = sb ^ (((sb >> 9) & 1) << 5); R = (st >> 1) * 16 + swz / 64; C = (st & 1) * 32 + (swz % 64) / 2; }
__host__ __device__ __forceinline__ int perm32(int rho) { const int n = rho >> 4, i = rho & 15; return 8 * (i >> 2) + 4 * n + (i & 3); }
struct Unit { int pm, pn; };
struct Gemm { const bf16_t* A; const bf16_t* Bt; int M, N, K, lda; };
struct StaticOrder {
    int nM, nN, nwg, G, c, dup;
    __device__ void init(int M, int N, int G_, int c_, int dup_ = 0) { nM = M / BM; nN = N / BM; nwg = nM * nN; G = G_; c = c_; dup = dup_; }
    __device__ bool next(int i, Unit& u) const {
        const long L = (long)(i >> dup) * G + c; if (L >= nwg) return false;
        int wgid = (int)L; { const int q = nwg / NXCD, r = nwg % NXCD, xcd = wgid % NXCD, off = wgid / NXCD; wgid = (xcd < r ? xcd * (q + 1) : r * (q + 1) + (xcd - r) * q) + off; }
        const int nig = WGM * nN, gid = wgid / nig, fm = gid * WGM, gsz = (nM - fm) < WGM ? (nM - fm) : WGM;
        u.pm = fm + ((wgid % nig) % gsz); u.pn = (wgid % nig) / gsz; return true;
    }
};

template <int MODE> struct EpiBf16 {
    static constexpr bool PERM = true;
    bf16_t* O; int ldc; const float* rs; int thr; const float* lb; int ssqmode;
    __device__ __forceinline__ void operator()(const f32x4 (&acc)[2][2][4][2], const Unit& u, int wr, int wc, int fr, int fq) const {
        const int row0 = u.pm * BM + wr * 64 + fr, col0 = u.pn * BM + wc * 32 + 8 * fq;
        const int sec = (u.pn * BM) >> 12;
        f32x4 lbv[2][2] = {};
        if (MODE == 2) { if (sec == 1) {
#pragma unroll
            for (int bj = 0; bj < 2; ++bj) { lbv[bj][0] = *(const f32x4*)(lb + col0 + bj * HALF - 4096); lbv[bj][1] = *(const f32x4*)(lb + col0 + bj * HALF - 4096 + 4); } } }
        float rsv[2][4];
#pragma unroll
        for (int ai = 0; ai < 2; ++ai)
#pragma unroll
            for (int m = 0; m < 4; ++m) { float t_ = rs[row0 + ai * HALF + m * 16]; if (ssqmode) t_ = 1.0f / sqrtf(t_ * (1.0f / 4096.0f) + EPS); rsv[ai][m] = t_; }
#pragma unroll
        for (int ai = 0; ai < 2; ++ai)
#pragma unroll
            for (int m = 0; m < 4; ++m) {
                const int row = row0 + ai * HALF + m * 16; const float s = rsv[ai][m];
                bf16_t* rowp = O + (size_t)row * ldc + col0;
#pragma unroll
                for (int bj = 0; bj < 2; ++bj) {
                    f32x4 v0 = acc[ai][bj][m][0] * s, v1 = acc[ai][bj][m][1] * s;
                    const int col = col0 + bj * HALF;
                    if (MODE == 1) { if (col >= thr) {
#pragma unroll
                        for (int j = 0; j < 4; ++j) { v0[j] = silu_f(v0[j]); v1[j] = silu_f(v1[j]); } } }
                    if (MODE == 2) {
                        if (sec == 0 || sec == 3) {
#pragma unroll
                            for (int j = 0; j < 4; ++j) { v0[j] = silu_f(v0[j]); v1[j] = silu_f(v1[j]); } }
                        else if (sec == 1) {
                            const f32x4 l0 = lbv[bj][0], l1 = lbv[bj][1];
#pragma unroll
                            for (int j = 0; j < 4; ++j) {
                                float sg = __builtin_amdgcn_rcpf(1.0f + fast_exp(-v0[j])); float fg = l0[j] + (1.0f - l0[j]) * sg; v0[j] = __logf(fg);
                                sg = __builtin_amdgcn_rcpf(1.0f + fast_exp(-v1[j])); fg = l1[j] + (1.0f - l1[j]) * sg; v1[j] = __logf(fg); }
                        }
                    }
                    u32x4 w; w.x = cvtpk(v0[0], v0[1]); w.y = cvtpk(v0[2], v0[3]); w.z = cvtpk(v1[0], v1[1]); w.w = cvtpk(v1[2], v1[3]);
                    *(u32x4*)(rowp + bj * HALF) = w;
                }
            }
    }
};
struct EpiResF32 {
    static constexpr bool PERM = false;
    const float* base; float* out; int ldc;
    __device__ __forceinline__ void operator()(const f32x4 (&acc)[2][2][4][2], const Unit& u, int wr, int wc, int fr, int fq) const {
        const int row0 = u.pm * BM + wr * 64 + fr, col0 = u.pn * BM + wc * 32 + 4 * fq;
        f32x4 bs[2][4];
#define RES_LOAD(g, slot) do { const size_t off_ = (size_t)(row0 + ((g) >> 2) * HALF + ((g) & 3) * 16) * ldc + col0; \
        _Pragma("unroll") for (int bj = 0; bj < 2; ++bj) _Pragma("unroll") for (int n = 0; n < 2; ++n) bs[slot][bj * 2 + n] = *(const f32x4*)(base + off_ + bj * HALF + n * 16); } while (0)
        RES_LOAD(0, 0);
#pragma unroll
        for (int g = 0; g < 8; ++g) {
            if (g + 1 < 8) RES_LOAD(g + 1, (g + 1) & 1);
            const int ai = g >> 2, m = g & 3; const size_t off = (size_t)(row0 + ai * HALF + m * 16) * ldc + col0;
#pragma unroll
            for (int bj = 0; bj < 2; ++bj)
#pragma unroll
                for (int n = 0; n < 2; ++n) *(f32x4*)(out + off + bj * HALF + n * 16) = bs[g & 1][bj * 2 + n] + acc[ai][bj][m][n];
        }
#undef RES_LOAD
    }
};

struct EpiResBf16Stat {
    static constexpr bool PERM = true;
    const float* base; bf16_t* O; int ldc; float* ssq;
    __device__ __forceinline__ void operator()(const f32x4 (&acc)[2][2][4][2], const Unit& u, int wr, int wc, int fr, int fq) const {
        const int row0 = u.pm * BM + wr * 64 + fr, col0 = u.pn * BM + wc * 32 + 8 * fq;
        f32x4 bs[2][4];
#define RES_LOAD(g, slot) do { const size_t off_ = (size_t)(row0 + ((g) >> 2) * HALF + ((g) & 3) * 16) * ldc + col0; \
        _Pragma("unroll") for (int bj = 0; bj < 2; ++bj) { bs[slot][bj * 2] = *(const f32x4*)(base + off_ + bj * HALF); bs[slot][bj * 2 + 1] = *(const f32x4*)(base + off_ + bj * HALF + 4); } } while (0)
        RES_LOAD(0, 0);
#pragma unroll
        for (int g = 0; g < 8; ++g) {
            if (g + 1 < 8) RES_LOAD(g + 1, (g + 1) & 1);
            const int ai = g >> 2, m = g & 3, row = row0 + ai * HALF + m * 16; float ss = 0.f;
#pragma unroll
            for (int bj = 0; bj < 2; ++bj) {
                const f32x4 v0 = acc[ai][bj][m][0] + bs[g & 1][bj * 2], v1 = acc[ai][bj][m][1] + bs[g & 1][bj * 2 + 1];
                ss += (v0[0] * v0[0] + v0[1] * v0[1]) + (v0[2] * v0[2] + v0[3] * v0[3]) + (v1[0] * v1[0] + v1[1] * v1[1]) + (v1[2] * v1[2] + v1[3] * v1[3]);
                u32x4 w; w.x = cvtpk(v0[0], v0[1]); w.y = cvtpk(v0[2], v0[3]); w.z = cvtpk(v1[0], v1[1]); w.w = cvtpk(v1[2], v1[3]);
                *(u32x4*)(O + (size_t)row * ldc + col0 + bj * HALF) = w;
            }
            ss += __shfl_xor(ss, 16); ss += __shfl_xor(ss, 32);
            if (fq == 0) atomicAdd(ssq + row, ss);
        }
#undef RES_LOAD
    }
};
struct EpiResBf16F32 {
    static constexpr bool PERM = false;
    const bf16_t* base; int ldb; float* out; int ldo;
    __device__ __forceinline__ void operator()(const f32x4 (&acc)[2][2][4][2], const Unit& u, int wr, int wc, int fr, int fq) const {
        const int row0 = u.pm * BM + wr * 64 + fr, col0 = u.pn * BM + wc * 32 + 4 * fq;
        u32x2 bs[2][4];
#define RES_LOAD(g, slot) do { const size_t off_ = (size_t)(row0 + ((g) >> 2) * HALF + ((g) & 3) * 16) * ldb + col0; \
        _Pragma("unroll") for (int bj = 0; bj < 2; ++bj) _Pragma("unroll") for (int n = 0; n < 2; ++n) bs[slot][bj * 2 + n] = *(const u32x2*)(base + off_ + bj * HALF + n * 16); } while (0)
        RES_LOAD(0, 0);
#pragma unroll
        for (int g = 0; g < 8; ++g) {
            if (g + 1 < 8) RES_LOAD(g + 1, (g + 1) & 1);
            const int ai = g >> 2, m = g & 3; const size_t off = (size_t)(row0 + ai * HALF + m * 16) * ldo + col0;
#pragma unroll
            for (int bj = 0; bj < 2; ++bj)
#pragma unroll
                for (int n = 0; n < 2; ++n) { const u32x2 b2 = bs[g & 1][bj * 2 + n]; const f32x4 bv = {bflo(b2.x), bfhi(b2.x), bflo(b2.y), bfhi(b2.y)};
                    *(f32x4*)(out + off + bj * HALF + n * 16) = bv + acc[ai][bj][m][n]; }
        }
#undef RES_LOAD
    }
};

struct EpiBf16ResBf16Stat {
    static constexpr bool PERM = true;
    const bf16_t* base; int ldb; bf16_t* O; int ldo; float* ssq;
    __device__ __forceinline__ void operator()(const f32x4 (&acc)[2][2][4][2], const Unit& u, int wr, int wc, int fr, int fq) const {
        const int row0 = u.pm * BM + wr * 64 + fr, col0 = u.pn * BM + wc * 32 + 8 * fq;
        u32x4 bs[2][2];
#define RES_LOAD(g, slot) do { const size_t off_ = (size_t)(row0 + ((g) >> 2) * HALF + ((g) & 3) * 16) * ldb + col0; \
        _Pragma("unroll") for (int bj = 0; bj < 2; ++bj) bs[slot][bj] = *(const u32x4*)(base + off_ + bj * HALF); } while (0)
        RES_LOAD(0, 0);
#pragma unroll
        for (int g = 0; g < 8; ++g) {
            if (g + 1 < 8) RES_LOAD(g + 1, (g + 1) & 1);
            const int ai = g >> 2, m = g & 3, row = row0 + ai * HALF + m * 16; float ss = 0.f;
#pragma unroll
            for (int bj = 0; bj < 2; ++bj) {
                const u32x4 b4 = bs[g & 1][bj];
                const f32x4 v0 = acc[ai][bj][m][0] + (f32x4){bflo(b4.x), bfhi(b4.x), bflo(b4.y), bfhi(b4.y)}, v1 = acc[ai][bj][m][1] + (f32x4){bflo(b4.z), bfhi(b4.z), bflo(b4.w), bfhi(b4.w)};
                ss += (v0[0] * v0[0] + v0[1] * v0[1]) + (v0[2] * v0[2] + v0[3] * v0[3]) + (v1[0] * v1[0] + v1[1] * v1[1]) + (v1[2] * v1[2] + v1[3] * v1[3]);
                u32x4 w; w.x = cvtpk(v0[0], v0[1]); w.y = cvtpk(v0[2], v0[3]); w.z = cvtpk(v1[0], v1[1]); w.w = cvtpk(v1[2], v1[3]);
                *(u32x4*)(O + (size_t)row * ldo + col0 + bj * HALF) = w;
            }
            ss += __shfl_xor(ss, 16); ss += __shfl_xor(ss, 32);
            if (fq == 0) atomicAdd(ssq + row, ss);
        }
#undef RES_LOAD
    }
};

template <class Epi, class Sched>
__device__ __forceinline__ void gemm_phase(LAS unsigned char* lds, const Gemm g, const Sched& S, const Epi& E) {
    int tid = threadIdx.x; asm volatile("" : "+v"(tid));
    const int wid = __builtin_amdgcn_readfirstlane(tid >> 6), lane = tid & 63, wr = wid >> 2, wc = wid & 3, fr = lane & 15, fq = lane >> 4;
    const int K = g.K, nt = K / BK, lda = g.lda;
    unsigned voffA[2], voffB[2];
#pragma unroll
    for (int i = 0; i < 2; ++i) { int R, C; stage_rc(tid * 16 + i * 8192, R, C); const int Rb = Epi::PERM ? ((R & ~31) + perm32(R & 31)) : R;
        voffA[i] = (unsigned)(R * lda + C) * 2u; voffB[i] = (unsigned)(Rb * K + C) * 2u; }
    const size_t kstep = (size_t)(BK * 2);
    const size_t hstepA = (size_t)HALF * lda * 2, hstepB = (size_t)HALF * K * 2;
    const size_t tstepA = 2 * hstepA, tstepB = 2 * hstepB;
    const unsigned ldsw = (unsigned)wid * 1024u;
    const int aoff = lds_byte(wr * 64 + fr, fq * 8), boff = lds_byte(wc * 32 + fr, fq * 8);
#define PG8_SA(b, h) (((b) * 2 + (h)) * HTB)
#define PG8_SB(b, h) ((4 + (b) * 2 + (h)) * HTB)
#define PG8_STAGE(bufoff, gbase, voff) do { _Pragma("unroll") for (int _i = 0; _i < 2; ++_i) \
        __builtin_amdgcn_global_load_lds((const unsigned*)((const char*)(gbase) + (voff)[_i]), (LAS unsigned*)(lds + (bufoff) + ldsw + _i * 8192), 16, 0, 0); } while (0)
#define PG8_LDA(dst, b, h) do { _Pragma("unroll") for (int m = 0; m < 4; ++m) _Pragma("unroll") for (int k = 0; k < 2; ++k) dst[m][k] = *(const LAS bf16x8*)(lds + PG8_SA(b, h) + aoff + m * 2048 + k * 1024); } while (0)
#define PG8_LDB(dst, b, h) do { _Pragma("unroll") for (int n = 0; n < 2; ++n) _Pragma("unroll") for (int k = 0; k < 2; ++k) dst[n][k] = *(const LAS bf16x8*)(lds + PG8_SB(b, h) + boff + n * 2048 + k * 1024); } while (0)
#define PG8_MMA(ai, bj, At, Bt) do { __builtin_amdgcn_s_setprio(1); _Pragma("unroll") for (int m = 0; m < 4; ++m) _Pragma("unroll") for (int n = 0; n < 2; ++n) _Pragma("unroll") for (int k = 0; k < 2; ++k) \
        acc[ai][bj][m][n] = __builtin_amdgcn_mfma_f32_16x16x32_bf16(Bt[n][k], At[m][k], acc[ai][bj][m][n], 0, 0, 0); __builtin_amdgcn_s_setprio(0); } while (0)
#define PG8_WAIT_V(n) asm volatile("s_waitcnt vmcnt(" #n ")" ::: "memory")
#define PG8_WAIT_L(n) asm volatile("s_waitcnt lgkmcnt(" #n ")" ::: "memory")
#define PG8_BAR __builtin_amdgcn_s_barrier()
#define PG8_SCHED __builtin_amdgcn_sched_barrier(0)
    Unit cur, nxt; int ui = 0;
    if (!S.next(0, cur)) return;
    f32x4 acc[2][2][4][2];
#pragma unroll
    for (int a = 0; a < 2; ++a)
#pragma unroll
        for (int b = 0; b < 2; ++b)
#pragma unroll
            for (int m = 0; m < 4; ++m)
#pragma unroll
                for (int n = 0; n < 2; ++n) acc[a][b][m][n] = (f32x4){0.f, 0.f, 0.f, 0.f};
    bf16x8 At[4][2], B0[2][2], B1[2][2];
    const char* cA = (const char*)g.A + (size_t)cur.pm * tstepA; const char* cB = (const char*)g.Bt + (size_t)cur.pn * tstepB;
    PG8_STAGE(PG8_SB(0, 0), cB, voffB); PG8_STAGE(PG8_SA(0, 0), cA, voffA); PG8_STAGE(PG8_SB(0, 1), cB + hstepB, voffB); PG8_STAGE(PG8_SA(0, 1), cA + hstepA, voffA);
    if (wr == 1) PG8_BAR;
    PG8_WAIT_V(4); PG8_BAR;
    PG8_STAGE(PG8_SB(1, 0), cB + kstep, voffB); PG8_STAGE(PG8_SA(1, 0), cA + kstep, voffA); PG8_STAGE(PG8_SB(1, 1), cB + hstepB + kstep, voffB);
    PG8_WAIT_V(6); PG8_BAR;
    for (;;) {
        const bool has_next = S.next(ui + 1, nxt);
        const char* nA = has_next ? (const char*)g.A + (size_t)nxt.pm * tstepA : cA; const char* nB = has_next ? (const char*)g.Bt + (size_t)nxt.pn * tstepB : cB;
        for (int t = 0; t < nt; t += 2) {
            const bool last = (t == nt - 2);
            const char* a1 = cA + (size_t)(t + 1) * kstep;
            const char* a2 = last ? nA : cA + (size_t)(t + 2) * kstep; const char* b2 = last ? nB : cB + (size_t)(t + 2) * kstep;
            const char* a3 = a2 + kstep; const char* b3 = b2 + kstep;
            PG8_LDB(B0, 0, 0); PG8_SCHED; PG8_LDA(At, 0, 0); PG8_STAGE(PG8_SA(1, 1), a1 + hstepA, voffA);
            PG8_WAIT_L(8); PG8_BAR; PG8_WAIT_L(0); PG8_MMA(0, 0, At, B0); PG8_BAR; PG8_SCHED;
            PG8_LDB(B1, 0, 1); PG8_STAGE(PG8_SB(0, 0), b2, voffB);
            PG8_BAR; PG8_WAIT_L(0); PG8_MMA(0, 1, At, B1); PG8_BAR;
            PG8_LDA(At, 0, 1); PG8_STAGE(PG8_SA(0, 0), a2, voffA);
            PG8_BAR; PG8_WAIT_L(0); PG8_MMA(1, 0, At, B0); PG8_BAR; PG8_SCHED;
            PG8_STAGE(PG8_SB(0, 1), b2 + hstepB, voffB);
            PG8_WAIT_V(6); PG8_BAR; PG8_MMA(1, 1, At, B1); PG8_BAR;
            PG8_LDB(B0, 1, 0); PG8_SCHED; PG8_LDA(At, 1, 0); PG8_STAGE(PG8_SA(0, 1), a2 + hstepA, voffA);
            PG8_WAIT_L(8); PG8_BAR; PG8_WAIT_L(0); PG8_MMA(0, 0, At, B0); PG8_BAR; PG8_SCHED;
            PG8_LDB(B1, 1, 1); PG8_STAGE(PG8_SB(1, 0), b3, voffB);
            PG8_BAR; PG8_WAIT_L(0); PG8_MMA(0, 1, At, B1); PG8_BAR;
            PG8_LDA(At, 1, 1); PG8_STAGE(PG8_SA(1, 0), a3, voffA);
            PG8_BAR; PG8_WAIT_L(0); PG8_MMA(1, 0, At, B0); PG8_BAR; PG8_SCHED;
            PG8_STAGE(PG8_SB(1, 1), b3 + hstepB, voffB);
            PG8_WAIT_V(6); PG8_BAR; PG8_MMA(1, 1, At, B1); PG8_BAR;
        }
        E(acc, cur, wr, wc, fr, fq);
        if (!has_next) break;
#pragma unroll
        for (int a = 0; a < 2; ++a)
#pragma unroll
            for (int b = 0; b < 2; ++b)
#pragma unroll
                for (int m = 0; m < 4; ++m)
#pragma unroll
                    for (int n = 0; n < 2; ++n) acc[a][b][m][n] = (f32x4){0.f, 0.f, 0.f, 0.f};
        cur = nxt; cA = nA; cB = nB; ++ui;
    }
    PG8_WAIT_V(0);
    if (wr == 0) PG8_BAR;
    PG8_BAR;
#undef PG8_SA
#undef PG8_SB
#undef PG8_STAGE
#undef PG8_LDA
#undef PG8_LDB
#undef PG8_MMA
#undef PG8_WAIT_V
#undef PG8_WAIT_L
#undef PG8_BAR
#undef PG8_SCHED
}
}
#define XB_TMO      128
#define XB_XCNT(j)  (256  + 64 * (j))
#define XB_XSUB(j)  (1280 + 64 * (j))
#define XB_XGEN(j)  (2304 + 64 * (j))
#define XB_TOP      3328
#define XB_TOPGEN   3392
#define XCD_BAR_WORDS 3456
#define XB_SPIN_CAP (1u << 18)

__device__ __forceinline__ unsigned xb_ld(unsigned* p)              { return __hip_atomic_load(p, __ATOMIC_RELAXED, __HIP_MEMORY_SCOPE_AGENT); }
__device__ __forceinline__ unsigned xb_add(unsigned* p, unsigned v) { return __hip_atomic_fetch_add(p, v, __ATOMIC_RELAXED, __HIP_MEMORY_SCOPE_AGENT); }
__device__ __forceinline__ unsigned xb_xcc_id() { return (unsigned)__builtin_amdgcn_s_getreg((3 << 11) | 20) & 0xFu; }
#define XB_SPIN(cond, bar) do { unsigned _sp = 0; while (cond) { __builtin_amdgcn_s_sleep(1); \
    if ((++_sp & 255u) == 0u) { if (xb_ld(&(bar)[XB_TMO])) break; if (_sp > XB_SPIN_CAP) { atomicAdd(&(bar)[XB_TMO], 1u); break; } } } } while (0)

struct XcdBarrier {
    unsigned* bar; unsigned x;
    volatile LAS unsigned* st;
};

__device__ __forceinline__ XcdBarrier xcd_barrier_post(unsigned* bar, volatile LAS unsigned* st) {
    XcdBarrier b; b.bar = bar; b.x = xb_xcc_id(); b.st = st;
    if (threadIdx.x == 0) (void)xb_add(&bar[XB_XCNT(b.x)], 1u);
    return b;
}
__device__ __forceinline__ void xcd_barrier_complete(unsigned* bar, unsigned x, unsigned& nloc, unsigned& nx) {
    const unsigned G = gridDim.x * gridDim.y * gridDim.z;
    unsigned sum, cnt, mine, sp = 0u;
    for (;;) {
        sum = 0u; cnt = 0u; mine = 0u;
#pragma unroll
        for (unsigned j = 0; j < 16; ++j) { const unsigned c = xb_ld(&bar[XB_XCNT(j)]); sum += c; cnt += (c > 0u) ? 1u : 0u; mine = (j == x) ? c : mine; }
        if (sum == G) break;
        __builtin_amdgcn_s_sleep(1);
        if ((++sp & 255u) == 0u) { if (xb_ld(&bar[XB_TMO])) break; if (sp > XB_SPIN_CAP) { atomicAdd(&bar[XB_TMO], 1u); break; } }
    }
    nloc = mine > 0u ? mine : 1u; nx = cnt > 0u ? cnt : 1u;
}

__device__ __forceinline__ void xcd_barrier(const XcdBarrier& b) {
    asm volatile("s_waitcnt vmcnt(0)" ::: "memory");
    __syncthreads();
    if (threadIdx.x == 0) {
        unsigned* bar = b.bar;
        __builtin_amdgcn_s_waitcnt(0);
        unsigned nloc = b.st[0], nx = b.st[1];
        if (nloc == 0u) { xcd_barrier_complete(bar, b.x, nloc, nx); b.st[0] = nloc; b.st[1] = nx; }
        const unsigned old = xb_add(&bar[XB_XSUB(b.x)], 1u);
        const unsigned gen = old / nloc;
        if (old + 1u == (gen + 1u) * nloc) {
            __builtin_amdgcn_fence(__ATOMIC_RELEASE, "agent");
            asm volatile("s_waitcnt vmcnt(0)" ::: "memory");
            const unsigned og = xb_add(&bar[XB_TOP], 1u);
            const unsigned tg = og / nx;
            if (og + 1u == (tg + 1u) * nx) xb_add(&bar[XB_TOPGEN], 1u);
            else XB_SPIN(xb_ld(&bar[XB_TOPGEN]) == tg, bar);
            __builtin_amdgcn_fence(__ATOMIC_ACQUIRE, "agent");
            xb_add(&bar[XB_XGEN(b.x)], 1u);
            asm volatile("s_waitcnt vmcnt(0)" ::: "memory");
        } else {
            XB_SPIN(xb_ld(&bar[XB_XGEN(b.x)]) == gen, bar);
            __builtin_amdgcn_fence(__ATOMIC_ACQUIRE, "agent");
            asm volatile("s_waitcnt vmcnt(0)" ::: "memory");
        }
    }
    __syncthreads();
}


namespace att {
constexpr int NW = 8, QBLK = 32, KVBLK = 64, QB = NW * QBLK;
constexpr int DQ = 192, DV = 128;
constexpr int QS = NQ, KVS = NKV, KRS = 64, OS = 4096, ZS = N0P;
constexpr int SHM_V = KVBLK * DV * 2, SHM_K = KVBLK * DQ * 2;
constexpr int QR_OFF = 2 * SHM_V + 2 * SHM_K + NW * 64 * 4;
constexpr int LDS_BYTES = QR_OFF + NW * 4096;
constexpr float SCALE = 0.07216878364870322f;
constexpr float THR = 8.f;
constexpr unsigned WBIG = 0x40000000u;

#define KSWZ(row, colB) ((row) * 384 + ((colB) ^ (((row) & 7) << 4)))
#define SBAR() __builtin_amdgcn_sched_barrier(0)
__device__ __forceinline__ int v_st(int k, int c) { const int kk = (k & ~0xC) | ((k & 4) << 1) | ((k & 8) >> 1); return ((kk >> 3) * 4 + (c >> 5)) * 512 + ((kk & 7) * 32 + (c & 31)) * 2; }
__device__ __forceinline__ int v_rd_base(int lane) { return ((lane & 3) << 3) | (((lane >> 2) & 3) << 6) | (((lane >> 4) & 1) << 5) | (((lane >> 5) & 1) << 8); }
constexpr int v_rd_off(int d0, int ks, int half) { return d0 * 512 + ks * 4096 + half * 2048; }
__device__ __forceinline__ int crow(int r, int hi) { return (r & 3) + 8 * (r >> 2) + 4 * hi; }
__device__ __forceinline__ bf16x8 load8(const bf16_t* p) { return *reinterpret_cast<const bf16x8*>(p); }

__device__ __forceinline__ void mask_tile(f32x16& p0, f32x16& p1, int dq) {
    const float NEG = -__builtin_inff();
#pragma unroll
    for (int r = 0; r < 16; ++r) {
        const int c = (r & 3) + 8 * (r >> 2);
        if ((unsigned)(dq - c) >= WBIG) p0[r] = NEG;
        if ((unsigned)(dq - c - 32) >= WBIG) p1[r] = NEG;
    }
}
__device__ __forceinline__ void partialSM(f32x16& p0, f32x16& p1, float& m_reg, float& mn, float& alpha) {
    float pmax = p0[0];
#pragma unroll
    for (int r = 1; r < 16; ++r) pmax = fmaxf(pmax, p0[r]);
#pragma unroll
    for (int r = 0; r < 16; ++r) pmax = fmaxf(pmax, p1[r]);
    { auto rr = __builtin_amdgcn_permlane32_swap(__float_as_uint(pmax), __float_as_uint(pmax), false, false);
      pmax = fmaxf(__uint_as_float(rr[0]), __uint_as_float(rr[1])); }
    constexpr float C2 = 1.4426950408889634f * SCALE;
    if (__builtin_expect(__all((pmax - m_reg) * SCALE <= THR), 1)) { mn = m_reg; alpha = 1.f; }
    else { mn = fmaxf(m_reg, pmax); alpha = __builtin_amdgcn_exp2f((m_reg - mn) * C2); m_reg = mn; }
    const float mnL = -mn * C2;
#pragma unroll
    for (int r = 0; r < 16; ++r) p0[r] = fmaf(p0[r], C2, mnL);
#pragma unroll
    for (int r = 0; r < 16; ++r) p1[r] = fmaf(p1[r], C2, mnL);
#pragma unroll
    for (int r = 0; r < 16; ++r) p0[r] = __builtin_amdgcn_exp2f(p0[r]);
}
__device__ __forceinline__ void finishSM(f32x16& p0, f32x16& p1, float alpha, float& l_reg, bf16x8& pa0, bf16x8& pa1, bf16x8& pa2, bf16x8& pa3) {
#pragma unroll
    for (int r = 0; r < 16; ++r) p1[r] = __builtin_amdgcn_exp2f(p1[r]);
    float ps = 0;
#pragma unroll
    for (int r = 0; r < 16; ++r) ps += p0[r];
#pragma unroll
    for (int r = 0; r < 16; ++r) ps += p1[r];
    { auto rr = __builtin_amdgcn_permlane32_swap(__float_as_uint(ps), __float_as_uint(ps), false, false);
      ps = __uint_as_float(rr[0]) + __uint_as_float(rr[1]); }
    l_reg = l_reg * alpha + ps;
#define PK4(P, B_, OUT) do { unsigned a0 = cvtpk(P[B_+0], P[B_+1]), a1 = cvtpk(P[B_+2], P[B_+3]);                          \
        unsigned b0 = cvtpk(P[B_+4], P[B_+5]), b1 = cvtpk(P[B_+6], P[B_+7]);                                             \
        auto r0 = __builtin_amdgcn_permlane32_swap(a0, b0, false, false); auto r1 = __builtin_amdgcn_permlane32_swap(a1, b1, false, false); \
        u32x4 w = {r0[0], r1[0], r0[1], r1[1]}; OUT = *reinterpret_cast<bf16x8*>(&w); } while (0)
    PK4(p0, 0, pa0); PK4(p0, 8, pa1); PK4(p1, 0, pa2); PK4(p1, 8, pa3);
#undef PK4
}
template <int KB>
__device__ __forceinline__ void qkt(f32x16& p0, f32x16& p1, const char* K_lds, int r32, int hi, const bf16x8* qr, const char* qrl) {
    p0 = f32x16{}; p1 = f32x16{};
    const char* kb[4];
#pragma unroll
    for (int dd = 0; dd < 4; ++dd) kb[dd] = K_lds + KB * SHM_K + KSWZ(r32, (dd * 16 + hi * 8) * 2);
#pragma unroll
    for (int d0 = 0; d0 < 12; ++d0) { const char* a = kb[d0 & 3] + (d0 >> 2) * 128;
        bf16x8 b0 = *reinterpret_cast<const bf16x8*>(a);
        bf16x8 b1 = *reinterpret_cast<const bf16x8*>(a + 32 * 384);
        bf16x8 qf; if (d0 < 8) qf = qr[d0]; else qf = *reinterpret_cast<const bf16x8*>(qrl + (d0 - 8) * 1024);
        p0 = __builtin_amdgcn_mfma_f32_32x32x16_bf16(b0, qf, p0, 0, 0, 0);
        p1 = __builtin_amdgcn_mfma_f32_32x32x16_bf16(b1, qf, p1, 0, 0, 0);
    }
}
template <int VB>
__device__ __forceinline__ void pv_tile(f32x16* o, int vb0, bf16x8 pa0, bf16x8 pa1, bf16x8 pa2, bf16x8 pa3) {
#define TRRD(dst, off) asm volatile("ds_read_b64_tr_b16 %0, %1 offset:%2" : "=&v"(dst) : "v"(vb0), "i"(off) : "memory")
#define PV_D0(d0) do { s16x4 l0, l1, l2, l3, h0, h1, h2, h3; constexpr int b_ = VB * SHM_V + v_rd_off(d0, 0, 0); \
        TRRD(l0, b_); TRRD(h0, b_ + 2048); TRRD(l1, b_ + 4096); TRRD(h1, b_ + 6144); TRRD(l2, b_ + 8192); TRRD(h2, b_ + 10240); TRRD(l3, b_ + 12288); TRRD(h3, b_ + 14336); \
        asm volatile("s_waitcnt lgkmcnt(0)" ::: "memory"); SBAR();   \
        o[d0] = __builtin_amdgcn_mfma_f32_32x32x16_bf16(pa0, (bf16x8){l0[0], l0[1], l0[2], l0[3], h0[0], h0[1], h0[2], h0[3]}, o[d0], 0, 0, 0);   \
        o[d0] = __builtin_amdgcn_mfma_f32_32x32x16_bf16(pa1, (bf16x8){l1[0], l1[1], l1[2], l1[3], h1[0], h1[1], h1[2], h1[3]}, o[d0], 0, 0, 0);   \
        o[d0] = __builtin_amdgcn_mfma_f32_32x32x16_bf16(pa2, (bf16x8){l2[0], l2[1], l2[2], l2[3], h2[0], h2[1], h2[2], h2[3]}, o[d0], 0, 0, 0);   \
        o[d0] = __builtin_amdgcn_mfma_f32_32x32x16_bf16(pa3, (bf16x8){l3[0], l3[1], l3[2], l3[3], h3[0], h3[1], h3[2], h3[3]}, o[d0], 0, 0, 0); } while (0)
    PV_D0(0); PV_D0(1); PV_D0(2); PV_D0(3);
#undef PV_D0
#undef TRRD
}

struct BlockRef { const bf16_t* Q; const bf16_t* K; const bf16_t* KR; const bf16_t* V; bf16_t* O; const bf16_t* Z; const float* CS; const float* SN; int P0; };
struct Stage { bf16x8 st_v0, st_v1, st_k0, st_k1, st_kr; };
#define VMW() asm volatile("s_waitcnt vmcnt(0)" ::: "memory")
#define SLOAD_H(R, k0) do { const char* kt_ = (const char*)(R).K + (size_t)(k0) * (KVS * 2); const char* kt2_ = kt_ + 32 * KVS * 2; const char* krt_ = (const char*)(R).KR + (size_t)(k0) * (KRS * 2); \
                            S.st_v0 = *(const bf16x8*)(kt_ + koff + 256); S.st_v1 = *(const bf16x8*)(kt2_ + koff + 256);  \
                            S.st_k0 = *(const bf16x8*)(kt_ + koff); S.st_k1 = *(const bf16x8*)(kt2_ + koff);  \
                            S.st_kr = *(const bf16x8*)(krt_ + kroff); } while (0)
#define SWRITE_HK(bf) do { *(bf16x8*)(K_lds + (bf) * SHM_K + kws) = S.st_k0; *(bf16x8*)(K_lds + (bf) * SHM_K + kws + 32 * 384) = S.st_k1; \
                           *(bf16x8*)(K_lds + (bf) * SHM_K + kwr) = S.st_kr; } while (0)
#define SWRITE_HV(bf) do { *(bf16x8*)(V_lds + (bf) * SHM_V + vst0) = S.st_v0; *(bf16x8*)(V_lds + (bf) * SHM_V + vst1) = S.st_v1; } while (0)
#define SWRITE_H(bf) do { SWRITE_HV(bf); SWRITE_HK(bf); } while (0)

__device__ __forceinline__ void rope_q(const BlockRef& cur, const bf16x8* qrp, char* qrl, int wid, int r32, int hi) {
    const int row = wid * QBLK + r32;
    const unsigned toff = (unsigned)((row * 32 + hi * 8) * 4);
    const float* cp = (const float*)((const char*)cur.CS + toff); const float* sp = (const float*)((const char*)cur.SN + toff);
#pragma unroll
    for (int pr = 0; pr < 2; ++pr) {
        const f32x4 c0 = *(const f32x4*)(cp + pr * 16), c1 = *(const f32x4*)(cp + pr * 16 + 4), s0 = *(const f32x4*)(sp + pr * 16), s1 = *(const f32x4*)(sp + pr * 16 + 4);
        const bf16x8 a = qrp[pr], b = qrp[2 + pr];
        f32x4 o1l, o1h, o2l, o2h;
#pragma unroll
        for (int j = 0; j < 4; ++j) {
            float t1 = bf2f((unsigned short)a[j]), t2 = bf2f((unsigned short)b[j]);
            o1l[j] = t1 * c0[j] - t2 * s0[j]; o2l[j] = t2 * c0[j] + t1 * s0[j];
            t1 = bf2f((unsigned short)a[4 + j]); t2 = bf2f((unsigned short)b[4 + j]);
            o1h[j] = t1 * c1[j] - t2 * s1[j]; o2h[j] = t2 * c1[j] + t1 * s1[j];
        }
        *(bf16x8*)(qrl + pr * 1024) = pack8(o1l, o1h); *(bf16x8*)(qrl + (2 + pr) * 1024) = pack8(o2l, o2h);
    }
}
__device__ __forceinline__ void causal_block(const BlockRef& cur, char* lds) {
    int tid = threadIdx.x; asm volatile("" : "+v"(tid));
    const int wid = __builtin_amdgcn_readfirstlane(tid >> 6), lane = tid & 63, r32 = lane & 31, hi = lane >> 5;
    const int NT = (cur.P0 + QB - 1) / KVBLK + 1;
    const int qlo = cur.P0 + wid * QBLK, qm = qlo + r32 - 4 * hi;
    char* V_lds = lds; char* K_lds = lds + 2 * SHM_V;
    float* ws = (float*)(lds + 2 * SHM_V + 2 * SHM_K) + wid * 64; float* li_l = ws, * al_l = ws + 32;
    float m_reg = -1e30f, l_reg = 0; f32x16 o[4] = {};
    const int sr = tid >> 4, sc = (tid & 15) * 8, vst0 = v_st(sr, sc), vst1 = v_st(32 + sr, sc), kws = KSWZ(sr, sc * 2);
    const int krr = tid >> 3, krc = (tid & 7) * 8, kwr = KSWZ(krr, (128 + krc) * 2);
    const int vb0 = (int)(uintptr_t)V_lds + v_rd_base(lane);
    unsigned koff = (unsigned)((sr * KVS + sc) * 2), kroff = (unsigned)((krr * KRS + krc) * 2);
    unsigned qoff = (unsigned)(((wid * QBLK + r32) * QS + hi * 8) * 2);
    asm volatile("" : "+v"(koff), "+v"(kroff), "+v"(qoff));
    Stage S; bf16x8 qr[8]; char* qrl = lds + QR_OFF + wid * 4096 + lane * 16;
    { bf16x8 qrp[4];
#pragma unroll
      for (int d0 = 0; d0 < 8; ++d0) qr[d0] = *(const bf16x8*)((const char*)cur.Q + qoff + d0 * 32);
#pragma unroll
      for (int d0 = 0; d0 < 4; ++d0) qrp[d0] = *(const bf16x8*)((const char*)cur.Q + qoff + (8 + d0) * 32);
      SLOAD_H(cur, 0);
      rope_q(cur, qrp, qrl, wid, r32, hi); }
    VMW(); SWRITE_H(0); SBAR();
    SLOAD_H(cur, KVBLK); SBAR();
    __syncthreads();
#define RESC(a) do { if (__any((a) < 1.f)) { if (hi == 0) al_l[r32] = (a); asm volatile("s_waitcnt lgkmcnt(0)" ::: "memory");              \
                     for (int d_ = 0; d_ < 4; ++d_) for (int r = 0; r < 16; ++r) o[d_][r] *= al_l[crow(r, hi)]; } } while (0)
#define KBASE(t) ((t) * KVBLK)
#define ACT(t) (KBASE(t) <= qlo + QBLK - 1)
#define QKT_OR_SKIP(KB_, P0_, P1_, t) do { if (ACT(t)) qkt<KB_>(P0_, P1_, K_lds, r32, hi, qr, qrl); else { const float ninf_ = -__builtin_inff(); _Pragma("unroll") for (int r_ = 0; r_ < 16; ++r_) { P0_[r_] = ninf_; P1_[r_] = ninf_; } } } while (0)
#define MASKT(P0_, P1_, t) do { const int kb_ = KBASE(t); if (kb_ + KVBLK - 1 > qlo) mask_tile(P0_, P1_, qm - kb_); } while (0)
    f32x16 pA0, pA1, pB0, pB1; float mnA, mnB, alA, alB; bf16x8 pa0, pa1, pa2, pa3;
    qkt<0>(pA0, pA1, K_lds, r32, hi, qr, qrl);
    MASKT(pA0, pA1, 0); partialSM(pA0, pA1, m_reg, mnA, alA);
    VMW(); SWRITE_H(1);
    __syncthreads();
#define HALF_STEP(PX0, PX1, mnX, alX, PY0, PY1, alY, t, KB, VB, SB) do {                                                      \
        SBAR(); QKT_OR_SKIP(KB, PX0, PX1, (t));                                                                               \
        finishSM(PY0, PY1, alY, l_reg, pa0, pa1, pa2, pa3); SBAR();                                                           \
        if ((t) + 1 < NT) { SLOAD_H(cur, KBASE((t) + 1)); SBAR(); }                                                           \
        if (ACT((t) - 1)) pv_tile<VB>(o, vb0, pa0, pa1, pa2, pa3); MASKT(PX0, PX1, (t)); partialSM(PX0, PX1, m_reg, mnX, alX); \
        __syncthreads();                                                                                                      \
        if ((t) + 1 < NT) { VMW(); SWRITE_H(SB); }                                                                            \
        RESC(alX); __syncthreads(); } while (0)
    for (int t = 1; t + 1 < NT; t += 2) {
        HALF_STEP(pB0, pB1, mnB, alB, pA0, pA1, alA, t, 1, 0, 0);
        HALF_STEP(pA0, pA1, mnA, alA, pB0, pB1, alB, t + 1, 0, 1, 1);
    }
    SBAR(); QKT_OR_SKIP(1, pB0, pB1, NT - 1); SBAR();
    finishSM(pA0, pA1, alA, l_reg, pa0, pa1, pa2, pa3); SBAR();
    if (ACT(NT - 2)) pv_tile<0>(o, vb0, pa0, pa1, pa2, pa3);
    MASKT(pB0, pB1, NT - 1); partialSM(pB0, pB1, m_reg, mnB, alB); __syncthreads(); RESC(alB);
    finishSM(pB0, pB1, alB, l_reg, pa0, pa1, pa2, pa3); SBAR(); if (ACT(NT - 1)) pv_tile<1>(o, vb0, pa0, pa1, pa2, pa3);
    SBAR();
    if (hi == 0) li_l[r32] = l_reg;
    __syncthreads();
    {
        char* ot = lds + wid * (32 * 272);
        const int wb = 4 * hi * 272 + r32 * 2;
#pragma unroll
        for (int rg = 0; rg < 4; ++rg) {
            const f32x4 lv = *(const f32x4*)(li_l + 8 * rg + 4 * hi);
#pragma unroll
            for (int j = 0; j < 4; ++j) { const int r = rg * 4 + j; const float rl = __builtin_amdgcn_rcpf(lv[j]);
#pragma unroll
                for (int d0 = 0; d0 < 4; ++d0) *(bf16_t*)(ot + wb + (j + 8 * rg) * 272 + d0 * 64) = f2bf(o[d0][r] * rl); }
        }
        asm volatile("s_waitcnt lgkmcnt(0)" ::: "memory");
        const int rr = lane >> 4, c8 = (lane & 15) * 8;
        const unsigned zoff = (unsigned)(((wid * QBLK + rr) * ZS + c8) * 2), ooff = (unsigned)(((wid * QBLK + rr) * OS + c8) * 2);
#pragma unroll
        for (int i = 0; i < 8; ++i) {
            const bf16x8 ov = *(const bf16x8*)(ot + (i * 4 + rr) * 272 + c8 * 2);
            const bf16x8 zv = *(const bf16x8*)((const char*)cur.Z + (size_t)(i * 4 * ZS * 2) + zoff);
            f32x4 a, b;
#pragma unroll
            for (int j = 0; j < 4; ++j) { a[j] = bf2f((unsigned short)ov[j]) * bf2f((unsigned short)zv[j]); b[j] = bf2f((unsigned short)ov[4 + j]) * bf2f((unsigned short)zv[4 + j]); }
            *(bf16x8*)((char*)cur.O + (size_t)(i * 4 * OS * 2) + ooff) = pack8(a, b);
        }
    }
    __syncthreads();
#undef RESC
#undef KBASE
#undef ACT
#undef QKT_OR_SKIP
#undef MASKT
#undef HALF_STEP
}
#undef VMW
#undef SLOAD_H
#undef SWRITE_HK
#undef SWRITE_HV
#undef SWRITE_H

struct Item { int bh, qb0, qb1; };
constexpr int NQB = SEQ / QB, NX = NQB / 2, NBH = 64, TOTAL = NX * NBH;
__device__ __forceinline__ Item decode(int L) {
    Item it; const int xcd = L & 7, k = L >> 3, gi = k / NX, r = k - gi * NX;
    it.bh = gi * 8 + xcd; it.qb0 = r; it.qb1 = NQB - 1 - r; return it;
}
struct Tensors { const bf16_t* q; const bf16_t* kv; const bf16_t* krot; bf16_t* og; const bf16_t* proj0; const float* cs; const float* sn; };
__device__ __forceinline__ BlockRef mkref(const Item& it, int pass, const Tensors& T) {
    const int qb = pass ? it.qb1 : it.qb0, b = it.bh >> 5, h = it.bh & 31;
    const size_t tok0 = (size_t)b * SEQ, row0 = tok0 + (size_t)qb * QB;
    BlockRef r;
    r.Q = T.q + row0 * QS + h * DQ; r.K = T.kv + tok0 * KVS + h * 256; r.V = r.K + 128; r.KR = T.krot + tok0 * KRS;
    r.O = T.og + row0 * OS + h * DV; r.Z = T.proj0 + row0 * ZS + 1600 + h * DV; r.CS = T.cs + row0 * 32; r.SN = T.sn + row0 * 32; r.P0 = qb * QB;
    return r;
}
__device__ __forceinline__ void attn_phase(char* lds, const Tensors& T) {
#ifndef PROBE_ATTDUP
#define PROBE_ATTDUP 0
#endif
    for (int i = 0; ; ++i) {
        const int L = blockIdx.x + (i >> PROBE_ATTDUP) * gridDim.x; if (L >= TOTAL) break;
        const Item it = decode(L);
#pragma unroll 1
        for (int pass = 0; pass < 2; ++pass) { const BlockRef cur = mkref(it, pass, T); causal_block(cur, lds); }
    }
}
}
__device__ __forceinline__ void wt_phase(const float* __restrict__ W, int K, int N, const float* __restrict__ scale, bf16_t* __restrict__ out, char* lds) {
    int tid = threadIdx.x; asm volatile("" : "+v"(tid));
    const int lane = tid & 63, wv = tid >> 6, gw = blockIdx.x * 8 + wv, nw = gridDim.x * 8;
    char* img = lds + wv * 8192;
    const int kr = lane >> 4, nq = lane & 15, ntn = N / 64, ntiles = ntn * (K / 64);
    for (int t = gw; t < ntiles; t += nw) {
        const int kb = (t / ntn) * 64, nb = (t % ntn) * 64;
        const float* src = W + (size_t)(kb + kr * 16) * N + nb + nq * 4;
        f32x4 v[16];
#pragma unroll
        for (int i = 0; i < 16; ++i) v[i] = *(const f32x4*)(src + (size_t)i * N);
        if (scale) {
            const float* sp = scale + kb + kr * 16;
#pragma unroll
            for (int i = 0; i < 16; i += 4) { const f32x4 sc = *(const f32x4*)(sp + i); v[i] *= sc[0]; v[i + 1] *= sc[1]; v[i + 2] *= sc[2]; v[i + 3] *= sc[3]; }
        }
#pragma unroll
        for (int j = 0; j < 4; ++j) {
            const int n = nq * 4 + j;
#pragma unroll
            for (int hf = 0; hf < 2; ++hf) {
                const f32x4 a = {v[hf * 8 + 0][j], v[hf * 8 + 1][j], v[hf * 8 + 2][j], v[hf * 8 + 3][j]}, b = {v[hf * 8 + 4][j], v[hf * 8 + 5][j], v[hf * 8 + 6][j], v[hf * 8 + 7][j]};
                *(bf16x8*)(img + n * 128 + (((kr * 2 + hf) ^ (nq & 7)) * 16)) = pack8(a, b);
            }
        }
#pragma unroll
        for (int i = 0; i < 8; ++i) {
            const int n = i * 8 + (lane >> 3), kc = lane & 7;
            const bf16x8 r = *(const bf16x8*)(img + n * 128 + ((kc ^ ((n >> 2) & 7)) * 16));
            *(bf16x8*)(out + (size_t)(nb + n) * K + kb + kc * 8) = r;
        }
    }
}
__device__ __forceinline__ void cast_rstd_phase(const float* __restrict__ src, bf16_t* __restrict__ dst, float* __restrict__ rstd) {
    const int lane = threadIdx.x & 63, gw = blockIdx.x * 8 + (threadIdx.x >> 6), nw = gridDim.x * 8;
    for (int row = gw; row < T_TOK; row += nw) {
        const float* s = src + (size_t)row * DM; bf16_t* d = dst + (size_t)row * DM; float ss = 0.f;
#pragma unroll
        for (int i = 0; i < 8; ++i) { const int c = (i * 64 + lane) * 8; const f32x4 a = *(const f32x4*)(s + c), b = *(const f32x4*)(s + c + 4);
            ss += a[0] * a[0] + a[1] * a[1] + a[2] * a[2] + a[3] * a[3] + b[0] * b[0] + b[1] * b[1] + b[2] * b[2] + b[3] * b[3];
            *(bf16x8*)(d + c) = pack8(a, b); }
        ss = wave_sum(ss);
        if (lane == 0) rstd[row] = 1.0f / sqrtf(ss * (1.0f / DM) + EPS);
    }
}
__device__ __forceinline__ void final_norm_phase(const float* __restrict__ src, size_t lds_, float* __restrict__ dst, const float* __restrict__ w) {
    const int lane = threadIdx.x & 63, gw = blockIdx.x * 8 + (threadIdx.x >> 6), nw = gridDim.x * 8;
    for (int row = gw; row < T_TOK; row += nw) {
        const float* s = src + (size_t)row * lds_; float* d = dst + (size_t)row * DM; f32x4 v[16]; float ss = 0.f;
#pragma unroll
        for (int i = 0; i < 16; ++i) { v[i] = *(const f32x4*)(s + (i * 64 + lane) * 4); ss += v[i][0] * v[i][0] + v[i][1] * v[i][1] + v[i][2] * v[i][2] + v[i][3] * v[i][3]; }
        ss = wave_sum(ss);
        const float r = 1.0f / sqrtf(ss * (1.0f / DM) + EPS);
#pragma unroll
        for (int i = 0; i < 16; ++i) { const f32x4 g = *(const f32x4*)(w + (i * 64 + lane) * 4); *(f32x4*)(d + (i * 64 + lane) * 4) = v[i] * r * g; }
    }
}
__device__ __forceinline__ void final_norm_bf16_phase(const bf16_t* __restrict__ src, size_t lds_, const float* __restrict__ ssq, float* __restrict__ dst, const float* __restrict__ w) {
    const int lane = threadIdx.x & 63, gw = blockIdx.x * 8 + (threadIdx.x >> 6), nw = gridDim.x * 8;
    for (int row = gw; row < T_TOK; row += nw) {
        const bf16_t* s = src + (size_t)row * lds_; float* d = dst + (size_t)row * DM;
        const float r = 1.0f / sqrtf(ssq[row] * (1.0f / DM) + EPS);
        bf16x8 v[8];
#pragma unroll
        for (int i = 0; i < 8; ++i) v[i] = *(const bf16x8*)(s + (i * 64 + lane) * 8);
#pragma unroll
        for (int i = 0; i < 8; ++i) { const int c = (i * 64 + lane) * 8; const f32x4 g0 = *(const f32x4*)(w + c), g1 = *(const f32x4*)(w + c + 4); f32x4 a, b;
#pragma unroll
            for (int j = 0; j < 4; ++j) { a[j] = bf2f((unsigned short)v[i][j]) * r * g0[j]; b[j] = bf2f((unsigned short)v[i][4 + j]) * r * g1[j]; }
            *(f32x4*)(d + c) = a; *(f32x4*)(d + c + 4) = b; }
    }
}
__device__ __forceinline__ void tables_phase(const Params& p, float* cs, float* sn, float* lb) {
    const int gt = blockIdx.x * blockDim.x + threadIdx.x, nt = gridDim.x * blockDim.x;
    for (int i = gt; i < T_TOK * 32; i += nt) {
        const int tok = i >> 5, j = i & 31;
        const float ang = (float)p.pos[tok] * p.inv_freq[j];
        const double rev = (double)ang * 0.15915494309189535; const float fr = (float)(rev - rint(rev));
        cs[i] = __builtin_amdgcn_cosf(fr); sn[i] = __builtin_amdgcn_sinf(fr);
    }
    for (int i = gt; i < 4096; i += nt) { const float l0 = p.lower_bounds[i], l1 = p.lower_bounds[4096 + i]; lb[i] = 1.0f / (1.0f + expf(l0 - l1)); }
}
__device__ __forceinline__ void stats_krot_phase(const bf16_t* __restrict__ proj0, float* __restrict__ rq, float* __restrict__ rkv, const float* __restrict__ cs, const float* __restrict__ sn, bf16_t* __restrict__ krot) {
    const int lane = threadIdx.x & 63, gw = blockIdx.x * 8 + (threadIdx.x >> 6), nw = gridDim.x * 8;
    for (int row0 = gw; row0 < T_TOK; row0 += 4 * nw) {
        bf16x8 a[4], b[4], c[4]; float t1[4], t2[4], cc[4], sv[4];
#pragma unroll
        for (int u4 = 0; u4 < 4; ++u4) { const int row = row0 + u4 * nw; const bool ok = row < T_TOK; const bf16_t* s = proj0 + (size_t)(ok ? row : row0) * N0P; const size_t tr = (size_t)(ok ? row : row0) * 32 + (lane & 31);
            a[u4] = *(const bf16x8*)(s + lane * 8); b[u4] = *(const bf16x8*)(s + 512 + lane * 8); c[u4] = *(const bf16x8*)(s + 1024 + lane * 8);
            t1[u4] = bf2f(s[1536 + (lane & 31)]); t2[u4] = bf2f(s[1568 + (lane & 31)]); cc[u4] = cs[tr]; sv[u4] = sn[tr]; }
#pragma unroll
        for (int u4 = 0; u4 < 4; ++u4) { const int row = row0 + u4 * nw; if (row >= T_TOK) continue;
            float sq = 0.f, sk = 0.f;
#pragma unroll
            for (int j = 0; j < 8; ++j) { const float x = bf2f((unsigned short)a[u4][j]), y = bf2f((unsigned short)b[u4][j]), z = bf2f((unsigned short)c[u4][j]); sq += x * x + y * y; sk += z * z; }
            sq = wave_sum(sq); sk = wave_sum(sk);
            if (lane == 0) { rq[row] = 1.0f / sqrtf(sq * (1.0f / 1024.0f) + EPS); rkv[row] = 1.0f / sqrtf(sk * (1.0f / 512.0f) + EPS); }
            if (lane < 32) { krot[(size_t)row * 64 + lane] = f2bf(t1[u4] * cc[u4] - t2[u4] * sv[u4]); krot[(size_t)row * 64 + 32 + lane] = f2bf(t2[u4] * cc[u4] + t1[u4] * sv[u4]); } }
    }
}
__device__ __forceinline__ void headnorm_phase(bf16_t* __restrict__ proj1, const bf16_t* __restrict__ oraw, const float* __restrict__ gn) {
    int tid = threadIdx.x; asm volatile("" : "+v"(tid));
    const int per = T_TOK / gridDim.x;
    const int h = tid >> 4, vs = (tid & 15) >> 2, c8 = (tid & 3) * 8;
    const int v0 = (tid & 15) * 8; const f32x4 g0 = *(const f32x4*)(gn + v0), g1 = *(const f32x4*)(gn + v0 + 4);
    for (int tok0 = blockIdx.x * per; tok0 < (blockIdx.x + 1) * per; tok0 += 4) {
        bf16x8 o[4], z[4];
#pragma unroll
        for (int u = 0; u < 4; ++u) { const int tok = tok0 + u, b = tok >> 13, sq = tok & (SEQ - 1);
            o[u] = *(const bf16x8*)(oraw + ((size_t)((b * 32 + h) * 4 + vs) * SEQ + sq) * 32 + c8); z[u] = *(const bf16x8*)(proj1 + (size_t)tok * N1 + 12288 + tid * 8); }
#pragma unroll
        for (int u = 0; u < 4; ++u) {
            float f[8], ss = 0.f;
#pragma unroll
            for (int j = 0; j < 8; ++j) { f[j] = bf2f((unsigned short)o[u][j]); ss += f[j] * f[j]; }
            ss += __shfl_xor(ss, 1); ss += __shfl_xor(ss, 2); ss += __shfl_xor(ss, 4); ss += __shfl_xor(ss, 8);
            const float r = 1.0f / sqrtf(ss * (1.0f / 128.0f) + EPS);
            f32x4 a, bb;
#pragma unroll
            for (int j = 0; j < 4; ++j) { a[j] = f[j] * r * g0[j] * bf2f((unsigned short)z[u][j]); bb[j] = f[4 + j] * r * g1[j] * bf2f((unsigned short)z[u][4 + j]); }
            *(bf16x8*)(proj1 + (size_t)(tok0 + u) * N1 + 8192 + tid * 8) = pack8(a, bb);
        }
    }
}

namespace hg {
constexpr int QT_S = 272, KD_S = 144;
constexpr int OFF_QT = 0, OFF_KT = OFF_QT + 64 * QT_S, OFF_QB = OFF_KT + 64 * QT_S, OFF_KD = OFF_QB + 64 * QT_S;
constexpr int OFF_VT = OFF_KD + 128 * KD_S, OFF_ST = OFF_VT + 32 * KD_S, OFF_ATT = OFF_ST + 32 * QT_S;
constexpr int OFF_SEG = OFF_ATT + 64 * KD_S, OFF_G32 = OFF_SEG + 2048, OFF_DEC = OFF_G32 + 512, LDS_BYTES = OFF_DEC + 512;
__device__ __forceinline__ int crow(int r, int hi) { return (r & 3) + 8 * (r >> 2) + 4 * hi; }

__device__ __forceinline__ void hgrn2_phase(char* lds, const bf16_t* __restrict__ proj1, bf16_t* __restrict__ oraw) {
    int tid = threadIdx.x; asm volatile("" : "+v"(tid));
    const int wid = __builtin_amdgcn_readfirstlane(tid >> 6), lane = tid & 63, r32 = lane & 31, hi = lane >> 5;
    const int kch = tid & 127, seg = tid >> 7;
    float* segtot = (float*)(lds + OFF_SEG); float* g32s = (float*)(lds + OFF_G32); float* decay = (float*)(lds + OFF_DEC);
    for (int item = blockIdx.x; item < 256; item += gridDim.x) {
        const int vs = item & 3, bh = item >> 2, b = bh >> 5, h = bh & 31;
        const bf16_t* base = proj1 + (size_t)b * SEQ * N1; bf16_t* ob = oraw + (size_t)item * SEQ * 32;
        const int qcol = h * 128 + kch, gcol = 4096 + h * 128 + kch, vcol = 8192 + h * 128 + vs * 32;
        f32x16 sacc = {};
        for (int i = tid; i < 32 * QT_S / 4; i += 512) ((unsigned*)(lds + OFF_ST))[i] = 0u;
        unsigned short graw[16], qraw[16]; u32x2 vraw;
        { const bf16_t* rp = base + (size_t)(seg * 16) * N1;
#pragma unroll
          for (int i = 0; i < 16; ++i) { graw[i] = rp[(size_t)i * N1 + gcol]; qraw[i] = rp[(size_t)i * N1 + qcol]; }
          vraw = *(const u32x2*)(base + (size_t)(tid >> 3) * N1 + vcol + (tid & 7) * 4); }
        for (int ch = 0; ch < 128; ++ch) {
            const int tok0 = ch * 64;
            float gl[16]; float cum = 0.f;
#pragma unroll
            for (int i = 0; i < 16; ++i) { cum += bf2f(graw[i]); gl[i] = cum; }
            segtot[seg * 128 + kch] = cum; if (seg == 2) g32s[kch] = bf2f(graw[0]);
            __syncthreads();
            { const float s0 = segtot[kch], s1 = segtot[128 + kch], s2 = segtot[256 + kch], s3 = segtot[384 + kch];
              const float off = (seg > 0 ? s0 : 0.f) + (seg > 1 ? s1 : 0.f) + (seg > 2 ? s2 : 0.f);
              const float tot = (s0 + s1) + (s2 + s3), bref = s0 + s1 + g32s[kch];
              if (seg == 0) decay[kch] = fast_exp(tot);
              float kd[16];
#pragma unroll
              for (int i = 0; i < 16; ++i) { const int t = seg * 16 + i; const float bb = off + gl[i], gv = bf2f(graw[i]), qv = bf2f(qraw[i]); const float kk = 1.0f - fast_exp(gv);
                  *(bf16_t*)(lds + OFF_QT + t * QT_S + kch * 2) = f2bf_n(qv * fast_exp(bb - bref));
                  *(bf16_t*)(lds + OFF_KT + t * QT_S + kch * 2) = f2bf_n(kk * fast_exp(bref - bb));
                  *(bf16_t*)(lds + OFF_QB + t * QT_S + kch * 2) = f2bf_n(qv * fast_exp(bb));
                  kd[i] = kk * fast_exp(tot - bb); }
              *(bf16x8*)(lds + OFF_KD + kch * KD_S + seg * 32) = pack8((f32x4){kd[0], kd[1], kd[2], kd[3]}, (f32x4){kd[4], kd[5], kd[6], kd[7]});
              *(bf16x8*)(lds + OFF_KD + kch * KD_S + seg * 32 + 16) = pack8((f32x4){kd[8], kd[9], kd[10], kd[11]}, (f32x4){kd[12], kd[13], kd[14], kd[15]});
              { const int t = tid >> 3, v4 = (tid & 7) * 4;
                *(bf16_t*)(lds + OFF_VT + (v4 + 0) * KD_S + t * 2) = (bf16_t)(vraw.x & 0xffffu); *(bf16_t*)(lds + OFF_VT + (v4 + 1) * KD_S + t * 2) = (bf16_t)(vraw.x >> 16);
                *(bf16_t*)(lds + OFF_VT + (v4 + 2) * KD_S + t * 2) = (bf16_t)(vraw.y & 0xffffu); *(bf16_t*)(lds + OFF_VT + (v4 + 3) * KD_S + t * 2) = (bf16_t)(vraw.y >> 16); }
            }
            if (ch + 1 < 128) { const bf16_t* rp = base + (size_t)(tok0 + 64 + seg * 16) * N1;
#pragma unroll
                for (int i = 0; i < 16; ++i) { graw[i] = rp[(size_t)i * N1 + gcol]; qraw[i] = rp[(size_t)i * N1 + qcol]; }
                vraw = *(const u32x2*)(base + (size_t)(tok0 + 64 + (tid >> 3)) * N1 + vcol + (tid & 7) * 4); }
            __syncthreads();
            f32x16 oacc = {};
            if (wid < 4) {
                const int ci = wid >> 1, si = wid & 1;
                if (!(ci == 0 && si == 1)) {
                    f32x16 aacc = {};
#pragma unroll
                    for (int kk = 0; kk < 8; ++kk) {
                        const bf16x8 af = *(const bf16x8*)(lds + OFF_QT + (32 * ci + r32) * QT_S + kk * 32 + hi * 16);
                        const bf16x8 bfr = *(const bf16x8*)(lds + OFF_KT + (32 * si + r32) * QT_S + kk * 32 + hi * 16);
                        aacc = __builtin_amdgcn_mfma_f32_32x32x16_bf16(af, bfr, aacc, 0, 0, 0); }
#pragma unroll
                    for (int i = 0; i < 16; ++i) { const int c = 32 * ci + crow(i, hi), s = 32 * si + r32; const float v = (c >= s) ? aacc[i] : 0.f;
                        *(bf16_t*)(lds + OFF_ATT + c * KD_S + s * 2) = f2bf_n(v); }
                } else {
#pragma unroll
                    for (int i = 0; i < 16; ++i) { const int c = crow(i, hi), s = 32 + r32; *(bf16_t*)(lds + OFF_ATT + c * KD_S + s * 2) = (bf16_t)0; }
                }
#pragma unroll
                for (int g4 = 0; g4 < 4; ++g4) { const f32x4 d = *(const f32x4*)(decay + 32 * wid + 8 * g4 + 4 * hi);
#pragma unroll
                    for (int j = 0; j < 4; ++j) sacc[g4 * 4 + j] *= d[j]; }
#pragma unroll
                for (int kk = 0; kk < 4; ++kk) {
                    const bf16x8 af = *(const bf16x8*)(lds + OFF_KD + (32 * wid + r32) * KD_S + kk * 32 + hi * 16);
                    const bf16x8 bfr = *(const bf16x8*)(lds + OFF_VT + r32 * KD_S + kk * 32 + hi * 16);
                    sacc = __builtin_amdgcn_mfma_f32_32x32x16_bf16(af, bfr, sacc, 0, 0, 0); }
            } else if (wid < 6) {
                const int ci = wid - 4;
#pragma unroll
                for (int kk = 0; kk < 8; ++kk) {
                    const bf16x8 af = *(const bf16x8*)(lds + OFF_QB + (32 * ci + r32) * QT_S + kk * 32 + hi * 16);
                    const bf16x8 bfr = *(const bf16x8*)(lds + OFF_ST + r32 * QT_S + kk * 32 + hi * 16);
                    oacc = __builtin_amdgcn_mfma_f32_32x32x16_bf16(af, bfr, oacc, 0, 0, 0); }
            }
            __syncthreads();
            if (wid < 4) {
#pragma unroll
                for (int g4 = 0; g4 < 4; ++g4) { u32x2 w; w.x = cvtpk_n(sacc[g4 * 4 + 0], sacc[g4 * 4 + 1]); w.y = cvtpk_n(sacc[g4 * 4 + 2], sacc[g4 * 4 + 3]);
                    *(u32x2*)(lds + OFF_ST + r32 * QT_S + (32 * wid + 8 * g4 + 4 * hi) * 2) = w; }
            } else if (wid < 6) {
                const int ci = wid - 4;
#pragma unroll
                for (int kk = 0; kk < 4; ++kk) {
                    const bf16x8 af = *(const bf16x8*)(lds + OFF_ATT + (32 * ci + r32) * KD_S + kk * 32 + hi * 16);
                    const bf16x8 bfr = *(const bf16x8*)(lds + OFF_VT + r32 * KD_S + kk * 32 + hi * 16);
                    oacc = __builtin_amdgcn_mfma_f32_32x32x16_bf16(af, bfr, oacc, 0, 0, 0); }
#pragma unroll
                for (int i = 0; i < 16; ++i) { const int c = 32 * ci + crow(i, hi); ob[(size_t)(tok0 + c) * 32 + r32] = f2bf_n(oacc[i]); }
            }
        }
        __syncthreads();
    }
}
}
namespace hg2 {
#define LBAR() do { asm volatile("s_waitcnt lgkmcnt(0)" ::: "memory"); __builtin_amdgcn_s_barrier(); asm volatile("" ::: "memory"); } while (0)
constexpr int QT_S = 272, KD_S = 144;
constexpr int OFF_QT = 0, OFF_KT = OFF_QT + 64 * QT_S, OFF_QB = OFF_KT + 64 * QT_S, OFF_KD = OFF_QB + 64 * QT_S;
constexpr int OFF_VT4 = OFF_KD + 128 * KD_S, OFF_ATT = OFF_VT4 + 128 * KD_S;
constexpr int OFF_SEG = OFF_ATT + 64 * KD_S, OFF_G32 = OFF_SEG + 2048, OFF_DEC = OFF_G32 + 512, LDS_BYTES = OFF_DEC + 512;
constexpr int ST_BYTES = 32 * QT_S;
__device__ __forceinline__ int crow(int r, int hi) { return (r & 3) + 8 * (r >> 2) + 4 * hi; }

__device__ __forceinline__ void prepass(char* lds, bf16_t* __restrict__ proj1, char* __restrict__ attbuf, float* __restrict__ decbuf) {
    int tid = threadIdx.x; asm volatile("" : "+v"(tid));
    const int wid = __builtin_amdgcn_readfirstlane(tid >> 6), lane = tid & 63, r32 = lane & 31, hi = lane >> 5;
    const int kch = tid & 127, seg = tid >> 7;
    float* segtot = (float*)(lds + OFF_SEG); float* g32s = (float*)(lds + OFF_G32); float* decay = (float*)(lds + OFF_DEC);
    unsigned short graw[16], qraw[16]; bf16x8 vr0, vr1;
#define PRE_LOAD(it_) do { const int bh_ = (it_) >> 7, ch_ = (it_) & 127, b_ = bh_ >> 5, h_ = bh_ & 31;                                   \
        const bf16_t* bs_ = proj1 + ((size_t)b_ * SEQ + ch_ * 64) * N1; const bf16_t* rp_ = bs_ + (size_t)(seg * 16) * N1 + h_ * 128 + kch; \
        _Pragma("unroll") for (int i = 0; i < 16; ++i) { graw[i] = rp_[(size_t)i * N1 + 4096]; qraw[i] = rp_[(size_t)i * N1]; }                \
        const bf16_t* vp_ = bs_ + (size_t)(tid & 63) * N1 + 8192 + h_ * 128 + (tid >> 6) * 16;                                                \
        vr0 = *(const bf16x8*)vp_; vr1 = *(const bf16x8*)(vp_ + 8); } while (0)
    if (blockIdx.x < 8192) PRE_LOAD(blockIdx.x);
    for (int item = blockIdx.x; item < 8192; item += gridDim.x) {
        const int bh = item >> 7, ch = item & 127, b = bh >> 5, h = bh & 31;
        bf16_t* base = proj1 + ((size_t)b * SEQ + ch * 64) * N1;
        const int qcol = h * 128, gcol = 4096 + h * 128, vcol = 8192 + h * 128;
        float gl[16]; float cum = 0.f;
#pragma unroll
        for (int i = 0; i < 16; ++i) { cum += bf2f(graw[i]); gl[i] = cum; }
        segtot[seg * 128 + kch] = cum; if (seg == 2) g32s[kch] = bf2f(graw[0]);
        LBAR();
        { const float s0 = segtot[kch], s1 = segtot[128 + kch], s2 = segtot[256 + kch], s3 = segtot[384 + kch];
          const float off = (seg > 0 ? s0 : 0.f) + (seg > 1 ? s1 : 0.f) + (seg > 2 ? s2 : 0.f);
          const float tot = (s0 + s1) + (s2 + s3), bref = s0 + s1 + g32s[kch];
          if (seg == 0) decay[kch] = fast_exp(tot);
          float kd[16];
#pragma unroll
          for (int i = 0; i < 16; ++i) { const int t = seg * 16 + i; const float bb = off + gl[i], gv = bf2f(graw[i]), qv = bf2f(qraw[i]); const float kk = 1.0f - fast_exp(gv);
              *(bf16_t*)(lds + OFF_QT + t * QT_S + kch * 2) = f2bf_n(qv * fast_exp(bb - bref));
              *(bf16_t*)(lds + OFF_KT + t * QT_S + kch * 2) = f2bf_n(kk * fast_exp(bref - bb));
              *(bf16_t*)(lds + OFF_QB + t * QT_S + kch * 2) = f2bf_n(qv * fast_exp(bb));
              kd[i] = kk * fast_exp(tot - bb); }
          *(bf16x8*)(lds + OFF_KD + kch * KD_S + seg * 32) = pack8((f32x4){kd[0], kd[1], kd[2], kd[3]}, (f32x4){kd[4], kd[5], kd[6], kd[7]});
          *(bf16x8*)(lds + OFF_KD + kch * KD_S + seg * 32 + 16) = pack8((f32x4){kd[8], kd[9], kd[10], kd[11]}, (f32x4){kd[12], kd[13], kd[14], kd[15]});
          { const int t = tid & 63, v16 = (tid >> 6) * 16;
#pragma unroll
            for (int j = 0; j < 8; ++j) { *(bf16_t*)(lds + OFF_VT4 + (v16 + j) * KD_S + t * 2) = (bf16_t)vr0[j]; *(bf16_t*)(lds + OFF_VT4 + (v16 + 8 + j) * KD_S + t * 2) = (bf16_t)vr1[j]; } }
        }
        if (item + (int)gridDim.x < 8192) PRE_LOAD(item + gridDim.x);
        LBAR();
        const size_t lrow = (size_t)(lane >> 4) * N1 + (lane & 15) * 8;
        if (wid < 4) {
            const int ci = wid >> 1, si = wid & 1;
            if (!(ci == 0 && si == 1)) {
                f32x16 aacc = {};
#pragma unroll
                for (int kk = 0; kk < 8; ++kk) {
                    const bf16x8 af = *(const bf16x8*)(lds + OFF_QT + (32 * ci + r32) * QT_S + kk * 32 + hi * 16);
                    const bf16x8 bfr = *(const bf16x8*)(lds + OFF_KT + (32 * si + r32) * QT_S + kk * 32 + hi * 16);
                    aacc = __builtin_amdgcn_mfma_f32_32x32x16_bf16(af, bfr, aacc, 0, 0, 0); }
#pragma unroll
                for (int i = 0; i < 16; ++i) { const int c = 32 * ci + crow(i, hi), s = 32 * si + r32; const float v = (c >= s) ? aacc[i] : 0.f;
                    *(bf16_t*)(lds + OFF_ATT + c * KD_S + s * 2) = f2bf_n(v); }
            } else {
#pragma unroll
                for (int i = 0; i < 16; ++i) { const int c = crow(i, hi), s = 32 + r32; *(bf16_t*)(lds + OFF_ATT + c * KD_S + s * 2) = (bf16_t)0; }
            }
        } else {
#pragma unroll
            for (int e = 0; e < 4; ++e) { const int f = 4 * (wid - 4) + e;
                { const int ci = f >> 3, kk = f & 7; const bf16x8 fr = *(const bf16x8*)(lds + OFF_QB + (32 * ci + r32) * QT_S + kk * 32 + hi * 16);
                  *(bf16x8*)(base + (size_t)(4 * f) * N1 + qcol + lrow) = fr; }
                { const int kt = f >> 2, kk = f & 3; const bf16x8 fr = *(const bf16x8*)(lds + OFF_KD + (32 * kt + r32) * KD_S + kk * 32 + hi * 16);
                  *(bf16x8*)(base + (size_t)(4 * f) * N1 + gcol + lrow) = fr; }
                { const int vs = f >> 2, kk = f & 3; const bf16x8 fr = *(const bf16x8*)(lds + OFF_VT4 + (32 * vs + r32) * KD_S + kk * 32 + hi * 16);
                  *(bf16x8*)(base + (size_t)(4 * f) * N1 + vcol + lrow) = fr; } }
        }
        LBAR();
        { const int f = wid, ci = f >> 2, kk = f & 3; const bf16x8 fr = *(const bf16x8*)(lds + OFF_ATT + (32 * ci + r32) * KD_S + kk * 32 + hi * 16);
          *(bf16x8*)(attbuf + ((size_t)item * 8 + f) * 1024 + lane * 16) = fr; }
        if (tid < 32) *(f32x4*)(decbuf + (size_t)item * 128 + tid * 4) = *(const f32x4*)(decay + tid * 4);
    }
#undef PRE_LOAD
    LBAR();
}

__device__ __forceinline__ void seqpass(char* lds, const bf16_t* __restrict__ proj1, const char* __restrict__ attbuf, const float* __restrict__ decbuf, bf16_t* __restrict__ oraw) {
    int tid = threadIdx.x; asm volatile("" : "+v"(tid));
    const int wid = __builtin_amdgcn_readfirstlane(tid >> 6), lane = tid & 63, r32 = lane & 31, hi = lane >> 5;
    constexpr int OFF_AV = 2 * ST_BYTES;
#ifndef PROBE_SEQDUP
#define PROBE_SEQDUP 0
#endif
    for (int it2 = blockIdx.x; it2 < (1 + PROBE_SEQDUP) * 256; it2 += gridDim.x) {
        const int w_ = it2 & 255;
        const int bh = (w_ & 7) * 8 + (w_ >> 5), vs = (w_ >> 3) & 3, item = bh * 4 + vs, b = bh >> 5, h = bh & 31;
        const char* base0 = (const char*)(proj1 + (size_t)b * SEQ * N1);
        const unsigned lrow = (unsigned)(((lane >> 4) * N1 + (lane & 15) * 8) * 2);
        constexpr size_t CHB = (size_t)64 * N1 * 2, FRB = (size_t)4 * N1 * 2;
        for (int i = tid; i < 2 * ST_BYTES / 4; i += 512) ((unsigned*)lds)[i] = 0u;
        if (wid < 4) {
            f32x16 sacc = {};
            const char* gb = base0 + (size_t)(4096 + h * 128) * 2 + (size_t)(wid * 4) * FRB;
            const char* vb = base0 + (size_t)(8192 + h * 128) * 2 + (size_t)(vs * 4) * FRB;
            const float* db = decbuf + (size_t)bh * 128 * 128 + 32 * wid + 4 * hi;
            bf16x8 K0[4], V0[4], K1[4], V1[4], K2[4], V2[4]; f32x4 D0[4], D1[4], D2[4];
#define ST_LOAD(K_, V_, d_, ch_) do { _Pragma("unroll") for (int kk = 0; kk < 4; ++kk) { K_[kk] = *(const bf16x8*)(gb + (size_t)(ch_) * CHB + kk * FRB + lrow);  \
                                                                                         V_[kk] = *(const bf16x8*)(vb + (size_t)(ch_) * CHB + kk * FRB + lrow);  \
                                                                                         d_[kk] = *(const f32x4*)(db + (size_t)(ch_) * 128 + 8 * kk); } } while (0)
#define ST_STEP(c_, K_, V_, d_, LK_, LV_, Ld_) do { if ((c_) + 2 < 128) ST_LOAD(LK_, LV_, Ld_, (c_) + 2);                                                      \
                char* st_nxt = lds + (((c_) + 1) & 1) * ST_BYTES;                                                                                                \
                _Pragma("unroll") for (int g4 = 0; g4 < 4; ++g4) _Pragma("unroll") for (int j = 0; j < 4; ++j) sacc[g4 * 4 + j] *= d_[g4][j];                    \
                _Pragma("unroll") for (int kk = 0; kk < 4; ++kk) sacc = __builtin_amdgcn_mfma_f32_32x32x16_bf16(K_[kk], V_[kk], sacc, 0, 0, 0);                  \
                _Pragma("unroll") for (int g4 = 0; g4 < 4; ++g4) { u32x2 w; w.x = cvtpk_n(sacc[g4 * 4 + 0], sacc[g4 * 4 + 1]); w.y = cvtpk_n(sacc[g4 * 4 + 2], sacc[g4 * 4 + 3]); \
                    *(u32x2*)(st_nxt + r32 * QT_S + (32 * wid + 8 * g4 + 4 * hi) * 2) = w; }                                                                    \
                LBAR(); } while (0)
            ST_LOAD(K0, V0, D0, 0); ST_LOAD(K1, V1, D1, 1);
            LBAR();
            for (int ch = 0; ch < 126; ch += 3) { ST_STEP(ch, K0, V0, D0, K2, V2, D2); ST_STEP(ch + 1, K1, V1, D1, K0, V0, D0); ST_STEP(ch + 2, K2, V2, D2, K1, V1, D1); }
            ST_STEP(126, K0, V0, D0, K2, V2, D2); ST_STEP(127, K1, V1, D1, K0, V0, D0);
#undef ST_STEP
#undef ST_LOAD
        } else if (wid < 6) {
            const int ci = wid - 4;
            const char* qb = base0 + (size_t)(h * 128) * 2 + (size_t)(ci * 8) * FRB;
            char* ob = (char*)(oraw + (size_t)item * SEQ * 32) + (size_t)(32 * ci) * 64;
            const unsigned ooff = (unsigned)((4 * hi * 32 + r32) * 2);
            char* ot = lds + OFF_AV + 16384 + ci * 2048;
            bf16x8 Q0[8], Q1[8], Q2[8];
#define O_LOAD(Q_, ch_) do { _Pragma("unroll") for (int kk = 0; kk < 8; ++kk) Q_[kk] = *(const bf16x8*)(qb + (size_t)(ch_) * CHB + kk * FRB + lrow); } while (0)
#define O_STEP(c_, Q_, LQ_) do { if ((c_) + 2 < 128) O_LOAD(LQ_, (c_) + 2);                                                                                      \
                const char* st_cur = lds + ((c_) & 1) * ST_BYTES; const char* av = lds + OFF_AV + ((((c_) & 1) * 2 + ci) * 4) * 1024 + lane * 16;               \
                f32x16 oacc;                                                                                                                                     \
                _Pragma("unroll") for (int q = 0; q < 4; ++q) { const f32x4 t4 = *(const f32x4*)(av + q * 1024); oacc[q * 4 + 0] = t4[0]; oacc[q * 4 + 1] = t4[1]; oacc[q * 4 + 2] = t4[2]; oacc[q * 4 + 3] = t4[3]; } \
                _Pragma("unroll") for (int kk = 0; kk < 8; ++kk) { const bf16x8 sf = *(const bf16x8*)(st_cur + r32 * QT_S + kk * 32 + hi * 16);                  \
                    oacc = __builtin_amdgcn_mfma_f32_32x32x16_bf16(Q_[kk], sf, oacc, 0, 0, 0); }                                                                \
                char* oc = ob + (size_t)(c_) * (64 * 64);                                                                                                        \
                _Pragma("unroll") for (int i = 0; i < 16; ++i) *(bf16_t*)(ot + ((i & 3) + 8 * (i >> 2)) * 64 + ooff) = f2bf_n(oacc[i]);     \
                asm volatile("s_waitcnt lgkmcnt(0)" ::: "memory");                                                                                               \
                { const bf16x8 w0 = *(const bf16x8*)(ot + lane * 16), w1 = *(const bf16x8*)(ot + 1024 + lane * 16);                                              \
                  *(bf16x8*)(oc + lane * 16) = w0; *(bf16x8*)(oc + 1024 + lane * 16) = w1; }                    \
                LBAR(); } while (0)
            O_LOAD(Q0, 0); O_LOAD(Q1, 1);
            LBAR();
            for (int ch = 0; ch < 126; ch += 3) { O_STEP(ch, Q0, Q2); O_STEP(ch + 1, Q1, Q0); O_STEP(ch + 2, Q2, Q1); }
            O_STEP(126, Q0, Q2); O_STEP(127, Q1, Q0);
#undef O_STEP
#undef O_LOAD
        } else {
            const int ci = wid - 6;
            const char* vb = base0 + (size_t)(8192 + h * 128) * 2 + (size_t)(vs * 4) * FRB;
            const char* ab = attbuf + ((size_t)bh * 128 * 8 + ci * 4) * 1024 + lane * 16;
            bf16x8 A0[4], V0[4], A1[4], V1[4], A2[4], V2[4];
#define AV_LOAD(A_, V_, ch_) do { _Pragma("unroll") for (int kk = 0; kk < 4; ++kk) { A_[kk] = *(const bf16x8*)(ab + (size_t)(ch_) * 8192 + kk * 1024);          \
                                                                                     V_[kk] = *(const bf16x8*)(vb + (size_t)(ch_) * CHB + kk * FRB + lrow); } } while (0)
#define AV_DO(A_, V_, slot_) do { f32x16 acc_ = {}; _Pragma("unroll") for (int kk = 0; kk < 4; ++kk) acc_ = __builtin_amdgcn_mfma_f32_32x32x16_bf16(A_[kk], V_[kk], acc_, 0, 0, 0); \
        char* av_ = lds + OFF_AV + ((((slot_) & 1) * 2 + ci) * 4) * 1024 + lane * 16;                                                                                   \
        _Pragma("unroll") for (int q = 0; q < 4; ++q) *(f32x4*)(av_ + q * 1024) = (f32x4){acc_[q * 4 + 0], acc_[q * 4 + 1], acc_[q * 4 + 2], acc_[q * 4 + 3]}; } while (0)
            AV_LOAD(A0, V0, 0); AV_LOAD(A1, V1, 1); AV_LOAD(A2, V2, 2);
            AV_DO(A0, V0, 0);
            LBAR();
#define AV_STEP(c_, A_, V_, LA_, LV_) do { if ((c_) + 3 < 128) AV_LOAD(LA_, LV_, (c_) + 3); if ((c_) + 1 < 128) AV_DO(A_, V_, (c_) + 1); LBAR(); } while (0)
            for (int ch = 0; ch < 126; ch += 3) { AV_STEP(ch, A1, V1, A0, V0); AV_STEP(ch + 1, A2, V2, A1, V1); AV_STEP(ch + 2, A0, V0, A2, V2); }
            AV_STEP(126, A1, V1, A0, V0); AV_STEP(127, A2, V2, A1, V1);
#undef AV_STEP
#undef AV_LOAD
#undef AV_DO
        }
    }
}
#undef LBAR
}
constexpr int LDS_MAIN = pg8::STAGE_BYTES;
constexpr int LDS_TOTAL = LDS_MAIN + 16;
constexpr size_t WS_BAR = WS_END;
static_assert(att::LDS_BYTES <= LDS_MAIN && hg::LDS_BYTES <= LDS_MAIN && hg2::LDS_BYTES <= LDS_MAIN, "lds");
static_assert((size_t)8192 * 8192 + (size_t)8192 * 512 <= WS_W1O, "attbuf/decbuf must fit in the dead weight region");

#ifndef PHMASK
#define PHMASK 0xFFFF
#endif
#define EN(n) (((PHMASK) >> (n)) & 1)
#ifndef SKIP_SEQ
#define SKIP_SEQ 0
#endif
#ifndef SKIP_PRE
#define SKIP_PRE 0
#endif
#ifndef PROBE_DUP7
#define PROBE_DUP7 0
#endif

__global__ void __launch_bounds__(512) mla_hgrn2_fwd(Params p) {
    extern __shared__ __attribute__((aligned(16))) unsigned char lds[];
    cg::grid_group grid = cg::this_grid();
    unsigned char* ws = p.ws;
    bf16_t* W0IN = (bf16_t*)(ws + WS_W0IN); bf16_t* WUQ = (bf16_t*)(ws + WS_WUQ); bf16_t* WUKV = (bf16_t*)(ws + WS_WUKV);
    bf16_t* W0O = (bf16_t*)(ws + WS_W0O); bf16_t* W1IN = (bf16_t*)(ws + WS_W1IN); bf16_t* W1O = (bf16_t*)(ws + WS_W1O);
    float* RSTD0 = (float*)(ws + WS_RSTD0); float* RSTDQ = (float*)(ws + WS_RSTDQ); float* RSTDKV = (float*)(ws + WS_RSTDKV); float* RSTD1 = (float*)(ws + WS_RSTD1);
    float* LB = (float*)(ws + WS_LB); float* COS = (float*)(ws + WS_COS); float* SIN = (float*)(ws + WS_SIN);
    bf16_t* KROT = (bf16_t*)(ws + WS_KROT); bf16_t* ACTA = (bf16_t*)(ws + WS_ACTA);
    bf16_t* PROJ0 = (bf16_t*)(ws + WS_PROJ0); bf16_t* QBUF = (bf16_t*)(ws + WS_Q); bf16_t* PROJ1 = (bf16_t*)(ws + WS_PROJ1);
    bf16_t* X1B = (bf16_t*)p.out;
    bf16_t* KVBUF = (bf16_t*)p.out;
    LAS unsigned char* ldsl = (LAS unsigned char*)lds;
    const int G = gridDim.x, c = blockIdx.x;
    volatile LAS unsigned* bst = (volatile LAS unsigned*)(ldsl + LDS_MAIN);
    if (threadIdx.x == 0) { bst[0] = 0u; bst[1] = 0u; bst[2] = 0u; bst[3] = 0u; }
    __syncthreads();
    const XcdBarrier xbar = xcd_barrier_post((unsigned*)(ws + WS_BAR), bst);
#define GRID_BAR() xcd_barrier(xbar)

    if (EN(0))
    {
        char* tile = (char*)lds;
        wt_phase(p.l0_w_in, 4096, N0, p.l0_norm, W0IN, tile);
        wt_phase(p.l0_w_uq, 1024, NQ, p.l0_q_norm, WUQ, tile);
        wt_phase(p.l0_w_ukv, 512, NKV, p.l0_kv_norm, WUKV, tile);
        wt_phase(p.l0_w_o, 4096, 4096, nullptr, W0O, tile);
        wt_phase(p.l1_w_in, 4096, N1, p.l1_norm, W1IN, tile);
        wt_phase(p.l1_w_o, 4096, 4096, nullptr, W1O, tile);
        { u32x4 z = {0u, 0u, 0u, 0u}; u32x4* pad = (u32x4*)(W0IN + (size_t)N0 * 4096); const int n16 = (N0P - N0) * 4096 * 2 / 16;
          for (int i = c * 512 + threadIdx.x; i < n16; i += G * 512) pad[i] = z; }
        cast_rstd_phase(p.x, ACTA, RSTD0);
        tables_phase(p, COS, SIN, LB);
        for (int i = c * 512 + threadIdx.x; i < T_TOK; i += G * 512) RSTD1[i] = 0.f;
    }
#ifdef PROBE_P02
    {
        char* tile = (char*)lds;
        wt_phase(p.l0_w_in, 4096, N0, p.l0_norm, W0IN, tile);
        wt_phase(p.l0_w_uq, 1024, NQ, p.l0_q_norm, WUQ, tile);
        wt_phase(p.l0_w_ukv, 512, NKV, p.l0_kv_norm, WUKV, tile);
        wt_phase(p.l0_w_o, 4096, 4096, nullptr, W0O, tile);
        wt_phase(p.l1_w_in, 4096, N1, p.l1_norm, W1IN, tile);
        wt_phase(p.l1_w_o, 4096, 4096, nullptr, W1O, tile);
    }
#endif
    if (p.ws == nullptr) grid.sync();
    GRID_BAR();
    if (EN(1)) {
        pg8::Gemm g{ACTA, W0IN, T_TOK, N0P, 4096, 4096}; pg8::StaticOrder S; S.init(T_TOK, N0P, G, c);
        pg8::EpiBf16<1> E{PROJ0, N0P, RSTD0, 1600, nullptr};
        pg8::gemm_phase(ldsl, g, S, E);
    }
    GRID_BAR();
    if (EN(2)) stats_krot_phase(PROJ0, RSTDQ, RSTDKV, COS, SIN, KROT);
    GRID_BAR();
    if (EN(3)) {
        pg8::Gemm g{PROJ0, WUQ, T_TOK, NQ, 1024, N0P}; pg8::StaticOrder S; S.init(T_TOK, NQ, G, c);
        pg8::EpiBf16<0> E{QBUF, NQ, RSTDQ, 0, nullptr};
        pg8::gemm_phase(ldsl, g, S, E);
    }
    if (EN(3)) {
        pg8::Gemm g{PROJ0 + 1024, WUKV, T_TOK, NKV, 512, N0P}; pg8::StaticOrder S; S.init(T_TOK, NKV, G, c);
        pg8::EpiBf16<0> E{KVBUF, NKV, RSTDKV, 0, nullptr};
        pg8::gemm_phase(ldsl, g, S, E);
    }
    GRID_BAR();
    if (EN(4)) {
        att::Tensors T{QBUF, KVBUF, KROT, ACTA, PROJ0, COS, SIN};
        att::attn_phase((char*)lds, T);
    }
    GRID_BAR();
    if (EN(5)) {
        for (int i = c * 512 + threadIdx.x; i < T_TOK; i += G * 512) RSTDQ[i] = 0.f;
        pg8::Gemm g{ACTA, W0O, T_TOK, 4096, 4096, 4096}; pg8::StaticOrder S; S.init(T_TOK, 4096, G, c);
        pg8::EpiResBf16Stat E{p.x, X1B, 4096, RSTD1};
        pg8::gemm_phase(ldsl, g, S, E);
    }
    GRID_BAR();
    if (EN(7)) {
        pg8::Gemm g{X1B, W1IN, T_TOK, N1, 4096, 4096}; pg8::StaticOrder S; S.init(T_TOK, N1, G, c, PROBE_DUP7);
        pg8::EpiBf16<2> E{PROJ1, N1, RSTD1, 0, LB, 1};
        pg8::gemm_phase(ldsl, g, S, E);
    }
    GRID_BAR();
#ifdef HG_OLD
    if (EN(8)) hg::hgrn2_phase((char*)lds, PROJ1, ACTA);
#else
    if (EN(8) && !SKIP_PRE) hg2::prepass((char*)lds, PROJ1, (char*)(ws + WS_W0IN), (float*)(ws + WS_W0IN + (size_t)8192 * 8192));
    GRID_BAR();
    if (EN(8) && !SKIP_SEQ) hg2::seqpass((char*)lds, PROJ1, (const char*)(ws + WS_W0IN), (const float*)(ws + WS_W0IN + (size_t)8192 * 8192), ACTA);
#endif
#ifdef PROBE_HG2
    __syncthreads(); hg::hgrn2_phase((char*)lds, PROJ1, ACTA);
#endif
    GRID_BAR();
    if (EN(9)) headnorm_phase(PROJ1, ACTA, p.l1_g_norm);
    GRID_BAR();
    if (EN(10)) {
        pg8::Gemm g{PROJ1 + 8192, W1O, T_TOK, 4096, 4096, N1}; pg8::StaticOrder S; S.init(T_TOK, 4096, G, c);
        pg8::EpiBf16ResBf16Stat E{X1B, 4096, PROJ1, N1, RSTDQ};
        pg8::gemm_phase(ldsl, g, S, E);
    }
    GRID_BAR();
    if (EN(11)) final_norm_bf16_phase(PROJ1, (size_t)N1, RSTDQ, p.out, p.final_norm);
}

extern "C" void kernel_launch(void* const* d_in, const int* in_sizes, int n_in, void* d_out, int out_size, void* d_ws, size_t ws_size, hipStream_t stream) {
    static int grid = 0;
    if (grid == 0) {
        if (n_in != 15 || ws_size < WS_BAR + XCD_BAR_WORDS * sizeof(unsigned)) { fprintf(stderr, "kernel_launch: unexpected inputs (n_in %d, ws %zu, need %zu)\n", n_in, ws_size, (size_t)(WS_BAR + XCD_BAR_WORDS * sizeof(unsigned))); grid = -1; return; }
        int dev = 0, cus = 0, per_cu = 0;
        (void)hipGetDevice(&dev); (void)hipDeviceGetAttribute(&cus, hipDeviceAttributeMultiprocessorCount, dev);
        if (hipFuncSetAttribute((const void*)mla_hgrn2_fwd, hipFuncAttributeMaxDynamicSharedMemorySize, LDS_TOTAL) != hipSuccess) { fprintf(stderr, "kernel_launch: hipFuncSetAttribute failed\n"); grid = -1; return; }
        if (hipOccupancyMaxActiveBlocksPerMultiprocessor(&per_cu, (const void*)mla_hgrn2_fwd, 512, LDS_TOTAL) != hipSuccess || per_cu < 1) { fprintf(stderr, "kernel_launch: occupancy query gave %d\n", per_cu); per_cu = 1; }
        (void)hipGetLastError();
        if (cus <= 0) cus = 256;
        grid = cus * per_cu;
        fprintf(stderr, "kernel_launch: grid %d (cus %d x %d)\n", grid, cus, per_cu);
    }
    if (grid < 0) return;
    Params p{};
    p.x = (const float*)d_in[0]; p.pos = (const int*)d_in[1]; p.l0_norm = (const float*)d_in[2]; p.l0_w_in = (const float*)d_in[3]; p.l0_q_norm = (const float*)d_in[4];
    p.l0_w_uq = (const float*)d_in[5]; p.l0_kv_norm = (const float*)d_in[6]; p.l0_w_ukv = (const float*)d_in[7]; p.l0_w_o = (const float*)d_in[8]; p.l1_norm = (const float*)d_in[9];
    p.l1_w_in = (const float*)d_in[10]; p.l1_g_norm = (const float*)d_in[11]; p.l1_w_o = (const float*)d_in[12]; p.lower_bounds = (const float*)d_in[13]; p.final_norm = (const float*)d_in[14];
    p.out = (float*)d_out; p.ws = (unsigned char*)d_ws;
    for (int j = 0; j < 32; ++j) p.inv_freq[j] = (float)(1.0 / pow(10000.0, (double)(2 * j) / 64.0));
    if (hipMemsetAsync((char*)d_ws + WS_BAR, 0, XCD_BAR_WORDS * sizeof(unsigned), stream) != hipSuccess) { fprintf(stderr, "kernel_launch: memset of the barrier words failed\n"); return; }
    void* args[] = {&p};
    hipError_t e = hipLaunchCooperativeKernel((const void*)mla_hgrn2_fwd, dim3(grid), dim3(512), args, LDS_TOTAL, stream);
    if (e != hipSuccess) fprintf(stderr, "kernel_launch: cooperative launch failed: %s (grid %d)\n", hipGetErrorString(e), grid);
}
```
